# Optimizing an MI355X kernel written in HIP

```python
import math
import jax, jax.numpy as jnp
from jax import lax
import numpy as np

D_MODEL = 1024
BATCH = 4
SEQ = 8192
DEPTH = 1

GRID_W = 64
CTX_LEN = 256
EPS = 1e-6
ROPE_THETA = 10000.0
Q_BLOCK = 128

DIFF_HEADS = 4
DIFF_HEAD_DIM = 64
DIFF_V_DIM = 2 * DIFF_HEAD_DIM
DIFF_WIDTH = DIFF_HEADS * DIFF_V_DIM
DIFF_SCALE = DIFF_HEAD_DIM ** -0.5

MLA_HEADS = 4
MLA_NOPE = 128
MLA_ROPE = 64
MLA_V = 128
MLA_Q_RANK = 256
MLA_KV_RANK = 128
MLA_WIDTH = MLA_HEADS * MLA_V
MLA_SCALE = (MLA_NOPE + MLA_ROPE) ** -0.5

MIX_WIDTH = DIFF_WIDTH + MLA_WIDTH
ROPE_PAIRS = DIFF_HEAD_DIM // 4

IN_SPLITS = (DIFF_HEADS * 2 * DIFF_HEAD_DIM,
             DIFF_HEADS * 2 * DIFF_HEAD_DIM,
             DIFF_HEADS * DIFF_V_DIM,
             MLA_Q_RANK,
             MLA_KV_RANK,
             MLA_ROPE)
IN_COLS = sum(IN_SPLITS)

N_EXPERTS = 32
TOP_K = 4
D_FF = 1024
SWIGLU_LIMIT = 7.0
SWIGLU_ALPHA = 1.702
MOE_BLOCK = 128

kernel_name = "hybrid_diffattn_mla_moe_dit_layer"


def rmsnorm(x, w):
    xf = x.astype(jnp.float32)
    y = xf * lax.rsqrt(jnp.mean(xf * xf, axis=-1, keepdims=True) + EPS)
    return (y * w.astype(jnp.float32)).astype(x.dtype)


def modulate(h, shift, scale):
    return h * (1 + scale) + shift


def axial_angles(n):
    rows = n // GRID_W
    row = jnp.repeat(jnp.arange(rows, dtype=jnp.float32), GRID_W)
    col = jnp.tile(jnp.arange(GRID_W, dtype=jnp.float32), rows)
    inv = ROPE_THETA ** (-jnp.arange(ROPE_PAIRS, dtype=jnp.float32) / ROPE_PAIRS)
    return jnp.stack([row[:, None] * inv, col[:, None] * inv], axis=1)


def apply_axial_rope(x, ang):
    p = x.shape[-1] // 4
    xf = x.astype(jnp.float32).reshape(*x.shape[:-1], 2, 2, p)
    x1, x2 = xf[..., 0, :], xf[..., 1, :]
    cos, sin = jnp.cos(ang), jnp.sin(ang)
    out = jnp.stack([x1 * cos - x2 * sin, x2 * cos + x1 * sin], axis=-2)
    return out.reshape(x.shape).astype(x.dtype)


def mixer_inputs(h, w_in, q_norm_w, kv_norm_w, w_uq, w_ukv, ang):
    B, n, _ = h.shape
    proj = h @ w_in
    cuts = list(np.cumsum(IN_SPLITS)[:-1])
    dq, dk, dv, cq, ckv, kr = jnp.split(proj, cuts, axis=-1)
    dq = dq.reshape(B, n, DIFF_HEADS, 2, DIFF_HEAD_DIM)
    dk = dk.reshape(B, n, DIFF_HEADS, 2, DIFF_HEAD_DIM)
    dv = dv.reshape(B, n, DIFF_HEADS, DIFF_V_DIM)
    q = (rmsnorm(cq, q_norm_w) @ w_uq).reshape(B, n, MLA_HEADS, MLA_NOPE + MLA_ROPE)
    kv = (rmsnorm(ckv, kv_norm_w) @ w_ukv).reshape(B, n, MLA_HEADS, MLA_NOPE + MLA_V)
    q_nope, q_rope = q[..., :MLA_NOPE], q[..., MLA_NOPE:]
    k_nope, mv = kv[..., :MLA_NOPE], kv[..., MLA_NOPE:]
    if ang is not None:
        dq = apply_axial_rope(dq, ang[:, None, None])
        dk = apply_axial_rope(dk, ang[:, None, None])
        q_rope = apply_axial_rope(q_rope, ang[:, None])
        kr = apply_axial_rope(kr, ang)
    return (dq, dk, dv, q_nope, q_rope, k_nope, kr, mv)


def diff_attend(q, k, v, lam):
    s = jnp.einsum('bqhcd,bkhcd->bchqk', q, k).astype(jnp.float32) * DIFF_SCALE
    p = jax.nn.softmax(s, axis=-1)
    p = p[:, 0] - lam * p[:, 1]
    return jnp.einsum('bhqk,bkhe->bqhe', p.astype(v.dtype), v)


def mla_attend(q_nope, q_rope, k_nope, k_rope, v):
    s = (jnp.einsum('bqhd,bkhd->bhqk', q_nope, k_nope)
         + jnp.einsum('bqhr,bkr->bhqk', q_rope, k_rope)).astype(jnp.float32) * MLA_SCALE
    p = jax.nn.softmax(s, axis=-1)
    return jnp.einsum('bhqk,bkhe->bqhe', p.astype(v.dtype), v)


def to_blocks(t):
    B, n = t.shape[:2]
    return jnp.moveaxis(t.reshape(B, n // Q_BLOCK, Q_BLOCK, *t.shape[2:]), 1, 0)


def from_blocks(t):
    t = jnp.moveaxis(t, 0, 1)
    return t.reshape(t.shape[0], -1, *t.shape[3:])


def merge_heads(o_diff, o_mla, subln_w, lam_init, w_out):
    B, n = o_diff.shape[:2]
    o_diff = rmsnorm(o_diff, subln_w) * (1.0 - lam_init)
    mix = jnp.concatenate([o_diff.reshape(B, n, DIFF_WIDTH), o_mla.reshape(B, n, MLA_WIDTH)], axis=-1)
    return mix @ w_out


def clamped_swiglu(g, u):
    g = jnp.minimum(g, SWIGLU_LIMIT)
    u = jnp.clip(u, -SWIGLU_LIMIT, SWIGLU_LIMIT)
    return g * jax.nn.sigmoid(SWIGLU_ALPHA * g) * (u + 1)


def moe(h, router_w, router_b, w1, b1, w2, b2):
    T, D = h.shape
    logits = (h @ router_w + router_b).astype(jnp.float32)
    top_v, top_i = lax.top_k(logits, TOP_K)
    gates = jax.nn.softmax(top_v, axis=-1).astype(h.dtype)
    flat_e = top_i.reshape(-1)
    flat_tok = jnp.repeat(jnp.arange(T, dtype=jnp.int32), TOP_K)
    order = jnp.argsort(flat_e)
    e_sorted = flat_e[order]
    tok_sorted = flat_tok[order]
    gate_sorted = gates.reshape(-1)[order]
    counts = jnp.bincount(flat_e, length=N_EXPERTS)
    padded = ((counts + MOE_BLOCK - 1) // MOE_BLOCK) * MOE_BLOCK
    ends = jnp.cumsum(padded)
    pad_start = ends - padded
    grp_start = jnp.cumsum(counts) - counts
    n_assign = T * TOP_K
    rank = jnp.arange(n_assign, dtype=jnp.int32) - grp_start[e_sorted]
    dest = pad_start[e_sorted] + rank
    n_blocks = (n_assign + N_EXPERTS * (MOE_BLOCK - 1) + MOE_BLOCK - 1) // MOE_BLOCK
    row_tok = jnp.full((n_blocks * MOE_BLOCK,), T, jnp.int32).at[dest].set(tok_sorted)
    h_pad = jnp.concatenate([h, jnp.zeros((1, D), h.dtype)], axis=0)
    xs = h_pad[row_tok].reshape(n_blocks, MOE_BLOCK, D)
    blk_e = jnp.minimum(jnp.searchsorted(ends, jnp.arange(n_blocks) * MOE_BLOCK, side='right'),
                        N_EXPERTS - 1)

    def expert_block(args):
        xb, e = args
        hid = xb @ w1[e] + b1[e]
        return clamped_swiglu(hid[:, :D_FF], hid[:, D_FF:]) @ w2[e] + b2[e]

    ys = lax.map(expert_block, (xs, blk_e)).reshape(-1, D)
    contrib = ys[dest] * gate_sorted[:, None]
    return jax.ops.segment_sum(contrib, tok_sorted, num_segments=T)


def setup_inputs(seed: int = 0) -> dict:
    key = jax.random.key(seed)
    ks = jax.random.split(key, 32)
    f32 = jnp.float32
    L = DEPTH

    def nrm(k, shape, scale):
        return jax.random.normal(k, shape, f32) * scale

    def gain(k, shape):
        return 1.0 + 0.05 * jax.random.normal(k, shape, f32)

    return {
        'x': nrm(ks[0], (BATCH, SEQ, D_MODEL), 1.0),
        'c': nrm(ks[1], (BATCH, D_MODEL), 1.0),
        'ctx': nrm(ks[2], (BATCH, CTX_LEN, D_MODEL), 1.0),
        'c_ctx': nrm(ks[3], (D_MODEL,), 1.0),
        'w_ada': nrm(ks[4], (L, D_MODEL, 6 * D_MODEL), 0.5 * D_MODEL ** -0.5),
        'b_ada': nrm(ks[5], (L, 6 * D_MODEL), 0.02),
        'attn_norm_w': gain(ks[6], (L, D_MODEL)),
        'w_in': nrm(ks[7], (L, D_MODEL, IN_COLS), D_MODEL ** -0.5),
        'q_norm_w': gain(ks[8], (L, MLA_Q_RANK)),
        'kv_norm_w': gain(ks[9], (L, MLA_KV_RANK)),
        'w_uq': nrm(ks[10], (L, MLA_Q_RANK, MLA_HEADS * (MLA_NOPE + MLA_ROPE)), MLA_Q_RANK ** -0.5),
        'w_ukv': nrm(ks[11], (L, MLA_KV_RANK, MLA_HEADS * (MLA_NOPE + MLA_V)), MLA_KV_RANK ** -0.5),
        'lambda_q1': nrm(ks[12], (L, DIFF_HEAD_DIM), 0.1),
        'lambda_k1': nrm(ks[13], (L, DIFF_HEAD_DIM), 0.1),
        'lambda_q2': nrm(ks[14], (L, DIFF_HEAD_DIM), 0.1),
        'lambda_k2': nrm(ks[15], (L, DIFF_HEAD_DIM), 0.1),
        'subln_w': gain(ks[16], (L, DIFF_V_DIM)),
        'w_out': nrm(ks[17], (L, MIX_WIDTH, D_MODEL), MIX_WIDTH ** -0.5),
        'ffn_norm_w': gain(ks[18], (L, D_MODEL)),
        'router_w': nrm(ks[19], (L, D_MODEL, N_EXPERTS), D_MODEL ** -0.5),
        'router_b': nrm(ks[20], (L, N_EXPERTS), 0.01),
        'w1': nrm(ks[21], (L, N_EXPERTS, D_MODEL, 2 * D_FF), D_MODEL ** -0.5),
        'b1': nrm(ks[22], (L, N_EXPERTS, 2 * D_FF), 0.02),
        'w2': nrm(ks[23], (L, N_EXPERTS, D_FF, D_MODEL), D_FF ** -0.5),
        'b2': nrm(ks[24], (L, N_EXPERTS, D_MODEL), 0.02),
        'final_norm_w': gain(ks[25], (D_MODEL,)),
    }


def reference(x, c, ctx, c_ctx, w_ada, b_ada, attn_norm_w, w_in, q_norm_w, kv_norm_w, w_uq, w_ukv,
              lambda_q1, lambda_k1, lambda_q2, lambda_k2, subln_w, w_out, ffn_norm_w,
              router_w, router_b, w1, b1, w2, b2, final_norm_w):
    B, n, D = x.shape
    ang = axial_angles(n)
    for l in range(DEPTH):
        last = l == DEPTH - 1
        lam_init = 0.8 - 0.6 * math.exp(-0.3 * l)
        mod_lat = (jax.nn.silu(c) @ w_ada[l] + b_ada[l])[:, None, :]
        mod_ctx = (jax.nn.silu(c_ctx) @ w_ada[l] + b_ada[l])[None, None, :]
        sa, sca, ga, sf, scf, gf = jnp.split(mod_lat, 6, axis=-1)
        csa, csca, cga, csf, cscf, cgf = jnp.split(mod_ctx, 6, axis=-1)
        lam = (jnp.exp(jnp.sum(lambda_q1[l].astype(jnp.float32) * lambda_k1[l].astype(jnp.float32)))
               - jnp.exp(jnp.sum(lambda_q2[l].astype(jnp.float32) * lambda_k2[l].astype(jnp.float32)))
               + lam_init)
        mp = (w_in[l], q_norm_w[l], kv_norm_w[l], w_uq[l], w_ukv[l])

        l_dq, l_dk, l_dv, l_qn, l_qr, l_kn, l_kr, l_v = mixer_inputs(
            modulate(rmsnorm(x, attn_norm_w[l]), sa, sca), *mp, ang)
        c_dq, c_dk, c_dv, c_qn, c_qr, c_kn, c_kr, c_v = mixer_inputs(
            modulate(rmsnorm(ctx, attn_norm_w[l]), csa, csca), *mp, None)
        dk_all = jnp.concatenate([c_dk, l_dk], axis=1)
        dv_all = jnp.concatenate([c_dv, l_dv], axis=1)
        kn_all = jnp.concatenate([c_kn, l_kn], axis=1)
        kr_all = jnp.concatenate([c_kr, l_kr], axis=1)
        v_all = jnp.concatenate([c_v, l_v], axis=1)
        o_diff = from_blocks(lax.map(lambda qb: diff_attend(qb, dk_all, dv_all, lam), to_blocks(l_dq)))
        o_mla = from_blocks(lax.map(lambda qs: mla_attend(qs[0], qs[1], kn_all, kr_all, v_all),
                                    (to_blocks(l_qn), to_blocks(l_qr))))
        x_new = x + ga * merge_heads(o_diff, o_mla, subln_w[l], lam_init, w_out[l])
        if not last:
            oc_diff = diff_attend(c_dq, c_dk, c_dv, lam)
            oc_mla = mla_attend(c_qn, c_qr, c_kn, c_kr, c_v)
            ctx = ctx + cga * merge_heads(oc_diff, oc_mla, subln_w[l], lam_init, w_out[l])
        x = x_new

        hf = modulate(rmsnorm(x, ffn_norm_w[l]), sf, scf)
        x = x + gf * moe(hf.reshape(B * n, D), router_w[l], router_b[l], w1[l], b1[l], w2[l], b2[l]).reshape(B, n, D)
        if not last:
            hc = modulate(rmsnorm(ctx, ffn_norm_w[l]), csf, cscf)
            ctx = ctx + cgf * moe(hc.reshape(-1, D), router_w[l], router_b[l], w1[l], b1[l], w2[l], b2[l]).reshape(ctx.shape)
    return rmsnorm(x, final_norm_w)
```

```cpp
#define MLA_NQR 2
#define STAGGER 0
#include <hip/hip_runtime.h>
#include <hip/hip_cooperative_groups.h>
#include <cstdio>
#include <cstdint>
namespace cg = cooperative_groups;

#ifndef DBG_STAGE
#define DBG_STAGE 0
#endif
#ifndef ATT_EXTRA
#define ATT_EXTRA 0
#define ATT_EXTRA_ROUND0 0
#endif
#ifndef ATT_X
#define ATT_X(cc) ((cc) & 7)
#define ATT_J(cc) ((cc) >> 3)
#endif
#ifndef ATT_FP8
#define ATT_FP8 1
#endif
#ifndef SIM_P2
#define SIM_P2 0
#endif
#ifndef SIM_P6
#define SIM_P6 0
#endif
#ifndef WCONV_IN_ATT
#define WCONV_IN_ATT 1
#endif
#ifndef P7A_VAR
#define P7A_VAR 0
#endif
#ifndef P10_NT
#define P10_NT 4
#endif
#ifndef YS_FP8
#define YS_FP8 1
#endif
constexpr float YS_SCALE = 16.f;
#ifndef STAGGER
#define STAGGER 1
#endif
#ifndef ATT_VAR
#define ATT_VAR 0
#endif
#ifndef LAST_PHASE
#define LAST_PHASE 99
#endif

constexpr int DM = 1024, NB = 4, SEQ = 8192, CTX = 256;
constexpr int T = NB * SEQ;
constexpr int RPB = CTX + SEQ;
constexpr int MALL = NB * RPB;
constexpr int NPROJ = 2048;
constexpr int NEXP = 32, TOPK = 4, DFF = 1024;
constexpr int RMAX = T * TOPK + NEXP * 256;
constexpr float EPS = 1e-6f;
constexpr int NTHREADS = 512, NWAVES = 8;
constexpr float WQ_SCALE = 64.f;
constexpr int LDS_BYTES = 163840;

typedef unsigned short bf16_t;
typedef float f32x4 __attribute__((ext_vector_type(4)));
typedef float f32x2 __attribute__((ext_vector_type(2)));
typedef unsigned u32x4 __attribute__((ext_vector_type(4)));
typedef unsigned u32x2 __attribute__((ext_vector_type(2)));
#define LAS __attribute__((address_space(3)))

constexpr size_t KiB = 1024, MiB = 1u << 20;
constexpr size_t WS_CNT  = 0;
constexpr size_t WS_BAR  = 16 * KiB;
constexpr size_t WS_BAR_BYTES = 16 * KiB;
constexpr size_t WS_MODS = 64 * KiB;
constexpr size_t WS_DUMMY = 192 * KiB;
constexpr size_t WS_ROPE = 256 * KiB;
constexpr size_t WS_RWF  = 320 * KiB;
constexpr size_t WS_RSQ  = 512 * KiB;
constexpr size_t WS_RSKV = 768 * KiB;
constexpr size_t WS_TOPI = 1 * MiB;
constexpr size_t WS_GATE = 1 * MiB + 512 * KiB;
constexpr size_t WS_RANK = 2 * MiB;
constexpr size_t WS_GSRT = 2 * MiB + 512 * KiB;
constexpr size_t WS_RSX  = 3 * MiB + 64 * KiB;
constexpr size_t WS_DEST = 3 * MiB + 256 * KiB;
constexpr size_t WS_WIN  = 4 * MiB;
constexpr size_t WS_WOUT = 8 * MiB;
constexpr size_t WS_WUQ  = 10 * MiB;
constexpr size_t WS_WUKV = 11 * MiB;
constexpr size_t WS_W1   = 12 * MiB;
constexpr size_t WS_W2   = 140 * MiB;
constexpr size_t WS_XN   = 204 * MiB;
constexpr size_t WS_XS   = 332 * MiB;
constexpr size_t WS_ACT  = 604 * MiB;
constexpr size_t WS_HF   = 876 * MiB;
constexpr size_t WS_RTOK = 940 * MiB;
constexpr size_t WS_END  = 941 * MiB;
constexpr size_t WS_HB   = 332 * MiB;
constexpr size_t WS_PJ   = 398 * MiB;
constexpr size_t WS_QM   = 530 * MiB;
constexpr size_t WS_KV   = 580 * MiB;
constexpr size_t WS_AO   = 646 * MiB;
constexpr size_t WS_MIX  = 745 * MiB;
constexpr size_t WS_Q8D  = 646 * MiB;
constexpr size_t WS_K8D  = 663 * MiB;
constexpr size_t WS_VT8D = 680 * MiB;
constexpr size_t WS_KR8  = 697 * MiB;
constexpr size_t WS_Q8M  = 332 * MiB;
constexpr size_t WS_K8M  = 357 * MiB;
constexpr size_t WS_VT8M = 374 * MiB;
static_assert(WS_MIX + (size_t)MALL * 1024 * 2 <= WS_HF && WS_XS + (size_t)RMAX * 2048 <= WS_ACT && WS_ACT + (size_t)RMAX * 2048 <= WS_HF, "ws map");

struct Params {
    const float* x; const float* c; const float* ctx; const float* c_ctx; const float* w_ada; const float* b_ada;
    const float* attn_norm_w; const float* w_in; const float* q_norm_w; const float* kv_norm_w; const float* w_uq; const float* w_ukv;
    const float* lq1; const float* lk1; const float* lq2; const float* lk2; const float* subln_w; const float* w_out;
    const float* ffn_norm_w; const float* router_w; const float* router_b; const float* w1; const float* b1; const float* w2; const float* b2;
    const float* final_norm_w;
    float* out; unsigned char* ws;
};

__device__ __forceinline__ int tid_opaque() { int t = threadIdx.x; asm volatile("" : "+v"(t)); return t; }
__device__ __forceinline__ float wave_sum(float v) {
#pragma unroll
    for (int o = 1; o < 64; o <<= 1) v += __shfl_xor(v, o);
    return v;
}
__device__ __forceinline__ float wave_max(float v) {
#pragma unroll
    for (int o = 1; o < 64; o <<= 1) v = fmaxf(v, __shfl_xor(v, o));
    return v;
}
__device__ __forceinline__ float silu_f(float v) { return v / (1.f + __expf(-v)); }
__device__ __forceinline__ unsigned cvt_pk_bf16(float lo, float hi) { unsigned r; asm volatile("v_cvt_pk_bf16_f32 %0, %1, %2" : "=v"(r) : "v"(lo), "v"(hi)); return r; }
__device__ __forceinline__ unsigned cvt4_fp8o(int old, float a, float b, float c, float d) { int r = __builtin_amdgcn_cvt_pk_fp8_f32(a, b, old, false); r = __builtin_amdgcn_cvt_pk_fp8_f32(c, d, r, true); return (unsigned)r; }
__device__ __forceinline__ unsigned cvt4_fp8(float a, float b, float c, float d) { int r = __builtin_amdgcn_cvt_pk_fp8_f32(a, b, 0, false); r = __builtin_amdgcn_cvt_pk_fp8_f32(c, d, r, true); return (unsigned)r; }
__device__ __forceinline__ float q8(float x) { const int pk = __builtin_amdgcn_cvt_pk_fp8_f32(x, x, 0, false); return __builtin_amdgcn_cvt_f32_fp8(pk, 0); }
#ifdef SIM_FP8_ATT
#define Q8(x) q8(x)
#define PSHIFT 8.f
#else
#define Q8(x) (x)
#define PSHIFT 0.f
#endif
__device__ __forceinline__ unsigned char f2fp8(float x) { return (unsigned char)(__builtin_amdgcn_cvt_pk_fp8_f32(x, x, 0, false) & 0xff); }
__device__ __forceinline__ int vt_pos(int kk) { return ((kk >> 2) & 1) * 32 + (kk >> 5) * 16 + ((kk >> 3) & 3) * 4 + (kk & 3); }
__device__ __forceinline__ unsigned quad_tr_bytes(unsigned w, int j) {
    const unsigned t0 = (unsigned)__builtin_amdgcn_mov_dpp((int)w, 0x00, 0xf, 0xf, true), t1 = (unsigned)__builtin_amdgcn_mov_dpp((int)w, 0x55, 0xf, 0xf, true);
    const unsigned t2 = (unsigned)__builtin_amdgcn_mov_dpp((int)w, 0xaa, 0xf, 0xf, true), t3 = (unsigned)__builtin_amdgcn_mov_dpp((int)w, 0xff, 0xf, 0xf, true);
    const unsigned sel = 0x0c0c0000u | ((4u + (unsigned)j) << 8) | (unsigned)j;
    const unsigned a = __builtin_amdgcn_perm(t1, t0, sel), b = __builtin_amdgcn_perm(t3, t2, sel);
    return __builtin_amdgcn_perm(b, a, 0x05040100u);
}
__device__ __forceinline__ bf16_t f2bf(float f) { return (bf16_t)(cvt_pk_bf16(f, 0.f) & 0xffffu); }
__device__ __forceinline__ float bf2f(bf16_t v) { return __uint_as_float((unsigned)v << 16); }
__device__ __forceinline__ float bflo(unsigned w) { return __uint_as_float(w << 16); }
__device__ __forceinline__ float bfhi(unsigned w) { return __uint_as_float(w & 0xffff0000u); }
#define GAS __attribute__((address_space(1)))
#define RLX_AGENT __ATOMIC_RELAXED, __HIP_MEMORY_SCOPE_AGENT
#define XB_TMO      128
#define XB_XCNT(j)  (256  + 64 * (j))
#define XB_XSUB(j)  (1280 + 64 * (j))
#define XB_XGEN(j)  (2304 + 64 * (j))
#define XB_TOP      3328
#define XB_TOPGEN   3392
#define XCD_BAR_WORDS 3456
#define XB_SPIN_CAP (1u << 18)

__device__ __forceinline__ unsigned xb_ld(unsigned* p)              { return __hip_atomic_load(p, __ATOMIC_RELAXED, __HIP_MEMORY_SCOPE_AGENT); }
__device__ __forceinline__ unsigned xb_add(unsigned* p, unsigned v) { return __hip_atomic_fetch_add(p, v, __ATOMIC_RELAXED, __HIP_MEMORY_SCOPE_AGENT); }
__device__ __forceinline__ unsigned xb_xcc_id() { return (unsigned)__builtin_amdgcn_s_getreg((3 << 11) | 20) & 0xFu; }
#define XB_SPIN(cond, bar) do { unsigned _sp = 0; while (cond) { __builtin_amdgcn_s_sleep(1); \
    if ((++_sp & 255u) == 0u) { if (xb_ld(&(bar)[XB_TMO])) break; if (_sp > XB_SPIN_CAP) { atomicAdd(&(bar)[XB_TMO], 1u); break; } } } } while (0)

struct XcdBarrier {
    unsigned* bar; unsigned x;
    volatile LAS unsigned* st;
};

__device__ __forceinline__ XcdBarrier xcd_barrier_post(unsigned* bar, volatile LAS unsigned* st) {
    XcdBarrier b; b.bar = bar; b.x = xb_xcc_id(); b.st = st;
    if (threadIdx.x == 0) (void)xb_add(&bar[XB_XCNT(b.x)], 1u);
    return b;
}
__device__ __forceinline__ void xcd_barrier_complete(unsigned* bar, unsigned x, unsigned& nloc, unsigned& nx) {
    const unsigned G = gridDim.x * gridDim.y * gridDim.z;
    unsigned sum, cnt, mine, sp = 0u;
    for (;;) {
        sum = 0u; cnt = 0u; mine = 0u;
#pragma unroll
        for (unsigned j = 0; j < 16; ++j) { const unsigned c = xb_ld(&bar[XB_XCNT(j)]); sum += c; cnt += (c > 0u) ? 1u : 0u; mine = (j == x) ? c : mine; }
        if (sum == G) break;
        __builtin_amdgcn_s_sleep(1);
        if ((++sp & 255u) == 0u) { if (xb_ld(&bar[XB_TMO])) break; if (sp > XB_SPIN_CAP) { atomicAdd(&bar[XB_TMO], 1u); break; } }
    }
    nloc = mine > 0u ? mine : 1u; nx = cnt > 0u ? cnt : 1u;
}

__device__ __forceinline__ void xcd_barrier(const XcdBarrier& b) {
    asm volatile("s_waitcnt vmcnt(0)" ::: "memory");
    __syncthreads();
    if (threadIdx.x == 0) {
        unsigned* bar = b.bar;
        __builtin_amdgcn_s_waitcnt(0);
        unsigned nloc = b.st[0], nx = b.st[1];
        if (nloc == 0u) { xcd_barrier_complete(bar, b.x, nloc, nx); b.st[0] = nloc; b.st[1] = nx; }
        const unsigned old = xb_add(&bar[XB_XSUB(b.x)], 1u);
        const unsigned gen = old / nloc;
        if (old + 1u == (gen + 1u) * nloc) {
            __builtin_amdgcn_fence(__ATOMIC_RELEASE, "agent");
            asm volatile("s_waitcnt vmcnt(0)" ::: "memory");
            const unsigned og = xb_add(&bar[XB_TOP], 1u);
            const unsigned tg = og / nx;
            if (og + 1u == (tg + 1u) * nx) xb_add(&bar[XB_TOPGEN], 1u);
            else XB_SPIN(xb_ld(&bar[XB_TOPGEN]) == tg, bar);
            __builtin_amdgcn_fence(__ATOMIC_ACQUIRE, "agent");
            xb_add(&bar[XB_XGEN(b.x)], 1u);
            asm volatile("s_waitcnt vmcnt(0)" ::: "memory");
        } else {
            XB_SPIN(xb_ld(&bar[XB_XGEN(b.x)]) == gen, bar);
            __builtin_amdgcn_fence(__ATOMIC_ACQUIRE, "agent");
            asm volatile("s_waitcnt vmcnt(0)" ::: "memory");
        }
    }
    __syncthreads();
}

__device__ __forceinline__ void p0_mods(const Params& p, float* lds_f, int item) {
    const int tid = tid_opaque();
    float* sc = lds_f;
    float* red = lds_f + 5 * 1024;
    for (int i = tid; i < 5 * 1024; i += NTHREADS) { const int r = i >> 10, k = i & 1023; sc[i] = silu_f(r < 4 ? p.c[r * 1024 + k] : p.c_ctx[k]); }
    __syncthreads();
    const int col = tid & 31, kg = tid >> 5;
    const float* w = p.w_ada + (size_t)(kg * 64) * 6144 + item * 32 + col;
    float a0 = 0, a1 = 0, a2 = 0, a3 = 0, a4 = 0;
#pragma unroll 8
    for (int k = 0; k < 64; ++k) { const float wv = w[(size_t)k * 6144]; const int kk = kg * 64 + k;
        a0 += sc[kk] * wv; a1 += sc[1024 + kk] * wv; a2 += sc[2048 + kk] * wv; a3 += sc[3072 + kk] * wv; a4 += sc[4096 + kk] * wv; }
    red[(kg * 5 + 0) * 32 + col] = a0; red[(kg * 5 + 1) * 32 + col] = a1; red[(kg * 5 + 2) * 32 + col] = a2; red[(kg * 5 + 3) * 32 + col] = a3; red[(kg * 5 + 4) * 32 + col] = a4;
    __syncthreads();
    if (tid < 160) { const int r = tid >> 5, cc = tid & 31; float s = p.b_ada[item * 32 + cc];
        for (int g = 0; g < 16; ++g) s += red[(g * 5 + r) * 32 + cc];
        ((float*)(p.ws + WS_MODS))[r * 6144 + item * 32 + cc] = s; }
    __syncthreads();
}

template <int SIMQ = 0>
__device__ __forceinline__ void p0_tr_item(const float* W, int ldw, bf16_t* WT, int ldk, int k0, int n0, int drow0, const float* kscale, float* scr, int lane) {
    const int nq = (lane & 15) * 4, kr = lane >> 4;
#pragma unroll 4
    for (int i = 0; i < 16; ++i) { const int kk = 4 * i + kr;
        f32x4 v = *(const f32x4*)(W + (size_t)(k0 + kk) * ldw + n0 + nq);
        if (kscale) { const float s = kscale[k0 + kk]; v = v * s; }
        float* d = scr + kk * 65 + nq; d[0] = v.x; d[1] = v.y; d[2] = v.z; d[3] = v.w; }
    asm volatile("s_waitcnt lgkmcnt(0)" ::: "memory");
    const int c = lane & 7;
#pragma unroll
    for (int j = 0; j < 8; ++j) { const int n = (lane >> 3) + 8 * j; const float* s = scr + (8 * c) * 65 + n;
        float w_[8];
#pragma unroll
        for (int i = 0; i < 8; ++i) { w_[i] = s[i * 65]; if (SIMQ) w_[i] = q8(w_[i] * 64.f) * (1.f / 64.f); }
        u32x4 o; o.x = cvt_pk_bf16(w_[0], w_[1]); o.y = cvt_pk_bf16(w_[2], w_[3]); o.z = cvt_pk_bf16(w_[4], w_[5]); o.w = cvt_pk_bf16(w_[6], w_[7]);
        *(u32x4*)(WT + (size_t)(drow0 + n) * ldk + k0 + 8 * c) = o; }
    asm volatile("s_waitcnt lgkmcnt(0)" ::: "memory");
}

__device__ __forceinline__ void p0_tr_item_f8(const float* W, int ldw, unsigned char* WT, int ldk, int k0, int n0, int drow0, const float wscale, float* scr, int lane) {
    const int nq = (lane & 15) * 4, kr = lane >> 4;
#pragma unroll 4
    for (int i = 0; i < 16; ++i) { const int kk = 4 * i + kr;
        const f32x4 v = *(const f32x4*)(W + (size_t)(k0 + kk) * ldw + n0 + nq) * wscale;
        float* d = scr + kk * 65 + nq; d[0] = v.x; d[1] = v.y; d[2] = v.z; d[3] = v.w; }
    asm volatile("s_waitcnt lgkmcnt(0)" ::: "memory");
    const int c = lane & 3;
#pragma unroll
    for (int j = 0; j < 4; ++j) { const int n = (lane >> 2) + 16 * j; const float* s = scr + (16 * c) * 65 + n;
        u32x4 o; o.x = cvt4_fp8(s[0 * 65], s[1 * 65], s[2 * 65], s[3 * 65]); o.y = cvt4_fp8(s[4 * 65], s[5 * 65], s[6 * 65], s[7 * 65]);
        o.z = cvt4_fp8(s[8 * 65], s[9 * 65], s[10 * 65], s[11 * 65]); o.w = cvt4_fp8(s[12 * 65], s[13 * 65], s[14 * 65], s[15 * 65]);
        *(u32x4*)(WT + (size_t)(drow0 + n) * ldk + k0 + 16 * c) = o; }
    asm volatile("s_waitcnt lgkmcnt(0)" ::: "memory");
}

__device__ __forceinline__ void p0_prologue(const Params& p, unsigned char* lds) {
    const int tid = tid_opaque(), lane = tid & 63, wave = tid >> 6;
    unsigned char* ws = p.ws;
    if (blockIdx.x == 0 && tid < 128) ((unsigned*)(ws + WS_CNT))[tid] = 0u;
    if (blockIdx.x == gridDim.x - 1) {
        for (int i = tid; i < 128 * 16; i += NTHREADS) { const int pv = i >> 4, pp = i & 15;
            const float inv = exp2f(-(float)pp * (13.287712379549449f / 16.f));
            const float ang = (float)pv * inv; float sn, cs; sincosf(ang, &sn, &cs);
            ((f32x2*)(ws + WS_ROPE))[i] = (f32x2){cs, sn}; }
    }
    { const int gt = blockIdx.x * NTHREADS + tid;
      if (gt < 4096) { const int l = gt & 63, nb = (gt >> 6) & 1, s = gt >> 7; unsigned hi4[4], lo4[4];
#pragma unroll
        for (int j = 0; j < 4; ++j) { const float w0 = p.router_w[(32 * s + 8 * (l >> 4) + 2 * j) * 32 + 16 * nb + (l & 15)], w1 = p.router_w[(32 * s + 8 * (l >> 4) + 2 * j + 1) * 32 + 16 * nb + (l & 15)];
            const unsigned hw = cvt_pk_bf16(w0, w1); hi4[j] = hw; lo4[j] = cvt_pk_bf16(w0 - bflo(hw), w1 - bfhi(hw)); }
        u32x4* dst = (u32x4*)(ws + WS_RWF) + ((s * 2 + nb) * 2) * 64 + l;
        dst[0] = (u32x4){hi4[0], hi4[1], hi4[2], hi4[3]}; dst[64] = (u32x4){lo4[0], lo4[1], lo4[2], lo4[3]}; } }
    for (int it = blockIdx.x; it < 192; it += gridDim.x) p0_mods(p, (float*)lds, it);
    float* scr = (float*)lds + wave * (64 * 65);
    const int gw = blockIdx.x * NWAVES + wave, NGW = gridDim.x * NWAVES;
    constexpr int I_W1 = WCONV_IN_ATT ? 0 : 32 * 16 * 32, I_W2 = WCONV_IN_ATT ? 0 : 32 * 16 * 16, I_IN = 16 * 31, I_OUT = 16 * 16, I_UQ = 4 * 12, I_UKV = 2 * 16;
    constexpr int NITEMS = I_W1 + I_W2 + I_IN + I_OUT + I_UQ + I_UKV;
    for (int it = gw; it < NITEMS; it += NGW) {
        int r = it;
        if (r < I_W1) { const int e = r >> 9, q = r & 511, kb = q >> 5, nb = q & 31, n0 = nb * 64;
            const int drow = ((n0 & 1023) >> 7) * 256 + (n0 >> 10) * 128 + (n0 & 127);
            p0_tr_item_f8(p.w1 + (size_t)e * 1024 * 2048, 2048, ws + WS_W1 + (size_t)e * 2048 * 1024, 1024, kb * 64, n0, drow, WQ_SCALE, scr, lane); continue; } r -= I_W1;
        if (r < I_W2) { const int e = r >> 8, q = r & 255, kb = q >> 4, nb = q & 15;
            p0_tr_item_f8(p.w2 + (size_t)e * 1024 * 1024, 1024, ws + WS_W2 + (size_t)e * 1024 * 1024, 1024, kb * 64, nb * 64, nb * 64, WQ_SCALE, scr, lane); continue; } r -= I_W2;
        if (r < I_IN) { const int kb = r / 31, nb = r % 31;
            p0_tr_item<SIM_P2>(p.w_in, 1984, (bf16_t*)(ws + WS_WIN), 1024, kb * 64, nb * 64, nb * 64, nullptr, scr, lane); continue; } r -= I_IN;
        if (r < I_OUT) { const int kb = r >> 4, nb = r & 15;
            p0_tr_item<SIM_P6>(p.w_out, 1024, (bf16_t*)(ws + WS_WOUT), 1024, kb * 64, nb * 64, nb * 64, nullptr, scr, lane); continue; } r -= I_OUT;
        if (r < I_UQ) { const int kb = r / 12, nb = r % 12;
            p0_tr_item(p.w_uq, 768, (bf16_t*)(ws + WS_WUQ), 256, kb * 64, nb * 64, nb * 64, p.q_norm_w, scr, lane); continue; } r -= I_UQ;
        { const int kb = r >> 4, nb = r & 15;
            p0_tr_item(p.w_ukv, 1024, (bf16_t*)(ws + WS_WUKV), 256, kb * 64, nb * 64, nb * 64, p.kv_norm_w, scr, lane); }
    }
    { const int gt = blockIdx.x * NTHREADS + tid, NGT = gridDim.x * NTHREADS; const u32x4 z = {0u, 0u, 0u, 0u};
      for (int i = gt; i < 64 * 128; i += NGT) ((u32x4*)((bf16_t*)(ws + WS_WIN) + (size_t)1984 * 1024))[i] = z;
      for (int i = gt; i < 1024 * 16; i += NGT) { const int row = i >> 4, ch = i & 15; *(u32x4*)((bf16_t*)(ws + WS_WUKV) + (size_t)row * 256 + 128 + ch * 8) = z; } }
}

__device__ __forceinline__ void p1_rows(const Params& p) {
    const int tid = tid_opaque(), lane = tid & 63, wave = tid >> 6;
    const int gw = blockIdx.x * NWAVES + wave, NGW = gridDim.x * NWAVES;
    const float* mods = (const float*)(p.ws + WS_MODS);
    bf16_t* HB = (bf16_t*)(p.ws + WS_HB);
    { const int gt = blockIdx.x * NTHREADS + tid, NGT = gridDim.x * NTHREADS;
      for (int i = gt; i < MALL; i += NGT) { ((float*)(p.ws + WS_RSQ))[i] = 0.f; ((float*)(p.ws + WS_RSKV))[i] = 0.f; }
      for (int i = gt; i < RMAX; i += NGT) ((int*)(p.ws + WS_RTOK))[i] = 0;
      for (int i = gt; i < T; i += NGT) ((float*)(p.ws + WS_RSX))[i] = 0.f; }
    f32x4 av[4], sv[4]; int curb = -1;
    for (int m0 = __builtin_amdgcn_readfirstlane(gw); m0 < MALL; m0 += 2 * NGW) {
        int mm[2]; bool ok[2]; f32x4 v[2][4];
#pragma unroll
        for (int q = 0; q < 2; ++q) { const int m_ = m0 + q * NGW; ok[q] = m_ < MALL; mm[q] = ok[q] ? m_ : m0;
            const int b = mm[q] / RPB, i = mm[q] - b * RPB; const bool isctx = i < CTX;
            const float* src = isctx ? p.ctx + ((size_t)b * CTX + i) * DM : p.x + ((size_t)b * SEQ + (i - CTX)) * DM;
            const f32x4* xr = (const f32x4*)src + lane;
#pragma unroll
            for (int j = 0; j < 4; ++j) v[q][j] = xr[64 * j]; }
#pragma unroll
        for (int q = 0; q < 2; ++q) { const int m = mm[q], b = m / RPB, i = m - b * RPB; const int bsel = i < CTX ? 4 : b;
            if (bsel != curb) { curb = bsel; const float* md = mods + bsel * 6144;
#pragma unroll
                for (int j = 0; j < 4; ++j) { av[j] = ((const f32x4*)p.attn_norm_w)[lane + 64 * j] * (((const f32x4*)(md + 1024))[lane + 64 * j] + 1.f); sv[j] = ((const f32x4*)md)[lane + 64 * j]; } }
            float s = 0.f;
#pragma unroll
            for (int j = 0; j < 4; ++j) s += (v[q][j].x * v[q][j].x + v[q][j].y * v[q][j].y) + (v[q][j].z * v[q][j].z + v[q][j].w * v[q][j].w);
            const float r = rsqrtf(wave_sum(s) * (1.f / DM) + EPS);
            if (ok[q]) { u32x2* o = (u32x2*)(HB + (size_t)m * DM) + lane;
#pragma unroll
                for (int j = 0; j < 4; ++j) { const f32x4 h = v[q][j] * r * av[j] + sv[j];
                    f32x4 hq = h; if (SIM_P2) hq = (f32x4){q8(h.x), q8(h.y), q8(h.z), q8(h.w)};
                    u32x2 pk; pk.x = cvt_pk_bf16(hq.x, hq.y); pk.y = cvt_pk_bf16(hq.z, hq.w); o[64 * j] = pk; } }
        }
    }
}
namespace pg8 {
typedef short bf16x8 __attribute__((ext_vector_type(8)));
typedef int v4i32_t __attribute__((ext_vector_type(4)));
typedef int v8i32_t __attribute__((ext_vector_type(8)));
constexpr int BM = 256, BK = 64, HALF = 128, HTB = HALF * BK * 2  , STAGE_BYTES = 8 * HTB;
__host__ __device__ __forceinline__ int lds_byte(int r, int c) { const int st = (r >> 4) * 2 + (c >> 5), rr = r & 15, cc = c & 31, ob = rr * 64 + cc * 2; return st * 1024 + (ob ^ (((ob >> 9) & 1) << 5)); }
__host__ __device__ __forceinline__ void stage_rc(int b, int& R, int& C) { const int st = b / 1024, sb = b % 1024, swz = sb ^ (((sb >> 9) & 1) << 5); R = (st >> 1) * 16 + swz / 64; C = (st & 1) * 32 + (swz % 64) / 2; }

struct Unit { int am, bn, pm, pn, e; };
struct Gemm { const bf16_t* A; int lda; const bf16_t* Bt; int K; const int* rowtok; };

template <class Epi, class Sched, bool GATHER = false, bool FP8 = false, bool ALIGN_EPI = true>
__device__ __forceinline__ void gemm_phase(LAS unsigned char* lds, const Gemm g, const Sched& S, const Epi& E) {
    const int tid = tid_opaque(), wid = __builtin_amdgcn_readfirstlane(tid >> 6), lane = tid & 63, wr = wid >> 2, wc = wid & 3, fr = lane & 15, fq = lane >> 4;
    const int K = g.K, lda = g.lda; int nt = K / BK; asm volatile("" : "+s"(nt));
    unsigned voffA[2], voffB[2];
#pragma unroll
    for (int i = 0; i < 2; ++i) { int R, C; stage_rc(tid * 16 + i * 8192, R, C);
        voffA[i] = (unsigned)(R * lda + C) * 2u; voffB[i] = (unsigned)(R * K + C) * 2u; }
    unsigned vA0[2], vA1[2];
    LAS u32x4* gnx = (LAS u32x4*)(lds + STAGE_BYTES + 4096) + tid;
#define PG8_GOFF(AM, o00, o01, o10, o11) do { int t_ = tid; asm volatile("" : "+v"(t_)); int R0_, C0_, R1_, C1_; stage_rc(t_ * 16, R0_, C0_); stage_rc(t_ * 16 + 8192, R1_, C1_); \
        const int* rt_ = g.rowtok + (AM) * 256; const unsigned lb_ = (unsigned)(lda * 2); \
        o00 = (unsigned)rt_[R0_] * lb_ + (unsigned)(C0_ * 2); o01 = (unsigned)rt_[R1_] * lb_ + (unsigned)(C1_ * 2); o10 = (unsigned)rt_[128 + R0_] * lb_ + (unsigned)(C0_ * 2); o11 = (unsigned)rt_[128 + R1_] * lb_ + (unsigned)(C1_ * 2); } while (0)
#define PG8_STAGE_A(bufoff, soff, h, W0, W1) do { PG8_STAGE(bufoff, rA, soff, ((h) ? W1 : W0)); } while (0)
    const unsigned kstep = (unsigned)(BK * 2);
    const unsigned hstepA = (unsigned)(HALF * lda * 2), hstepB = (unsigned)(HALF * K * 2);
    const unsigned tstepA = 2 * hstepA, tstepB = 2 * hstepB;
    const __amdgpu_buffer_rsrc_t rA = __builtin_amdgcn_make_buffer_rsrc((void*)g.A, 0, 0xffffffff, 0x00020000), rB = __builtin_amdgcn_make_buffer_rsrc((void*)g.Bt, 0, 0xffffffff, 0x00020000);
    const unsigned ldsw = (unsigned)wid * 1024u;
    const int aoff = lds_byte(wr * 64 + fr, fq * 8), boff = lds_byte(wc * 32 + fr, fq * 8);
#define PG8_SA(b, h) (((b) * 2 + (h)) * HTB)
#define PG8_SB(b, h) ((4 + (b) * 2 + (h)) * HTB)
#define PG8_STAGE(bufoff, rs, soff, voff) do { _Pragma("unroll") for (int _i = 0; _i < 2; ++_i) \
        __builtin_amdgcn_raw_ptr_buffer_load_lds(rs, (LAS unsigned*)(lds + (bufoff) + ldsw + _i * 8192), 16, (int)(voff)[_i], (int)(soff), 0, 0); } while (0)
#define PG8_LDA(dst, b, h) do { _Pragma("unroll") for (int m = 0; m < 4; ++m) { const v4i32_t lo_ = *(const LAS v4i32_t*)(lds + PG8_SA(b, h) + aoff + m * 2048), hi_ = *(const LAS v4i32_t*)(lds + PG8_SA(b, h) + aoff + m * 2048 + 1024); \
        dst[m] = __builtin_shufflevector(lo_, hi_, 0, 1, 2, 3, 4, 5, 6, 7); } } while (0)
#define PG8_LDB(dst, b, h) do { _Pragma("unroll") for (int n = 0; n < 2; ++n) { const v4i32_t lo_ = *(const LAS v4i32_t*)(lds + PG8_SB(b, h) + boff + n * 2048), hi_ = *(const LAS v4i32_t*)(lds + PG8_SB(b, h) + boff + n * 2048 + 1024); \
        dst[n] = __builtin_shufflevector(lo_, hi_, 0, 1, 2, 3, 4, 5, 6, 7); } } while (0)
#define PG8_LO(x) __builtin_bit_cast(bf16x8, __builtin_shufflevector(x, x, 0, 1, 2, 3))
#define PG8_HI(x) __builtin_bit_cast(bf16x8, __builtin_shufflevector(x, x, 4, 5, 6, 7))
#define PG8_MMA(ai, bj, At, Bt) do { __builtin_amdgcn_s_setprio(1); _Pragma("unroll") for (int m = 0; m < 4; ++m) _Pragma("unroll") for (int n = 0; n < 2; ++n) { \
        if constexpr (FP8) acc[ai][bj][m][n] = __builtin_amdgcn_mfma_scale_f32_16x16x128_f8f6f4(Bt[n], At[m], acc[ai][bj][m][n], 0, 0, 0, 0, 0, 0)    ; \
        else { acc[ai][bj][m][n] = __builtin_amdgcn_mfma_f32_16x16x32_bf16(PG8_LO(Bt[n]), PG8_LO(At[m]), acc[ai][bj][m][n], 0, 0, 0); \
               acc[ai][bj][m][n] = __builtin_amdgcn_mfma_f32_16x16x32_bf16(PG8_HI(Bt[n]), PG8_HI(At[m]), acc[ai][bj][m][n], 0, 0, 0); } } __builtin_amdgcn_s_setprio(0); } while (0)
#define PG8_WAIT_V(n) asm volatile("s_waitcnt vmcnt(" #n ")" ::: "memory")
#define PG8_STR_(x) #x
#define PG8_XSTR_(x) PG8_STR_(x)
#define PG8_WAIT_V8X() do { if (relax) asm volatile("s_waitcnt vmcnt(%0)" :: "n"(8 + Epi::NST) : "memory"); else asm volatile("s_waitcnt vmcnt(8)" ::: "memory"); } while (0)
#define PG8_WAIT_L(n) asm volatile("s_waitcnt lgkmcnt(" #n ")" ::: "memory")
#define PG8_BAR __builtin_amdgcn_s_barrier()
#define PG8_SCHED __builtin_amdgcn_sched_barrier(0)
    Unit cur, nxt; int ui = 0;
    if (!S.next(0, cur)) return;
    f32x4 acc[2][2][4][2];
#pragma unroll
    for (int a = 0; a < 2; ++a)
#pragma unroll
        for (int b = 0; b < 2; ++b)
#pragma unroll
            for (int m = 0; m < 4; ++m)
#pragma unroll
                for (int n = 0; n < 2; ++n) acc[a][b][m][n] = (f32x4){0.f, 0.f, 0.f, 0.f};
    v8i32_t At[4], B0[2], B1[2];
    unsigned cA = GATHER ? 0u : (unsigned)cur.am * tstepA, cB = (unsigned)cur.bn * tstepB;
    if constexpr (GATHER) { PG8_GOFF(cur.am, vA0[0], vA0[1], vA1[0], vA1[1]); }
    else { vA0[0] = voffA[0]; vA0[1] = voffA[1]; vA1[0] = voffA[0] + hstepA; vA1[1] = voffA[1] + hstepA; }
    PG8_STAGE(PG8_SB(0, 0), rB, cB, voffB); PG8_STAGE(PG8_SB(0, 1), rB, cB + hstepB, voffB); PG8_STAGE_A(PG8_SA(0, 0), cA, 0, vA0, vA1); PG8_STAGE_A(PG8_SA(0, 1), cA, 1, vA0, vA1);
    if (wr == 1) PG8_BAR;
    PG8_WAIT_V(2); PG8_BAR;
    PG8_STAGE(PG8_SB(1, 0), rB, cB + kstep, voffB); PG8_STAGE_A(PG8_SA(1, 0), cA + kstep, 0, vA0, vA1); PG8_STAGE(PG8_SB(1, 1), rB, cB + hstepB + kstep, voffB);
    PG8_WAIT_V(6); PG8_BAR;
    for (;;) {
        const bool has_next = S.next(ui + 1, nxt);
        const unsigned nA = (has_next && !GATHER) ? (unsigned)nxt.am * tstepA : cA, nB = has_next ? (unsigned)nxt.bn * tstepB : cB;
        if constexpr (GATHER) { const int am_ = has_next ? nxt.am : cur.am; u32x4 nv_; PG8_GOFF(am_, nv_.x, nv_.y, nv_.z, nv_.w); *gnx = nv_; }
        for (int t = 0; t < nt; t += 2) {
            const bool last = (t == nt - 2); const bool relax = Epi::NST > 0 && t == 0 && ui > 0;
            const unsigned a1 = cA + (unsigned)(t + 1) * kstep;
            const unsigned a2 = last ? nA : cA + (unsigned)(t + 2) * kstep, b2 = last ? nB : cB + (unsigned)(t + 2) * kstep;
            const unsigned a3 = a2 + kstep, b3 = b2 + kstep;
            if constexpr (GATHER) { if (last) { const u32x4 nv_ = *gnx; vA0[0] = nv_.x; vA0[1] = nv_.y; }
            } else if constexpr (FP8) { if (last) asm volatile("s_nop 0"); }
            PG8_LDB(B0, 0, 0); PG8_LDB(B1, 0, 1); PG8_SCHED; PG8_LDA(At, 0, 0); PG8_STAGE_A(PG8_SA(1, 1), a1, 1, vA0, vA1);
            PG8_WAIT_V8X(); PG8_WAIT_L(0); PG8_BAR; PG8_MMA(0, 0, At, B0); PG8_MMA(0, 1, At, B1); PG8_BAR; PG8_SCHED;
            PG8_LDA(At, 0, 1); PG8_STAGE(PG8_SB(0, 0), rB, b2, voffB); PG8_STAGE(PG8_SB(0, 1), rB, b2 + hstepB, voffB); PG8_STAGE_A(PG8_SA(0, 0), a2, 0, vA0, vA1);
            if constexpr (GATHER) { if (last) { const u32x4 nv_ = *gnx; vA1[0] = nv_.z; vA1[1] = nv_.w; } }
            else if constexpr (FP8) { if (last) asm volatile("s_nop 0"); }
            PG8_WAIT_V8X(); PG8_WAIT_L(0); PG8_BAR; PG8_MMA(1, 0, At, B0); PG8_MMA(1, 1, At, B1); PG8_BAR; PG8_SCHED;
            PG8_LDB(B0, 1, 0); PG8_LDB(B1, 1, 1); PG8_SCHED; PG8_LDA(At, 1, 0); PG8_STAGE_A(PG8_SA(0, 1), a2, 1, vA0, vA1);
            PG8_WAIT_V(8); PG8_WAIT_L(0); PG8_BAR; PG8_MMA(0, 0, At, B0); PG8_MMA(0, 1, At, B1); PG8_BAR; PG8_SCHED;
            PG8_LDA(At, 1, 1); PG8_STAGE(PG8_SB(1, 0), rB, b3, voffB); PG8_STAGE(PG8_SB(1, 1), rB, b3 + hstepB, voffB); PG8_STAGE_A(PG8_SA(1, 0), a3, 0, vA0, vA1);
            PG8_WAIT_V(8); PG8_WAIT_L(0); PG8_BAR; PG8_MMA(1, 0, At, B0); PG8_MMA(1, 1, At, B1); PG8_BAR; PG8_SCHED;
        }
        if constexpr (ALIGN_EPI) { if (wr == 0) PG8_BAR; }
        PG8_SCHED;
        { int fr_ = fr, fq_ = fq; asm volatile("" : "+v"(fr_), "+v"(fq_));
          E(acc, cur, wr, wc, fr_, fq_); }
        if (!has_next) break;
#pragma unroll
        for (int a = 0; a < 2; ++a)
#pragma unroll
            for (int b = 0; b < 2; ++b)
#pragma unroll
                for (int m = 0; m < 4; ++m)
#pragma unroll
                    for (int n = 0; n < 2; ++n) acc[a][b][m][n] = (f32x4){0.f, 0.f, 0.f, 0.f};
        cur = nxt; cA = nA; cB = nB; ++ui;
        if constexpr (ALIGN_EPI) { if (wr == 1) PG8_BAR; }
    }
    PG8_WAIT_V(0);
    if constexpr (!ALIGN_EPI) { if (wr == 0) PG8_BAR; }
    PG8_BAR;
#undef PG8_SA
#undef PG8_SB
#undef PG8_STAGE
#undef PG8_STAGE_A
#undef PG8_GOFF
#undef PG8_LDA
#undef PG8_LDB
#undef PG8_MMA
#undef PG8_LO
#undef PG8_HI
#undef PG8_WAIT_V
#undef PG8_WAIT_V8X
#undef PG8_WAIT_L
#undef PG8_BAR
#undef PG8_SCHED
}
}
struct PlainOrder {
    int nM, nN, nwg, G, c, latent_only;
    __device__ void init(int nM_, int nN_, int G_, int c_, int latent_only_) { nM = nM_; nN = nN_; nwg = nM * nN; G = G_; c = c_; latent_only = latent_only_; }
    __device__ bool next(int i, pg8::Unit& u) const {
        const long L = (long)i * G + c; if (L >= nwg) return false;
        int wgid = (int)L; { const int q = nwg / 8, r = nwg % 8, xcd = wgid % 8, off = wgid / 8; wgid = (xcd < r ? xcd * (q + 1) : r * (q + 1) + (xcd - r) * q) + off; }
        const int WGM = 8, nig = WGM * nN, gid = wgid / nig, fm = gid * WGM, gsz = (nM - fm) < WGM ? (nM - fm) : WGM;
        const int pm = fm + ((wgid % nig) % gsz), pn = (wgid % nig) / gsz;
        u.pm = pm; u.pn = pn; u.e = 0; u.bn = pn;
        u.am = latent_only ? (pm >> 5) * 33 + 1 + (pm & 31) : pm;
        return true;
    }
};
struct ProjOrder {
    PlainOrder P; int G, c, part, split;
    __device__ void init(int G_, int c_, int part_) { G = G_; c = c_; part = part_; split = (G_ == 256); P.init(MALL / 256, 7, G_, c_, 0); }
    __device__ bool next(int i, pg8::Unit& u) const {
        int pm, pn;
        if (part == 0) { const long L = (long)i * G + c; if (L >= (split ? 1024 : 1056)) return false;
            if (L < 924) { if (!P.next(i, u)) return false; pm = u.pm; pn = u.pn + 1; } else { pm = (int)L - 924; pn = 0; } }
        else { if (!split || i > 0 || c >= 32) return false; pm = 100 + c; pn = 0; }
        u.pm = pm; u.pn = pn; u.e = 0; u.bn = pn; u.am = pm; return true;
    }
};
struct MoeOrder {
    const int* seg; int NT, ncol, G, c;
    __device__ bool next(int i, pg8::Unit& u) const {
        int rt, pn;
        if (G == 256) { const int x = c & 7, s = c >> 3;
            if (ncol == 8) { rt = i * 32 + x * 4 + (s >> 3); pn = s & 7; } else { rt = i * 64 + x * 8 + (s >> 2); pn = s & 3; } }
        else { const long L = (long)i * G + c; rt = (int)(L / ncol); pn = (int)(L % ncol); }
        if (rt >= NT) return false;
        const int r0 = rt * 256; int e = 0;
        while (e < 31 && r0 >= seg[e + 1]) ++e;
        u.am = rt; u.pm = rt; u.pn = pn; u.e = e; u.bn = e * ncol + pn; return true;
    }
};

typedef f32x4 AccT[2][2][4][2];
constexpr float QSCALE_DIFF = 0.125f * 1.4426950408889634f;
constexpr float QSCALE_MLA = 0.07216878364870322f * 1.4426950408889634f;
struct EpiProj {
    static constexpr int NST = 0;
    bf16_t* PJ; const f32x2* rope; float* rsq; float* rskv; unsigned char* ws;
    __device__ __forceinline__ void operator()(const AccT& acc, const pg8::Unit& u, int wr, int wc, int fr, int fq) const {
        const int pm = u.pm, pn = u.pn; const bool latent = (pm % 33) != 0;
        const int a = wc & 1;
#pragma unroll
        for (int ai = 0; ai < 2; ++ai)
#pragma unroll
            for (int m = 0; m < 4; ++m) {
                const int row = pm * 256 + ai * 128 + wr * 64 + m * 16 + fr;
                const int i = row % RPB, pos = i - CTX, pv = a ? (pos & 63) : (pos >> 6);
                float ss = 0.f;
#pragma unroll
                for (int bj = 0; bj < 2; ++bj) {
                    f32x4 v0 = acc[ai][bj][m][0], v1 = acc[ai][bj][m][1];
                    if (pn == 6 || (pn == 7 && bj == 0)) ss += (v0.x * v0.x + v0.y * v0.y) + (v0.z * v0.z + v0.w * v0.w) + (v1.x * v1.x + v1.y * v1.y) + (v1.z * v1.z + v1.w * v1.w);
                    if (pn < 2) { v0 = v0 * QSCALE_DIFF; v1 = v1 * QSCALE_DIFF; }
                    const bool rp = latent && (pn < 4 || (pn == 7 && bj == 1 && wc < 2));
                    if (rp) { const f32x4* t = (const f32x4*)(rope + pv * 16 + 4 * fq); const f32x4 t0 = t[0], t1 = t[1];
                        const f32x4 cs = {t0.x, t0.z, t1.x, t1.z}, sn = {t0.y, t0.w, t1.y, t1.w};
                        const f32x4 o0 = v0 * cs - v1 * sn, o1 = v1 * cs + v0 * sn; v0 = o0; v1 = o1; }
#ifdef SIM_FP8_ATT
                    if (pn < 6 || (pn == 7 && bj == 1 && wc < 2)) { v0 = (f32x4){q8(v0.x), q8(v0.y), q8(v0.z), q8(v0.w)}; v1 = (f32x4){q8(v1.x), q8(v1.y), q8(v1.z), q8(v1.w)}; }
#endif
#if ATT_FP8
                    const int cl = (pn & 1) * 256 + bj * 128 + wc * 32 + 4 * fq;
                    if (pn < 4) { unsigned char* d8 = ws + (pn < 2 ? WS_Q8D : WS_K8D) + (size_t)row * 512 + cl;
                        *(unsigned*)d8 = cvt4_fp8(v0.x, v0.y, v0.z, v0.w); *(unsigned*)(d8 + 16) = cvt4_fp8(v1.x, v1.y, v1.z, v1.w); }
                    else if (pn < 6) { const int b_ = row / RPB, i_ = row - b_ * RPB, hh = cl >> 7, e0 = cl & 127;
                        unsigned char* d8 = ws + WS_VT8D + ((size_t)(b_ * 4 + hh) * 128 + e0 + (fr & 3)) * RPB + (i_ & ~63) + vt_pos(i_ & 60);
                        *(unsigned*)d8 = quad_tr_bytes(cvt4_fp8(v0.x, v0.y, v0.z, v0.w), fr & 3); *(unsigned*)(d8 + 16 * RPB) = quad_tr_bytes(cvt4_fp8(v1.x, v1.y, v1.z, v1.w), fr & 3); }
                    else if (pn == 7 && bj == 1 && wc < 2) { unsigned char* d8 = ws + WS_KR8 + (size_t)row * 64 + wc * 32 + 4 * fq;
                        *(unsigned*)d8 = cvt4_fp8(v0.x, v0.y, v0.z, v0.w); *(unsigned*)(d8 + 16) = cvt4_fp8(v1.x, v1.y, v1.z, v1.w); }
                    if (pn >= 6)
#endif
                    { bf16_t* dst = PJ + (size_t)row * NPROJ + pn * 256 + bj * 128 + wc * 32 + 4 * fq;
                    u32x2 w0, w1; w0.x = cvt_pk_bf16(v0.x, v0.y); w0.y = cvt_pk_bf16(v0.z, v0.w); w1.x = cvt_pk_bf16(v1.x, v1.y); w1.y = cvt_pk_bf16(v1.z, v1.w);
                    *(u32x2*)dst = w0; *(u32x2*)(dst + 16) = w1; }
                }
                if (pn >= 6) { ss += __shfl_xor(ss, 16); ss += __shfl_xor(ss, 32); if (fq == 0) atomicAdd((pn == 6 ? rsq : rskv) + row, ss); }
                asm volatile("" ::: "memory");
            }
    }
};
struct EpiQ {
    static constexpr int NST = 0;
    bf16_t* QM; const f32x2* rope; const float* rsq; unsigned char* ws;
    __device__ __forceinline__ void operator()(const AccT& acc, const pg8::Unit& u, int wr, int wc, int fr, int fq) const {
        const int pm = u.pm, pn = u.pn; const bool latent = (pm % 33) != 0;
#pragma unroll
        for (int ai = 0; ai < 2; ++ai)
#pragma unroll
            for (int m = 0; m < 4; ++m) {
                const int row = pm * 256 + ai * 128 + wr * 64 + m * 16 + fr;
                const float rq = rsqrtf(rsq[row] * (1.f / 256.f) + EPS);
                const int i = row % RPB, pos = i - CTX;
#pragma unroll
                for (int bj = 0; bj < 2; ++bj) {
                    f32x4 v0 = acc[ai][bj][m][0] * rq, v1 = acc[ai][bj][m][1] * rq;
                    const int g6 = (pn * 8 + bj * 4 + wc) % 6;
                    if (latent && g6 >= 4) { const int pv = (g6 == 5) ? (pos & 63) : (pos >> 6);
                        const f32x4* t = (const f32x4*)(rope + pv * 16 + 4 * fq); const f32x4 t0 = t[0], t1 = t[1];
                        const f32x4 cs = {t0.x, t0.z, t1.x, t1.z}, sn = {t0.y, t0.w, t1.y, t1.w};
                        const f32x4 o0 = v0 * cs - v1 * sn, o1 = v1 * cs + v0 * sn; v0 = o0; v1 = o1; }
#ifdef SIM_FP8_ATT
                    v0 = (f32x4){q8(v0.x), q8(v0.y), q8(v0.z), q8(v0.w)}; v1 = (f32x4){q8(v1.x), q8(v1.y), q8(v1.z), q8(v1.w)};
#endif
#if ATT_FP8
                    { unsigned char* d8 = ws + WS_Q8M + (size_t)row * 768 + pn * 256 + bj * 128 + wc * 32 + 4 * fq; v0 = v0 * QSCALE_MLA; v1 = v1 * QSCALE_MLA;
                      *(unsigned*)d8 = cvt4_fp8(v0.x, v0.y, v0.z, v0.w); *(unsigned*)(d8 + 16) = cvt4_fp8(v1.x, v1.y, v1.z, v1.w); }
#else
                    bf16_t* dst = QM + (size_t)row * 768 + pn * 256 + bj * 128 + wc * 32 + 4 * fq;
                    u32x2 w0, w1; w0.x = cvt_pk_bf16(v0.x, v0.y); w0.y = cvt_pk_bf16(v0.z, v0.w); w1.x = cvt_pk_bf16(v1.x, v1.y); w1.y = cvt_pk_bf16(v1.z, v1.w);
                    *(u32x2*)dst = w0; *(u32x2*)(dst + 16) = w1;
#endif
                }
            }
    }
};
struct EpiKV {
    static constexpr int NST = 0;
    bf16_t* KV; const float* rskv; unsigned char* ws;
    __device__ __forceinline__ void operator()(const AccT& acc, const pg8::Unit& u, int wr, int wc, int fr, int fq) const {
        const int pm = u.pm, pn = u.pn;
#pragma unroll
        for (int ai = 0; ai < 2; ++ai)
#pragma unroll
            for (int m = 0; m < 4; ++m) {
                const int row = pm * 256 + ai * 128 + wr * 64 + m * 16 + fr;
                const float rk = rsqrtf(rskv[row] * (1.f / 128.f) + EPS);
#pragma unroll
                for (int bj = 0; bj < 2; ++bj) {
                    f32x4 v0 = acc[ai][bj][m][0] * rk, v1 = acc[ai][bj][m][1] * rk;
#ifdef SIM_FP8_ATT
                    v0 = (f32x4){q8(v0.x), q8(v0.y), q8(v0.z), q8(v0.w)}; v1 = (f32x4){q8(v1.x), q8(v1.y), q8(v1.z), q8(v1.w)};
#endif
#if ATT_FP8
                    if (bj == 0) { unsigned char* d8 = ws + WS_K8M + (size_t)row * 512 + pn * 128 + wc * 32 + 4 * fq;
                        *(unsigned*)d8 = cvt4_fp8(v0.x, v0.y, v0.z, v0.w); *(unsigned*)(d8 + 16) = cvt4_fp8(v1.x, v1.y, v1.z, v1.w); }
                    else { const int b_ = row / RPB, i_ = row - b_ * RPB, e0 = wc * 32 + 4 * fq;
                        unsigned char* d8 = ws + WS_VT8M + ((size_t)(b_ * 4 + pn) * 128 + e0 + (fr & 3)) * RPB + (i_ & ~63) + vt_pos(i_ & 60);
                        *(unsigned*)d8 = quad_tr_bytes(cvt4_fp8(v0.x, v0.y, v0.z, v0.w), fr & 3); *(unsigned*)(d8 + 16 * RPB) = quad_tr_bytes(cvt4_fp8(v1.x, v1.y, v1.z, v1.w), fr & 3); }
#else
                    bf16_t* dst = KV + (size_t)row * 1024 + pn * 256 + bj * 128 + wc * 32 + 4 * fq;
                    u32x2 w0, w1; w0.x = cvt_pk_bf16(v0.x, v0.y); w0.y = cvt_pk_bf16(v0.z, v0.w); w1.x = cvt_pk_bf16(v1.x, v1.y); w1.y = cvt_pk_bf16(v1.z, v1.w);
                    *(u32x2*)dst = w0; *(u32x2*)(dst + 16) = w1;
#endif
                }
            }
    }
};
struct EpiOut {
    static constexpr int NST = 0;
    bf16_t* XN; const float* x; const float* mods; float* rsx;
    __device__ __forceinline__ void operator()(const AccT& acc, const pg8::Unit& u, int wr, int wc, int fr, int fq) const {
        const int pm = u.pm, pn = u.pn, b = pm >> 5;
        const float* ga = mods + b * 6144 + 2 * 1024;
        float ssr[2][4];
#pragma unroll
        for (int ai = 0; ai < 2; ++ai)
#pragma unroll
            for (int m = 0; m < 4; ++m) ssr[ai][m] = 0.f;
#pragma unroll
        for (int bj = 0; bj < 2; ++bj) { const int cb = pn * 256 + bj * 128 + wc * 32;
            const f32x4 gv0 = *(const f32x4*)(ga + cb + 4 * fq), gv1 = *(const f32x4*)(ga + cb + 16 + 4 * fq);
#pragma unroll
            for (int ai = 0; ai < 2; ++ai)
#pragma unroll
                for (int m = 0; m < 4; ++m) { const size_t ro = (size_t)(pm * 256 + ai * 128 + wr * 64 + m * 16 + fr) * DM + cb;
                    const f32x4 v0 = *(const f32x4*)(x + ro + 4 * fq) + gv0 * acc[ai][bj][m][0], v1 = *(const f32x4*)(x + ro + 16 + 4 * fq) + gv1 * acc[ai][bj][m][1];
                    ssr[ai][m] += ((v0.x * v0.x + v0.y * v0.y) + (v0.z * v0.z + v0.w * v0.w)) + ((v1.x * v1.x + v1.y * v1.y) + (v1.z * v1.z + v1.w * v1.w));
                    unsigned ax = cvt_pk_bf16(v0.x, v0.y), ay = cvt_pk_bf16(v0.z, v0.w), bx = cvt_pk_bf16(v1.x, v1.y), by = cvt_pk_bf16(v1.z, v1.w);
                    { auto r_ = __builtin_amdgcn_permlane32_swap(ax, bx, false, false); ax = r_[0]; bx = r_[1]; } { auto r_ = __builtin_amdgcn_permlane32_swap(ay, by, false, false); ay = r_[0]; by = r_[1]; }
                    { auto r_ = __builtin_amdgcn_permlane16_swap(ax, bx, false, false); ax = r_[0]; bx = r_[1]; } { auto r_ = __builtin_amdgcn_permlane16_swap(ay, by, false, false); ay = r_[0]; by = r_[1]; }
                    *(u32x4*)(XN + ro + 8 * fq) = (u32x4){ax, ay, bx, by}; } }
#pragma unroll
        for (int ai = 0; ai < 2; ++ai)
#pragma unroll
            for (int m = 0; m < 4; ++m) { float s = ssr[ai][m]; s += __shfl_xor(s, 16); s += __shfl_xor(s, 32);
                if (fq == 0) atomicAdd(rsx + pm * 256 + ai * 128 + wr * 64 + m * 16 + fr, s); }
    }
};
struct EpiAct {
    static constexpr int NST = 16;
    unsigned char* ACT; const float* b1;
    __device__ __forceinline__ void operator()(const AccT& acc, const pg8::Unit& u, int wr, int wc, int fr, int fq) const {
        const int pm = u.pm, pn = u.pn; const float* bb = b1 + (size_t)u.e * 2048;
#pragma unroll
        for (int n = 0; n < 2; ++n) { const int col = pn * 128 + wc * 32 + n * 16 + 4 * fq; const f32x4 bg = *(const f32x4*)(bb + col), bu = *(const f32x4*)(bb + 1024 + col);
#pragma unroll
            for (int ai = 0; ai < 2; ++ai)
#pragma unroll
                for (int m = 0; m < 4; ++m) { const int row = pm * 256 + ai * 128 + wr * 64 + m * 16 + fr;
                    const f32x4 gq = acc[ai][0][m][n] * (1.f / WQ_SCALE) + bg, uq = acc[ai][1][m][n] * (1.f / WQ_SCALE) + bu; float o[4];
#pragma unroll
                    for (int e = 0; e < 4; ++e) { const float gg = fminf(gq[e], 7.f), uu = fminf(fmaxf(uq[e], -7.f), 7.f);
                        o[e] = gg * __builtin_amdgcn_rcpf(1.f + __expf(-1.702f * gg)) * (uu + 1.f); }
                    *(unsigned*)(ACT + (size_t)row * 1024 + col) = cvt4_fp8(o[0], o[1], o[2], o[3]); } }
    }
};
struct EpiY {
    static constexpr int NST = 16;
    bf16_t* YS; const float* b2; const float* gsrt; int mode = 0;
    __device__ __forceinline__ void operator()(const AccT& acc, const pg8::Unit& u, int wr, int wc, int fr, int fq) const {
        const int pm = u.pm, pn = u.pn; const float* bb = b2 + (size_t)u.e * 1024;
        float gt[2][4];
#pragma unroll
        for (int ai = 0; ai < 2; ++ai)
#pragma unroll
            for (int m = 0; m < 4; ++m) gt[ai][m] = gsrt[pm * 256 + ai * 128 + wr * 64 + m * 16 + fr] * (YS_FP8 ? YS_SCALE : 1.f);
#pragma unroll
        for (int bj = 0; bj < 2; ++bj) { const int cb = pn * 256 + bj * 128 + wc * 32;
            const f32x4 bv0 = *(const f32x4*)(bb + cb + 4 * fq), bv1 = *(const f32x4*)(bb + cb + 16 + 4 * fq);
#pragma unroll
            for (int ai = 0; ai < 2; ++ai)
#pragma unroll
                for (int m = 0; m < 4; ++m) { const int row = pm * 256 + ai * 128 + wr * 64 + m * 16 + fr;
                    const f32x4 v0 = (acc[ai][bj][m][0] * (1.f / WQ_SCALE) + bv0) * gt[ai][m], v1 = (acc[ai][bj][m][1] * (1.f / WQ_SCALE) + bv1) * gt[ai][m];
#if YS_FP8
                    unsigned ax = cvt4_fp8(v0.x, v0.y, v0.z, v0.w), bx = cvt4_fp8(v1.x, v1.y, v1.z, v1.w);
                    { auto r_ = __builtin_amdgcn_permlane32_swap(ax, bx, false, false); ax = r_[0]; bx = r_[1]; }
                    { auto r_ = __builtin_amdgcn_permlane16_swap(ax, bx, false, false); ax = r_[0]; bx = r_[1]; }
                    if (mode == 0 || ax == 0x12345678u) *(u32x2*)((unsigned char*)YS + (size_t)row * 1024 + cb + 8 * fq) = (u32x2){ax, bx};
#else
                    unsigned ax = cvt_pk_bf16(v0.x, v0.y), ay = cvt_pk_bf16(v0.z, v0.w), bx = cvt_pk_bf16(v1.x, v1.y), by = cvt_pk_bf16(v1.z, v1.w);
                    { auto r_ = __builtin_amdgcn_permlane32_swap(ax, bx, false, false); ax = r_[0]; bx = r_[1]; } { auto r_ = __builtin_amdgcn_permlane32_swap(ay, by, false, false); ay = r_[0]; by = r_[1]; }
                    { auto r_ = __builtin_amdgcn_permlane16_swap(ax, bx, false, false); ax = r_[0]; bx = r_[1]; } { auto r_ = __builtin_amdgcn_permlane16_swap(ay, by, false, false); ay = r_[0]; by = r_[1]; }
                    if (mode == 0 || ax == 0x12345678u) *(u32x4*)(YS + (size_t)row * 1024 + cb + 8 * fq) = (u32x4){ax, ay, bx, by};
#endif
                } }
    }
};
namespace attn {
using bf16x8 = __attribute__((ext_vector_type(8))) short;
using s16x4  = __attribute__((ext_vector_type(4))) short;
using f32x16 = __attribute__((ext_vector_type(16))) float;
constexpr int QBLK = 32, KVBLK = 64;
constexpr int SHM_V = KVBLK * 128 * 2;
#ifndef ATT_THR
#define ATT_THR 8.f
#endif
constexpr float THR = ATT_THR;
#define KOFF(row, ch) ((row) * 128 + ((((ch) ^ ((row) >> 1)) & 7) << 4))
#define SBAR() __builtin_amdgcn_sched_barrier(0)
__device__ __forceinline__ int crow(int r, int hi) { return (r & 3) + 8 * (r >> 2) + 4 * hi; }

template <int VAR = 0>
__device__ __forceinline__ void partialSM(f32x16& p0, f32x16& p1, float& m_reg, float& mn, float& alpha, const float C, const float thr_raw) {
  if constexpr (VAR == 1) { mn = m_reg; alpha = 1.f;
    _Pragma("unroll") for (int r = 0; r < 16; ++r) { p0[r] = p0[r] * C; p1[r] = p1[r] * C; } return; }
  float pmax = p0[0];
#pragma unroll
  for (int r = 1; r < 16; ++r) pmax = fmaxf(pmax, p0[r]);
#pragma unroll
  for (int r = 0; r < 16; ++r) pmax = fmaxf(pmax, p1[r]);
  { auto rr = __builtin_amdgcn_permlane32_swap(__float_as_uint(pmax), __float_as_uint(pmax), false, false);
    pmax = fmaxf(__uint_as_float(rr[0]), __uint_as_float(rr[1])); }
  if (__builtin_expect(__all(pmax - m_reg <= thr_raw), 1)) { mn = m_reg; alpha = 1.f; }
  else { mn = fmaxf(m_reg, pmax); alpha = __builtin_amdgcn_exp2f((m_reg - mn) * C); m_reg = mn; }
  const float mnC = -mn * C + PSHIFT;
#pragma unroll
  for (int r = 0; r < 16; ++r) p0[r] = fmaf(p0[r], C, mnC);
#pragma unroll
  for (int r = 0; r < 16; ++r) p1[r] = fmaf(p1[r], C, mnC);
#pragma unroll
  for (int r = 0; r < 16; ++r) p0[r] = __builtin_amdgcn_exp2f(p0[r]);
}
template <int VAR = 0>
__device__ __forceinline__ void finishSM(f32x16& p0, f32x16& p1, float alpha, float& l_reg, bf16x8& pa0, bf16x8& pa1, bf16x8& pa2, bf16x8& pa3) {
  if constexpr (VAR != 1) {
#pragma unroll
  for (int r = 0; r < 16; ++r) p1[r] = __builtin_amdgcn_exp2f(p1[r]); }
  float ps = 0;
#pragma unroll
  for (int r = 0; r < 16; ++r) ps += p0[r];
#pragma unroll
  for (int r = 0; r < 16; ++r) ps += p1[r];
  { auto rr = __builtin_amdgcn_permlane32_swap(__float_as_uint(ps), __float_as_uint(ps), false, false);
    ps = __uint_as_float(rr[0]) + __uint_as_float(rr[1]); }
  l_reg = l_reg * alpha + ps;
#define PK4(P, BASE, OUT) do { unsigned a0 = cvt_pk_bf16(P[BASE + 0], P[BASE + 1]), a1 = cvt_pk_bf16(P[BASE + 2], P[BASE + 3]);   \
    unsigned b0 = cvt_pk_bf16(P[BASE + 4], P[BASE + 5]), b1 = cvt_pk_bf16(P[BASE + 6], P[BASE + 7]);                              \
    auto r0 = __builtin_amdgcn_permlane32_swap(a0, b0, false, false); auto r1 = __builtin_amdgcn_permlane32_swap(a1, b1, false, false); \
    u32x4 w = {r0[0], r1[0], r0[1], r1[1]}; OUT = *reinterpret_cast<bf16x8*>(&w); } while (0)
  PK4(p0, 0, pa0); PK4(p0, 8, pa1); PK4(p1, 0, pa2); PK4(p1, 8, pa3);
#undef PK4
}
template <int NKC, int NQR, int KBOFF>
__device__ __forceinline__ void qkt(f32x16& p0, f32x16& p1, const int* kb, const bf16x8* qr, int ql) {
  p0 = f32x16{}; p1 = f32x16{};
  if constexpr (NQR != NKC) asm volatile("" : "+v"(ql));
#pragma unroll
  for (int c = 0; c < NKC; ++c)
#pragma unroll
    for (int d0 = 0; d0 < 4; ++d0) {
      const bf16x8 b0 = *(const LAS bf16x8*)(uintptr_t)(unsigned)(kb[d0] + (KBOFF + c * 8192));
      const bf16x8 b1 = *(const LAS bf16x8*)(uintptr_t)(unsigned)(kb[d0] + (KBOFF + c * 8192 + 4096));
      bf16x8 qf; if constexpr (NQR == NKC) qf = qr[c * 4 + d0]; else { if (c < NQR) qf = qr[(c < NQR ? c : 0) * 4 + d0]; else qf = *(const LAS bf16x8*)(uintptr_t)(unsigned)(ql + ((c - NQR) * 4 + d0) * 1024); }
      p0 = __builtin_amdgcn_mfma_f32_32x32x16_bf16(b0, qf, p0, 0, 0, 0);
      p1 = __builtin_amdgcn_mfma_f32_32x32x16_bf16(b1, qf, p1, 0, 0, 0); }
}
__device__ __forceinline__ int v_st(int k, int c) { const int kk = (k & ~0xC) | ((k & 4) << 1) | ((k & 8) >> 1); return ((kk >> 3) * 4 + (c >> 5)) * 512 + ((kk & 7) * 32 + (c & 31)) * 2; }
__device__ __forceinline__ int v_rd_base(int lane) { return ((lane & 3) << 3) | (((lane >> 2) & 3) << 6) | (((lane >> 4) & 1) << 5) | (((lane >> 5) & 1) << 8); }
constexpr int v_rd_off(int d0, int ks, int half) { return d0 * 512 + ks * 4096 + half * 2048; }
template <int OFF> __device__ __forceinline__ s16x4 tr_read(int vb) {
  s16x4 r; asm volatile("ds_read_b64_tr_b16 %0, %1 offset:%2" : "=&v"(r) : "v"(vb), "i"(OFF) : "memory"); return r;
}
template <int D0> __device__ __forceinline__ void pv_one(f32x16& od, int vb, bf16x8 pa0, bf16x8 pa1, bf16x8 pa2, bf16x8 pa3) {
  const s16x4 l0 = tr_read<v_rd_off(D0, 0, 0)>(vb), h0 = tr_read<v_rd_off(D0, 0, 1)>(vb), l1 = tr_read<v_rd_off(D0, 1, 0)>(vb), h1 = tr_read<v_rd_off(D0, 1, 1)>(vb);
  const s16x4 l2 = tr_read<v_rd_off(D0, 2, 0)>(vb), h2 = tr_read<v_rd_off(D0, 2, 1)>(vb), l3 = tr_read<v_rd_off(D0, 3, 0)>(vb), h3 = tr_read<v_rd_off(D0, 3, 1)>(vb);
  asm volatile("s_waitcnt lgkmcnt(0)" ::: "memory"); SBAR();
#define PK(L, H) (bf16x8){L[0], L[1], L[2], L[3], H[0], H[1], H[2], H[3]}
  od = __builtin_amdgcn_mfma_f32_32x32x16_bf16(pa0, PK(l0, h0), od, 0, 0, 0);
  od = __builtin_amdgcn_mfma_f32_32x32x16_bf16(pa1, PK(l1, h1), od, 0, 0, 0);
  od = __builtin_amdgcn_mfma_f32_32x32x16_bf16(pa2, PK(l2, h2), od, 0, 0, 0);
  od = __builtin_amdgcn_mfma_f32_32x32x16_bf16(pa3, PK(l3, h3), od, 0, 0, 0);
#undef PK
}
__device__ __forceinline__ void pv_d0(f32x16* o, int vb, bf16x8 pa0, bf16x8 pa1, bf16x8 pa2, bf16x8 pa3) {
  pv_one<0>(o[0], vb, pa0, pa1, pa2, pa3); pv_one<1>(o[1], vb, pa0, pa1, pa2, pa3); pv_one<2>(o[2], vb, pa0, pa1, pa2, pa3); pv_one<3>(o[3], vb, pa0, pa1, pa2, pa3);
}

typedef short v4i16 __attribute__((ext_vector_type(4)));
template <int OFF> __device__ __forceinline__ bf16x8 vfrag(int vb) {
  const v4i16 l = __builtin_amdgcn_ds_read_tr16_b64_v4i16((LAS v4i16*)(uintptr_t)(unsigned)(vb + OFF));
  const v4i16 h = __builtin_amdgcn_ds_read_tr16_b64_v4i16((LAS v4i16*)(uintptr_t)(unsigned)(vb + OFF + 2048));
  return (bf16x8){l[0], l[1], l[2], l[3], h[0], h[1], h[2], h[3]};
}
__device__ __forceinline__ float max3f(float a, float b, float c) { return __builtin_fmaxf(__builtin_fmaxf(a, b), c); }
#define PK4X(P, BASE, OUT) do { unsigned a0 = cvt_pk_bf16(Q8(P[BASE + 0]), Q8(P[BASE + 1])), a1 = cvt_pk_bf16(Q8(P[BASE + 2]), Q8(P[BASE + 3]));   \
    unsigned b0 = cvt_pk_bf16(Q8(P[BASE + 4]), Q8(P[BASE + 5])), b1 = cvt_pk_bf16(Q8(P[BASE + 6]), Q8(P[BASE + 7]));                              \
    auto r0 = __builtin_amdgcn_permlane32_swap(a0, b0, false, false); auto r1 = __builtin_amdgcn_permlane32_swap(a1, b1, false, false); \
    u32x4 w = {r0[0], r1[0], r0[1], r1[1]}; OUT = *reinterpret_cast<bf16x8*>(&w); } while (0)

template <int NKC, int NQR, int VAR = 0, int OM = 0>
__device__ __forceinline__ void attn_unit(const bf16_t* __restrict__ Qb, int ldq, const bf16_t* kp0, int kld0, const bf16_t* kp1, int kld1, const bf16_t* kp2, int kld2,
                                          const bf16_t* __restrict__ Vh, int ldv, bf16_t* __restrict__ Ob, int ldo, int seq, const float C, char* lds,
                                          char* stash = nullptr, const float lam = 0.f, const float* __restrict__ subw = nullptr) {
  constexpr int SHM_K = NKC * 8192, NG = NKC * 8;
  const int tid = tid_opaque(), wid = tid >> 6, lane = tid & 63, r32 = lane & 31, hi = lane >> 5;
  const float thr_raw = THR * 1.4426950408889634f / C;
  char* V_lds = lds; char* K_lds = lds + 3 * SHM_V;
  float* ws = (float*)(lds + 3 * SHM_V + 3 * SHM_K) + wid * 64; float* li_l = ws; float* al_l = ws + 32;
  float m_reg = -1e30f, l_reg = 0; f32x16 o[4] = {}; bf16x8 qr[NQR * 4];
  const bf16_t* Qw = Qb + (long)(wid * QBLK + r32) * ldq + hi * 8;
  int ql = (int)(uintptr_t)(lds + 3 * SHM_V + 3 * SHM_K + 2048) + wid * ((NKC - NQR) * 4096) + lane * 16;
  int kb[4];
#pragma unroll
  for (int d0 = 0; d0 < 4; ++d0) kb[d0] = (int)(uintptr_t)K_lds + KOFF(r32, d0 * 2 + hi);
  __syncthreads();
#pragma unroll
  for (int d0 = 0; d0 < NQR * 4; ++d0) qr[d0] = *reinterpret_cast<const bf16x8*>(Qw + d0 * 16);
#pragma unroll
  for (int d0 = NQR * 4; d0 < NKC * 4; ++d0) *(LAS bf16x8*)(uintptr_t)(unsigned)(ql + (d0 - NQR * 4) * 1024) = *reinterpret_cast<const bf16x8*>(Qw + d0 * 16);
  const int sr = tid >> 4, sc = (tid & 15) * 8, vst0 = v_st(sr, sc), vst1 = v_st(32 + sr, sc);
  const int krow = tid >> 3, kch = tid & 7, kst = KOFF(krow, kch);
  const int vb0 = (int)(uintptr_t)V_lds + v_rd_base(lane);
  const unsigned vo0 = (unsigned)(sr * ldv + sc) * 2u, vo1 = (unsigned)((32 + sr) * ldv + sc) * 2u;
  const unsigned ko0 = (unsigned)(krow * kld0 + kch * 8) * 2u, ko1 = (unsigned)(krow * kld1 + kch * 8) * 2u, ko2 = (unsigned)(krow * kld2 + kch * 8) * 2u;
  struct { bf16x8 vs0, vs1, k0, k1, k2; } sg;
  const __amdgpu_buffer_rsrc_t rV = __builtin_amdgcn_make_buffer_rsrc((void*)Vh, 0, 0xffffffff, 0x00020000);
  const __amdgpu_buffer_rsrc_t rK0 = __builtin_amdgcn_make_buffer_rsrc((void*)kp0, 0, 0xffffffff, 0x00020000);
  const __amdgpu_buffer_rsrc_t rK1 = __builtin_amdgcn_make_buffer_rsrc((void*)(NKC > 1 ? kp1 : kp0), 0, 0xffffffff, 0x00020000);
  const __amdgpu_buffer_rsrc_t rK2 = __builtin_amdgcn_make_buffer_rsrc((void*)(NKC > 2 ? kp2 : kp0), 0, 0xffffffff, 0x00020000);
#define BL128(r, vo, so) __builtin_bit_cast(bf16x8, __builtin_amdgcn_raw_buffer_load_b128(r, (int)(vo), (int)(so), 0))
#define SLOAD(kb_) do { const int so_ = (kb_) * (ldv * 2); \
    sg.vs0 = BL128(rV, vo0, so_); sg.vs1 = BL128(rV, vo1, so_); \
    sg.k0 = BL128(rK0, ko0, (kb_) * (kld0 * 2)); \
    if constexpr (NKC > 1) sg.k1 = BL128(rK1, ko1, (kb_) * (kld1 * 2)); \
    if constexpr (NKC > 2) sg.k2 = BL128(rK2, ko2, (kb_) * (kld2 * 2)); } while (0)
#define SWRITE(b) do { *(bf16x8*)(V_lds + (b) * SHM_V + vst0) = sg.vs0; *(bf16x8*)(V_lds + (b) * SHM_V + vst1) = sg.vs1; \
    *(bf16x8*)(K_lds + (b) * SHM_K + kst) = sg.k0; \
    if constexpr (NKC > 1) *(bf16x8*)(K_lds + (b) * SHM_K + 8192 + kst) = sg.k1; \
    if constexpr (NKC > 2) *(bf16x8*)(K_lds + (b) * SHM_K + 16384 + kst) = sg.k2; } while (0)
#define RESC(a) do { if (__any((a) < 1.f)) { if (hi == 0) al_l[r32] = (a); asm volatile("s_waitcnt lgkmcnt(0)" ::: "memory"); \
    _Pragma("unroll") for (int d = 0; d < 4; ++d) _Pragma("unroll") for (int r = 0; r < 16; ++r) o[d][r] *= al_l[crow(r, hi)]; } } while (0)
#define KLD(g, KB) (*(const LAS bf16x8*)(uintptr_t)(unsigned)(kb[((g) & 7) >> 1] + ((KB) + ((g) >> 3) * 8192 + ((g) & 1) * 4096)))
#define QLD(j) (*(const LAS bf16x8*)(uintptr_t)(unsigned)(ql + (j) * 1024))
  f32x16 pA0, pA1, pB0, pB1; float alA, alB; bf16x8 pa[4]; const int NT = seq / KVBLK;
  constexpr bool NEGM = (NKC == 1); f32x16 negm = {}; const float thr2 = THR * 1.4426950408889634f;
#define STEP(PN0, PN1, alN, PC0, PC1, alC, BKN, BVC, BW, DO_QK, DO_WR, DO_LD, tt) do { \
    bf16x8 kf[3], vf[3], qlf[2]; float ps = 0.f, mxa = 0.f, mxb = 0.f, mnC = 0.f; \
    SBAR(); \
    if (DO_QK) { if constexpr (NQR != NKC) asm volatile("" : "+v"(ql)); kf[0] = KLD(0, (BKN) * SHM_K); kf[1] = KLD(1, (BKN) * SHM_K); } \
    _Pragma("unroll") for (int g = 0; g < NG; ++g) { \
      const int c_ = g >> 3, d0_ = (g & 7) >> 1, s_ = g / NKC; const bool fs_ = (g % NKC) == 0; \
      if (DO_QK) { bf16x8 qf_; if (c_ < NQR) qf_ = qr[(c_ < NQR ? c_ : 0) * 4 + d0_]; else { if ((g & 1) == 0) qlf[d0_ & 1] = QLD((c_ - NQR) * 4 + d0_); qf_ = qlf[d0_ & 1]; } \
        if ((g & 1) == 0) { if (g == 0) PN0 = __builtin_amdgcn_mfma_f32_32x32x16_bf16(kf[g % 3], qf_, NEGM ? negm : (f32x16){}, 0, 0, 0); else PN0 = __builtin_amdgcn_mfma_f32_32x32x16_bf16(kf[g % 3], qf_, PN0, 0, 0, 0); } \
        else { if (g == 1) PN1 = __builtin_amdgcn_mfma_f32_32x32x16_bf16(kf[g % 3], qf_, NEGM ? negm : (f32x16){}, 0, 0, 0); else PN1 = __builtin_amdgcn_mfma_f32_32x32x16_bf16(kf[g % 3], qf_, PN1, 0, 0, 0); } } \
      if (fs_ && VAR < 4) {   \
        if (!NEGM && s_ < 7) { PC1[2 * s_] = __builtin_amdgcn_exp2f(PC1[2 * s_]); PC1[2 * s_ + 1] = __builtin_amdgcn_exp2f(PC1[2 * s_ + 1]); } \
        if (!NEGM && s_ == 4) { PC1[14] = __builtin_amdgcn_exp2f(PC1[14]); PC1[15] = __builtin_amdgcn_exp2f(PC1[15]); } \
        if (s_ == 0) { ps = (PC0[0] + PC0[1]) + (PC0[2] + PC0[3]); PK4X(PC0, 0, pa[0]); } \
        if (s_ == 1) { ps += (PC0[4] + PC0[5]) + (PC0[6] + PC0[7]); PK4X(PC0, 8, pa[1]); } \
        if (s_ == 2) { ps += (PC0[8] + PC0[9]) + (PC0[10] + PC0[11]); ps += (PC0[12] + PC0[13]) + (PC0[14] + PC0[15]); } \
        if (s_ == 3) { ps += (PC1[0] + PC1[1]) + (PC1[2] + PC1[3]); } \
        if (s_ == 4) { ps += (PC1[4] + PC1[5]) + (PC1[6] + PC1[7]); } \
        if (s_ == 5) { ps += (PC1[8] + PC1[9]); PK4X(PC1, 0, pa[2]); } \
        if (s_ == 6) { ps += (PC1[10] + PC1[11]) + (PC1[12] + PC1[13]); } \
        if (s_ == 7) { ps += (PC1[14] + PC1[15]); PK4X(PC1, 8, pa[3]); \
          auto rr_ = __builtin_amdgcn_permlane32_swap(__float_as_uint(ps), __float_as_uint(ps), false, false); ps = __uint_as_float(rr_[0]) + __uint_as_float(rr_[1]); l_reg = l_reg * (alC) + ps; } } \
      if (DO_QK && g + 2 < NG) kf[(g + 2) % 3] = KLD(g + 2, (BKN) * SHM_K); \
      if (g == NG - 2) vf[0] = vfrag<v_rd_off(0, 0, 0)>(vb0 + (BVC) * (int)SHM_V); \
      if (g == NG - 1) vf[1] = vfrag<v_rd_off(1, 0, 0)>(vb0 + (BVC) * (int)SHM_V); \
      SBAR(); } \
    _Pragma("unroll") for (int g = 0; g < 16; ++g) { \
      const int ks_ = g >> 2, d0_ = g & 3; \
      o[d0_] = __builtin_amdgcn_mfma_f32_32x32x16_bf16(pa[ks_], vf[g % 3], o[d0_], 0, 0, 0); \
      if (g == 0 && (DO_WR) && VAR != 5) { SWRITE(BW); } \
      if (g == 1 && (DO_LD) && VAR != 5) { SLOAD(((tt) + 3) * KVBLK); } \
      if (DO_QK && VAR < 4) {   \
        if (g == 2) { mxa = max3f(PN0[0], PN0[1], PN0[2]); mxa = max3f(mxa, PN0[3], PN0[4]); mxb = max3f(PN0[5], PN0[6], PN0[7]); mxb = max3f(mxb, PN0[8], PN0[9]); } \
        if (g == 3) { mxa = max3f(mxa, PN0[10], PN0[11]); mxb = max3f(mxb, PN0[12], PN0[13]); mxa = max3f(mxa, PN0[14], PN0[15]); mxb = max3f(mxb, PN1[0], PN1[1]); } \
        if (g == 4) { mxa = max3f(mxa, PN1[2], PN1[3]); mxb = max3f(mxb, PN1[4], PN1[5]); mxa = max3f(mxa, PN1[6], PN1[7]); mxb = max3f(mxb, PN1[8], PN1[9]); } \
        if (g == 5) { mxa = max3f(mxa, PN1[10], PN1[11]); mxb = max3f(mxb, PN1[12], PN1[13]); mxa = max3f(mxa, PN1[14], PN1[15]); mxa = __builtin_fmaxf(mxa, mxb); } \
        if (g == 6) { auto rr_ = __builtin_amdgcn_permlane32_swap(__float_as_uint(mxa), __float_as_uint(mxa), false, false); const float pmax_ = __builtin_fmaxf(__uint_as_float(rr_[0]), __uint_as_float(rr_[1])); \
          if constexpr (NEGM) { alN = 1.f; if (__builtin_expect(!__all(pmax_ <= thr2 + PSHIFT), 0)) { const float dl_ = __builtin_fmaxf(pmax_ - PSHIFT, 0.f); alN = __builtin_amdgcn_exp2f(-dl_); \
              _Pragma("unroll") for (int r = 0; r < 16; ++r) { PN0[r] -= dl_; PN1[r] -= dl_; negm[r] -= dl_; } } } \
          else { const bool ok_ = __all(pmax_ - m_reg <= thr_raw); const float mn_ = ok_ ? m_reg : __builtin_fmaxf(m_reg, pmax_); \
            alN = __builtin_amdgcn_exp2f((m_reg - mn_) * C); m_reg = mn_; mnC = -mn_ * C + PSHIFT; } } \
        if (g >= 7) { const int i_ = g - 7; \
          if constexpr (NEGM) {   \
            if (i_ < 4) { _Pragma("unroll") for (int r = 4 * i_; r < 4 * i_ + 4; ++r) PN0[r] = __builtin_amdgcn_exp2f(PN0[r]); } \
            else if (i_ < 8) { _Pragma("unroll") for (int r = 4 * (i_ - 4); r < 4 * (i_ - 4) + 4; ++r) PN1[r] = __builtin_amdgcn_exp2f(PN1[r]); } } \
          else {   \
          if (i_ < 4) { _Pragma("unroll") for (int r = 4 * i_; r < 4 * i_ + 4; ++r) PN0[r] = fmaf(PN0[r], C, mnC); } \
          else if (i_ < 8) { _Pragma("unroll") for (int r = 4 * (i_ - 4); r < 4 * (i_ - 4) + 4; ++r) PN1[r] = fmaf(PN1[r], C, mnC); } \
          if (i_ >= 1) { PN0[2 * (i_ - 1)] = __builtin_amdgcn_exp2f(PN0[2 * (i_ - 1)]); PN0[2 * (i_ - 1) + 1] = __builtin_amdgcn_exp2f(PN0[2 * (i_ - 1) + 1]); } } \
          asm volatile("" : "+v"(PN0), "+v"(PN1));   } } \
      if (g + 2 < 16) { constexpr int dummy_ = 0; (void)dummy_; \
        if (g + 2 == 2) vf[2] = vfrag<v_rd_off(2, 0, 0)>(vb0 + (BVC) * (int)SHM_V); if (g + 2 == 3) vf[0] = vfrag<v_rd_off(3, 0, 0)>(vb0 + (BVC) * (int)SHM_V); \
        if (g + 2 == 4) vf[1] = vfrag<v_rd_off(0, 1, 0)>(vb0 + (BVC) * (int)SHM_V); if (g + 2 == 5) vf[2] = vfrag<v_rd_off(1, 1, 0)>(vb0 + (BVC) * (int)SHM_V); \
        if (g + 2 == 6) vf[0] = vfrag<v_rd_off(2, 1, 0)>(vb0 + (BVC) * (int)SHM_V); if (g + 2 == 7) vf[1] = vfrag<v_rd_off(3, 1, 0)>(vb0 + (BVC) * (int)SHM_V); \
        if (g + 2 == 8) vf[2] = vfrag<v_rd_off(0, 2, 0)>(vb0 + (BVC) * (int)SHM_V); if (g + 2 == 9) vf[0] = vfrag<v_rd_off(1, 2, 0)>(vb0 + (BVC) * (int)SHM_V); \
        if (g + 2 == 10) vf[1] = vfrag<v_rd_off(2, 2, 0)>(vb0 + (BVC) * (int)SHM_V); if (g + 2 == 11) vf[2] = vfrag<v_rd_off(3, 2, 0)>(vb0 + (BVC) * (int)SHM_V); \
        if (g + 2 == 12) vf[0] = vfrag<v_rd_off(0, 3, 0)>(vb0 + (BVC) * (int)SHM_V); if (g + 2 == 13) vf[1] = vfrag<v_rd_off(1, 3, 0)>(vb0 + (BVC) * (int)SHM_V); \
        if (g + 2 == 14) vf[2] = vfrag<v_rd_off(2, 3, 0)>(vb0 + (BVC) * (int)SHM_V); if (g + 2 == 15) vf[0] = vfrag<v_rd_off(3, 3, 0)>(vb0 + (BVC) * (int)SHM_V); } \
      SBAR(); } \
    if (VAR >= 4) { asm volatile("" : "+v"(PN0), "+v"(PN1)); pa[0] = __builtin_bit_cast(bf16x8, (u32x4){(unsigned)tt, 1u, 2u, 3u}); pa[1] = pa[0]; pa[2] = pa[0]; pa[3] = pa[0]; } \
    if (DO_QK && VAR < 4) { RESC(alN); } \
    if (VAR != 5) __syncthreads(); } while (0)
  SLOAD(0); SWRITE(0); SLOAD(KVBLK); SWRITE(1); SLOAD(2 * KVBLK); __syncthreads();
  { float mn0_; qkt<NKC, NQR, 0>(pA0, pA1, kb, qr, ql);
    if constexpr (NEGM) { float pm_ = pA0[0];
      _Pragma("unroll") for (int r = 1; r < 16; ++r) pm_ = fmaxf(pm_, pA0[r]);
      _Pragma("unroll") for (int r = 0; r < 16; ++r) pm_ = fmaxf(pm_, pA1[r]);
      { auto rr_ = __builtin_amdgcn_permlane32_swap(__float_as_uint(pm_), __float_as_uint(pm_), false, false); pm_ = fmaxf(__uint_as_float(rr_[0]), __uint_as_float(rr_[1])); }
      _Pragma("unroll") for (int r = 0; r < 16; ++r) { pA0[r] = __builtin_amdgcn_exp2f(pA0[r] - pm_ + PSHIFT); pA1[r] = __builtin_amdgcn_exp2f(pA1[r] - pm_ + PSHIFT); negm[r] = -pm_ + PSHIFT; }
      alA = 1.f; (void)mn0_; }
    else partialSM(pA0, pA1, m_reg, mn0_, alA, C, thr_raw); }
#ifdef ATT_STATIC_PRIO
  if (__builtin_amdgcn_readfirstlane(tid) >= 256) __builtin_amdgcn_s_setprio(1);
#endif
  int t = 0;
  for (; t + 6 < NT; t += 6) {
    STEP(pB0, pB1, alB, pA0, pA1, alA, 1, 0, 2, true, true, true, t);
    STEP(pA0, pA1, alA, pB0, pB1, alB, 2, 1, 0, true, true, true, t + 1);
    STEP(pB0, pB1, alB, pA0, pA1, alA, 0, 2, 1, true, true, true, t + 2);
    STEP(pA0, pA1, alA, pB0, pB1, alB, 1, 0, 2, true, true, true, t + 3);
    STEP(pB0, pB1, alB, pA0, pA1, alA, 2, 1, 0, true, true, true, t + 4);
    STEP(pA0, pA1, alA, pB0, pB1, alB, 0, 2, 1, true, true, true, t + 5);
  }
  STEP(pB0, pB1, alB, pA0, pA1, alA, 1, 0, 2, true, true, true, t);
  STEP(pA0, pA1, alA, pB0, pB1, alB, 2, 1, 0, true, true, true, t + 1);
  STEP(pB0, pB1, alB, pA0, pA1, alA, 0, 2, 1, true, true, true, t + 2);
  STEP(pA0, pA1, alA, pB0, pB1, alB, 1, 0, 2, true, true, false, t + 3);
  STEP(pB0, pB1, alB, pA0, pA1, alA, 2, 1, 0, true, false, false, t + 4);
  STEP(pA0, pA1, alA, pB0, pB1, alB, 0, 2, 1, false, false, false, t + 5);
#ifdef ATT_STATIC_PRIO
  __builtin_amdgcn_s_setprio(0);
#endif
  if (hi == 0) li_l[r32] = l_reg; asm volatile("s_waitcnt lgkmcnt(0)" ::: "memory");
  float rli[16];
#pragma unroll
  for (int r = 0; r < 16; ++r) rli[r] = __builtin_amdgcn_rcpf(li_l[crow(r, hi)]);
  if constexpr (OM == 1) {
    unsigned* st = (unsigned*)stash + tid;
#pragma unroll
    for (int r = 0; r < 16; ++r) { st[(2 * r) * 512] = cvt_pk_bf16(o[0][r] * rli[r], o[1][r] * rli[r]); st[(2 * r + 1) * 512] = cvt_pk_bf16(o[2][r] * rli[r], o[3][r] * rli[r]); }
  } else if constexpr (OM == 2) {
    const unsigned* st = (const unsigned*)stash + tid;
    float sw[4];
#pragma unroll
    for (int d0 = 0; d0 < 4; ++d0) sw[d0] = subw[d0 * 32 + r32] * 0.8f;
    bf16_t* Ow = Ob + (long)(wid * QBLK) * ldo;
#pragma unroll
    for (int r = 0; r < 16; ++r) { const unsigned w01 = st[(2 * r) * 512], w23 = st[(2 * r + 1) * 512];
      const float d0v = bflo(w01) - lam * (o[0][r] * rli[r]), d1v = bfhi(w01) - lam * (o[1][r] * rli[r]), d2v = bflo(w23) - lam * (o[2][r] * rli[r]), d3v = bfhi(w23) - lam * (o[3][r] * rli[r]);
      float ss = (d0v * d0v + d1v * d1v) + (d2v * d2v + d3v * d3v);
      ss += __shfl_xor(ss, 1); ss += __shfl_xor(ss, 2); ss += __shfl_xor(ss, 4); ss += __shfl_xor(ss, 8); ss += __shfl_xor(ss, 16);
      const float rn = rsqrtf(ss * (1.f / 128.f) + EPS); const long ob = (long)crow(r, hi) * ldo + r32;
      Ow[ob] = f2bf(d0v * rn * sw[0]); Ow[ob + 32] = f2bf(d1v * rn * sw[1]); Ow[ob + 64] = f2bf(d2v * rn * sw[2]); Ow[ob + 96] = f2bf(d3v * rn * sw[3]); }
  } else {
  bf16_t* Ow = Ob + (long)(wid * QBLK) * ldo;
#pragma unroll
  for (int r = 0; r < 16; ++r) { const int orow = crow(r, hi);
#pragma unroll
    for (int d0 = 0; d0 < 4; ++d0) Ow[(long)orow * ldo + d0 * 32 + r32] = f2bf(o[d0][r] * rli[r]); }
  }
#undef SLOAD
#undef BL128
#undef SWRITE
#undef RESC
#undef STEP
#undef KLD
#undef QLD
}
#undef PK4X
#undef KOFF
#undef SBAR
}
namespace attn8 {
#if SIM_P6
#define SQ6(x) q8(x)
#else
#define SQ6(x) (x)
#endif
using attn::f32x16; using attn::crow; using attn::max3f;
typedef int v8i32 __attribute__((ext_vector_type(8)));
typedef int v4i32 __attribute__((ext_vector_type(4)));
#ifndef ATT8_THRL
#define ATT8_THRL 3.5f
#endif
constexpr float PSH = 5.f, THRL = ATT8_THRL;
#define OFF8(row, piece) ((row) * 64 + ((((piece) ^ ((row) >> 2)) & 3) << 4))
#define SBAR() __builtin_amdgcn_sched_barrier(0)
#define MFMA8(a, b, c) __builtin_amdgcn_mfma_scale_f32_32x32x64_f8f6f4(a, b, c, 0, 0, 0, 0, 0, 0)
#define LD32(addr0, addr1) __builtin_shufflevector(*(const LAS v4i32*)(uintptr_t)(unsigned)(addr0), *(const LAS v4i32*)(uintptr_t)(unsigned)(addr1), 0, 1, 2, 3, 4, 5, 6, 7)

constexpr int WCONV_I1 = 32 * 128 * 32, WCONV_I2 = 32 * 128 * 16, WCONV_ITEMS = WCONV_I1 + WCONV_I2;
struct WConv { float v[8]; };
__device__ __forceinline__ void wconv_load(const Params& p, int it, int lane, WConv& w) {
    it = min(it, WCONV_ITEMS - 1);
    const bool m1 = it < WCONV_I1; const int i2 = m1 ? it : it - WCONV_I1;
    const int e = m1 ? (i2 >> 12) : (i2 >> 11), kb = m1 ? ((i2 >> 5) & 127) : ((i2 >> 4) & 127), nb = m1 ? (i2 & 31) : (i2 & 15), ldn = m1 ? 2048 : 1024;
    const __amdgpu_buffer_rsrc_t r = __builtin_amdgcn_make_buffer_rsrc((void*)(m1 ? p.w1 : p.w2), 0, 0xffffffff, 0x00020000);
    const int so = ((e * 1024 + kb * 8) * ldn + nb * 64) * 4;
#pragma unroll
    for (int j = 0; j < 8; ++j) w.v[j] = __builtin_bit_cast(float, __builtin_amdgcn_raw_buffer_load_b32(r, lane * 4, so + j * ldn * 4, 0));
}
__device__ __forceinline__ void wconv_store(const Params& p, int it0, int lane, const WConv& w) {
    const int it = min(it0, WCONV_ITEMS - 1);
    const bool m1 = it < WCONV_I1; const int i2 = m1 ? it : it - WCONV_I1;
    const int e = m1 ? (i2 >> 12) : (i2 >> 11), kb = m1 ? ((i2 >> 5) & 127) : ((i2 >> 4) & 127), nb = m1 ? (i2 & 31) : (i2 & 15);
    const int n = nb * 64 + lane;
    const int drow = m1 ? (e * 2048 + ((n & 1023) >> 7) * 256 + (n >> 10) * 128 + (n & 127)) : (e * 1024 + n);
    unsigned char* dst = it0 < WCONV_ITEMS ? p.ws + (m1 ? WS_W1 : WS_W2) + (size_t)drow * 1024 + kb * 8 : p.ws + WS_DUMMY + lane * 8;
    u32x2 o; o.x = cvt4_fp8(w.v[0] * WQ_SCALE, w.v[1] * WQ_SCALE, w.v[2] * WQ_SCALE, w.v[3] * WQ_SCALE); o.y = cvt4_fp8(w.v[4] * WQ_SCALE, w.v[5] * WQ_SCALE, w.v[6] * WQ_SCALE, w.v[7] * WQ_SCALE);
    *(u32x2*)dst = o;
}
template <int NKC, int OM, int VAR = 0, bool WC = false>
__device__ __forceinline__ void attn_unit(const unsigned char* __restrict__ Qb, int ldq, const unsigned char* kp0, int kld0, const unsigned char* kp1, int kld1, const unsigned char* kp2, int kld2,
                                          const unsigned char* __restrict__ VT, bf16_t* __restrict__ Ob, int ldo, int seq, char* lds,
                                          char* stash = nullptr, const float lam = 0.f, const float* __restrict__ subw = nullptr, const Params* pp = nullptr, int wc_base = 0) {
  constexpr int SHM_K = NKC * 4096, SHM_V = 8192, NG = 2 * NKC;
  constexpr bool STG = ((STAGGER) >> (NKC == 1 ? 0 : 1)) & 1;
  constexpr bool V_M = VAR >= 32, V_NOLDS = VAR == 6 || VAR == 9 || V_M, V_NOSTG = VAR == 2 || VAR == 3 || VAR == 9 || V_M, V_NOBAR = VAR == 3 || VAR == 9 || V_M;
  constexpr bool V_NOEXP = VAR == 1 || VAR == 7 || (V_M && (VAR & 1)), V_NOMAX = VAR == 1 || VAR == 7 || (V_M && (VAR & 2)), V_NOPACK = V_M && (VAR & 4);
  constexpr bool V_NOPV = VAR == 4 || VAR == 7 || (V_M && (VAR & 8)), V_NOQK = VAR == 5 || (V_M && (VAR & 16));
  const int tid = tid_opaque(), wid = tid >> 6, lane = tid & 63, r32 = lane & 31, hi = lane >> 5;
  char* V_lds = lds; char* K_lds = lds + 4 * SHM_V;
  float* ws = (float*)(lds + 4 * SHM_V + 4 * SHM_K) + wid * 64; float* al_l = ws + 32;
  f32x16 o[4] = {}, ol = {}; v8i32 qf[NKC];
  v8i32 ones8 = {0x38383838, 0x38383838, 0x38383838, 0x38383838, 0x38383838, 0x38383838, 0x38383838, 0x38383838};
  asm volatile("" : "+v"(ones8));
  { const unsigned char* Qw = Qb + (long)(wid * 32 + r32) * ldq + hi * 32;
#pragma unroll
    for (int c = 0; c < NKC; ++c) qf[c] = __builtin_shufflevector(*(const v4i32*)(Qw + c * 64), *(const v4i32*)(Qw + c * 64 + 16), 0, 1, 2, 3, 4, 5, 6, 7); }
  const int fa0 = OFF8(r32, 2 * hi), fa1 = OFF8(r32, 2 * hi + 1);
  const LAS char* kA = (const LAS char*)(uintptr_t)(unsigned)((int)(uintptr_t)K_lds + fa0); const LAS char* kB = (const LAS char*)(uintptr_t)(unsigned)((int)(uintptr_t)K_lds + fa1);
  const LAS char* vA = (const LAS char*)(uintptr_t)(unsigned)((int)(uintptr_t)V_lds + fa0); const LAS char* vB = (const LAS char*)(uintptr_t)(unsigned)((int)(uintptr_t)V_lds + fa1);
  const int ve = tid >> 2, pc = tid & 3, krow = (tid & 255) >> 2;
  const int vst = OFF8(ve, pc), kst = OFF8(krow, pc);
  const bool lowhalf = tid < 256;
  const bool grpB = __builtin_amdgcn_readfirstlane(wid) >= 4;
  const unsigned vo = (unsigned)(ve * RPB + pc * 16);
  const unsigned ko0 = (unsigned)(krow * kld0 + pc * 16), ko1 = (unsigned)(krow * kld1 + pc * 16), ko2 = (unsigned)(krow * kld2 + pc * 16);
  const __amdgpu_buffer_rsrc_t rV = __builtin_amdgcn_make_buffer_rsrc((void*)VT, 0, 0xffffffff, 0x00020000);
  const __amdgpu_buffer_rsrc_t rK0 = __builtin_amdgcn_make_buffer_rsrc((void*)kp0, 0, 0xffffffff, 0x00020000);
  const __amdgpu_buffer_rsrc_t rK1 = __builtin_amdgcn_make_buffer_rsrc((void*)(NKC > 1 ? kp1 : kp0), 0, 0xffffffff, 0x00020000);
  const __amdgpu_buffer_rsrc_t rK2 = __builtin_amdgcn_make_buffer_rsrc((void*)(NKC > 2 ? kp2 : kp0), 0, 0xffffffff, 0x00020000);
  struct { v4i32 v, ka, kc; } sg;
#define BL16(r, vo_, so_) __builtin_bit_cast(v4i32, __builtin_amdgcn_raw_buffer_load_b128(r, (int)(vo_), (int)(so_), 0))
#define SLOAD(k0) do { sg.v = BL16(rV, vo, (k0)); \
    if constexpr (NKC == 1) { if (lowhalf) sg.ka = BL16(rK0, ko0, (k0) * kld0); } \
    else { if (lowhalf) { sg.ka = BL16(rK0, ko0, (k0) * kld0); sg.kc = BL16(rK2, ko2, (k0) * kld2); } else sg.ka = BL16(rK1, ko1, (k0) * kld1); } } while (0)
#define SWRITE(b) do { *(v4i32*)(V_lds + (b) * SHM_V + vst) = sg.v; \
    if constexpr (NKC == 1) { if (lowhalf) *(v4i32*)(K_lds + (b) * SHM_K + kst) = sg.ka; } \
    else { if (lowhalf) { *(v4i32*)(K_lds + (b) * SHM_K + kst) = sg.ka; *(v4i32*)(K_lds + (b) * SHM_K + 8192 + kst) = sg.kc; } else *(v4i32*)(K_lds + (b) * SHM_K + 4096 + kst) = sg.ka; } } while (0)
#define RESC(a) do { if (raised_) { if (hi == 0) al_l[r32] = (a); asm volatile("s_waitcnt lgkmcnt(0)" ::: "memory"); \
    _Pragma("unroll") for (int r = 0; r < 16; ++r) { const float a_ = al_l[crow(r, hi)]; o[0][r] *= a_; o[1][r] *= a_; o[2][r] *= a_; o[3][r] *= a_; ol[r] *= a_; } } } while (0)
#define LDP(pa, pb, off) __builtin_shufflevector(*(const LAS v4i32*)((pa) + (off)), *(const LAS v4i32*)((pb) + (off)), 0, 1, 2, 3, 4, 5, 6, 7)
#define KFR(g, KB) (V_NOLDS ? qf[0] : LDP(kA, kB, (KB) + ((g) >> 1) * 4096 + ((g) & 1) * 2048))
#define VFR(d0, VB) (V_NOLDS ? qf[0] : LDP(vA, vB, (VB) + (d0) * 2048))
  f32x16 P0, P1, negm; float al = 1.f; const int NT = seq / 64;
  v8i32 kpf0, kpf1;
  v8i32 pf;
#define PACKP() do { pf = (v8i32){(int)cvt4_fp8(P0[0], P0[1], P0[2], P0[3]), (int)cvt4_fp8(P0[4], P0[5], P0[6], P0[7]), (int)cvt4_fp8(P0[8], P0[9], P0[10], P0[11]), (int)cvt4_fp8(P0[12], P0[13], P0[14], P0[15]), \
    (int)cvt4_fp8(P1[0], P1[1], P1[2], P1[3]), (int)cvt4_fp8(P1[4], P1[5], P1[6], P1[7]), (int)cvt4_fp8(P1[8], P1[9], P1[10], P1[11]), (int)cvt4_fp8(P1[12], P1[13], P1[14], P1[15])}; } while (0)
#define PACK0() do { asm volatile("" : "+v"(P0)); pf[0] = (int)cvt4_fp8o(pf[0], P0[0], P0[1], P0[2], P0[3]); pf[1] = (int)cvt4_fp8o(pf[1], P0[4], P0[5], P0[6], P0[7]); \
    pf[2] = (int)cvt4_fp8o(pf[2], P0[8], P0[9], P0[10], P0[11]); pf[3] = (int)cvt4_fp8o(pf[3], P0[12], P0[13], P0[14], P0[15]); asm volatile("" : "+v"(pf)); } while (0)
#define PACK1() do { asm volatile("" : "+v"(P1)); pf[4] = (int)cvt4_fp8o(pf[4], P1[0], P1[1], P1[2], P1[3]); pf[5] = (int)cvt4_fp8o(pf[5], P1[4], P1[5], P1[6], P1[7]); \
    pf[6] = (int)cvt4_fp8o(pf[6], P1[8], P1[9], P1[10], P1[11]); pf[7] = (int)cvt4_fp8o(pf[7], P1[12], P1[13], P1[14], P1[15]); asm volatile("" : "+v"(pf)); } while (0)
#define MAX0() do { m0_ = max3f(P0[0], P0[1], P0[2]); m0_ = max3f(m0_, P0[3], P0[4]); m0_ = max3f(m0_, P0[5], P0[6]); m0_ = max3f(m0_, P0[7], P0[8]); m0_ = max3f(m0_, P0[9], P0[10]); \
    m0_ = max3f(m0_, P0[11], P0[12]); m0_ = max3f(m0_, P0[13], P0[14]); asm volatile("" : "+v"(m0_)); } while (0)
#define MAXFIN() do { float m1_ = max3f(P1[0], P1[1], P1[2]); m1_ = max3f(m1_, P1[3], P1[4]); m1_ = max3f(m1_, P1[5], P1[6]); m1_ = max3f(m1_, P1[7], P1[8]); m1_ = max3f(m1_, P1[9], P1[10]); \
    m1_ = max3f(m1_, P1[11], P1[12]); m1_ = max3f(m1_, P1[13], P1[14]); m1_ = max3f(m1_, P1[15], P0[15]); mx_ = fmaxf(m1_, m0_);          \
    if (__builtin_expect(!__all(mx_ <= PSH + THRL), 0)) { \
      { auto rr_ = __builtin_amdgcn_permlane32_swap(__float_as_uint(mx_), __float_as_uint(mx_), false, false); mx_ = fmaxf(__uint_as_float(rr_[0]), __uint_as_float(rr_[1])); }     \
      const float dl_ = fmaxf(mx_ - PSH, 0.f); al = __builtin_amdgcn_exp2f(-dl_); raised_ = true; \
      _Pragma("unroll") for (int r = 0; r < 16; ++r) { P0[r] -= dl_; P1[r] -= dl_; negm[r] -= dl_; } } } while (0)
#define EXPS(P, ra, rb) do { asm volatile("" : "+v"(P)); _Pragma("unroll") for (int r = (ra); r < (rb); ++r) P[r] = __builtin_amdgcn_exp2f(P[r]); asm volatile("" : "+v"(P)); } while (0)
#define MPIN(acc) asm volatile("" : "+v"(acc))
#define STEP(BKN, BVC, BW, BKP, DO_QK, DO_WR, DO_LD, DO_KP, tt) do { \
    v8i32 kf[2], vf[3]; float mx_ = 0.f, m0_ = 0.f; bool raised_ = false; \
    SBAR(); \
    if (DO_QK && NG > 2) { kf[0] = KFR(2, (BKN) * SHM_K); kf[1] = KFR(3, (BKN) * SHM_K); } \
    _Pragma("unroll") for (int g = 0; g < NG; ++g) { \
      if (DO_QK && !V_NOQK) { if (g == 0) { P0 = MFMA8(kpf0, qf[0], negm); MPIN(P0); } else if (g == 1) { P1 = MFMA8(kpf1, qf[0], negm); MPIN(P1); } \
        else if ((g & 1) == 0) { P0 = MFMA8(kf[g & 1], qf[g >> 1], P0); MPIN(P0); } else { P1 = MFMA8(kf[g & 1], qf[g >> 1], P1); MPIN(P1); } } \
      SBAR(); \
      if (g == 0 && !V_NOPACK) { PACK1(); }                            \
      if (DO_QK && NG == 2 && g == 1 && !V_NOMAX) { MAX0(); } \
      if (DO_QK && g >= 2 && g + 2 < NG) kf[g & 1] = KFR(g + 2, (BKN) * SHM_K); \
      if (g == NG - 2) vf[0] = VFR(0, (BVC) * SHM_V); if (g == NG - 1) vf[1] = VFR(1, (BVC) * SHM_V); \
      SBAR(); } \
      \
    if (!V_NOPV) { o[0] = MFMA8(pf, vf[0], o[0]); MPIN(o[0]); } SBAR(); if (DO_WR && !V_NOSTG) { SWRITE(BW); } if (DO_LD && !V_NOSTG) { SLOAD(((tt) + 4) * 64); } vf[2] = VFR(2, (BVC) * SHM_V); al = 1.f; \
    if (DO_QK && !V_NOMAX) { if (NG == 2) { MAXFIN(); } else { MAX0(); } } SBAR(); \
      \
    if (!V_NOPV) { o[1] = MFMA8(pf, vf[1], o[1]); MPIN(o[1]); } SBAR(); vf[0] = VFR(3, (BVC) * SHM_V); \
    if (DO_QK && NG == 2 && !V_NOEXP) { EXPS(P0, 0, 8); } if (DO_QK && NG != 2 && !V_NOMAX) { MAXFIN(); } SBAR(); \
    if (STG && grpB && !V_NOBAR) { __syncthreads(); } SBAR();   \
      \
    if (!V_NOPV) { o[2] = MFMA8(pf, vf[2], o[2]); MPIN(o[2]); } SBAR(); if (DO_QK && !V_NOEXP) { if (NG == 2) { EXPS(P0, 8, 16); } else { EXPS(P0, 0, 11); } } SBAR(); \
    if (!V_NOPV) { o[3] = MFMA8(pf, vf[0], o[3]); MPIN(o[3]); } SBAR(); if (DO_QK && !V_NOEXP) { if (NG == 2) { EXPS(P1, 0, 8); } else { EXPS(P0, 11, 16); EXPS(P1, 0, 6); } } \
    if (DO_KP) { kpf0 = KFR(0, (BKP) * SHM_K); kpf1 = KFR(1, (BKP) * SHM_K); } SBAR(); \
    if (!V_NOPV) { ol = MFMA8(pf, ones8, ol); MPIN(ol); } SBAR(); if (DO_QK && !V_NOEXP) { if (NG == 2) { EXPS(P1, 8, 16); } else { EXPS(P1, 6, 16); } } SBAR(); \
    if (DO_QK) { if (!V_NOPACK) { PACK0(); } RESC(al); } \
    if (!V_NOBAR && !(STG && grpB)) __syncthreads(); } while (0)
  __syncthreads();
  SLOAD(0); SWRITE(0); SLOAD(64); SWRITE(1); SLOAD(128); SWRITE(2); SLOAD(192); __syncthreads();
#pragma unroll
  for (int r = 0; r < 16; ++r) negm[r] = 0.f;
#pragma unroll
  for (int c = 0; c < NKC; ++c) { const v8i32 k0_ = KFR(2 * c, 0), k1_ = KFR(2 * c + 1, 0);
    if (c == 0) { P0 = MFMA8(k0_, qf[c], negm); P1 = MFMA8(k1_, qf[c], negm); } else { P0 = MFMA8(k0_, qf[c], P0); P1 = MFMA8(k1_, qf[c], P1); } }
  { float mx_ = P0[0];
#pragma unroll
    for (int r = 1; r < 16; ++r) mx_ = fmaxf(mx_, P0[r]);
#pragma unroll
    for (int r = 0; r < 16; ++r) mx_ = fmaxf(mx_, P1[r]);
    { auto rr_ = __builtin_amdgcn_permlane32_swap(__float_as_uint(mx_), __float_as_uint(mx_), false, false); mx_ = fmaxf(__uint_as_float(rr_[0]), __uint_as_float(rr_[1])); }
#pragma unroll
    for (int r = 0; r < 16; ++r) { P0[r] = __builtin_amdgcn_exp2f(P0[r] - mx_ + PSH); P1[r] = __builtin_amdgcn_exp2f(P1[r] - mx_ + PSH); negm[r] = PSH - mx_; } }
  PACKP();
  kpf0 = KFR(0, 1 * SHM_K); kpf1 = KFR(1, 1 * SHM_K);
  int t = 0;
  WConv wcv; int wc_it = wc_base + __builtin_amdgcn_readfirstlane(wid);
  for (; t + 7 < NT; t += 4) {
    STEP(1, 0, 3, 2, true, true, true, true, t);
    if constexpr (WC) wconv_load(*pp, wc_it, lane, wcv);
    STEP(2, 1, 0, 3, true, true, true, true, t + 1);
    STEP(3, 2, 1, 0, true, true, true, true, t + 2);
    if constexpr (WC) { wconv_store(*pp, wc_it, lane, wcv); wc_it += (int)gridDim.x * 8; }
    STEP(0, 3, 2, 1, true, true, true, true, t + 3);
  }
  STEP(1, 0, 3, 2, true, true, false, true, t);
  STEP(2, 1, 0, 3, true, false, false, true, t + 1);
  STEP(3, 2, 1, 0, true, false, false, false, t + 2);
  STEP(0, 3, 2, 1, false, false, false, false, t + 3);
  float rli[16];
#pragma unroll
  for (int r = 0; r < 16; ++r) rli[r] = __builtin_amdgcn_rcpf(ol[r]);
  if constexpr (OM == 1) {
    unsigned* st = (unsigned*)stash + tid;
#pragma unroll
    for (int r = 0; r < 16; ++r) { st[(2 * r) * 512] = cvt_pk_bf16(o[0][r] * rli[r], o[1][r] * rli[r]); st[(2 * r + 1) * 512] = cvt_pk_bf16(o[2][r] * rli[r], o[3][r] * rli[r]); }
  } else if constexpr (OM == 2) {
    const unsigned* st = (const unsigned*)stash + tid;
    float sw[4];
#pragma unroll
    for (int d0 = 0; d0 < 4; ++d0) sw[d0] = subw[d0 * 32 + r32] * 0.8f;
    bf16_t* Ow = Ob + (long)(wid * 32) * ldo;
#pragma unroll
    for (int r = 0; r < 16; ++r) { const unsigned w01 = st[(2 * r) * 512], w23 = st[(2 * r + 1) * 512];
      const float d0v = bflo(w01) - lam * (o[0][r] * rli[r]), d1v = bfhi(w01) - lam * (o[1][r] * rli[r]), d2v = bflo(w23) - lam * (o[2][r] * rli[r]), d3v = bfhi(w23) - lam * (o[3][r] * rli[r]);
      float ss = (d0v * d0v + d1v * d1v) + (d2v * d2v + d3v * d3v);
      ss += __shfl_xor(ss, 1); ss += __shfl_xor(ss, 2); ss += __shfl_xor(ss, 4); ss += __shfl_xor(ss, 8); ss += __shfl_xor(ss, 16);
      const float rn = rsqrtf(ss * (1.f / 128.f) + EPS); const long ob = (long)crow(r, hi) * ldo + r32;
      Ow[ob] = f2bf(SQ6(d0v * rn * sw[0])); Ow[ob + 32] = f2bf(SQ6(d1v * rn * sw[1])); Ow[ob + 64] = f2bf(SQ6(d2v * rn * sw[2])); Ow[ob + 96] = f2bf(SQ6(d3v * rn * sw[3])); }
  } else {
    bf16_t* Ow = Ob + (long)(wid * 32) * ldo;
#pragma unroll
    for (int r = 0; r < 16; ++r) { const int orow = crow(r, hi);
#pragma unroll
      for (int d0 = 0; d0 < 4; ++d0) Ow[(long)orow * ldo + d0 * 32 + r32] = f2bf(SQ6(o[d0][r] * rli[r] * 32.f) * (1.f / 32.f)); }
  }
#undef BL16
#undef SLOAD
#undef SWRITE
#undef RESC
#undef KFR
#undef VFR
#undef LDP
#undef STEP
#undef PACKP
#undef MPIN
#undef PACK0
#undef PACK1
#undef MAX0
#undef MAXFIN
#undef EXPS
}
#undef OFF8
#undef SBAR
#undef MFMA8
#undef LD32
}
#ifdef HW_XCD_MAP
__device__ __forceinline__ int att_cc(const Params& p, const char* lds, int u) {
    const volatile unsigned* bst = (const volatile unsigned*)(lds + 160 * 1024 - 512); const unsigned* cnt = (const unsigned*)(p.ws + WS_BAR) + 3500;
    bool ok = gridDim.x == 256;
#pragma unroll
    for (int i = 0; i < 8; ++i) ok = ok && (__hip_atomic_load(cnt + i, __ATOMIC_RELAXED, __HIP_MEMORY_SCOPE_AGENT) == 32u);
    return ok ? (int)(bst[2] + 8u * bst[3]) : -1;
}
#define ATT_CC(u) (hwcc_ >= 0 ? hwcc_ : ((u) & 255))
#else
#define ATT_CC(u) ((u) & 255)
#endif
#ifdef HW_XCD_MAP
#define ATT_CC_INIT const int hwcc_ = __builtin_amdgcn_readfirstlane(att_cc(p, lds, 0));
#else
#define ATT_CC_INIT
#endif
__device__ __forceinline__ void p4_attention_diff(const Params& p, char* lds) {
    unsigned char* ws = p.ws;
    const bf16_t* PJ = (const bf16_t*)(ws + WS_PJ); bf16_t* MIX = (bf16_t*)(ws + WS_MIX);
    char* stash = lds + 80 * 1024;
    ATT_CC_INIT
#if ATT_FP8 && WCONV_IN_ATT
    const int wcoff = gridDim.x == 256 ? 0 : attn8::WCONV_ITEMS;
    if (gridDim.x != 256) { const int tid_ = tid_opaque(), lane_ = tid_ & 63, gw_ = blockIdx.x * NWAVES + (tid_ >> 6), NGW_ = gridDim.x * NWAVES;
        for (int it = gw_; it < attn8::WCONV_ITEMS; it += NGW_) { attn8::WConv w_; attn8::wconv_load(p, it, lane_, w_); attn8::wconv_store(p, it, lane_, w_); } }
#else
    const int wcoff = 0;
#endif
    for (int u = blockIdx.x; u < 512 + ATT_EXTRA; u += gridDim.x) {
        const int round = (u >> 8) & 1, cc = ATT_CC(u), x = ATT_X(cc), j = ATT_J(cc);
        const int pd = x * 2 + round, b = pd >> 2, h = pd & 3;
        const size_t krow0 = (size_t)b * RPB, qrow0 = krow0 + CTX + (size_t)j * 256;
#if ATT_EXTRA
        if (u >= 512) { const unsigned char* vtx_ = ws + WS_VT8D + (size_t)(b * 4 + h) * 128 * RPB;
            attn8::attn_unit<1, 0, ATT_VAR>(ws + WS_Q8D + qrow0 * 512 + (2 * h) * 64, 512, ws + WS_K8D + krow0 * 512 + (2 * h) * 64, 512, nullptr, 0, nullptr, 0, vtx_, (bf16_t*)(ws + WS_AO) + qrow0 * 128, 128, RPB, lds);
            attn8::attn_unit<1, 0, ATT_VAR>(ws + WS_Q8D + qrow0 * 512 + (2 * h + 1) * 64, 512, ws + WS_K8D + krow0 * 512 + (2 * h + 1) * 64, 512, nullptr, 0, nullptr, 0, vtx_, (bf16_t*)(ws + WS_AO) + qrow0 * 128, 128, RPB, lds);
            continue; }
#endif
#if ATT_FP8
        const unsigned char* vt_ = ws + WS_VT8D + (size_t)(b * 4 + h) * 128 * RPB;
        const int wcb0 = wcoff + ((u / (int)gridDim.x) * 2 + 0) * 32 * (int)gridDim.x * 8 + (int)blockIdx.x * 8, wcb1 = wcb0 + 32 * (int)gridDim.x * 8;
        if (u < (int)gridDim.x) attn8::attn_unit<1, 1, 0, WCONV_IN_ATT != 0>(ws + WS_Q8D + qrow0 * 512 + (2 * h) * 64, 512, ws + WS_K8D + krow0 * 512 + (2 * h) * 64, 512, nullptr, 0, nullptr, 0, vt_, nullptr, 0, RPB, lds, stash, 0.f, nullptr, &p, wcoff + 131072 + (int)blockIdx.x * 8);
        else attn8::attn_unit<1, 1, 0, false>(ws + WS_Q8D + qrow0 * 512 + (2 * h) * 64, 512, ws + WS_K8D + krow0 * 512 + (2 * h) * 64, 512, nullptr, 0, nullptr, 0, vt_, nullptr, 0, RPB, lds, stash);
#else
        attn::attn_unit<1, 1, 0, 1>(PJ + qrow0 * NPROJ + (2 * h) * 64, NPROJ, PJ + krow0 * NPROJ + 512 + (2 * h) * 64, NPROJ, nullptr, 0, nullptr, 0,
                              PJ + krow0 * NPROJ + 1024 + h * 128, NPROJ, nullptr, 0, RPB, 1.f, lds, stash);
#endif
        const int lane_ = tid_opaque() & 63;
        const float s1 = wave_sum(p.lq1[lane_] * p.lk1[lane_]), s2 = wave_sum(p.lq2[lane_] * p.lk2[lane_]);
        const float lam = __expf(s1) - __expf(s2) + 0.2f;
#if ATT_FP8
        attn8::attn_unit<1, 2, 0, false>(ws + WS_Q8D + qrow0 * 512 + (2 * h + 1) * 64, 512, ws + WS_K8D + krow0 * 512 + (2 * h + 1) * 64, 512, nullptr, 0, nullptr, 0, vt_, MIX + qrow0 * 1024 + h * 128, 1024, RPB, lds, stash, lam, p.subln_w, &p, wcb1);
#else
        attn::attn_unit<1, 1, 0, 2>(PJ + qrow0 * NPROJ + (2 * h + 1) * 64, NPROJ, PJ + krow0 * NPROJ + 512 + (2 * h + 1) * 64, NPROJ, nullptr, 0, nullptr, 0,
                              PJ + krow0 * NPROJ + 1024 + h * 128, NPROJ, MIX + qrow0 * 1024 + h * 128, 1024, RPB, 1.f, lds, stash, lam, p.subln_w);
#endif
    }
}
__device__ __forceinline__ void p4_attention_mla(const Params& p, char* lds) {
    unsigned char* ws = p.ws;
    const bf16_t* PJ = (const bf16_t*)(ws + WS_PJ); const bf16_t* QM = (const bf16_t*)(ws + WS_QM); const bf16_t* KVb = (const bf16_t*)(ws + WS_KV);
    bf16_t* MIX = (bf16_t*)(ws + WS_MIX);
    constexpr float LOG2E = 1.4426950408889634f;
    ATT_CC_INIT
    for (int u = blockIdx.x; u < 512; u += gridDim.x) {
        const int round = u >> 8, cc = ATT_CC(u), x = ATT_X(cc), j = ATT_J(cc);
        const int pd = x * 2 + round, b = pd >> 2, h = pd & 3;
        const size_t krow0 = (size_t)b * RPB, qrow0 = krow0 + CTX + (size_t)j * 256;
#if ATT_FP8
        const int wcb = (gridDim.x == 256 ? 0 : attn8::WCONV_ITEMS) + (u / (int)gridDim.x) * 32 * (int)gridDim.x * 8 + (int)blockIdx.x * 8;
        attn8::attn_unit<3, 0, 0, WCONV_IN_ATT != 0>(ws + WS_Q8M + qrow0 * 768 + h * 192, 768, ws + WS_K8M + krow0 * 512 + h * 128, 512, ws + WS_K8M + krow0 * 512 + h * 128 + 64, 512, ws + WS_KR8 + krow0 * 64, 64,
                               ws + WS_VT8M + (size_t)(b * 4 + h) * 128 * RPB, MIX + qrow0 * 1024 + 512 + h * 128, 1024, RPB, lds, nullptr, 0.f, nullptr, &p, wcb);
#else
        attn::attn_unit<3, MLA_NQR>(QM + qrow0 * 768 + h * 192, 768, KVb + krow0 * 1024 + h * 256, 1024, KVb + krow0 * 1024 + h * 256 + 64, 1024, PJ + krow0 * NPROJ + 1920, NPROJ,
                              KVb + krow0 * 1024 + h * 256 + 128, 1024, MIX + qrow0 * 1024 + 512 + h * 128, 1024, RPB, 0.07216878364870322f * LOG2E, lds);
#endif
    }
}

__device__ __forceinline__ void p5_mix(const Params& p) {
    const int tid = tid_opaque(), lane = tid & 63, wave = tid >> 6;
    const int gw = blockIdx.x * NWAVES + wave, NGW = gridDim.x * NWAVES;
    const bf16_t* AO = (const bf16_t*)(p.ws + WS_AO); bf16_t* MIX = (bf16_t*)(p.ws + WS_MIX);
    const float s1 = wave_sum(p.lq1[lane] * p.lk1[lane]), s2 = wave_sum(p.lq2[lane] * p.lk2[lane]);
    const float lam_init = 0.2f, lam = __expf(s1) - __expf(s2) + lam_init;
    const int hh = lane >> 4, e0 = (lane & 15) * 8;
    float sw[8];
#pragma unroll
    for (int i = 0; i < 8; ++i) sw[i] = p.subln_w[e0 + i] * (1.f - lam_init);
    for (int t = gw; t < T; t += NGW) {
        const int b = t >> 13, row = b * RPB + CTX + (t & 8191);
        const bf16_t* src = AO + (size_t)row * 1536;
        const u32x4 a = *(const u32x4*)(src + hh * 256 + e0), bq = *(const u32x4*)(src + hh * 256 + 128 + e0), mq = *(const u32x4*)(src + 1024 + lane * 8);
        float o[8];
        o[0] = bflo(a.x) - lam * bflo(bq.x); o[1] = bfhi(a.x) - lam * bfhi(bq.x); o[2] = bflo(a.y) - lam * bflo(bq.y); o[3] = bfhi(a.y) - lam * bfhi(bq.y);
        o[4] = bflo(a.z) - lam * bflo(bq.z); o[5] = bfhi(a.z) - lam * bfhi(bq.z); o[6] = bflo(a.w) - lam * bflo(bq.w); o[7] = bfhi(a.w) - lam * bfhi(bq.w);
        float ss = 0.f;
#pragma unroll
        for (int i = 0; i < 8; ++i) ss += o[i] * o[i];
        ss += __shfl_xor(ss, 1); ss += __shfl_xor(ss, 2); ss += __shfl_xor(ss, 4); ss += __shfl_xor(ss, 8);
        const float r = rsqrtf(ss * (1.f / 128.f) + EPS);
        u32x4 w; w.x = cvt_pk_bf16(o[0] * r * sw[0], o[1] * r * sw[1]); w.y = cvt_pk_bf16(o[2] * r * sw[2], o[3] * r * sw[3]);
        w.z = cvt_pk_bf16(o[4] * r * sw[4], o[5] * r * sw[5]); w.w = cvt_pk_bf16(o[6] * r * sw[6], o[7] * r * sw[7]);
        bf16_t* dst = MIX + (size_t)row * 1024;
        *(u32x4*)(dst + hh * 128 + e0) = w; *(u32x4*)(dst + 512 + lane * 8) = mq;
    }
}

typedef short bf16x8_t __attribute__((ext_vector_type(8)));
__device__ __forceinline__ void p7a_route(const Params& p, unsigned char* lds) {
    const int tid = tid_opaque(), lane = tid & 63, wave = tid >> 6, row = lane & 15, kq = lane >> 4;
    int* lcnt = (int*)(lds + 147456); int* lbase = lcnt + 32; int* tok_e = lbase + 32; int* tok_r = tok_e + 1024;
    for (int i = tid; i < 8192; i += NTHREADS) ((u32x4*)lds)[i] = ((const u32x4*)(p.ws + WS_RWF))[i];
    if (tid < 32) lcnt[tid] = 0;
    const int chunk = (T + gridDim.x - 1) / gridDim.x;
    const int t0 = blockIdx.x * chunk, t1 = (t0 + chunk < T) ? t0 + chunk : T;
    float* vab = (float*)(lds + 131072); const int b0 = t0 >> 13;
    { const float* mods_ = (const float*)(p.ws + WS_MODS);
      for (int i = tid; i < 2048; i += NTHREADS) { const int bb = min(b0 + (i >> 10), NB - 1), k = i & 1023; const float* md_ = mods_ + bb * 6144;
          vab[(i >> 10) * 2048 + k] = p.ffn_norm_w[k] * (md_[4 * 1024 + k] + 1.f); vab[(i >> 10) * 2048 + 1024 + k] = md_[3 * 1024 + k]; } }
    __syncthreads();
    const bf16_t* XN = (const bf16_t*)(p.ws + WS_XN); const float* mods = (const float*)(p.ws + WS_MODS);
    unsigned char* HF = p.ws + WS_HF;
    int* TOPI = (int*)(p.ws + WS_TOPI); float* GATE = (float*)(p.ws + WS_GATE); int* RANK = (int*)(p.ws + WS_RANK); int* CNT = (int*)(p.ws + WS_CNT);
    const u32x4* rwf = (const u32x4*)lds + lane;
    for (int tb = t0 + 16 * wave; tb < t1; tb += 16 * NWAVES) {
        const int t = tb + row, b = tb >> 13; const float* md = mods + b * 6144;
        const bf16_t* xr = XN + (size_t)t * DM + 8 * kq;
        const float r = rsqrtf(((const float*)(p.ws + WS_RSX))[t] * (1.f / DM) + EPS);
        f32x4 acc0 = {0.f, 0.f, 0.f, 0.f}, acc1 = {0.f, 0.f, 0.f, 0.f};
        const float* va = vab + ((tb >> 13) - b0) * 2048 + 8 * kq; const float* vb = va + 1024;
        u32x4 xq[4];
#pragma unroll
        for (int j = 0; j < 4; ++j) xq[j] = *(const u32x4*)(xr + 32 * j);
#pragma unroll 4
        for (int s = 0; s < 32; ++s) { const int k0 = 32 * s + 8 * kq;
            const u32x4 xw = xq[s & 3]; if (s + 4 < 32) xq[s & 3] = *(const u32x4*)(xr + 32 * (s + 4));
            const f32x4 xa = {bflo(xw.x), bfhi(xw.x), bflo(xw.y), bfhi(xw.y)}, xc = {bflo(xw.z), bfhi(xw.z), bflo(xw.w), bfhi(xw.w)};
            const f32x4 ha = xa * r * *(const f32x4*)(va + 32 * s) + *(const f32x4*)(vb + 32 * s), hc = xc * r * *(const f32x4*)(va + 32 * s + 4) + *(const f32x4*)(vb + 32 * s + 4);
            u32x4 hi, lo;
            hi.x = cvt_pk_bf16(ha.x, ha.y); hi.y = cvt_pk_bf16(ha.z, ha.w); hi.z = cvt_pk_bf16(hc.x, hc.y); hi.w = cvt_pk_bf16(hc.z, hc.w);
            lo.x = cvt_pk_bf16(ha.x - bflo(hi.x), ha.y - bfhi(hi.x)); lo.y = cvt_pk_bf16(ha.z - bflo(hi.y), ha.w - bfhi(hi.y));
            lo.z = cvt_pk_bf16(hc.x - bflo(hi.z), hc.y - bfhi(hi.z)); lo.w = cvt_pk_bf16(hc.z - bflo(hi.w), hc.w - bfhi(hi.w));
            { u32x2 h8; h8.x = cvt4_fp8(ha.x, ha.y, ha.z, ha.w); h8.y = cvt4_fp8(hc.x, hc.y, hc.z, hc.w); *(u32x2*)(HF + (size_t)t * DM + k0) = h8; }
            const bf16x8_t Ah = __builtin_bit_cast(bf16x8_t, hi), Al = __builtin_bit_cast(bf16x8_t, lo);
            const bf16x8_t Bh0 = __builtin_bit_cast(bf16x8_t, rwf[(s * 4 + 0) * 64]), Bl0 = __builtin_bit_cast(bf16x8_t, rwf[(s * 4 + 1) * 64]);
            const bf16x8_t Bh1 = __builtin_bit_cast(bf16x8_t, rwf[(s * 4 + 2) * 64]), Bl1 = __builtin_bit_cast(bf16x8_t, rwf[(s * 4 + 3) * 64]);
            acc0 = __builtin_amdgcn_mfma_f32_16x16x32_bf16(Ah, Bh0, acc0, 0, 0, 0); acc0 = __builtin_amdgcn_mfma_f32_16x16x32_bf16(Ah, Bl0, acc0, 0, 0, 0); acc0 = __builtin_amdgcn_mfma_f32_16x16x32_bf16(Al, Bh0, acc0, 0, 0, 0);
            acc1 = __builtin_amdgcn_mfma_f32_16x16x32_bf16(Ah, Bh1, acc1, 0, 0, 0); acc1 = __builtin_amdgcn_mfma_f32_16x16x32_bf16(Ah, Bl1, acc1, 0, 0, 0); acc1 = __builtin_amdgcn_mfma_f32_16x16x32_bf16(Al, Bh1, acc1, 0, 0, 0); }
        const float rb0 = p.router_b[row], rb1 = p.router_b[16 + row];
#pragma unroll
        for (int reg = 0; reg < 4; ++reg) { float v0 = acc0[reg] + rb0, v1 = acc1[reg] + rb1; float tv[4]; int ti[4];
#pragma unroll
            for (int k = 0; k < 4; ++k) { float m = fmaxf(v0, v1);
                m = fmaxf(m, __shfl_xor(m, 1)); m = fmaxf(m, __shfl_xor(m, 2)); m = fmaxf(m, __shfl_xor(m, 4)); m = fmaxf(m, __shfl_xor(m, 8));
                int cand = (v0 == m) ? row : ((v1 == m) ? 16 + row : 99);
                cand = min(cand, __shfl_xor(cand, 1)); cand = min(cand, __shfl_xor(cand, 2)); cand = min(cand, __shfl_xor(cand, 4)); cand = min(cand, __shfl_xor(cand, 8));
                tv[k] = m; ti[k] = cand; if (cand == row) v0 = -INFINITY; if (cand == 16 + row) v1 = -INFINITY; }
            const float e1 = __expf(tv[1] - tv[0]), e2 = __expf(tv[2] - tv[0]), e3 = __expf(tv[3] - tv[0]); const float inv = 1.f / (1.f + e1 + e2 + e3);
            const int tt = tb + 4 * kq + reg;
            if (row < 4 && tt < t1) { const int ei = row == 0 ? ti[0] : row == 1 ? ti[1] : row == 2 ? ti[2] : ti[3]; const float gv = (row == 0 ? 1.f : row == 1 ? e1 : row == 2 ? e2 : e3) * inv;
                const int lr = atomicAdd(&lcnt[ei], 1);
                TOPI[tt * 4 + row] = ei; GATE[tt * 4 + row] = gv; tok_e[(tt - t0) * 4 + row] = ei; tok_r[(tt - t0) * 4 + row] = lr; } }
    }
    __syncthreads();
    if (tid < 32) lbase[tid] = atomicAdd(&CNT[tid], lcnt[tid]);
    __syncthreads();
    for (int i = tid; i < (t1 - t0) * 4; i += NTHREADS) RANK[t0 * 4 + i] = lbase[tok_e[i]] + tok_r[i];
}

__device__ __forceinline__ void moe_segments(const Params& p, int* seg) {
    if (threadIdx.x == 0) { const int* CNT = (const int*)(p.ws + WS_CNT); int s = 0;
        for (int e = 0; e < 32; ++e) { seg[e] = s; s += (CNT[e] + 255) & ~255; } seg[32] = s; }
    __syncthreads();
}
__device__ __forceinline__ void p7b_scatter(const Params& p, const int* seg) {
    const int tid = tid_opaque();
    const int gt = blockIdx.x * NTHREADS + tid, NGT = gridDim.x * NTHREADS;
    const int* TOPI = (const int*)(p.ws + WS_TOPI); const float* GATE = (const float*)(p.ws + WS_GATE); const int* RANK = (const int*)(p.ws + WS_RANK);
    int* DEST = (int*)(p.ws + WS_DEST); float* GS = (float*)(p.ws + WS_GSRT); int* RTOK = (int*)(p.ws + WS_RTOK);
    for (int i = gt; i < T * 4; i += NGT) { const int dest = seg[TOPI[i]] + RANK[i]; DEST[i] = dest; GS[dest] = GATE[i]; RTOK[dest] = i >> 2; }
}
__device__ __forceinline__ void p10_final(const Params& p, const bool with_moe) {
    const int tid = tid_opaque(), lane = tid & 63, wave = tid >> 6;
    const int gw = blockIdx.x * NWAVES + wave, NGW = gridDim.x * NWAVES;
    const bf16_t* XN = (const bf16_t*)(p.ws + WS_XN); const float* mods = (const float*)(p.ws + WS_MODS);
    const int* DEST = (const int*)(p.ws + WS_DEST);
    const f32x4* w4 = (const f32x4*)p.final_norm_w;
    for (int tb = gw; tb < T; tb += P10_NT * NGW) {
        int tt[P10_NT]; bool ok[P10_NT]; u32x2 xw[P10_NT][4];
#if YS_FP8
        unsigned yw[P10_NT][4][4];
#else
        u32x2 yw[P10_NT][4][4];
#endif
#pragma unroll
        for (int q = 0; q < P10_NT; ++q) { const int t_ = tb + q * NGW; ok[q] = t_ < T; tt[q] = ok[q] ? t_ : tb; }
#pragma unroll
        for (int q = 0; q < P10_NT; ++q) { const u32x2* xr = (const u32x2*)(XN + (size_t)tt[q] * DM);
#pragma unroll
            for (int j = 0; j < 4; ++j) xw[q][j] = xr[64 * j + lane];
            if (with_moe) {
#pragma unroll
                for (int k = 0; k < 4; ++k) { const int d = DEST[tt[q] * 4 + k];
#if YS_FP8
                    const unsigned* yr = (const unsigned*)(p.ws + WS_XS + (size_t)d * 1024);
#else
                    const u32x2* yr = (const u32x2*)(p.ws + WS_XS + (size_t)d * 2048);
#endif
#pragma unroll
                    for (int j = 0; j < 4; ++j) yw[q][k][j] = yr[64 * j + lane]; } } }
#pragma unroll
        for (int q = 0; q < P10_NT; ++q) { const int t = tt[q], b = t >> 13; const f32x4* g4 = (const f32x4*)(mods + b * 6144 + 5 * 1024);
            f32x4 xv[4];
#pragma unroll
            for (int j = 0; j < 4; ++j) { xv[j] = (f32x4){bflo(xw[q][j].x), bfhi(xw[q][j].x), bflo(xw[q][j].y), bfhi(xw[q][j].y)};
                if (with_moe) { f32x4 y = {0.f, 0.f, 0.f, 0.f};
#pragma unroll
                    for (int k = 0; k < 4; ++k) {
#if YS_FP8
                        const int w_ = (int)yw[q][k][j]; const auto lo_ = __builtin_amdgcn_cvt_pk_f32_fp8(w_, false), hi_ = __builtin_amdgcn_cvt_pk_f32_fp8(w_, true);
                        y += (f32x4){lo_[0], lo_[1], hi_[0], hi_[1]};
#else
                        const u32x2 w_ = yw[q][k][j]; y += (f32x4){bflo(w_.x), bfhi(w_.x), bflo(w_.y), bfhi(w_.y)};
#endif
                    }
                    xv[j] += g4[64 * j + lane] * y * (YS_FP8 ? 1.f / YS_SCALE : 1.f); } }
            float s = 0.f;
#pragma unroll
            for (int j = 0; j < 4; ++j) s += (xv[j].x * xv[j].x + xv[j].y * xv[j].y) + (xv[j].z * xv[j].z + xv[j].w * xv[j].w);
            float r = rsqrtf(wave_sum(s) * (1.f / DM) + EPS);
#if DBG_STAGE
            r *= 1.f + 10.f * fminf(__uint_as_float(((const unsigned*)(p.ws + WS_CNT))[64]), 100.f);
#endif
            if (ok[q]) { f32x4* o = (f32x4*)(p.out + (size_t)t * DM);
#pragma unroll
                for (int j = 0; j < 4; ++j) o[64 * j + lane] = xv[j] * r * w4[64 * j + lane]; }
        }
    }
}
#if DBG_STAGE
__device__ __forceinline__ void dbg_report(const Params& p, float err) {
    if (!(err >= 0.f)) err = 1e6f;
    atomicMax((unsigned*)(p.ws + WS_CNT) + 64, __float_as_uint(err));
}
__device__ __forceinline__ void dbg_rope(float& x1, float& x2, int pv, int pp) {
    const float inv = exp2f(-(float)pp * (13.287712379549449f / 16.f)); float sn, cs; sincosf((float)pv * inv, &sn, &cs);
    const float a = x1 * cs - x2 * sn, b = x2 * cs + x1 * sn; x1 = a; x2 = b;
}
__device__ __forceinline__ void dbg_check_proj(const Params& p) {
    const int gt = blockIdx.x * NTHREADS + threadIdx.x, NGT = gridDim.x * NTHREADS;
    const bf16_t* HB = (const bf16_t*)(p.ws + WS_HB); const bf16_t* PJ = (const bf16_t*)(p.ws + WS_PJ); const bf16_t* QM = (const bf16_t*)(p.ws + WS_QM); const bf16_t* KVb = (const bf16_t*)(p.ws + WS_KV);
    float emax = 0.f;
    for (int it = gt; it < 24 * 224; it += NGT) { const int rs = it / 224, cpi = it % 224; const int row = rs < 6 ? (rs & 3) * RPB + (rs * 37) % CTX : (rs * 1409 + 77) % MALL; const int grp = cpi >> 4, pp = cpi & 15, c0 = 1536 + grp * 32 + pp, c1 = c0 + 16;
        float a0 = 0.f, a1 = 0.f;
        for (int k = 0; k < 1024; ++k) { const float h = bf2f(HB[(size_t)row * 1024 + k]); a0 += h * bf2f(f2bf(p.w_in[(size_t)k * 1984 + c0])); a1 += h * bf2f(f2bf(p.w_in[(size_t)k * 1984 + c1])); }
        const int i = row % RPB; if (i >= CTX && c0 >= 1920) { const int pos = i - CTX, a = (c0 >> 5) & 1; dbg_rope(a0, a1, a ? (pos & 63) : (pos >> 6), pp); }
        const float f0 = bf2f(PJ[(size_t)row * NPROJ + c0]), f1 = bf2f(PJ[(size_t)row * NPROJ + c1]);
        emax = fmaxf(emax, fmaxf(fabsf(f0 - a0), fabsf(f1 - a1))); }
    for (int it = gt; it < 24 * 384; it += NGT) { const int rs = it / 384, cpi = it % 384; const int row = rs < 6 ? (rs & 3) * RPB + (rs * 41) % CTX : (rs * 1409 + 300) % MALL; const int grp = cpi >> 4, pp = cpi & 15, c0 = grp * 32 + pp, c1 = c0 + 16;
        float ss = 0.f, a0 = 0.f, a1 = 0.f;
        for (int k = 0; k < 256; ++k) { const float v = bf2f(PJ[(size_t)row * NPROJ + 1536 + k]); ss += v * v; const float vw = v * p.q_norm_w[k]; a0 += vw * p.w_uq[(size_t)k * 768 + c0]; a1 += vw * p.w_uq[(size_t)k * 768 + c1]; }
        const float r = rsqrtf(ss / 256.f + EPS); a0 *= r; a1 *= r;
        const int i = row % RPB, g6 = grp % 6; if (i >= CTX && g6 >= 4) { const int pos = i - CTX; dbg_rope(a0, a1, g6 == 5 ? (pos & 63) : (pos >> 6), pp); }
        const float f0 = bf2f(QM[(size_t)row * 768 + c0]), f1 = bf2f(QM[(size_t)row * 768 + c1]);
        emax = fmaxf(emax, fmaxf(fabsf(f0 - a0), fabsf(f1 - a1))); }
    for (int it = gt; it < 24 * 1024; it += NGT) { const int rs = it >> 10, c0 = it & 1023; const int row = rs < 6 ? (rs & 3) * RPB + (rs * 43) % CTX : (rs * 1409 + 555) % MALL;
        float ss = 0.f, a0 = 0.f;
        for (int k = 0; k < 128; ++k) { const float v = bf2f(PJ[(size_t)row * NPROJ + 1792 + k]); ss += v * v; a0 += v * p.kv_norm_w[k] * p.w_ukv[(size_t)k * 1024 + c0]; }
        a0 *= rsqrtf(ss / 128.f + EPS);
        emax = fmaxf(emax, fabsf(bf2f(KVb[(size_t)row * 1024 + c0]) - a0)); }
    emax = wave_max(emax);
    if ((threadIdx.x & 63) == 0) dbg_report(p, emax);
}
__device__ __forceinline__ void dbg_check_attn(const Params& p, unsigned char* lds, int kind_sel) {
    const int tid = threadIdx.x;
    const bf16_t* PJ = (const bf16_t*)(p.ws + WS_PJ); const bf16_t* QM = (const bf16_t*)(p.ws + WS_QM); const bf16_t* KVb = (const bf16_t*)(p.ws + WS_KV); const bf16_t* AO = (const bf16_t*)(p.ws + WS_MIX);
    float* sc = (float*)lds; float* red = sc + 8448; float* qv = red + 1024;
    for (int s = blockIdx.x; s < 128; s += gridDim.x) {
        const int kind = s & 1; if (kind_sel >= 0 && kind != kind_sel) continue;
        const int b = (s >> 1) & 3, hh = (s >> 3) & 7, qpos = ((s >> 1) * 2731 + 13) & 8191;
        const size_t krow0 = (size_t)b * RPB, qrow = krow0 + CTX + qpos;
        const int dqk = kind ? 192 : 64; const int h = kind ? (hh & 3) : hh;
#if ATT_FP8
        const float scale = 0.6931471805599453f;
        const unsigned char* W8 = p.ws;
#define F8(ptr) __builtin_amdgcn_cvt_f32_fp8((int)(*(const unsigned char*)(ptr)), 0)
        __syncthreads();
        if (tid < dqk) qv[tid] = kind ? F8(W8 + WS_Q8M + qrow * 768 + h * 192 + tid) : F8(W8 + WS_Q8D + qrow * 512 + h * 64 + tid);
        __syncthreads();
        float lmax = -1e30f;
        for (int k = tid; k < RPB; k += NTHREADS) { float a = 0.f;
            if (kind) { for (int d = 0; d < 128; ++d) a += qv[d] * F8(W8 + WS_K8M + (krow0 + k) * 512 + h * 128 + d); for (int d = 0; d < 64; ++d) a += qv[128 + d] * F8(W8 + WS_KR8 + (krow0 + k) * 64 + d); }
            else { for (int d = 0; d < 64; ++d) a += qv[d] * F8(W8 + WS_K8D + (krow0 + k) * 512 + h * 64 + d); }
            a *= scale; sc[k] = a; lmax = fmaxf(lmax, a); }
#else
        const float scale = kind ? 0.07216878364870322f : 0.6931471805599453f;
        __syncthreads();
        if (tid < dqk) qv[tid] = kind ? bf2f(QM[qrow * 768 + h * 192 + tid]) : bf2f(PJ[qrow * NPROJ + h * 64 + tid]);
        __syncthreads();
        float lmax = -1e30f;
        for (int k = tid; k < RPB; k += NTHREADS) { float a = 0.f;
            if (kind) { for (int d = 0; d < 128; ++d) a += qv[d] * bf2f(KVb[(krow0 + k) * 1024 + h * 256 + d]); for (int d = 0; d < 64; ++d) a += qv[128 + d] * bf2f(PJ[(krow0 + k) * NPROJ + 1920 + d]); }
            else { for (int d = 0; d < 64; ++d) a += qv[d] * bf2f(PJ[(krow0 + k) * NPROJ + 512 + h * 64 + d]); }
            a *= scale; sc[k] = a; lmax = fmaxf(lmax, a); }
#endif
        lmax = wave_max(lmax); if ((tid & 63) == 0) red[tid >> 6] = lmax; __syncthreads();
        float m = red[0]; for (int w = 1; w < 8; ++w) m = fmaxf(m, red[w]); __syncthreads();
        float lsum = 0.f; for (int k = tid; k < RPB; k += NTHREADS) { const float e = __expf(sc[k] - m); sc[k] = e; lsum += e; }
        lsum = wave_sum(lsum); if ((tid & 63) == 0) red[tid >> 6] = lsum; __syncthreads();
        float l = 0.f; for (int w = 0; w < 8; ++w) l += red[w]; __syncthreads();
        const int e = tid & 127, part = tid >> 7; float o = 0.f;
#if ATT_FP8
        for (int k = part; k < RPB; k += 4) { const unsigned char* vt = p.ws + (kind ? WS_VT8M : WS_VT8D) + ((size_t)(b * 4 + (kind ? h : (h >> 1))) * 128 + e) * RPB + (k & ~63) + vt_pos(k & 63); o += sc[k] * F8(vt); }
#else
        for (int k = part; k < RPB; k += 4) { const float v = kind ? bf2f(KVb[(krow0 + k) * 1024 + h * 256 + 128 + e]) : bf2f(PJ[(krow0 + k) * NPROJ + 1024 + (h >> 1) * 128 + e]); o += sc[k] * v; }
#endif
        red[tid] = o; __syncthreads();
        if (tid < 128) { const float on = (red[tid] + red[tid + 128] + red[tid + 256] + red[tid + 384]) / l;
            const float of = bf2f(AO[qrow * 1024 + 512 + h * 128 + tid]);
            float d2 = (of - on) * (of - on), n2 = on * on;
            d2 = wave_sum(d2); n2 = wave_sum(n2); red[512 + (tid >> 6) * 2] = d2; red[512 + (tid >> 6) * 2 + 1] = n2; }
        __syncthreads();
        if (tid == 0) { const float d2 = red[512] + red[514], n2 = red[513] + red[515]; dbg_report(p, sqrtf(d2 / (n2 + 1e-30f))); }
    }
    __syncthreads();
}
#endif
typedef const __attribute__((address_space(4))) Params* ParamsK;
#if defined(__HIP_DEVICE_COMPILE__)
#define LOAD_PARAMS() ({ ParamsK q_ = (ParamsK)__builtin_amdgcn_kernarg_segment_ptr(); asm volatile("" : "+s"(q_)); Params r_ = *q_; r_; })
#else
#define LOAD_PARAMS() (Params{})
#endif
#ifndef FIRST_PHASE
#define FIRST_PHASE 0
#endif
#define PH(k) ((k) >= FIRST_PHASE && (k) <= LAST_PHASE)
#ifndef EPIY_PROBE
#define EPIY_PROBE 0
#endif
#ifndef REP_MASK
#define REP_MASK 0
#endif
#define REP(k) for (int rep_ = 0; rep_ < (((REP_MASK) >> (k)) & 1) + 1; ++rep_)
#define PH_BEGIN { const Params p = LOAD_PARAMS(); unsigned char* ws = p.ws; (void)ws;
#define PH_END }
__global__ void __launch_bounds__(NTHREADS, 2) fwd_kernel(Params p_unused) {
    extern __shared__ __attribute__((aligned(16))) unsigned char lds[];
    cg::grid_group grid = cg::this_grid();
    LAS unsigned char* lds3 = (LAS unsigned char*)lds;
    const int G = gridDim.x, c = blockIdx.x;
    int* seg = (int*)(lds + 160 * 1024 - 256);
    volatile LAS unsigned* bst = (volatile LAS unsigned*)(lds3 + 160 * 1024 - 512);
    if (threadIdx.x < 2) bst[threadIdx.x] = 0u;
    __syncthreads();
    XcdBarrier bar;
    { ParamsK q_ = (ParamsK)__builtin_amdgcn_kernarg_segment_ptr(); bar = xcd_barrier_post((unsigned*)(q_->ws + WS_BAR), bst);
#ifdef HW_XCD_MAP
      if (threadIdx.x == 0) { const unsigned x_ = xb_xcc_id() & 7u; bst[2] = x_; bst[3] = atomicAdd((unsigned*)(q_->ws + WS_BAR) + 3500 + x_, 1u); }
#endif
    }
#ifdef USE_CG_SYNC
#define GRID_SYNC() grid.sync()
#else
#define GRID_SYNC() xcd_barrier(bar)
#endif

#ifdef ONLY4
#ifndef NO_DIFF
    PH_BEGIN p4_attention_diff(p, (char*)lds); PH_END
#endif
#ifndef NO_MLA
    PH_BEGIN p4_attention_mla(p, (char*)lds); PH_END
#endif
    return;
#endif
#ifdef UBENCH
    { typedef int v8i32_ __attribute__((ext_vector_type(8))); typedef float f32x16_ __attribute__((ext_vector_type(16))); typedef int v4i32_ __attribute__((ext_vector_type(4)));
      const int wv_ = __builtin_amdgcn_readfirstlane((int)threadIdx.x >> 6);
      float s_ = 0.f;
      LAS v4i32_* lp_ = (LAS v4i32_*)(lds3 + 65536) + threadIdx.x * 2;
      if (wv_ >= 4) { if (UBENCH != 5) {
          v8i32_ a_ = {(int)threadIdx.x, 1, 2, 3, 4, 5, 6, 7}, b_ = {7, 6, 5, 4, 3, 2, 1, (int)blockIdx.x}; f32x16_ c0 = {}, c1 = {}, c2 = {}, c3 = {}, c4 = {};
          for (int it = 0; it < 10000; ++it) {
              if (UBENCH >= 8) { const v4i32_ x0 = lp_[0], x1 = lp_[1]; b_ = __builtin_shufflevector(x0, x1, 0, 1, 2, 3, 4, 5, 6, 7); }
              c0 = __builtin_amdgcn_mfma_scale_f32_32x32x64_f8f6f4(a_, b_, c0, 0, 0, 0, 0, 0, 0); c1 = __builtin_amdgcn_mfma_scale_f32_32x32x64_f8f6f4(a_, b_, c1, 0, 0, 0, 0, 0, 0);
              c2 = __builtin_amdgcn_mfma_scale_f32_32x32x64_f8f6f4(a_, b_, c2, 0, 0, 0, 0, 0, 0); c3 = __builtin_amdgcn_mfma_scale_f32_32x32x64_f8f6f4(a_, b_, c3, 0, 0, 0, 0, 0, 0);
              c4 = __builtin_amdgcn_mfma_scale_f32_32x32x64_f8f6f4(a_, b_, c4, 0, 0, 0, 0, 0, 0); __builtin_amdgcn_sched_barrier(0);
              if (UBENCH >= 7) __syncthreads(); }
#pragma unroll
          for (int i = 0; i < 16; ++i) s_ += c0[i] + c1[i] + c2[i] + c3[i] + c4[i]; } }
      else if (UBENCH != 6) {
          float e_[32]; unsigned pk_[8];
#pragma unroll
          for (int i = 0; i < 32; ++i) e_[i] = (float)(threadIdx.x + i) * 1e-3f;
#pragma unroll
          for (int i = 0; i < 8; ++i) pk_[i] = 0u;
          for (int it = 0; it < 10000; ++it) {
              float m_ = e_[0];
#pragma unroll
              for (int i = 1; i < 31; i += 2) m_ = __builtin_fmaxf(__builtin_fmaxf(m_, e_[i]), e_[i + 1]);
#pragma unroll
              for (int i = 0; i < 32; ++i) e_[i] = __builtin_amdgcn_exp2f(e_[i] - m_);
#pragma unroll
              for (int i = 0; i < 8; ++i) pk_[i] = cvt4_fp8o((int)pk_[i], e_[4 * i], e_[4 * i + 1], e_[4 * i + 2], e_[4 * i + 3]);
              if (UBENCH >= 8) { lp_[0] = (v4i32_){(int)pk_[0], (int)pk_[1], (int)pk_[2], (int)pk_[3]}; lp_[1] = (v4i32_){(int)pk_[4], (int)pk_[5], (int)pk_[6], (int)pk_[7]}; }
              __builtin_amdgcn_sched_barrier(0);
              if (UBENCH >= 7) __syncthreads(); }
#pragma unroll
          for (int i = 0; i < 8; ++i) s_ += (float)pk_[i]; }
      if (s_ == 123.456f) ((float*)(LOAD_PARAMS().ws + WS_CNT))[100] = s_; }
#endif
#if PH(0)
    REP(0) { PH_BEGIN p0_prologue(p, lds); PH_END
    GRID_SYNC(); }
    if (gridDim.y == 0x7fffffffu) grid.sync();
#endif
    REP(2) {
#if PH(1)
    PH_BEGIN p1_rows(p); PH_END
    GRID_SYNC();
#endif
#if PH(2)
    PH_BEGIN { pg8::Gemm g{(const bf16_t*)(ws + WS_HB), 1024, (const bf16_t*)(ws + WS_WIN), 1024}; ProjOrder S; S.init(G, c, 0);
      EpiProj E{(bf16_t*)(ws + WS_PJ), (const f32x2*)(ws + WS_ROPE), (float*)(ws + WS_RSQ), (float*)(ws + WS_RSKV), ws};
      pg8::gemm_phase<EpiProj, ProjOrder>(lds3, g, S, E); } PH_END
    GRID_SYNC();
#endif
    }
#if PH(3)
    REP(3) {
    const bool p3split = (G == 256); const int G3 = p3split ? G - 32 : G, c3 = p3split ? c - 32 : c;
    if (p3split && c < 32) {
    PH_BEGIN { pg8::Gemm g{(const bf16_t*)(ws + WS_HB), 1024, (const bf16_t*)(ws + WS_WIN), 1024}; ProjOrder S; S.init(G, c, 1);
      EpiProj E{(bf16_t*)(ws + WS_PJ), (const f32x2*)(ws + WS_ROPE), (float*)(ws + WS_RSQ), (float*)(ws + WS_RSKV), ws};
      pg8::gemm_phase<EpiProj, ProjOrder>(lds3, g, S, E); } PH_END
    } else {
#ifndef NO_P3A
    PH_BEGIN { pg8::Gemm g{(const bf16_t*)(ws + WS_PJ) + 1536, NPROJ, (const bf16_t*)(ws + WS_WUQ), 256}; PlainOrder S; S.init(MALL / 256, 3, G3, c3, 0);
      EpiQ E{(bf16_t*)(ws + WS_QM), (const f32x2*)(ws + WS_ROPE), (const float*)(ws + WS_RSQ), ws};
      pg8::gemm_phase<EpiQ, PlainOrder>(lds3, g, S, E); } PH_END
#endif
#ifndef NO_P3B
    PH_BEGIN { pg8::Gemm g{(const bf16_t*)(ws + WS_PJ) + 1792, NPROJ, (const bf16_t*)(ws + WS_WUKV), 256}; PlainOrder S; S.init(MALL / 256, 4, G3, c3, 0);
      EpiKV E{(bf16_t*)(ws + WS_KV), (const float*)(ws + WS_RSKV), ws};
      pg8::gemm_phase<EpiKV, PlainOrder>(lds3, g, S, E); } PH_END
#endif
    }
    GRID_SYNC(); }
#endif
#if PH(4)
    REP(4) { PH_BEGIN p4_attention_diff(p, (char*)lds); PH_END
    PH_BEGIN p4_attention_mla(p, (char*)lds); PH_END
    GRID_SYNC(); }
#endif
#if DBG_STAGE == 1
    PH_BEGIN dbg_check_proj(p); PH_END
#elif DBG_STAGE == 2
    PH_BEGIN dbg_check_attn(p, lds, 0); PH_END
#elif DBG_STAGE == 3
    PH_BEGIN dbg_check_attn(p, lds, 1); PH_END
#endif
#if PH(6)
    REP(6) {
    PH_BEGIN { pg8::Gemm g{(const bf16_t*)(ws + WS_MIX), 1024, (const bf16_t*)(ws + WS_WOUT), 1024}; PlainOrder S; S.init(T / 256, 4, G, c, 1);
      EpiOut E{(bf16_t*)(ws + WS_XN), p.x, (const float*)(ws + WS_MODS), (float*)(ws + WS_RSX)};
      pg8::gemm_phase<EpiOut, PlainOrder>(lds3, g, S, E); } PH_END
    GRID_SYNC(); }
#endif
#if PH(7)
#if (REP_MASK >> 11) & 1
    PH_BEGIN p7a_route(p, lds); PH_END
    GRID_SYNC();
    PH_BEGIN if (blockIdx.x == 0 && threadIdx.x < 32) ((unsigned*)(p.ws + WS_CNT))[threadIdx.x] = 0u; PH_END
    GRID_SYNC();
#endif
    PH_BEGIN p7a_route(p, lds); PH_END
    GRID_SYNC();
    REP(12) { PH_BEGIN moe_segments(p, seg); p7b_scatter(p, seg); PH_END }
    GRID_SYNC();
#endif
#if PH(8)
    REP(8) {
    PH_BEGIN { pg8::Gemm g{(const bf16_t*)(ws + WS_HF), 512, (const bf16_t*)(ws + WS_W1), 512, (const int*)(ws + WS_RTOK)}; MoeOrder S{seg, seg[32] >> 8, 8, G, c};
      EpiAct E{ws + WS_ACT, p.b1};
      pg8::gemm_phase<EpiAct, MoeOrder, true, true>(lds3, g, S, E); } PH_END
    GRID_SYNC(); }
#endif
#if PH(9)
    REP(9) {
    PH_BEGIN { pg8::Gemm g{(const bf16_t*)(ws + WS_ACT), 512, (const bf16_t*)(ws + WS_W2), 512}; MoeOrder S{seg, seg[32] >> 8, 4, G, c};
      EpiY E{(bf16_t*)(ws + WS_XS), p.b2, (const float*)(ws + WS_GSRT), (EPIY_PROBE) ? rep_ : 0};
      pg8::gemm_phase<EpiY, MoeOrder, false, true>(lds3, g, S, E); } PH_END
    GRID_SYNC(); }
#endif
#if LAST_PHASE >= 9
    REP(10) { PH_BEGIN p10_final(p, true); PH_END }
#elif LAST_PHASE >= 6
    PH_BEGIN p10_final(p, false); PH_END
#else
    PH_BEGIN { const int lane = threadIdx.x & 63, wave = threadIdx.x >> 6; const int gw = blockIdx.x * NWAVES + wave, NGW = gridDim.x * NWAVES;
      for (int t = gw; t < T; t += NGW) { const f32x4* xr = (const f32x4*)(p.x + (size_t)t * DM) + lane; f32x4 v[4]; float s = 0.f;
#pragma unroll
        for (int j = 0; j < 4; ++j) { v[j] = xr[64 * j]; s += (v[j].x * v[j].x + v[j].y * v[j].y) + (v[j].z * v[j].z + v[j].w * v[j].w); }
        const float r = rsqrtf(wave_sum(s) * (1.f / DM) + EPS); f32x4* o = (f32x4*)(p.out + (size_t)t * DM) + lane;
#pragma unroll
        for (int j = 0; j < 4; ++j) o[64 * j] = v[j] * r * ((const f32x4*)p.final_norm_w)[lane + 64 * j]; } } PH_END
#endif
}

extern "C" void kernel_launch(void* const* d_in, const int* in_sizes, int n_in, void* d_out, int out_size, void* d_ws, size_t ws_size, hipStream_t stream) {
    static int grid = 0;
    if (grid == 0) {
        if (n_in != 26 || in_sizes[0] != T * DM || out_size != T * DM || ws_size < WS_END) {
            fprintf(stderr, "kernel_launch: unexpected shapes: n_in %d in0 %d out %d ws %zu (need %zu)\n", n_in, n_in > 0 ? in_sizes[0] : -1, out_size, ws_size, (size_t)WS_END);
            grid = -1; return; }
        int dev = 0, cus = 0, per_cu = 0;
        (void)hipGetDevice(&dev);
        (void)hipDeviceGetAttribute(&cus, hipDeviceAttributeMultiprocessorCount, dev);
        if (hipFuncSetAttribute((const void*)fwd_kernel, hipFuncAttributeMaxDynamicSharedMemorySize, LDS_BYTES) != hipSuccess) { fprintf(stderr, "kernel_launch: hipFuncSetAttribute failed\n"); grid = -1; return; }
        if (hipOccupancyMaxActiveBlocksPerMultiprocessor(&per_cu, (const void*)fwd_kernel, NTHREADS, LDS_BYTES) != hipSuccess || per_cu < 1) { fprintf(stderr, "kernel_launch: occupancy query failed (%d)\n", per_cu); (void)hipGetLastError(); grid = -1; return; }
        grid = cus;
        if (grid < 128 || grid > 1024) { fprintf(stderr, "kernel_launch: unsupported CU count %d\n", cus); grid = -1; return; }
    }
    if (grid < 0) return;
    Params p{};
    const float** pp = (const float**)&p;
    for (int i = 0; i < 26; ++i) pp[i] = (const float*)d_in[i];
    p.out = (float*)d_out; p.ws = (unsigned char*)d_ws;
    if (hipMemsetAsync((char*)d_ws + WS_BAR, 0, WS_BAR_BYTES, stream) != hipSuccess) { fprintf(stderr, "kernel_launch: hipMemsetAsync failed\n"); return; }
    void* args[] = {&p};
    hipError_t e = hipLaunchCooperativeKernel((const void*)fwd_kernel, dim3(grid), dim3(NTHREADS), args, LDS_BYTES, stream);
    if (e != hipSuccess) fprintf(stderr, "cooperative launch failed: %s (grid %d)\n", hipGetErrorString(e), grid);
}
```

```cpp
#define MLA_NQR 2
#define STAGGER 0
#include <hip/hip_runtime.h>
#include <hip/hip_cooperative_groups.h>
#include <cstdio>
#include <cstdint>
namespace cg = cooperative_groups;

#ifndef DBG_STAGE
#define DBG_STAGE 0
#endif
#ifndef ATT_EXTRA
#define ATT_EXTRA 0
#define ATT_EXTRA_ROUND0 0
#endif
#ifndef ATT_X
#define ATT_X(cc) ((cc) & 7)
#define ATT_J(cc) ((cc) >> 3)
#endif
#ifndef ATT_FP8
#define ATT_FP8 1
#endif
#ifndef SIM_P2
#define SIM_P2 0
#endif
#ifndef SIM_P6
#define SIM_P6 0
#endif
#ifndef WCONV_IN_ATT
#define WCONV_IN_ATT 1
#endif
#ifndef P7A_VAR
#define P7A_VAR 0
#endif
#ifndef P10_NT
#define P10_NT 4
#endif
#ifndef P2_FP8
#define P2_FP8 1
#endif
#ifndef YS_FP8
#define YS_FP8 1
#endif
constexpr float YS_SCALE = 16.f;
#ifndef STAGGER
#define STAGGER 1
#endif
#ifndef ATT_VAR
#define ATT_VAR 0
#endif
#ifndef LAST_PHASE
#define LAST_PHASE 99
#endif

constexpr int DM = 1024, NB = 4, SEQ = 8192, CTX = 256;
constexpr int T = NB * SEQ;
constexpr int RPB = CTX + SEQ;
constexpr int MALL = NB * RPB;
constexpr int NPROJ = 2048;
constexpr int NEXP = 32, TOPK = 4, DFF = 1024;
constexpr int RMAX = T * TOPK + NEXP * 256;
constexpr float EPS = 1e-6f;
constexpr int NTHREADS = 512, NWAVES = 8;
constexpr float WQ_SCALE = 64.f;
constexpr int LDS_BYTES = 163840;

typedef unsigned short bf16_t;
typedef float f32x4 __attribute__((ext_vector_type(4)));
typedef float f32x2 __attribute__((ext_vector_type(2)));
typedef unsigned u32x4 __attribute__((ext_vector_type(4)));
typedef unsigned u32x2 __attribute__((ext_vector_type(2)));
#define LAS __attribute__((address_space(3)))

constexpr size_t KiB = 1024, MiB = 1u << 20;
constexpr size_t WS_CNT  = 0;
constexpr size_t WS_BAR  = 16 * KiB;
constexpr size_t WS_BAR_BYTES = 16 * KiB;
constexpr size_t WS_MODS = 64 * KiB;
constexpr size_t WS_DUMMY = 192 * KiB;
constexpr size_t WS_ROPE = 256 * KiB;
constexpr size_t WS_RWF  = 320 * KiB;
constexpr size_t WS_RSQ  = 512 * KiB;
constexpr size_t WS_RSKV = 768 * KiB;
constexpr size_t WS_TOPI = 1 * MiB;
constexpr size_t WS_GATE = 1 * MiB + 512 * KiB;
constexpr size_t WS_RANK = 2 * MiB;
constexpr size_t WS_GSRT = 2 * MiB + 512 * KiB;
constexpr size_t WS_RSX  = 3 * MiB + 64 * KiB;
constexpr size_t WS_DEST = 3 * MiB + 256 * KiB;
constexpr size_t WS_WIN  = 4 * MiB;
constexpr size_t WS_WOUT = 8 * MiB;
constexpr size_t WS_WUQ  = 10 * MiB;
constexpr size_t WS_WUKV = 11 * MiB;
constexpr size_t WS_W1   = 12 * MiB;
constexpr size_t WS_W2   = 140 * MiB;
constexpr size_t WS_XN   = 204 * MiB;
constexpr size_t WS_XS   = 332 * MiB;
constexpr size_t WS_ACT  = 604 * MiB;
constexpr size_t WS_HF   = 876 * MiB;
constexpr size_t WS_RTOK = 940 * MiB;
constexpr size_t WS_END  = 941 * MiB;
constexpr size_t WS_HB   = 332 * MiB;
constexpr size_t WS_PJ   = 398 * MiB;
constexpr size_t WS_QM   = 530 * MiB;
constexpr size_t WS_KV   = 580 * MiB;
constexpr size_t WS_AO   = 646 * MiB;
constexpr size_t WS_MIX  = 745 * MiB;
constexpr size_t WS_Q8D  = 646 * MiB;
constexpr size_t WS_K8D  = 663 * MiB;
constexpr size_t WS_VT8D = 680 * MiB;
constexpr size_t WS_KR8  = 697 * MiB;
constexpr size_t WS_Q8M  = 332 * MiB;
constexpr size_t WS_K8M  = 357 * MiB;
constexpr size_t WS_VT8M = 374 * MiB;
static_assert(WS_MIX + (size_t)MALL * 1024 * 2 <= WS_HF && WS_XS + (size_t)RMAX * 2048 <= WS_ACT && WS_ACT + (size_t)RMAX * 2048 <= WS_HF, "ws map");

struct Params {
    const float* x; const float* c; const float* ctx; const float* c_ctx; const float* w_ada; const float* b_ada;
    const float* attn_norm_w; const float* w_in; const float* q_norm_w; const float* kv_norm_w; const float* w_uq; const float* w_ukv;
    const float* lq1; const float* lk1; const float* lq2; const float* lk2; const float* subln_w; const float* w_out;
    const float* ffn_norm_w; const float* router_w; const float* router_b; const float* w1; const float* b1; const float* w2; const float* b2;
    const float* final_norm_w;
    float* out; unsigned char* ws;
};

__device__ __forceinline__ int tid_opaque() { int t = threadIdx.x; asm volatile("" : "+v"(t)); return t; }
__device__ __forceinline__ float wave_sum(float v) {
#pragma unroll
    for (int o = 1; o < 64; o <<= 1) v += __shfl_xor(v, o);
    return v;
}
__device__ __forceinline__ float wave_max(float v) {
#pragma unroll
    for (int o = 1; o < 64; o <<= 1) v = fmaxf(v, __shfl_xor(v, o));
    return v;
}
__device__ __forceinline__ float silu_f(float v) { return v / (1.f + __expf(-v)); }
__device__ __forceinline__ unsigned cvt_pk_bf16(float lo, float hi) { unsigned r; asm volatile("v_cvt_pk_bf16_f32 %0, %1, %2" : "=v"(r) : "v"(lo), "v"(hi)); return r; }
__device__ __forceinline__ unsigned cvt4_fp8o(int old, float a, float b, float c, float d) { int r = __builtin_amdgcn_cvt_pk_fp8_f32(a, b, old, false); r = __builtin_amdgcn_cvt_pk_fp8_f32(c, d, r, true); return (unsigned)r; }
__device__ __forceinline__ unsigned cvt4_fp8(float a, float b, float c, float d) { int r = __builtin_amdgcn_cvt_pk_fp8_f32(a, b, 0, false); r = __builtin_amdgcn_cvt_pk_fp8_f32(c, d, r, true); return (unsigned)r; }
__device__ __forceinline__ float q8(float x) { const int pk = __builtin_amdgcn_cvt_pk_fp8_f32(x, x, 0, false); return __builtin_amdgcn_cvt_f32_fp8(pk, 0); }
#ifdef SIM_FP8_ATT
#define Q8(x) q8(x)
#define PSHIFT 8.f
#else
#define Q8(x) (x)
#define PSHIFT 0.f
#endif
__device__ __forceinline__ unsigned char f2fp8(float x) { return (unsigned char)(__builtin_amdgcn_cvt_pk_fp8_f32(x, x, 0, false) & 0xff); }
__device__ __forceinline__ int vt_pos(int kk) { return ((kk >> 2) & 1) * 32 + (kk >> 5) * 16 + ((kk >> 3) & 3) * 4 + (kk & 3); }
__device__ __forceinline__ unsigned quad_tr_bytes(unsigned w, int j) {
    const unsigned t0 = (unsigned)__builtin_amdgcn_mov_dpp((int)w, 0x00, 0xf, 0xf, true), t1 = (unsigned)__builtin_amdgcn_mov_dpp((int)w, 0x55, 0xf, 0xf, true);
    const unsigned t2 = (unsigned)__builtin_amdgcn_mov_dpp((int)w, 0xaa, 0xf, 0xf, true), t3 = (unsigned)__builtin_amdgcn_mov_dpp((int)w, 0xff, 0xf, 0xf, true);
    const unsigned sel = 0x0c0c0000u | ((4u + (unsigned)j) << 8) | (unsigned)j;
    const unsigned a = __builtin_amdgcn_perm(t1, t0, sel), b = __builtin_amdgcn_perm(t3, t2, sel);
    return __builtin_amdgcn_perm(b, a, 0x05040100u);
}
__device__ __forceinline__ bf16_t f2bf(float f) { return (bf16_t)(cvt_pk_bf16(f, 0.f) & 0xffffu); }
__device__ __forceinline__ float bf2f(bf16_t v) { return __uint_as_float((unsigned)v << 16); }
__device__ __forceinline__ float bflo(unsigned w) { return __uint_as_float(w << 16); }
__device__ __forceinline__ float bfhi(unsigned w) { return __uint_as_float(w & 0xffff0000u); }
#define GAS __attribute__((address_space(1)))
#define RLX_AGENT __ATOMIC_RELAXED, __HIP_MEMORY_SCOPE_AGENT
#define XB_TMO      128
#define XB_XCNT(j)  (256  + 64 * (j))
#define XB_XSUB(j)  (1280 + 64 * (j))
#define XB_XGEN(j)  (2304 + 64 * (j))
#define XB_TOP      3328
#define XB_TOPGEN   3392
#define XCD_BAR_WORDS 3456
#define XB_SPIN_CAP (1u << 18)

__device__ __forceinline__ unsigned xb_ld(unsigned* p)              { return __hip_atomic_load(p, __ATOMIC_RELAXED, __HIP_MEMORY_SCOPE_AGENT); }
__device__ __forceinline__ unsigned xb_add(unsigned* p, unsigned v) { return __hip_atomic_fetch_add(p, v, __ATOMIC_RELAXED, __HIP_MEMORY_SCOPE_AGENT); }
__device__ __forceinline__ unsigned xb_xcc_id() { return (unsigned)__builtin_amdgcn_s_getreg((3 << 11) | 20) & 0xFu; }
#define XB_SPIN(cond, bar) do { unsigned _sp = 0; while (cond) { __builtin_amdgcn_s_sleep(1); \
    if ((++_sp & 255u) == 0u) { if (xb_ld(&(bar)[XB_TMO])) break; if (_sp > XB_SPIN_CAP) { atomicAdd(&(bar)[XB_TMO], 1u); break; } } } } while (0)

struct XcdBarrier {
    unsigned* bar; unsigned x;
    volatile LAS unsigned* st;
};

__device__ __forceinline__ XcdBarrier xcd_barrier_post(unsigned* bar, volatile LAS unsigned* st) {
    XcdBarrier b; b.bar = bar; b.x = xb_xcc_id(); b.st = st;
    if (threadIdx.x == 0) (void)xb_add(&bar[XB_XCNT(b.x)], 1u);
    return b;
}
__device__ __forceinline__ void xcd_barrier_complete(unsigned* bar, unsigned x, unsigned& nloc, unsigned& nx) {
    const unsigned G = gridDim.x * gridDim.y * gridDim.z;
    unsigned sum, cnt, mine, sp = 0u;
    for (;;) {
        sum = 0u; cnt = 0u; mine = 0u;
#pragma unroll
        for (unsigned j = 0; j < 16; ++j) { const unsigned c = xb_ld(&bar[XB_XCNT(j)]); sum += c; cnt += (c > 0u) ? 1u : 0u; mine = (j == x) ? c : mine; }
        if (sum == G) break;
        __builtin_amdgcn_s_sleep(1);
        if ((++sp & 255u) == 0u) { if (xb_ld(&bar[XB_TMO])) break; if (sp > XB_SPIN_CAP) { atomicAdd(&bar[XB_TMO], 1u); break; } }
    }
    nloc = mine > 0u ? mine : 1u; nx = cnt > 0u ? cnt : 1u;
}

__device__ __forceinline__ void xcd_barrier(const XcdBarrier& b) {
    asm volatile("s_waitcnt vmcnt(0)" ::: "memory");
    __syncthreads();
    if (threadIdx.x == 0) {
        unsigned* bar = b.bar;
        __builtin_amdgcn_s_waitcnt(0);
        unsigned nloc = b.st[0], nx = b.st[1];
        if (nloc == 0u) { xcd_barrier_complete(bar, b.x, nloc, nx); b.st[0] = nloc; b.st[1] = nx; }
        const unsigned old = xb_add(&bar[XB_XSUB(b.x)], 1u);
        const unsigned gen = old / nloc;
        if (old + 1u == (gen + 1u) * nloc) {
            __builtin_amdgcn_fence(__ATOMIC_RELEASE, "agent");
            asm volatile("s_waitcnt vmcnt(0)" ::: "memory");
            const unsigned og = xb_add(&bar[XB_TOP], 1u);
            const unsigned tg = og / nx;
            if (og + 1u == (tg + 1u) * nx) xb_add(&bar[XB_TOPGEN], 1u);
            else XB_SPIN(xb_ld(&bar[XB_TOPGEN]) == tg, bar);
            __builtin_amdgcn_fence(__ATOMIC_ACQUIRE, "agent");
            xb_add(&bar[XB_XGEN(b.x)], 1u);
            asm volatile("s_waitcnt vmcnt(0)" ::: "memory");
        } else {
            XB_SPIN(xb_ld(&bar[XB_XGEN(b.x)]) == gen, bar);
            __builtin_amdgcn_fence(__ATOMIC_ACQUIRE, "agent");
            asm volatile("s_waitcnt vmcnt(0)" ::: "memory");
        }
    }
    __syncthreads();
}

__device__ __forceinline__ void p0_mods(const Params& p, float* lds_f, int item) {
    const int tid = tid_opaque();
    float* sc = lds_f;
    float* red = lds_f + 5 * 1024;
    for (int i = tid; i < 5 * 1024; i += NTHREADS) { const int r = i >> 10, k = i & 1023; sc[i] = silu_f(r < 4 ? p.c[r * 1024 + k] : p.c_ctx[k]); }
    __syncthreads();
    const int col = tid & 31, kg = tid >> 5;
    const float* w = p.w_ada + (size_t)(kg * 64) * 6144 + item * 32 + col;
    float a0 = 0, a1 = 0, a2 = 0, a3 = 0, a4 = 0;
#pragma unroll 8
    for (int k = 0; k < 64; ++k) { const float wv = w[(size_t)k * 6144]; const int kk = kg * 64 + k;
        a0 += sc[kk] * wv; a1 += sc[1024 + kk] * wv; a2 += sc[2048 + kk] * wv; a3 += sc[3072 + kk] * wv; a4 += sc[4096 + kk] * wv; }
    red[(kg * 5 + 0) * 32 + col] = a0; red[(kg * 5 + 1) * 32 + col] = a1; red[(kg * 5 + 2) * 32 + col] = a2; red[(kg * 5 + 3) * 32 + col] = a3; red[(kg * 5 + 4) * 32 + col] = a4;
    __syncthreads();
    if (tid < 160) { const int r = tid >> 5, cc = tid & 31; float s = p.b_ada[item * 32 + cc];
        for (int g = 0; g < 16; ++g) s += red[(g * 5 + r) * 32 + cc];
        ((float*)(p.ws + WS_MODS))[r * 6144 + item * 32 + cc] = s; }
    __syncthreads();
}

template <int SIMQ = 0>
__device__ __forceinline__ void p0_tr_item(const float* W, int ldw, bf16_t* WT, int ldk, int k0, int n0, int drow0, const float* kscale, float* scr, int lane) {
    const int nq = (lane & 15) * 4, kr = lane >> 4;
#pragma unroll 4
    for (int i = 0; i < 16; ++i) { const int kk = 4 * i + kr;
        f32x4 v = *(const f32x4*)(W + (size_t)(k0 + kk) * ldw + n0 + nq);
        if (kscale) { const float s = kscale[k0 + kk]; v = v * s; }
        float* d = scr + kk * 65 + nq; d[0] = v.x; d[1] = v.y; d[2] = v.z; d[3] = v.w; }
    asm volatile("s_waitcnt lgkmcnt(0)" ::: "memory");
    const int c = lane & 7;
#pragma unroll
    for (int j = 0; j < 8; ++j) { const int n = (lane >> 3) + 8 * j; const float* s = scr + (8 * c) * 65 + n;
        float w_[8];
#pragma unroll
        for (int i = 0; i < 8; ++i) { w_[i] = s[i * 65]; if (SIMQ) w_[i] = q8(w_[i] * 64.f) * (1.f / 64.f); }
        u32x4 o; o.x = cvt_pk_bf16(w_[0], w_[1]); o.y = cvt_pk_bf16(w_[2], w_[3]); o.z = cvt_pk_bf16(w_[4], w_[5]); o.w = cvt_pk_bf16(w_[6], w_[7]);
        *(u32x4*)(WT + (size_t)(drow0 + n) * ldk + k0 + 8 * c) = o; }
    asm volatile("s_waitcnt lgkmcnt(0)" ::: "memory");
}

__device__ __forceinline__ void p0_tr_item_f8(const float* W, int ldw, unsigned char* WT, int ldk, int k0, int n0, int drow0, const float wscale, float* scr, int lane) {
    const int nq = (lane & 15) * 4, kr = lane >> 4;
#pragma unroll 4
    for (int i = 0; i < 16; ++i) { const int kk = 4 * i + kr;
        const f32x4 v = *(const f32x4*)(W + (size_t)(k0 + kk) * ldw + n0 + nq) * wscale;
        float* d = scr + kk * 65 + nq; d[0] = v.x; d[1] = v.y; d[2] = v.z; d[3] = v.w; }
    asm volatile("s_waitcnt lgkmcnt(0)" ::: "memory");
    const int c = lane & 3;
#pragma unroll
    for (int j = 0; j < 4; ++j) { const int n = (lane >> 2) + 16 * j; const float* s = scr + (16 * c) * 65 + n;
        u32x4 o; o.x = cvt4_fp8(s[0 * 65], s[1 * 65], s[2 * 65], s[3 * 65]); o.y = cvt4_fp8(s[4 * 65], s[5 * 65], s[6 * 65], s[7 * 65]);
        o.z = cvt4_fp8(s[8 * 65], s[9 * 65], s[10 * 65], s[11 * 65]); o.w = cvt4_fp8(s[12 * 65], s[13 * 65], s[14 * 65], s[15 * 65]);
        *(u32x4*)(WT + (size_t)(drow0 + n) * ldk + k0 + 16 * c) = o; }
    asm volatile("s_waitcnt lgkmcnt(0)" ::: "memory");
}

__device__ __forceinline__ void p0_prologue(const Params& p, unsigned char* lds) {
    const int tid = tid_opaque(), lane = tid & 63, wave = tid >> 6;
    unsigned char* ws = p.ws;
    if (blockIdx.x == 0 && tid < 128) ((unsigned*)(ws + WS_CNT))[tid] = 0u;
    if (blockIdx.x == gridDim.x - 1) {
        for (int i = tid; i < 128 * 16; i += NTHREADS) { const int pv = i >> 4, pp = i & 15;
            const float inv = exp2f(-(float)pp * (13.287712379549449f / 16.f));
            const float ang = (float)pv * inv; float sn, cs; sincosf(ang, &sn, &cs);
            ((f32x2*)(ws + WS_ROPE))[i] = (f32x2){cs, sn}; }
    }
    { const int gt = blockIdx.x * NTHREADS + tid;
      if (gt < 4096) { const int l = gt & 63, nb = (gt >> 6) & 1, s = gt >> 7; unsigned hi4[4], lo4[4];
#pragma unroll
        for (int j = 0; j < 4; ++j) { const float w0 = p.router_w[(32 * s + 8 * (l >> 4) + 2 * j) * 32 + 16 * nb + (l & 15)], w1 = p.router_w[(32 * s + 8 * (l >> 4) + 2 * j + 1) * 32 + 16 * nb + (l & 15)];
            const unsigned hw = cvt_pk_bf16(w0, w1); hi4[j] = hw; lo4[j] = cvt_pk_bf16(w0 - bflo(hw), w1 - bfhi(hw)); }
        u32x4* dst = (u32x4*)(ws + WS_RWF) + ((s * 2 + nb) * 2) * 64 + l;
        dst[0] = (u32x4){hi4[0], hi4[1], hi4[2], hi4[3]}; dst[64] = (u32x4){lo4[0], lo4[1], lo4[2], lo4[3]}; } }
    for (int it = blockIdx.x; it < 192; it += gridDim.x) p0_mods(p, (float*)lds, it);
    float* scr = (float*)lds + wave * (64 * 65);
    const int gw = blockIdx.x * NWAVES + wave, NGW = gridDim.x * NWAVES;
    constexpr int I_W1 = WCONV_IN_ATT ? 0 : 32 * 16 * 32, I_W2 = WCONV_IN_ATT ? 0 : 32 * 16 * 16, I_IN = 16 * 31, I_OUT = 16 * 16, I_UQ = 4 * 12, I_UKV = 2 * 16;
    constexpr int NITEMS = I_W1 + I_W2 + I_IN + I_OUT + I_UQ + I_UKV;
    for (int it = gw; it < NITEMS; it += NGW) {
        int r = it;
        if (r < I_W1) { const int e = r >> 9, q = r & 511, kb = q >> 5, nb = q & 31, n0 = nb * 64;
            const int drow = ((n0 & 1023) >> 7) * 256 + (n0 >> 10) * 128 + (n0 & 127);
            p0_tr_item_f8(p.w1 + (size_t)e * 1024 * 2048, 2048, ws + WS_W1 + (size_t)e * 2048 * 1024, 1024, kb * 64, n0, drow, WQ_SCALE, scr, lane); continue; } r -= I_W1;
        if (r < I_W2) { const int e = r >> 8, q = r & 255, kb = q >> 4, nb = q & 15;
            p0_tr_item_f8(p.w2 + (size_t)e * 1024 * 1024, 1024, ws + WS_W2 + (size_t)e * 1024 * 1024, 1024, kb * 64, nb * 64, nb * 64, WQ_SCALE, scr, lane); continue; } r -= I_W2;
        if (r < I_IN) { const int kb = r / 31, nb = r % 31;
#if P2_FP8
            p0_tr_item_f8(p.w_in, 1984, ws + WS_WIN, 1024, kb * 64, nb * 64, nb * 64, WQ_SCALE, scr, lane); continue; } r -= I_IN;
#else
            p0_tr_item<SIM_P2>(p.w_in, 1984, (bf16_t*)(ws + WS_WIN), 1024, kb * 64, nb * 64, nb * 64, nullptr, scr, lane); continue; } r -= I_IN;
#endif
        if (r < I_OUT) { const int kb = r >> 4, nb = r & 15;
            p0_tr_item<SIM_P6>(p.w_out, 1024, (bf16_t*)(ws + WS_WOUT), 1024, kb * 64, nb * 64, nb * 64, nullptr, scr, lane); continue; } r -= I_OUT;
        if (r < I_UQ) { const int kb = r / 12, nb = r % 12;
            p0_tr_item(p.w_uq, 768, (bf16_t*)(ws + WS_WUQ), 256, kb * 64, nb * 64, nb * 64, p.q_norm_w, scr, lane); continue; } r -= I_UQ;
        { const int kb = r >> 4, nb = r & 15;
            p0_tr_item(p.w_ukv, 1024, (bf16_t*)(ws + WS_WUKV), 256, kb * 64, nb * 64, nb * 64, p.kv_norm_w, scr, lane); }
    }
    { const int gt = blockIdx.x * NTHREADS + tid, NGT = gridDim.x * NTHREADS; const u32x4 z = {0u, 0u, 0u, 0u};
      for (int i = gt; i < 64 * (P2_FP8 ? 64 : 128); i += NGT) ((u32x4*)(ws + WS_WIN + (size_t)1984 * (P2_FP8 ? 1024 : 2048)))[i] = z;
      for (int i = gt; i < 1024 * 16; i += NGT) { const int row = i >> 4, ch = i & 15; *(u32x4*)((bf16_t*)(ws + WS_WUKV) + (size_t)row * 256 + 128 + ch * 8) = z; } }
}

__device__ __forceinline__ void p1_rows(const Params& p) {
    const int tid = tid_opaque(), lane = tid & 63, wave = tid >> 6;
    const int gw = blockIdx.x * NWAVES + wave, NGW = gridDim.x * NWAVES;
    const float* mods = (const float*)(p.ws + WS_MODS);
    bf16_t* HB = (bf16_t*)(p.ws + WS_HB);
    { const int gt = blockIdx.x * NTHREADS + tid, NGT = gridDim.x * NTHREADS;
      for (int i = gt; i < MALL; i += NGT) { ((float*)(p.ws + WS_RSQ))[i] = 0.f; ((float*)(p.ws + WS_RSKV))[i] = 0.f; }
      for (int i = gt; i < RMAX; i += NGT) ((int*)(p.ws + WS_RTOK))[i] = 0;
      for (int i = gt; i < T; i += NGT) ((float*)(p.ws + WS_RSX))[i] = 0.f; }
    f32x4 av[4], sv[4]; int curb = -1;
    for (int m0 = __builtin_amdgcn_readfirstlane(gw); m0 < MALL; m0 += 2 * NGW) {
        int mm[2]; bool ok[2]; f32x4 v[2][4];
#pragma unroll
        for (int q = 0; q < 2; ++q) { const int m_ = m0 + q * NGW; ok[q] = m_ < MALL; mm[q] = ok[q] ? m_ : m0;
            const int b = mm[q] / RPB, i = mm[q] - b * RPB; const bool isctx = i < CTX;
            const float* src = isctx ? p.ctx + ((size_t)b * CTX + i) * DM : p.x + ((size_t)b * SEQ + (i - CTX)) * DM;
            const f32x4* xr = (const f32x4*)src + lane;
#pragma unroll
            for (int j = 0; j < 4; ++j) v[q][j] = xr[64 * j]; }
#pragma unroll
        for (int q = 0; q < 2; ++q) { const int m = mm[q], b = m / RPB, i = m - b * RPB; const int bsel = i < CTX ? 4 : b;
            if (bsel != curb) { curb = bsel; const float* md = mods + bsel * 6144;
#pragma unroll
                for (int j = 0; j < 4; ++j) { av[j] = ((const f32x4*)p.attn_norm_w)[lane + 64 * j] * (((const f32x4*)(md + 1024))[lane + 64 * j] + 1.f); sv[j] = ((const f32x4*)md)[lane + 64 * j]; } }
            float s = 0.f;
#pragma unroll
            for (int j = 0; j < 4; ++j) s += (v[q][j].x * v[q][j].x + v[q][j].y * v[q][j].y) + (v[q][j].z * v[q][j].z + v[q][j].w * v[q][j].w);
            const float r = rsqrtf(wave_sum(s) * (1.f / DM) + EPS);
#if P2_FP8
            if (ok[q]) { unsigned* o = (unsigned*)((unsigned char*)HB + (size_t)m * DM) + lane;
#pragma unroll
                for (int j = 0; j < 4; ++j) { const f32x4 h = v[q][j] * r * av[j] + sv[j]; o[64 * j] = cvt4_fp8(h.x, h.y, h.z, h.w); } }
#else
            if (ok[q]) { u32x2* o = (u32x2*)(HB + (size_t)m * DM) + lane;
#pragma unroll
                for (int j = 0; j < 4; ++j) { const f32x4 h = v[q][j] * r * av[j] + sv[j];
                    f32x4 hq = h; if (SIM_P2) hq = (f32x4){q8(h.x), q8(h.y), q8(h.z), q8(h.w)};
                    u32x2 pk; pk.x = cvt_pk_bf16(hq.x, hq.y); pk.y = cvt_pk_bf16(hq.z, hq.w); o[64 * j] = pk; } }
#endif
        }
    }
}
namespace pg8 {
typedef short bf16x8 __attribute__((ext_vector_type(8)));
typedef int v4i32_t __attribute__((ext_vector_type(4)));
typedef int v8i32_t __attribute__((ext_vector_type(8)));
constexpr int BM = 256, BK = 64, HALF = 128, HTB = HALF * BK * 2  , STAGE_BYTES = 8 * HTB;
__host__ __device__ __forceinline__ int lds_byte(int r, int c) { const int st = (r >> 4) * 2 + (c >> 5), rr = r & 15, cc = c & 31, ob = rr * 64 + cc * 2; return st * 1024 + (ob ^ (((ob >> 9) & 1) << 5)); }
__host__ __device__ __forceinline__ void stage_rc(int b, int& R, int& C) { const int st = b / 1024, sb = b % 1024, swz = sb ^ (((sb >> 9) & 1) << 5); R = (st >> 1) * 16 + swz / 64; C = (st & 1) * 32 + (swz % 64) / 2; }

struct Unit { int am, bn, pm, pn, e; };
struct Gemm { const bf16_t* A; int lda; const bf16_t* Bt; int K; const int* rowtok; };

template <class Epi, class Sched, bool GATHER = false, bool FP8 = false, bool ALIGN_EPI = true>
__device__ __forceinline__ void gemm_phase(LAS unsigned char* lds, const Gemm g, const Sched& S, const Epi& E) {
    const int tid = tid_opaque(), wid = __builtin_amdgcn_readfirstlane(tid >> 6), lane = tid & 63, wr = wid >> 2, wc = wid & 3, fr = lane & 15, fq = lane >> 4;
    const int K = g.K, lda = g.lda; int nt = K / BK; asm volatile("" : "+s"(nt));
    unsigned voffA[2], voffB[2];
#pragma unroll
    for (int i = 0; i < 2; ++i) { int R, C; stage_rc(tid * 16 + i * 8192, R, C);
        voffA[i] = (unsigned)(R * lda + C) * 2u; voffB[i] = (unsigned)(R * K + C) * 2u; }
    unsigned vA0[2], vA1[2];
    LAS u32x4* gnx = (LAS u32x4*)(lds + STAGE_BYTES + 4096) + tid;
#define PG8_GOFF(AM, o00, o01, o10, o11) do { int t_ = tid; asm volatile("" : "+v"(t_)); int R0_, C0_, R1_, C1_; stage_rc(t_ * 16, R0_, C0_); stage_rc(t_ * 16 + 8192, R1_, C1_); \
        const int* rt_ = g.rowtok + (AM) * 256; const unsigned lb_ = (unsigned)(lda * 2); \
        o00 = (unsigned)rt_[R0_] * lb_ + (unsigned)(C0_ * 2); o01 = (unsigned)rt_[R1_] * lb_ + (unsigned)(C1_ * 2); o10 = (unsigned)rt_[128 + R0_] * lb_ + (unsigned)(C0_ * 2); o11 = (unsigned)rt_[128 + R1_] * lb_ + (unsigned)(C1_ * 2); } while (0)
#define PG8_STAGE_A(bufoff, soff, h, W0, W1) do { PG8_STAGE(bufoff, rA, soff, ((h) ? W1 : W0)); } while (0)
    const unsigned kstep = (unsigned)(BK * 2);
    const unsigned hstepA = (unsigned)(HALF * lda * 2), hstepB = (unsigned)(HALF * K * 2);
    const unsigned tstepA = 2 * hstepA, tstepB = 2 * hstepB;
    const __amdgpu_buffer_rsrc_t rA = __builtin_amdgcn_make_buffer_rsrc((void*)g.A, 0, 0xffffffff, 0x00020000), rB = __builtin_amdgcn_make_buffer_rsrc((void*)g.Bt, 0, 0xffffffff, 0x00020000);
    const unsigned ldsw = (unsigned)wid * 1024u;
    const int aoff = lds_byte(wr * 64 + fr, fq * 8), boff = lds_byte(wc * 32 + fr, fq * 8);
#define PG8_SA(b, h) (((b) * 2 + (h)) * HTB)
#define PG8_SB(b, h) ((4 + (b) * 2 + (h)) * HTB)
#define PG8_STAGE(bufoff, rs, soff, voff) do { _Pragma("unroll") for (int _i = 0; _i < 2; ++_i) \
        __builtin_amdgcn_raw_ptr_buffer_load_lds(rs, (LAS unsigned*)(lds + (bufoff) + ldsw + _i * 8192), 16, (int)(voff)[_i], (int)(soff), 0, 0); } while (0)
#define PG8_LDA(dst, b, h) do { _Pragma("unroll") for (int m = 0; m < 4; ++m) { const v4i32_t lo_ = *(const LAS v4i32_t*)(lds + PG8_SA(b, h) + aoff + m * 2048), hi_ = *(const LAS v4i32_t*)(lds + PG8_SA(b, h) + aoff + m * 2048 + 1024); \
        dst[m] = __builtin_shufflevector(lo_, hi_, 0, 1, 2, 3, 4, 5, 6, 7); } } while (0)
#define PG8_LDB(dst, b, h) do { _Pragma("unroll") for (int n = 0; n < 2; ++n) { const v4i32_t lo_ = *(const LAS v4i32_t*)(lds + PG8_SB(b, h) + boff + n * 2048), hi_ = *(const LAS v4i32_t*)(lds + PG8_SB(b, h) + boff + n * 2048 + 1024); \
        dst[n] = __builtin_shufflevector(lo_, hi_, 0, 1, 2, 3, 4, 5, 6, 7); } } while (0)
#define PG8_LO(x) __builtin_bit_cast(bf16x8, __builtin_shufflevector(x, x, 0, 1, 2, 3))
#define PG8_HI(x) __builtin_bit_cast(bf16x8, __builtin_shufflevector(x, x, 4, 5, 6, 7))
#define PG8_MMA(ai, bj, At, Bt) do { __builtin_amdgcn_s_setprio(1); _Pragma("unroll") for (int m = 0; m < 4; ++m) _Pragma("unroll") for (int n = 0; n < 2; ++n) { \
        if constexpr (FP8) acc[ai][bj][m][n] = __builtin_amdgcn_mfma_scale_f32_16x16x128_f8f6f4(Bt[n], At[m], acc[ai][bj][m][n], 0, 0, 0, 0, 0, 0)    ; \
        else { acc[ai][bj][m][n] = __builtin_amdgcn_mfma_f32_16x16x32_bf16(PG8_LO(Bt[n]), PG8_LO(At[m]), acc[ai][bj][m][n], 0, 0, 0); \
               acc[ai][bj][m][n] = __builtin_amdgcn_mfma_f32_16x16x32_bf16(PG8_HI(Bt[n]), PG8_HI(At[m]), acc[ai][bj][m][n], 0, 0, 0); } } __builtin_amdgcn_s_setprio(0); } while (0)
#define PG8_WAIT_V(n) asm volatile("s_waitcnt vmcnt(" #n ")" ::: "memory")
#define PG8_STR_(x) #x
#define PG8_XSTR_(x) PG8_STR_(x)
#define PG8_WAIT_V8X() do { if (relax) asm volatile("s_waitcnt vmcnt(%0)" :: "n"(8 + Epi::NST) : "memory"); else asm volatile("s_waitcnt vmcnt(8)" ::: "memory"); } while (0)
#define PG8_WAIT_L(n) asm volatile("s_waitcnt lgkmcnt(" #n ")" ::: "memory")
#define PG8_BAR __builtin_amdgcn_s_barrier()
#define PG8_SCHED __builtin_amdgcn_sched_barrier(0)
    Unit cur, nxt; int ui = 0;
    if (!S.next(0, cur)) return;
    f32x4 acc[2][2][4][2];
#pragma unroll
    for (int a = 0; a < 2; ++a)
#pragma unroll
        for (int b = 0; b < 2; ++b)
#pragma unroll
            for (int m = 0; m < 4; ++m)
#pragma unroll
                for (int n = 0; n < 2; ++n) acc[a][b][m][n] = (f32x4){0.f, 0.f, 0.f, 0.f};
    v8i32_t At[4], B0[2], B1[2];
    unsigned cA = GATHER ? 0u : (unsigned)cur.am * tstepA, cB = (unsigned)cur.bn * tstepB;
    if constexpr (GATHER) { PG8_GOFF(cur.am, vA0[0], vA0[1], vA1[0], vA1[1]); }
    else { vA0[0] = voffA[0]; vA0[1] = voffA[1]; vA1[0] = voffA[0] + hstepA; vA1[1] = voffA[1] + hstepA; }
    PG8_STAGE(PG8_SB(0, 0), rB, cB, voffB); PG8_STAGE(PG8_SB(0, 1), rB, cB + hstepB, voffB); PG8_STAGE_A(PG8_SA(0, 0), cA, 0, vA0, vA1); PG8_STAGE_A(PG8_SA(0, 1), cA, 1, vA0, vA1);
    if (wr == 1) PG8_BAR;
    PG8_WAIT_V(2); PG8_BAR;
    PG8_STAGE(PG8_SB(1, 0), rB, cB + kstep, voffB); PG8_STAGE_A(PG8_SA(1, 0), cA + kstep, 0, vA0, vA1); PG8_STAGE(PG8_SB(1, 1), rB, cB + hstepB + kstep, voffB);
    PG8_WAIT_V(6); PG8_BAR;
    for (;;) {
        const bool has_next = S.next(ui + 1, nxt);
        const unsigned nA = (has_next && !GATHER) ? (unsigned)nxt.am * tstepA : cA, nB = has_next ? (unsigned)nxt.bn * tstepB : cB;
        if constexpr (GATHER) { const int am_ = has_next ? nxt.am : cur.am; u32x4 nv_; PG8_GOFF(am_, nv_.x, nv_.y, nv_.z, nv_.w); *gnx = nv_; }
        for (int t = 0; t < nt; t += 2) {
            const bool last = (t == nt - 2); const bool relax = Epi::NST > 0 && t == 0 && ui > 0;
            const unsigned a1 = cA + (unsigned)(t + 1) * kstep;
            const unsigned a2 = last ? nA : cA + (unsigned)(t + 2) * kstep, b2 = last ? nB : cB + (unsigned)(t + 2) * kstep;
            const unsigned a3 = a2 + kstep, b3 = b2 + kstep;
            if constexpr (GATHER) { if (last) { const u32x4 nv_ = *gnx; vA0[0] = nv_.x; vA0[1] = nv_.y; }
            } else if constexpr (FP8) { if (last) asm volatile("s_nop 0"); }
            PG8_LDB(B0, 0, 0); PG8_LDB(B1, 0, 1); PG8_SCHED; PG8_LDA(At, 0, 0); PG8_STAGE_A(PG8_SA(1, 1), a1, 1, vA0, vA1);
            PG8_WAIT_V8X(); PG8_WAIT_L(0); PG8_BAR; PG8_MMA(0, 0, At, B0); PG8_MMA(0, 1, At, B1); PG8_BAR; PG8_SCHED;
            PG8_LDA(At, 0, 1); PG8_STAGE(PG8_SB(0, 0), rB, b2, voffB); PG8_STAGE(PG8_SB(0, 1), rB, b2 + hstepB, voffB); PG8_STAGE_A(PG8_SA(0, 0), a2, 0, vA0, vA1);
            if constexpr (GATHER) { if (last) { const u32x4 nv_ = *gnx; vA1[0] = nv_.z; vA1[1] = nv_.w; } }
            else if constexpr (FP8) { if (last) asm volatile("s_nop 0"); }
            PG8_WAIT_V8X(); PG8_WAIT_L(0); PG8_BAR; PG8_MMA(1, 0, At, B0); PG8_MMA(1, 1, At, B1); PG8_BAR; PG8_SCHED;
            PG8_LDB(B0, 1, 0); PG8_LDB(B1, 1, 1); PG8_SCHED; PG8_LDA(At, 1, 0); PG8_STAGE_A(PG8_SA(0, 1), a2, 1, vA0, vA1);
            PG8_WAIT_V(8); PG8_WAIT_L(0); PG8_BAR; PG8_MMA(0, 0, At, B0); PG8_MMA(0, 1, At, B1); PG8_BAR; PG8_SCHED;
            PG8_LDA(At, 1, 1); PG8_STAGE(PG8_SB(1, 0), rB, b3, voffB); PG8_STAGE(PG8_SB(1, 1), rB, b3 + hstepB, voffB); PG8_STAGE_A(PG8_SA(1, 0), a3, 0, vA0, vA1);
            PG8_WAIT_V(8); PG8_WAIT_L(0); PG8_BAR; PG8_MMA(1, 0, At, B0); PG8_MMA(1, 1, At, B1); PG8_BAR; PG8_SCHED;
        }
        if constexpr (ALIGN_EPI) { if (wr == 0) PG8_BAR; }
        PG8_SCHED;
        { int fr_ = fr, fq_ = fq; asm volatile("" : "+v"(fr_), "+v"(fq_));
          E(acc, cur, wr, wc, fr_, fq_); }
        if (!has_next) break;
#pragma unroll
        for (int a = 0; a < 2; ++a)
#pragma unroll
            for (int b = 0; b < 2; ++b)
#pragma unroll
                for (int m = 0; m < 4; ++m)
#pragma unroll
                    for (int n = 0; n < 2; ++n) acc[a][b][m][n] = (f32x4){0.f, 0.f, 0.f, 0.f};
        cur = nxt; cA = nA; cB = nB; ++ui;
        if constexpr (ALIGN_EPI) { if (wr == 1) PG8_BAR; }
    }
    PG8_WAIT_V(0);
    if constexpr (!ALIGN_EPI) { if (wr == 0) PG8_BAR; }
    PG8_BAR;
#undef PG8_SA
#undef PG8_SB
#undef PG8_STAGE
#undef PG8_STAGE_A
#undef PG8_GOFF
#undef PG8_LDA
#undef PG8_LDB
#undef PG8_MMA
#undef PG8_LO
#undef PG8_HI
#undef PG8_WAIT_V
#undef PG8_WAIT_V8X
#undef PG8_WAIT_L
#undef PG8_BAR
#undef PG8_SCHED
}
}
struct PlainOrder {
    int nM, nN, nwg, G, c, latent_only;
    __device__ void init(int nM_, int nN_, int G_, int c_, int latent_only_) { nM = nM_; nN = nN_; nwg = nM * nN; G = G_; c = c_; latent_only = latent_only_; }
    __device__ bool next(int i, pg8::Unit& u) const {
        const long L = (long)i * G + c; if (L >= nwg) return false;
        int wgid = (int)L; { const int q = nwg / 8, r = nwg % 8, xcd = wgid % 8, off = wgid / 8; wgid = (xcd < r ? xcd * (q + 1) : r * (q + 1) + (xcd - r) * q) + off; }
        const int WGM = 8, nig = WGM * nN, gid = wgid / nig, fm = gid * WGM, gsz = (nM - fm) < WGM ? (nM - fm) : WGM;
        const int pm = fm + ((wgid % nig) % gsz), pn = (wgid % nig) / gsz;
        u.pm = pm; u.pn = pn; u.e = 0; u.bn = pn;
        u.am = latent_only ? (pm >> 5) * 33 + 1 + (pm & 31) : pm;
        return true;
    }
};
struct ProjOrder {
    PlainOrder P; int G, c, part, split;
    __device__ void init(int G_, int c_, int part_) { G = G_; c = c_; part = part_; split = (G_ == 256); P.init(MALL / 256, 7, G_, c_, 0); }
    __device__ bool next(int i, pg8::Unit& u) const {
        int pm, pn;
        if (part == 0) { const long L = (long)i * G + c; if (L >= (split ? 1024 : 1056)) return false;
            if (L < 924) { if (!P.next(i, u)) return false; pm = u.pm; pn = u.pn + 1; } else { pm = (int)L - 924; pn = 0; } }
        else { if (!split || i > 0 || c >= 32) return false; pm = 100 + c; pn = 0; }
        u.pm = pm; u.pn = pn; u.e = 0; u.bn = pn; u.am = pm; return true;
    }
};
struct MoeOrder {
    const int* seg; int NT, ncol, G, c;
    __device__ bool next(int i, pg8::Unit& u) const {
        int rt, pn;
        if (G == 256) { const int x = c & 7, s = c >> 3;
            if (ncol == 8) { rt = i * 32 + x * 4 + (s >> 3); pn = s & 7; } else { rt = i * 64 + x * 8 + (s >> 2); pn = s & 3; } }
        else { const long L = (long)i * G + c; rt = (int)(L / ncol); pn = (int)(L % ncol); }
        if (rt >= NT) return false;
        const int r0 = rt * 256; int e = 0;
        while (e < 31 && r0 >= seg[e + 1]) ++e;
        u.am = rt; u.pm = rt; u.pn = pn; u.e = e; u.bn = e * ncol + pn; return true;
    }
};

typedef f32x4 AccT[2][2][4][2];
constexpr float QSCALE_DIFF = 0.125f * 1.4426950408889634f;
constexpr float QSCALE_MLA = 0.07216878364870322f * 1.4426950408889634f;
struct EpiProj {
    static constexpr int NST = 0;
    bf16_t* PJ; const f32x2* rope; float* rsq; float* rskv; unsigned char* ws;
    __device__ __forceinline__ void operator()(const AccT& acc, const pg8::Unit& u, int wr, int wc, int fr, int fq) const {
        const int pm = u.pm, pn = u.pn; const bool latent = (pm % 33) != 0;
        const int a = wc & 1;
#pragma unroll
        for (int ai = 0; ai < 2; ++ai)
#pragma unroll
            for (int m = 0; m < 4; ++m) {
                const int row = pm * 256 + ai * 128 + wr * 64 + m * 16 + fr;
                const int i = row % RPB, pos = i - CTX, pv = a ? (pos & 63) : (pos >> 6);
                float ss = 0.f;
#pragma unroll
                for (int bj = 0; bj < 2; ++bj) {
                    f32x4 v0 = acc[ai][bj][m][0] * (P2_FP8 ? 1.f / WQ_SCALE : 1.f), v1 = acc[ai][bj][m][1] * (P2_FP8 ? 1.f / WQ_SCALE : 1.f);
                    if (pn == 6 || (pn == 7 && bj == 0)) ss += (v0.x * v0.x + v0.y * v0.y) + (v0.z * v0.z + v0.w * v0.w) + (v1.x * v1.x + v1.y * v1.y) + (v1.z * v1.z + v1.w * v1.w);
                    if (pn < 2) { v0 = v0 * QSCALE_DIFF; v1 = v1 * QSCALE_DIFF; }
                    const bool rp = latent && (pn < 4 || (pn == 7 && bj == 1 && wc < 2));
                    if (rp) { const f32x4* t = (const f32x4*)(rope + pv * 16 + 4 * fq); const f32x4 t0 = t[0], t1 = t[1];
                        const f32x4 cs = {t0.x, t0.z, t1.x, t1.z}, sn = {t0.y, t0.w, t1.y, t1.w};
                        const f32x4 o0 = v0 * cs - v1 * sn, o1 = v1 * cs + v0 * sn; v0 = o0; v1 = o1; }
#ifdef SIM_FP8_ATT
                    if (pn < 6 || (pn == 7 && bj == 1 && wc < 2)) { v0 = (f32x4){q8(v0.x), q8(v0.y), q8(v0.z), q8(v0.w)}; v1 = (f32x4){q8(v1.x), q8(v1.y), q8(v1.z), q8(v1.w)}; }
#endif
#if ATT_FP8
                    const int cl = (pn & 1) * 256 + bj * 128 + wc * 32 + 4 * fq;
                    if (pn < 4) { unsigned char* d8 = ws + (pn < 2 ? WS_Q8D : WS_K8D) + (size_t)row * 512 + cl;
                        *(unsigned*)d8 = cvt4_fp8(v0.x, v0.y, v0.z, v0.w); *(unsigned*)(d8 + 16) = cvt4_fp8(v1.x, v1.y, v1.z, v1.w); }
                    else if (pn < 6) { const int b_ = row / RPB, i_ = row - b_ * RPB, hh = cl >> 7, e0 = cl & 127;
                        unsigned char* d8 = ws + WS_VT8D + ((size_t)(b_ * 4 + hh) * 128 + e0 + (fr & 3)) * RPB + (i_ & ~63) + vt_pos(i_ & 60);
                        *(unsigned*)d8 = quad_tr_bytes(cvt4_fp8(v0.x, v0.y, v0.z, v0.w), fr & 3); *(unsigned*)(d8 + 16 * RPB) = quad_tr_bytes(cvt4_fp8(v1.x, v1.y, v1.z, v1.w), fr & 3); }
                    else if (pn == 7 && bj == 1 && wc < 2) { unsigned char* d8 = ws + WS_KR8 + (size_t)row * 64 + wc * 32 + 4 * fq;
                        *(unsigned*)d8 = cvt4_fp8(v0.x, v0.y, v0.z, v0.w); *(unsigned*)(d8 + 16) = cvt4_fp8(v1.x, v1.y, v1.z, v1.w); }
                    if (pn >= 6)
#endif
                    { bf16_t* dst = PJ + (size_t)row * NPROJ + pn * 256 + bj * 128 + wc * 32 + 4 * fq;
                    u32x2 w0, w1; w0.x = cvt_pk_bf16(v0.x, v0.y); w0.y = cvt_pk_bf16(v0.z, v0.w); w1.x = cvt_pk_bf16(v1.x, v1.y); w1.y = cvt_pk_bf16(v1.z, v1.w);
                    *(u32x2*)dst = w0; *(u32x2*)(dst + 16) = w1; }
                }
                if (pn >= 6) { ss += __shfl_xor(ss, 16); ss += __shfl_xor(ss, 32); if (fq == 0) atomicAdd((pn == 6 ? rsq : rskv) + row, ss); }
                asm volatile("" ::: "memory");
            }
    }
};
struct EpiQ {
    static constexpr int NST = 0;
    bf16_t* QM; const f32x2* rope; const float* rsq; unsigned char* ws;
    __device__ __forceinline__ void operator()(const AccT& acc, const pg8::Unit& u, int wr, int wc, int fr, int fq) const {
        const int pm = u.pm, pn = u.pn; const bool latent = (pm % 33) != 0;
#pragma unroll
        for (int ai = 0; ai < 2; ++ai)
#pragma unroll
            for (int m = 0; m < 4; ++m) {
                const int row = pm * 256 + ai * 128 + wr * 64 + m * 16 + fr;
                const float rq = rsqrtf(rsq[row] * (1.f / 256.f) + EPS);
                const int i = row % RPB, pos = i - CTX;
#pragma unroll
                for (int bj = 0; bj < 2; ++bj) {
                    f32x4 v0 = acc[ai][bj][m][0] * rq, v1 = acc[ai][bj][m][1] * rq;
                    const int g6 = (pn * 8 + bj * 4 + wc) % 6;
                    if (latent && g6 >= 4) { const int pv = (g6 == 5) ? (pos & 63) : (pos >> 6);
                        const f32x4* t = (const f32x4*)(rope + pv * 16 + 4 * fq); const f32x4 t0 = t[0], t1 = t[1];
                        const f32x4 cs = {t0.x, t0.z, t1.x, t1.z}, sn = {t0.y, t0.w, t1.y, t1.w};
                        const f32x4 o0 = v0 * cs - v1 * sn, o1 = v1 * cs + v0 * sn; v0 = o0; v1 = o1; }
#ifdef SIM_FP8_ATT
                    v0 = (f32x4){q8(v0.x), q8(v0.y), q8(v0.z), q8(v0.w)}; v1 = (f32x4){q8(v1.x), q8(v1.y), q8(v1.z), q8(v1.w)};
#endif
#if ATT_FP8
                    { unsigned char* d8 = ws + WS_Q8M + (size_t)row * 768 + pn * 256 + bj * 128 + wc * 32 + 4 * fq; v0 = v0 * QSCALE_MLA; v1 = v1 * QSCALE_MLA;
                      *(unsigned*)d8 = cvt4_fp8(v0.x, v0.y, v0.z, v0.w); *(unsigned*)(d8 + 16) = cvt4_fp8(v1.x, v1.y, v1.z, v1.w); }
#else
                    bf16_t* dst = QM + (size_t)row * 768 + pn * 256 + bj * 128 + wc * 32 + 4 * fq;
                    u32x2 w0, w1; w0.x = cvt_pk_bf16(v0.x, v0.y); w0.y = cvt_pk_bf16(v0.z, v0.w); w1.x = cvt_pk_bf16(v1.x, v1.y); w1.y = cvt_pk_bf16(v1.z, v1.w);
                    *(u32x2*)dst = w0; *(u32x2*)(dst + 16) = w1;
#endif
                }
            }
    }
};
struct EpiKV {
    static constexpr int NST = 0;
    bf16_t* KV; const float* rskv; unsigned char* ws;
    __device__ __forceinline__ void operator()(const AccT& acc, const pg8::Unit& u, int wr, int wc, int fr, int fq) const {
        const int pm = u.pm, pn = u.pn;
#pragma unroll
        for (int ai = 0; ai < 2; ++ai)
#pragma unroll
            for (int m = 0; m < 4; ++m) {
                const int row = pm * 256 + ai * 128 + wr * 64 + m * 16 + fr;
                const float rk = rsqrtf(rskv[row] * (1.f / 128.f) + EPS);
#pragma unroll
                for (int bj = 0; bj < 2; ++bj) {
                    f32x4 v0 = acc[ai][bj][m][0] * rk, v1 = acc[ai][bj][m][1] * rk;
#ifdef SIM_FP8_ATT
                    v0 = (f32x4){q8(v0.x), q8(v0.y), q8(v0.z), q8(v0.w)}; v1 = (f32x4){q8(v1.x), q8(v1.y), q8(v1.z), q8(v1.w)};
#endif
#if ATT_FP8
                    if (bj == 0) { unsigned char* d8 = ws + WS_K8M + (size_t)row * 512 + pn * 128 + wc * 32 + 4 * fq;
                        *(unsigned*)d8 = cvt4_fp8(v0.x, v0.y, v0.z, v0.w); *(unsigned*)(d8 + 16) = cvt4_fp8(v1.x, v1.y, v1.z, v1.w); }
                    else { const int b_ = row / RPB, i_ = row - b_ * RPB, e0 = wc * 32 + 4 * fq;
                        unsigned char* d8 = ws + WS_VT8M + ((size_t)(b_ * 4 + pn) * 128 + e0 + (fr & 3)) * RPB + (i_ & ~63) + vt_pos(i_ & 60);
                        *(unsigned*)d8 = quad_tr_bytes(cvt4_fp8(v0.x, v0.y, v0.z, v0.w), fr & 3); *(unsigned*)(d8 + 16 * RPB) = quad_tr_bytes(cvt4_fp8(v1.x, v1.y, v1.z, v1.w), fr & 3); }
#else
                    bf16_t* dst = KV + (size_t)row * 1024 + pn * 256 + bj * 128 + wc * 32 + 4 * fq;
                    u32x2 w0, w1; w0.x = cvt_pk_bf16(v0.x, v0.y); w0.y = cvt_pk_bf16(v0.z, v0.w); w1.x = cvt_pk_bf16(v1.x, v1.y); w1.y = cvt_pk_bf16(v1.z, v1.w);
                    *(u32x2*)dst = w0; *(u32x2*)(dst + 16) = w1;
#endif
                }
            }
    }
};
struct EpiOut {
    static constexpr int NST = 0;
    bf16_t* XN; const float* x; const float* mods; float* rsx;
    __device__ __forceinline__ void operator()(const AccT& acc, const pg8::Unit& u, int wr, int wc, int fr, int fq) const {
        const int pm = u.pm, pn = u.pn, b = pm >> 5;
        const float* ga = mods + b * 6144 + 2 * 1024;
        float ssr[2][4];
#pragma unroll
        for (int ai = 0; ai < 2; ++ai)
#pragma unroll
            for (int m = 0; m < 4; ++m) ssr[ai][m] = 0.f;
#pragma unroll
        for (int bj = 0; bj < 2; ++bj) { const int cb = pn * 256 + bj * 128 + wc * 32;
            const f32x4 gv0 = *(const f32x4*)(ga + cb + 4 * fq), gv1 = *(const f32x4*)(ga + cb + 16 + 4 * fq);
#pragma unroll
            for (int ai = 0; ai < 2; ++ai)
#pragma unroll
                for (int m = 0; m < 4; ++m) { const size_t ro = (size_t)(pm * 256 + ai * 128 + wr * 64 + m * 16 + fr) * DM + cb;
                    const f32x4 v0 = *(const f32x4*)(x + ro + 4 * fq) + gv0 * acc[ai][bj][m][0], v1 = *(const f32x4*)(x + ro + 16 + 4 * fq) + gv1 * acc[ai][bj][m][1];
                    ssr[ai][m] += ((v0.x * v0.x + v0.y * v0.y) + (v0.z * v0.z + v0.w * v0.w)) + ((v1.x * v1.x + v1.y * v1.y) + (v1.z * v1.z + v1.w * v1.w));
                    unsigned ax = cvt_pk_bf16(v0.x, v0.y), ay = cvt_pk_bf16(v0.z, v0.w), bx = cvt_pk_bf16(v1.x, v1.y), by = cvt_pk_bf16(v1.z, v1.w);
                    { auto r_ = __builtin_amdgcn_permlane32_swap(ax, bx, false, false); ax = r_[0]; bx = r_[1]; } { auto r_ = __builtin_amdgcn_permlane32_swap(ay, by, false, false); ay = r_[0]; by = r_[1]; }
                    { auto r_ = __builtin_amdgcn_permlane16_swap(ax, bx, false, false); ax = r_[0]; bx = r_[1]; } { auto r_ = __builtin_amdgcn_permlane16_swap(ay, by, false, false); ay = r_[0]; by = r_[1]; }
                    *(u32x4*)(XN + ro + 8 * fq) = (u32x4){ax, ay, bx, by}; } }
#pragma unroll
        for (int ai = 0; ai < 2; ++ai)
#pragma unroll
            for (int m = 0; m < 4; ++m) { float s = ssr[ai][m]; s += __shfl_xor(s, 16); s += __shfl_xor(s, 32);
                if (fq == 0) atomicAdd(rsx + pm * 256 + ai * 128 + wr * 64 + m * 16 + fr, s); }
    }
};
struct EpiAct {
    static constexpr int NST = 16;
    unsigned char* ACT; const float* b1;
    __device__ __forceinline__ void operator()(const AccT& acc, const pg8::Unit& u, int wr, int wc, int fr, int fq) const {
        const int pm = u.pm, pn = u.pn; const float* bb = b1 + (size_t)u.e * 2048;
#pragma unroll
        for (int n = 0; n < 2; ++n) { const int col = pn * 128 + wc * 32 + n * 16 + 4 * fq; const f32x4 bg = *(const f32x4*)(bb + col), bu = *(const f32x4*)(bb + 1024 + col);
#pragma unroll
            for (int ai = 0; ai < 2; ++ai)
#pragma unroll
                for (int m = 0; m < 4; ++m) { const int row = pm * 256 + ai * 128 + wr * 64 + m * 16 + fr;
                    const f32x4 gq = acc[ai][0][m][n] * (1.f / WQ_SCALE) + bg, uq = acc[ai][1][m][n] * (1.f / WQ_SCALE) + bu; float o[4];
#pragma unroll
                    for (int e = 0; e < 4; ++e) { const float gg = fminf(gq[e], 7.f), uu = fminf(fmaxf(uq[e], -7.f), 7.f);
                        o[e] = gg * __builtin_amdgcn_rcpf(1.f + __expf(-1.702f * gg)) * (uu + 1.f); }
                    *(unsigned*)(ACT + (size_t)row * 1024 + col) = cvt4_fp8(o[0], o[1], o[2], o[3]); } }
    }
};
struct EpiY {
    static constexpr int NST = 16;
    bf16_t* YS; const float* b2; const float* gsrt; int mode = 0;
    __device__ __forceinline__ void operator()(const AccT& acc, const pg8::Unit& u, int wr, int wc, int fr, int fq) const {
        const int pm = u.pm, pn = u.pn; const float* bb = b2 + (size_t)u.e * 1024;
        float gt[2][4];
#pragma unroll
        for (int ai = 0; ai < 2; ++ai)
#pragma unroll
            for (int m = 0; m < 4; ++m) gt[ai][m] = gsrt[pm * 256 + ai * 128 + wr * 64 + m * 16 + fr] * (YS_FP8 ? YS_SCALE : 1.f);
#pragma unroll
        for (int bj = 0; bj < 2; ++bj) { const int cb = pn * 256 + bj * 128 + wc * 32;
            const f32x4 bv0 = *(const f32x4*)(bb + cb + 4 * fq), bv1 = *(const f32x4*)(bb + cb + 16 + 4 * fq);
#pragma unroll
            for (int ai = 0; ai < 2; ++ai)
#pragma unroll
                for (int m = 0; m < 4; ++m) { const int row = pm * 256 + ai * 128 + wr * 64 + m * 16 + fr;
                    const f32x4 v0 = (acc[ai][bj][m][0] * (1.f / WQ_SCALE) + bv0) * gt[ai][m], v1 = (acc[ai][bj][m][1] * (1.f / WQ_SCALE) + bv1) * gt[ai][m];
#if YS_FP8
                    unsigned ax = cvt4_fp8(v0.x, v0.y, v0.z, v0.w), bx = cvt4_fp8(v1.x, v1.y, v1.z, v1.w);
                    { auto r_ = __builtin_amdgcn_permlane32_swap(ax, bx, false, false); ax = r_[0]; bx = r_[1]; }
                    { auto r_ = __builtin_amdgcn_permlane16_swap(ax, bx, false, false); ax = r_[0]; bx = r_[1]; }
                    if (mode == 0 || ax == 0x12345678u) *(u32x2*)((unsigned char*)YS + (size_t)row * 1024 + cb + 8 * fq) = (u32x2){ax, bx};
#else
                    unsigned ax = cvt_pk_bf16(v0.x, v0.y), ay = cvt_pk_bf16(v0.z, v0.w), bx = cvt_pk_bf16(v1.x, v1.y), by = cvt_pk_bf16(v1.z, v1.w);
                    { auto r_ = __builtin_amdgcn_permlane32_swap(ax, bx, false, false); ax = r_[0]; bx = r_[1]; } { auto r_ = __builtin_amdgcn_permlane32_swap(ay, by, false, false); ay = r_[0]; by = r_[1]; }
                    { auto r_ = __builtin_amdgcn_permlane16_swap(ax, bx, false, false); ax = r_[0]; bx = r_[1]; } { auto r_ = __builtin_amdgcn_permlane16_swap(ay, by, false, false); ay = r_[0]; by = r_[1]; }
                    if (mode == 0 || ax == 0x12345678u) *(u32x4*)(YS + (size_t)row * 1024 + cb + 8 * fq) = (u32x4){ax, ay, bx, by};
#endif
                } }
    }
};
namespace attn {
using bf16x8 = __attribute__((ext_vector_type(8))) short;
using s16x4  = __attribute__((ext_vector_type(4))) short;
using f32x16 = __attribute__((ext_vector_type(16))) float;
constexpr int QBLK = 32, KVBLK = 64;
constexpr int SHM_V = KVBLK * 128 * 2;
#ifndef ATT_THR
#define ATT_THR 8.f
#endif
constexpr float THR = ATT_THR;
#define KOFF(row, ch) ((row) * 128 + ((((ch) ^ ((row) >> 1)) & 7) << 4))
#define SBAR() __builtin_amdgcn_sched_barrier(0)
__device__ __forceinline__ int crow(int r, int hi) { return (r & 3) + 8 * (r >> 2) + 4 * hi; }

template <int VAR = 0>
__device__ __forceinline__ void partialSM(f32x16& p0, f32x16& p1, float& m_reg, float& mn, float& alpha, const float C, const float thr_raw) {
  if constexpr (VAR == 1) { mn = m_reg; alpha = 1.f;
    _Pragma("unroll") for (int r = 0; r < 16; ++r) { p0[r] = p0[r] * C; p1[r] = p1[r] * C; } return; }
  float pmax = p0[0];
#pragma unroll
  for (int r = 1; r < 16; ++r) pmax = fmaxf(pmax, p0[r]);
#pragma unroll
  for (int r = 0; r < 16; ++r) pmax = fmaxf(pmax, p1[r]);
  { auto rr = __builtin_amdgcn_permlane32_swap(__float_as_uint(pmax), __float_as_uint(pmax), false, false);
    pmax = fmaxf(__uint_as_float(rr[0]), __uint_as_float(rr[1])); }
  if (__builtin_expect(__all(pmax - m_reg <= thr_raw), 1)) { mn = m_reg; alpha = 1.f; }
  else { mn = fmaxf(m_reg, pmax); alpha = __builtin_amdgcn_exp2f((m_reg - mn) * C); m_reg = mn; }
  const float mnC = -mn * C + PSHIFT;
#pragma unroll
  for (int r = 0; r < 16; ++r) p0[r] = fmaf(p0[r], C, mnC);
#pragma unroll
  for (int r = 0; r < 16; ++r) p1[r] = fmaf(p1[r], C, mnC);
#pragma unroll
  for (int r = 0; r < 16; ++r) p0[r] = __builtin_amdgcn_exp2f(p0[r]);
}
template <int VAR = 0>
__device__ __forceinline__ void finishSM(f32x16& p0, f32x16& p1, float alpha, float& l_reg, bf16x8& pa0, bf16x8& pa1, bf16x8& pa2, bf16x8& pa3) {
  if constexpr (VAR != 1) {
#pragma unroll
  for (int r = 0; r < 16; ++r) p1[r] = __builtin_amdgcn_exp2f(p1[r]); }
  float ps = 0;
#pragma unroll
  for (int r = 0; r < 16; ++r) ps += p0[r];
#pragma unroll
  for (int r = 0; r < 16; ++r) ps += p1[r];
  { auto rr = __builtin_amdgcn_permlane32_swap(__float_as_uint(ps), __float_as_uint(ps), false, false);
    ps = __uint_as_float(rr[0]) + __uint_as_float(rr[1]); }
  l_reg = l_reg * alpha + ps;
#define PK4(P, BASE, OUT) do { unsigned a0 = cvt_pk_bf16(P[BASE + 0], P[BASE + 1]), a1 = cvt_pk_bf16(P[BASE + 2], P[BASE + 3]);   \
    unsigned b0 = cvt_pk_bf16(P[BASE + 4], P[BASE + 5]), b1 = cvt_pk_bf16(P[BASE + 6], P[BASE + 7]);                              \
    auto r0 = __builtin_amdgcn_permlane32_swap(a0, b0, false, false); auto r1 = __builtin_amdgcn_permlane32_swap(a1, b1, false, false); \
    u32x4 w = {r0[0], r1[0], r0[1], r1[1]}; OUT = *reinterpret_cast<bf16x8*>(&w); } while (0)
  PK4(p0, 0, pa0); PK4(p0, 8, pa1); PK4(p1, 0, pa2); PK4(p1, 8, pa3);
#undef PK4
}
template <int NKC, int NQR, int KBOFF>
__device__ __forceinline__ void qkt(f32x16& p0, f32x16& p1, const int* kb, const bf16x8* qr, int ql) {
  p0 = f32x16{}; p1 = f32x16{};
  if constexpr (NQR != NKC) asm volatile("" : "+v"(ql));
#pragma unroll
  for (int c = 0; c < NKC; ++c)
#pragma unroll
    for (int d0 = 0; d0 < 4; ++d0) {
      const bf16x8 b0 = *(const LAS bf16x8*)(uintptr_t)(unsigned)(kb[d0] + (KBOFF + c * 8192));
      const bf16x8 b1 = *(const LAS bf16x8*)(uintptr_t)(unsigned)(kb[d0] + (KBOFF + c * 8192 + 4096));
      bf16x8 qf; if constexpr (NQR == NKC) qf = qr[c * 4 + d0]; else { if (c < NQR) qf = qr[(c < NQR ? c : 0) * 4 + d0]; else qf = *(const LAS bf16x8*)(uintptr_t)(unsigned)(ql + ((c - NQR) * 4 + d0) * 1024); }
      p0 = __builtin_amdgcn_mfma_f32_32x32x16_bf16(b0, qf, p0, 0, 0, 0);
      p1 = __builtin_amdgcn_mfma_f32_32x32x16_bf16(b1, qf, p1, 0, 0, 0); }
}
__device__ __forceinline__ int v_st(int k, int c) { const int kk = (k & ~0xC) | ((k & 4) << 1) | ((k & 8) >> 1); return ((kk >> 3) * 4 + (c >> 5)) * 512 + ((kk & 7) * 32 + (c & 31)) * 2; }
__device__ __forceinline__ int v_rd_base(int lane) { return ((lane & 3) << 3) | (((lane >> 2) & 3) << 6) | (((lane >> 4) & 1) << 5) | (((lane >> 5) & 1) << 8); }
constexpr int v_rd_off(int d0, int ks, int half) { return d0 * 512 + ks * 4096 + half * 2048; }
template <int OFF> __device__ __forceinline__ s16x4 tr_read(int vb) {
  s16x4 r; asm volatile("ds_read_b64_tr_b16 %0, %1 offset:%2" : "=&v"(r) : "v"(vb), "i"(OFF) : "memory"); return r;
}
template <int D0> __device__ __forceinline__ void pv_one(f32x16& od, int vb, bf16x8 pa0, bf16x8 pa1, bf16x8 pa2, bf16x8 pa3) {
  const s16x4 l0 = tr_read<v_rd_off(D0, 0, 0)>(vb), h0 = tr_read<v_rd_off(D0, 0, 1)>(vb), l1 = tr_read<v_rd_off(D0, 1, 0)>(vb), h1 = tr_read<v_rd_off(D0, 1, 1)>(vb);
  const s16x4 l2 = tr_read<v_rd_off(D0, 2, 0)>(vb), h2 = tr_read<v_rd_off(D0, 2, 1)>(vb), l3 = tr_read<v_rd_off(D0, 3, 0)>(vb), h3 = tr_read<v_rd_off(D0, 3, 1)>(vb);
  asm volatile("s_waitcnt lgkmcnt(0)" ::: "memory"); SBAR();
#define PK(L, H) (bf16x8){L[0], L[1], L[2], L[3], H[0], H[1], H[2], H[3]}
  od = __builtin_amdgcn_mfma_f32_32x32x16_bf16(pa0, PK(l0, h0), od, 0, 0, 0);
  od = __builtin_amdgcn_mfma_f32_32x32x16_bf16(pa1, PK(l1, h1), od, 0, 0, 0);
  od = __builtin_amdgcn_mfma_f32_32x32x16_bf16(pa2, PK(l2, h2), od, 0, 0, 0);
  od = __builtin_amdgcn_mfma_f32_32x32x16_bf16(pa3, PK(l3, h3), od, 0, 0, 0);
#undef PK
}
__device__ __forceinline__ void pv_d0(f32x16* o, int vb, bf16x8 pa0, bf16x8 pa1, bf16x8 pa2, bf16x8 pa3) {
  pv_one<0>(o[0], vb, pa0, pa1, pa2, pa3); pv_one<1>(o[1], vb, pa0, pa1, pa2, pa3); pv_one<2>(o[2], vb, pa0, pa1, pa2, pa3); pv_one<3>(o[3], vb, pa0, pa1, pa2, pa3);
}

typedef short v4i16 __attribute__((ext_vector_type(4)));
template <int OFF> __device__ __forceinline__ bf16x8 vfrag(int vb) {
  const v4i16 l = __builtin_amdgcn_ds_read_tr16_b64_v4i16((LAS v4i16*)(uintptr_t)(unsigned)(vb + OFF));
  const v4i16 h = __builtin_amdgcn_ds_read_tr16_b64_v4i16((LAS v4i16*)(uintptr_t)(unsigned)(vb + OFF + 2048));
  return (bf16x8){l[0], l[1], l[2], l[3], h[0], h[1], h[2], h[3]};
}
__device__ __forceinline__ float max3f(float a, float b, float c) { return __builtin_fmaxf(__builtin_fmaxf(a, b), c); }
#define PK4X(P, BASE, OUT) do { unsigned a0 = cvt_pk_bf16(Q8(P[BASE + 0]), Q8(P[BASE + 1])), a1 = cvt_pk_bf16(Q8(P[BASE + 2]), Q8(P[BASE + 3]));   \
    unsigned b0 = cvt_pk_bf16(Q8(P[BASE + 4]), Q8(P[BASE + 5])), b1 = cvt_pk_bf16(Q8(P[BASE + 6]), Q8(P[BASE + 7]));                              \
    auto r0 = __builtin_amdgcn_permlane32_swap(a0, b0, false, false); auto r1 = __builtin_amdgcn_permlane32_swap(a1, b1, false, false); \
    u32x4 w = {r0[0], r1[0], r0[1], r1[1]}; OUT = *reinterpret_cast<bf16x8*>(&w); } while (0)

template <int NKC, int NQR, int VAR = 0, int OM = 0>
__device__ __forceinline__ void attn_unit(const bf16_t* __restrict__ Qb, int ldq, const bf16_t* kp0, int kld0, const bf16_t* kp1, int kld1, const bf16_t* kp2, int kld2,
                                          const bf16_t* __restrict__ Vh, int ldv, bf16_t* __restrict__ Ob, int ldo, int seq, const float C, char* lds,
                                          char* stash = nullptr, const float lam = 0.f, const float* __restrict__ subw = nullptr) {
  constexpr int SHM_K = NKC * 8192, NG = NKC * 8;
  const int tid = tid_opaque(), wid = tid >> 6, lane = tid & 63, r32 = lane & 31, hi = lane >> 5;
  const float thr_raw = THR * 1.4426950408889634f / C;
  char* V_lds = lds; char* K_lds = lds + 3 * SHM_V;
  float* ws = (float*)(lds + 3 * SHM_V + 3 * SHM_K) + wid * 64; float* li_l = ws; float* al_l = ws + 32;
  float m_reg = -1e30f, l_reg = 0; f32x16 o[4] = {}; bf16x8 qr[NQR * 4];
  const bf16_t* Qw = Qb + (long)(wid * QBLK + r32) * ldq + hi * 8;
  int ql = (int)(uintptr_t)(lds + 3 * SHM_V + 3 * SHM_K + 2048) + wid * ((NKC - NQR) * 4096) + lane * 16;
  int kb[4];
#pragma unroll
  for (int d0 = 0; d0 < 4; ++d0) kb[d0] = (int)(uintptr_t)K_lds + KOFF(r32, d0 * 2 + hi);
  __syncthreads();
#pragma unroll
  for (int d0 = 0; d0 < NQR * 4; ++d0) qr[d0] = *reinterpret_cast<const bf16x8*>(Qw + d0 * 16);
#pragma unroll
  for (int d0 = NQR * 4; d0 < NKC * 4; ++d0) *(LAS bf16x8*)(uintptr_t)(unsigned)(ql + (d0 - NQR * 4) * 1024) = *reinterpret_cast<const bf16x8*>(Qw + d0 * 16);
  const int sr = tid >> 4, sc = (tid & 15) * 8, vst0 = v_st(sr, sc), vst1 = v_st(32 + sr, sc);
  const int krow = tid >> 3, kch = tid & 7, kst = KOFF(krow, kch);
  const int vb0 = (int)(uintptr_t)V_lds + v_rd_base(lane);
  const unsigned vo0 = (unsigned)(sr * ldv + sc) * 2u, vo1 = (unsigned)((32 + sr) * ldv + sc) * 2u;
  const unsigned ko0 = (unsigned)(krow * kld0 + kch * 8) * 2u, ko1 = (unsigned)(krow * kld1 + kch * 8) * 2u, ko2 = (unsigned)(krow * kld2 + kch * 8) * 2u;
  struct { bf16x8 vs0, vs1, k0, k1, k2; } sg;
  const __amdgpu_buffer_rsrc_t rV = __builtin_amdgcn_make_buffer_rsrc((void*)Vh, 0, 0xffffffff, 0x00020000);
  const __amdgpu_buffer_rsrc_t rK0 = __builtin_amdgcn_make_buffer_rsrc((void*)kp0, 0, 0xffffffff, 0x00020000);
  const __amdgpu_buffer_rsrc_t rK1 = __builtin_amdgcn_make_buffer_rsrc((void*)(NKC > 1 ? kp1 : kp0), 0, 0xffffffff, 0x00020000);
  const __amdgpu_buffer_rsrc_t rK2 = __builtin_amdgcn_make_buffer_rsrc((void*)(NKC > 2 ? kp2 : kp0), 0, 0xffffffff, 0x00020000);
#define BL128(r, vo, so) __builtin_bit_cast(bf16x8, __builtin_amdgcn_raw_buffer_load_b128(r, (int)(vo), (int)(so), 0))
#define SLOAD(kb_) do { const int so_ = (kb_) * (ldv * 2); \
    sg.vs0 = BL128(rV, vo0, so_); sg.vs1 = BL128(rV, vo1, so_); \
    sg.k0 = BL128(rK0, ko0, (kb_) * (kld0 * 2)); \
    if constexpr (NKC > 1) sg.k1 = BL128(rK1, ko1, (kb_) * (kld1 * 2)); \
    if constexpr (NKC > 2) sg.k2 = BL128(rK2, ko2, (kb_) * (kld2 * 2)); } while (0)
#define SWRITE(b) do { *(bf16x8*)(V_lds + (b) * SHM_V + vst0) = sg.vs0; *(bf16x8*)(V_lds + (b) * SHM_V + vst1) = sg.vs1; \
    *(bf16x8*)(K_lds + (b) * SHM_K + kst) = sg.k0; \
    if constexpr (NKC > 1) *(bf16x8*)(K_lds + (b) * SHM_K + 8192 + kst) = sg.k1; \
    if constexpr (NKC > 2) *(bf16x8*)(K_lds + (b) * SHM_K + 16384 + kst) = sg.k2; } while (0)
#define RESC(a) do { if (__any((a) < 1.f)) { if (hi == 0) al_l[r32] = (a); asm volatile("s_waitcnt lgkmcnt(0)" ::: "memory"); \
    _Pragma("unroll") for (int d = 0; d < 4; ++d) _Pragma("unroll") for (int r = 0; r < 16; ++r) o[d][r] *= al_l[crow(r, hi)]; } } while (0)
#define KLD(g, KB) (*(const LAS bf16x8*)(uintptr_t)(unsigned)(kb[((g) & 7) >> 1] + ((KB) + ((g) >> 3) * 8192 + ((g) & 1) * 4096)))
#define QLD(j) (*(const LAS bf16x8*)(uintptr_t)(unsigned)(ql + (j) * 1024))
  f32x16 pA0, pA1, pB0, pB1; float alA, alB; bf16x8 pa[4]; const int NT = seq / KVBLK;
  constexpr bool NEGM = (NKC == 1); f32x16 negm = {}; const float thr2 = THR * 1.4426950408889634f;
#define STEP(PN0, PN1, alN, PC0, PC1, alC, BKN, BVC, BW, DO_QK, DO_WR, DO_LD, tt) do { \
    bf16x8 kf[3], vf[3], qlf[2]; float ps = 0.f, mxa = 0.f, mxb = 0.f, mnC = 0.f; \
    SBAR(); \
    if (DO_QK) { if constexpr (NQR != NKC) asm volatile("" : "+v"(ql)); kf[0] = KLD(0, (BKN) * SHM_K); kf[1] = KLD(1, (BKN) * SHM_K); } \
    _Pragma("unroll") for (int g = 0; g < NG; ++g) { \
      const int c_ = g >> 3, d0_ = (g & 7) >> 1, s_ = g / NKC; const bool fs_ = (g % NKC) == 0; \
      if (DO_QK) { bf16x8 qf_; if (c_ < NQR) qf_ = qr[(c_ < NQR ? c_ : 0) * 4 + d0_]; else { if ((g & 1) == 0) qlf[d0_ & 1] = QLD((c_ - NQR) * 4 + d0_); qf_ = qlf[d0_ & 1]; } \
        if ((g & 1) == 0) { if (g == 0) PN0 = __builtin_amdgcn_mfma_f32_32x32x16_bf16(kf[g % 3], qf_, NEGM ? negm : (f32x16){}, 0, 0, 0); else PN0 = __builtin_amdgcn_mfma_f32_32x32x16_bf16(kf[g % 3], qf_, PN0, 0, 0, 0); } \
        else { if (g == 1) PN1 = __builtin_amdgcn_mfma_f32_32x32x16_bf16(kf[g % 3], qf_, NEGM ? negm : (f32x16){}, 0, 0, 0); else PN1 = __builtin_amdgcn_mfma_f32_32x32x16_bf16(kf[g % 3], qf_, PN1, 0, 0, 0); } } \
      if (fs_ && VAR < 4) {   \
        if (!NEGM && s_ < 7) { PC1[2 * s_] = __builtin_amdgcn_exp2f(PC1[2 * s_]); PC1[2 * s_ + 1] = __builtin_amdgcn_exp2f(PC1[2 * s_ + 1]); } \
        if (!NEGM && s_ == 4) { PC1[14] = __builtin_amdgcn_exp2f(PC1[14]); PC1[15] = __builtin_amdgcn_exp2f(PC1[15]); } \
        if (s_ == 0) { ps = (PC0[0] + PC0[1]) + (PC0[2] + PC0[3]); PK4X(PC0, 0, pa[0]); } \
        if (s_ == 1) { ps += (PC0[4] + PC0[5]) + (PC0[6] + PC0[7]); PK4X(PC0, 8, pa[1]); } \
        if (s_ == 2) { ps += (PC0[8] + PC0[9]) + (PC0[10] + PC0[11]); ps += (PC0[12] + PC0[13]) + (PC0[14] + PC0[15]); } \
        if (s_ == 3) { ps += (PC1[0] + PC1[1]) + (PC1[2] + PC1[3]); } \
        if (s_ == 4) { ps += (PC1[4] + PC1[5]) + (PC1[6] + PC1[7]); } \
        if (s_ == 5) { ps += (PC1[8] + PC1[9]); PK4X(PC1, 0, pa[2]); } \
        if (s_ == 6) { ps += (PC1[10] + PC1[11]) + (PC1[12] + PC1[13]); } \
        if (s_ == 7) { ps += (PC1[14] + PC1[15]); PK4X(PC1, 8, pa[3]); \
          auto rr_ = __builtin_amdgcn_permlane32_swap(__float_as_uint(ps), __float_as_uint(ps), false, false); ps = __uint_as_float(rr_[0]) + __uint_as_float(rr_[1]); l_reg = l_reg * (alC) + ps; } } \
      if (DO_QK && g + 2 < NG) kf[(g + 2) % 3] = KLD(g + 2, (BKN) * SHM_K); \
      if (g == NG - 2) vf[0] = vfrag<v_rd_off(0, 0, 0)>(vb0 + (BVC) * (int)SHM_V); \
      if (g == NG - 1) vf[1] = vfrag<v_rd_off(1, 0, 0)>(vb0 + (BVC) * (int)SHM_V); \
      SBAR(); } \
    _Pragma("unroll") for (int g = 0; g < 16; ++g) { \
      const int ks_ = g >> 2, d0_ = g & 3; \
      o[d0_] = __builtin_amdgcn_mfma_f32_32x32x16_bf16(pa[ks_], vf[g % 3], o[d0_], 0, 0, 0); \
      if (g == 0 && (DO_WR) && VAR != 5) { SWRITE(BW); } \
      if (g == 1 && (DO_LD) && VAR != 5) { SLOAD(((tt) + 3) * KVBLK); } \
      if (DO_QK && VAR < 4) {   \
        if (g == 2) { mxa = max3f(PN0[0], PN0[1], PN0[2]); mxa = max3f(mxa, PN0[3], PN0[4]); mxb = max3f(PN0[5], PN0[6], PN0[7]); mxb = max3f(mxb, PN0[8], PN0[9]); } \
        if (g == 3) { mxa = max3f(mxa, PN0[10], PN0[11]); mxb = max3f(mxb, PN0[12], PN0[13]); mxa = max3f(mxa, PN0[14], PN0[15]); mxb = max3f(mxb, PN1[0], PN1[1]); } \
        if (g == 4) { mxa = max3f(mxa, PN1[2], PN1[3]); mxb = max3f(mxb, PN1[4], PN1[5]); mxa = max3f(mxa, PN1[6], PN1[7]); mxb = max3f(mxb, PN1[8], PN1[9]); } \
        if (g == 5) { mxa = max3f(mxa, PN1[10], PN1[11]); mxb = max3f(mxb, PN1[12], PN1[13]); mxa = max3f(mxa, PN1[14], PN1[15]); mxa = __builtin_fmaxf(mxa, mxb); } \
        if (g == 6) { auto rr_ = __builtin_amdgcn_permlane32_swap(__float_as_uint(mxa), __float_as_uint(mxa), false, false); const float pmax_ = __builtin_fmaxf(__uint_as_float(rr_[0]), __uint_as_float(rr_[1])); \
          if constexpr (NEGM) { alN = 1.f; if (__builtin_expect(!__all(pmax_ <= thr2 + PSHIFT), 0)) { const float dl_ = __builtin_fmaxf(pmax_ - PSHIFT, 0.f); alN = __builtin_amdgcn_exp2f(-dl_); \
              _Pragma("unroll") for (int r = 0; r < 16; ++r) { PN0[r] -= dl_; PN1[r] -= dl_; negm[r] -= dl_; } } } \
          else { const bool ok_ = __all(pmax_ - m_reg <= thr_raw); const float mn_ = ok_ ? m_reg : __builtin_fmaxf(m_reg, pmax_); \
            alN = __builtin_amdgcn_exp2f((m_reg - mn_) * C); m_reg = mn_; mnC = -mn_ * C + PSHIFT; } } \
        if (g >= 7) { const int i_ = g - 7; \
          if constexpr (NEGM) {   \
            if (i_ < 4) { _Pragma("unroll") for (int r = 4 * i_; r < 4 * i_ + 4; ++r) PN0[r] = __builtin_amdgcn_exp2f(PN0[r]); } \
            else if (i_ < 8) { _Pragma("unroll") for (int r = 4 * (i_ - 4); r < 4 * (i_ - 4) + 4; ++r) PN1[r] = __builtin_amdgcn_exp2f(PN1[r]); } } \
          else {   \
          if (i_ < 4) { _Pragma("unroll") for (int r = 4 * i_; r < 4 * i_ + 4; ++r) PN0[r] = fmaf(PN0[r], C, mnC); } \
          else if (i_ < 8) { _Pragma("unroll") for (int r = 4 * (i_ - 4); r < 4 * (i_ - 4) + 4; ++r) PN1[r] = fmaf(PN1[r], C, mnC); } \
          if (i_ >= 1) { PN0[2 * (i_ - 1)] = __builtin_amdgcn_exp2f(PN0[2 * (i_ - 1)]); PN0[2 * (i_ - 1) + 1] = __builtin_amdgcn_exp2f(PN0[2 * (i_ - 1) + 1]); } } \
          asm volatile("" : "+v"(PN0), "+v"(PN1));   } } \
      if (g + 2 < 16) { constexpr int dummy_ = 0; (void)dummy_; \
        if (g + 2 == 2) vf[2] = vfrag<v_rd_off(2, 0, 0)>(vb0 + (BVC) * (int)SHM_V); if (g + 2 == 3) vf[0] = vfrag<v_rd_off(3, 0, 0)>(vb0 + (BVC) * (int)SHM_V); \
        if (g + 2 == 4) vf[1] = vfrag<v_rd_off(0, 1, 0)>(vb0 + (BVC) * (int)SHM_V); if (g + 2 == 5) vf[2] = vfrag<v_rd_off(1, 1, 0)>(vb0 + (BVC) * (int)SHM_V); \
        if (g + 2 == 6) vf[0] = vfrag<v_rd_off(2, 1, 0)>(vb0 + (BVC) * (int)SHM_V); if (g + 2 == 7) vf[1] = vfrag<v_rd_off(3, 1, 0)>(vb0 + (BVC) * (int)SHM_V); \
        if (g + 2 == 8) vf[2] = vfrag<v_rd_off(0, 2, 0)>(vb0 + (BVC) * (int)SHM_V); if (g + 2 == 9) vf[0] = vfrag<v_rd_off(1, 2, 0)>(vb0 + (BVC) * (int)SHM_V); \
        if (g + 2 == 10) vf[1] = vfrag<v_rd_off(2, 2, 0)>(vb0 + (BVC) * (int)SHM_V); if (g + 2 == 11) vf[2] = vfrag<v_rd_off(3, 2, 0)>(vb0 + (BVC) * (int)SHM_V); \
        if (g + 2 == 12) vf[0] = vfrag<v_rd_off(0, 3, 0)>(vb0 + (BVC) * (int)SHM_V); if (g + 2 == 13) vf[1] = vfrag<v_rd_off(1, 3, 0)>(vb0 + (BVC) * (int)SHM_V); \
        if (g + 2 == 14) vf[2] = vfrag<v_rd_off(2, 3, 0)>(vb0 + (BVC) * (int)SHM_V); if (g + 2 == 15) vf[0] = vfrag<v_rd_off(3, 3, 0)>(vb0 + (BVC) * (int)SHM_V); } \
      SBAR(); } \
    if (VAR >= 4) { asm volatile("" : "+v"(PN0), "+v"(PN1)); pa[0] = __builtin_bit_cast(bf16x8, (u32x4){(unsigned)tt, 1u, 2u, 3u}); pa[1] = pa[0]; pa[2] = pa[0]; pa[3] = pa[0]; } \
    if (DO_QK && VAR < 4) { RESC(alN); } \
    if (VAR != 5) __syncthreads(); } while (0)
  SLOAD(0); SWRITE(0); SLOAD(KVBLK); SWRITE(1); SLOAD(2 * KVBLK); __syncthreads();
  { float mn0_; qkt<NKC, NQR, 0>(pA0, pA1, kb, qr, ql);
    if constexpr (NEGM) { float pm_ = pA0[0];
      _Pragma("unroll") for (int r = 1; r < 16; ++r) pm_ = fmaxf(pm_, pA0[r]);
      _Pragma("unroll") for (int r = 0; r < 16; ++r) pm_ = fmaxf(pm_, pA1[r]);
      { auto rr_ = __builtin_amdgcn_permlane32_swap(__float_as_uint(pm_), __float_as_uint(pm_), false, false); pm_ = fmaxf(__uint_as_float(rr_[0]), __uint_as_float(rr_[1])); }
      _Pragma("unroll") for (int r = 0; r < 16; ++r) { pA0[r] = __builtin_amdgcn_exp2f(pA0[r] - pm_ + PSHIFT); pA1[r] = __builtin_amdgcn_exp2f(pA1[r] - pm_ + PSHIFT); negm[r] = -pm_ + PSHIFT; }
      alA = 1.f; (void)mn0_; }
    else partialSM(pA0, pA1, m_reg, mn0_, alA, C, thr_raw); }
#ifdef ATT_STATIC_PRIO
  if (__builtin_amdgcn_readfirstlane(tid) >= 256) __builtin_amdgcn_s_setprio(1);
#endif
  int t = 0;
  for (; t + 6 < NT; t += 6) {
    STEP(pB0, pB1, alB, pA0, pA1, alA, 1, 0, 2, true, true, true, t);
    STEP(pA0, pA1, alA, pB0, pB1, alB, 2, 1, 0, true, true, true, t + 1);
    STEP(pB0, pB1, alB, pA0, pA1, alA, 0, 2, 1, true, true, true, t + 2);
    STEP(pA0, pA1, alA, pB0, pB1, alB, 1, 0, 2, true, true, true, t + 3);
    STEP(pB0, pB1, alB, pA0, pA1, alA, 2, 1, 0, true, true, true, t + 4);
    STEP(pA0, pA1, alA, pB0, pB1, alB, 0, 2, 1, true, true, true, t + 5);
  }
  STEP(pB0, pB1, alB, pA0, pA1, alA, 1, 0, 2, true, true, true, t);
  STEP(pA0, pA1, alA, pB0, pB1, alB, 2, 1, 0, true, true, true, t + 1);
  STEP(pB0, pB1, alB, pA0, pA1, alA, 0, 2, 1, true, true, true, t + 2);
  STEP(pA0, pA1, alA, pB0, pB1, alB, 1, 0, 2, true, true, false, t + 3);
  STEP(pB0, pB1, alB, pA0, pA1, alA, 2, 1, 0, true, false, false, t + 4);
  STEP(pA0, pA1, alA, pB0, pB1, alB, 0, 2, 1, false, false, false, t + 5);
#ifdef ATT_STATIC_PRIO
  __builtin_amdgcn_s_setprio(0);
#endif
  if (hi == 0) li_l[r32] = l_reg; asm volatile("s_waitcnt lgkmcnt(0)" ::: "memory");
  float rli[16];
#pragma unroll
  for (int r = 0; r < 16; ++r) rli[r] = __builtin_amdgcn_rcpf(li_l[crow(r, hi)]);
  if constexpr (OM == 1) {
    unsigned* st = (unsigned*)stash + tid;
#pragma unroll
    for (int r = 0; r < 16; ++r) { st[(2 * r) * 512] = cvt_pk_bf16(o[0][r] * rli[r], o[1][r] * rli[r]); st[(2 * r + 1) * 512] = cvt_pk_bf16(o[2][r] * rli[r], o[3][r] * rli[r]); }
  } else if constexpr (OM == 2) {
    const unsigned* st = (const unsigned*)stash + tid;
    float sw[4];
#pragma unroll
    for (int d0 = 0; d0 < 4; ++d0) sw[d0] = subw[d0 * 32 + r32] * 0.8f;
    bf16_t* Ow = Ob + (long)(wid * QBLK) * ldo;
#pragma unroll
    for (int r = 0; r < 16; ++r) { const unsigned w01 = st[(2 * r) * 512], w23 = st[(2 * r + 1) * 512];
      const float d0v = bflo(w01) - lam * (o[0][r] * rli[r]), d1v = bfhi(w01) - lam * (o[1][r] * rli[r]), d2v = bflo(w23) - lam * (o[2][r] * rli[r]), d3v = bfhi(w23) - lam * (o[3][r] * rli[r]);
      float ss = (d0v * d0v + d1v * d1v) + (d2v * d2v + d3v * d3v);
      ss += __shfl_xor(ss, 1); ss += __shfl_xor(ss, 2); ss += __shfl_xor(ss, 4); ss += __shfl_xor(ss, 8); ss += __shfl_xor(ss, 16);
      const float rn = rsqrtf(ss * (1.f / 128.f) + EPS); const long ob = (long)crow(r, hi) * ldo + r32;
      Ow[ob] = f2bf(d0v * rn * sw[0]); Ow[ob + 32] = f2bf(d1v * rn * sw[1]); Ow[ob + 64] = f2bf(d2v * rn * sw[2]); Ow[ob + 96] = f2bf(d3v * rn * sw[3]); }
  } else {
  bf16_t* Ow = Ob + (long)(wid * QBLK) * ldo;
#pragma unroll
  for (int r = 0; r < 16; ++r) { const int orow = crow(r, hi);
#pragma unroll
    for (int d0 = 0; d0 < 4; ++d0) Ow[(long)orow * ldo + d0 * 32 + r32] = f2bf(o[d0][r] * rli[r]); }
  }
#undef SLOAD
#undef BL128
#undef SWRITE
#undef RESC
#undef STEP
#undef KLD
#undef QLD
}
#undef PK4X
#undef KOFF
#undef SBAR
}
namespace attn8 {
#if SIM_P6
#define SQ6(x) q8(x)
#else
#define SQ6(x) (x)
#endif
using attn::f32x16; using attn::crow; using attn::max3f;
typedef int v8i32 __attribute__((ext_vector_type(8)));
typedef int v4i32 __attribute__((ext_vector_type(4)));
#ifndef ATT8_THRL
#define ATT8_THRL 3.5f
#endif
constexpr float PSH = 5.f, THRL = ATT8_THRL;
#define OFF8(row, piece) ((row) * 64 + ((((piece) ^ ((row) >> 2)) & 3) << 4))
#define SBAR() __builtin_amdgcn_sched_barrier(0)
#define MFMA8(a, b, c) __builtin_amdgcn_mfma_scale_f32_32x32x64_f8f6f4(a, b, c, 0, 0, 0, 0, 0, 0)
#define LD32(addr0, addr1) __builtin_shufflevector(*(const LAS v4i32*)(uintptr_t)(unsigned)(addr0), *(const LAS v4i32*)(uintptr_t)(unsigned)(addr1), 0, 1, 2, 3, 4, 5, 6, 7)

constexpr int WCONV_I1 = 32 * 128 * 32, WCONV_I2 = 32 * 128 * 16, WCONV_ITEMS = WCONV_I1 + WCONV_I2;
struct WConv { float v[8]; };
__device__ __forceinline__ void wconv_load(const Params& p, int it, int lane, WConv& w) {
    it = min(it, WCONV_ITEMS - 1);
    const bool m1 = it < WCONV_I1; const int i2 = m1 ? it : it - WCONV_I1;
    const int e = m1 ? (i2 >> 12) : (i2 >> 11), kb = m1 ? ((i2 >> 5) & 127) : ((i2 >> 4) & 127), nb = m1 ? (i2 & 31) : (i2 & 15), ldn = m1 ? 2048 : 1024;
    const __amdgpu_buffer_rsrc_t r = __builtin_amdgcn_make_buffer_rsrc((void*)(m1 ? p.w1 : p.w2), 0, 0xffffffff, 0x00020000);
    const int so = ((e * 1024 + kb * 8) * ldn + nb * 64) * 4;
#pragma unroll
    for (int j = 0; j < 8; ++j) w.v[j] = __builtin_bit_cast(float, __builtin_amdgcn_raw_buffer_load_b32(r, lane * 4, so + j * ldn * 4, 0));
}
__device__ __forceinline__ void wconv_store(const Params& p, int it0, int lane, const WConv& w) {
    const int it = min(it0, WCONV_ITEMS - 1);
    const bool m1 = it < WCONV_I1; const int i2 = m1 ? it : it - WCONV_I1;
    const int e = m1 ? (i2 >> 12) : (i2 >> 11), kb = m1 ? ((i2 >> 5) & 127) : ((i2 >> 4) & 127), nb = m1 ? (i2 & 31) : (i2 & 15);
    const int n = nb * 64 + lane;
    const int drow = m1 ? (e * 2048 + ((n & 1023) >> 7) * 256 + (n >> 10) * 128 + (n & 127)) : (e * 1024 + n);
    unsigned char* dst = it0 < WCONV_ITEMS ? p.ws + (m1 ? WS_W1 : WS_W2) + (size_t)drow * 1024 + kb * 8 : p.ws + WS_DUMMY + lane * 8;
    u32x2 o; o.x = cvt4_fp8(w.v[0] * WQ_SCALE, w.v[1] * WQ_SCALE, w.v[2] * WQ_SCALE, w.v[3] * WQ_SCALE); o.y = cvt4_fp8(w.v[4] * WQ_SCALE, w.v[5] * WQ_SCALE, w.v[6] * WQ_SCALE, w.v[7] * WQ_SCALE);
    *(u32x2*)dst = o;
}
template <int NKC, int OM, int VAR = 0, bool WC = false>
__device__ __forceinline__ void attn_unit(const unsigned char* __restrict__ Qb, int ldq, const unsigned char* kp0, int kld0, const unsigned char* kp1, int kld1, const unsigned char* kp2, int kld2,
                                          const unsigned char* __restrict__ VT, bf16_t* __restrict__ Ob, int ldo, int seq, char* lds,
                                          char* stash = nullptr, const float lam = 0.f, const float* __restrict__ subw = nullptr, const Params* pp = nullptr, int wc_base = 0) {
  constexpr int SHM_K = NKC * 4096, SHM_V = 8192, NG = 2 * NKC;
  constexpr bool STG = ((STAGGER) >> (NKC == 1 ? 0 : 1)) & 1;
  constexpr bool V_M = VAR >= 32, V_NOLDS = VAR == 6 || VAR == 9 || V_M, V_NOSTG = VAR == 2 || VAR == 3 || VAR == 9 || V_M, V_NOBAR = VAR == 3 || VAR == 9 || V_M;
  constexpr bool V_NOEXP = VAR == 1 || VAR == 7 || (V_M && (VAR & 1)), V_NOMAX = VAR == 1 || VAR == 7 || (V_M && (VAR & 2)), V_NOPACK = V_M && (VAR & 4);
  constexpr bool V_NOPV = VAR == 4 || VAR == 7 || (V_M && (VAR & 8)), V_NOQK = VAR == 5 || (V_M && (VAR & 16));
  const int tid = tid_opaque(), wid = tid >> 6, lane = tid & 63, r32 = lane & 31, hi = lane >> 5;
  char* V_lds = lds; char* K_lds = lds + 4 * SHM_V;
  float* ws = (float*)(lds + 4 * SHM_V + 4 * SHM_K) + wid * 64; float* al_l = ws + 32;
  f32x16 o[4] = {}, ol = {}; v8i32 qf[NKC];
  v8i32 ones8 = {0x38383838, 0x38383838, 0x38383838, 0x38383838, 0x38383838, 0x38383838, 0x38383838, 0x38383838};
  asm volatile("" : "+v"(ones8));
  { const unsigned char* Qw = Qb + (long)(wid * 32 + r32) * ldq + hi * 32;
#pragma unroll
    for (int c = 0; c < NKC; ++c) qf[c] = __builtin_shufflevector(*(const v4i32*)(Qw + c * 64), *(const v4i32*)(Qw + c * 64 + 16), 0, 1, 2, 3, 4, 5, 6, 7); }
  const int fa0 = OFF8(r32, 2 * hi), fa1 = OFF8(r32, 2 * hi + 1);
  const LAS char* kA = (const LAS char*)(uintptr_t)(unsigned)((int)(uintptr_t)K_lds + fa0); const LAS char* kB = (const LAS char*)(uintptr_t)(unsigned)((int)(uintptr_t)K_lds + fa1);
  const LAS char* vA = (const LAS char*)(uintptr_t)(unsigned)((int)(uintptr_t)V_lds + fa0); const LAS char* vB = (const LAS char*)(uintptr_t)(unsigned)((int)(uintptr_t)V_lds + fa1);
  const int ve = tid >> 2, pc = tid & 3, krow = (tid & 255) >> 2;
  const int vst = OFF8(ve, pc), kst = OFF8(krow, pc);
  const bool lowhalf = tid < 256;
  const bool grpB = __builtin_amdgcn_readfirstlane(wid) >= 4;
  const unsigned vo = (unsigned)(ve * RPB + pc * 16);
  const unsigned ko0 = (unsigned)(krow * kld0 + pc * 16), ko1 = (unsigned)(krow * kld1 + pc * 16), ko2 = (unsigned)(krow * kld2 + pc * 16);
  const __amdgpu_buffer_rsrc_t rV = __builtin_amdgcn_make_buffer_rsrc((void*)VT, 0, 0xffffffff, 0x00020000);
  const __amdgpu_buffer_rsrc_t rK0 = __builtin_amdgcn_make_buffer_rsrc((void*)kp0, 0, 0xffffffff, 0x00020000);
  const __amdgpu_buffer_rsrc_t rK1 = __builtin_amdgcn_make_buffer_rsrc((void*)(NKC > 1 ? kp1 : kp0), 0, 0xffffffff, 0x00020000);
  const __amdgpu_buffer_rsrc_t rK2 = __builtin_amdgcn_make_buffer_rsrc((void*)(NKC > 2 ? kp2 : kp0), 0, 0xffffffff, 0x00020000);
  struct { v4i32 v, ka, kc; } sg;
#define BL16(r, vo_, so_) __builtin_bit_cast(v4i32, __builtin_amdgcn_raw_buffer_load_b128(r, (int)(vo_), (int)(so_), 0))
#define SLOAD(k0) do { sg.v = BL16(rV, vo, (k0)); \
    if constexpr (NKC == 1) { if (lowhalf) sg.ka = BL16(rK0, ko0, (k0) * kld0); } \
    else { if (lowhalf) { sg.ka = BL16(rK0, ko0, (k0) * kld0); sg.kc = BL16(rK2, ko2, (k0) * kld2); } else sg.ka = BL16(rK1, ko1, (k0) * kld1); } } while (0)
#define SWRITE(b) do { *(v4i32*)(V_lds + (b) * SHM_V + vst) = sg.v; \
    if constexpr (NKC == 1) { if (lowhalf) *(v4i32*)(K_lds + (b) * SHM_K + kst) = sg.ka; } \
    else { if (lowhalf) { *(v4i32*)(K_lds + (b) * SHM_K + kst) = sg.ka; *(v4i32*)(K_lds + (b) * SHM_K + 8192 + kst) = sg.kc; } else *(v4i32*)(K_lds + (b) * SHM_K + 4096 + kst) = sg.ka; } } while (0)
#define RESC(a) do { if (raised_) { if (hi == 0) al_l[r32] = (a); asm volatile("s_waitcnt lgkmcnt(0)" ::: "memory"); \
    _Pragma("unroll") for (int r = 0; r < 16; ++r) { const float a_ = al_l[crow(r, hi)]; o[0][r] *= a_; o[1][r] *= a_; o[2][r] *= a_; o[3][r] *= a_; ol[r] *= a_; } } } while (0)
#define LDP(pa, pb, off) __builtin_shufflevector(*(const LAS v4i32*)((pa) + (off)), *(const LAS v4i32*)((pb) + (off)), 0, 1, 2, 3, 4, 5, 6, 7)
#define KFR(g, KB) (V_NOLDS ? qf[0] : LDP(kA, kB, (KB) + ((g) >> 1) * 4096 + ((g) & 1) * 2048))
#define VFR(d0, VB) (V_NOLDS ? qf[0] : LDP(vA, vB, (VB) + (d0) * 2048))
  f32x16 P0, P1, negm; float al = 1.f; const int NT = seq / 64;
  v8i32 kpf0, kpf1;
  v8i32 pf;
#define PACKP() do { pf = (v8i32){(int)cvt4_fp8(P0[0], P0[1], P0[2], P0[3]), (int)cvt4_fp8(P0[4], P0[5], P0[6], P0[7]), (int)cvt4_fp8(P0[8], P0[9], P0[10], P0[11]), (int)cvt4_fp8(P0[12], P0[13], P0[14], P0[15]), \
    (int)cvt4_fp8(P1[0], P1[1], P1[2], P1[3]), (int)cvt4_fp8(P1[4], P1[5], P1[6], P1[7]), (int)cvt4_fp8(P1[8], P1[9], P1[10], P1[11]), (int)cvt4_fp8(P1[12], P1[13], P1[14], P1[15])}; } while (0)
#define PACK0() do { asm volatile("" : "+v"(P0)); pf[0] = (int)cvt4_fp8o(pf[0], P0[0], P0[1], P0[2], P0[3]); pf[1] = (int)cvt4_fp8o(pf[1], P0[4], P0[5], P0[6], P0[7]); \
    pf[2] = (int)cvt4_fp8o(pf[2], P0[8], P0[9], P0[10], P0[11]); pf[3] = (int)cvt4_fp8o(pf[3], P0[12], P0[13], P0[14], P0[15]); asm volatile("" : "+v"(pf)); } while (0)
#define PACK1() do { asm volatile("" : "+v"(P1)); pf[4] = (int)cvt4_fp8o(pf[4], P1[0], P1[1], P1[2], P1[3]); pf[5] = (int)cvt4_fp8o(pf[5], P1[4], P1[5], P1[6], P1[7]); \
    pf[6] = (int)cvt4_fp8o(pf[6], P1[8], P1[9], P1[10], P1[11]); pf[7] = (int)cvt4_fp8o(pf[7], P1[12], P1[13], P1[14], P1[15]); asm volatile("" : "+v"(pf)); } while (0)
#define MAX0() do { m0_ = max3f(P0[0], P0[1], P0[2]); m0_ = max3f(m0_, P0[3], P0[4]); m0_ = max3f(m0_, P0[5], P0[6]); m0_ = max3f(m0_, P0[7], P0[8]); m0_ = max3f(m0_, P0[9], P0[10]); \
    m0_ = max3f(m0_, P0[11], P0[12]); m0_ = max3f(m0_, P0[13], P0[14]); asm volatile("" : "+v"(m0_)); } while (0)
#define MAXFIN() do { float m1_ = max3f(P1[0], P1[1], P1[2]); m1_ = max3f(m1_, P1[3], P1[4]); m1_ = max3f(m1_, P1[5], P1[6]); m1_ = max3f(m1_, P1[7], P1[8]); m1_ = max3f(m1_, P1[9], P1[10]); \
    m1_ = max3f(m1_, P1[11], P1[12]); m1_ = max3f(m1_, P1[13], P1[14]); m1_ = max3f(m1_, P1[15], P0[15]); mx_ = fmaxf(m1_, m0_);          \
    if (__builtin_expect(!__all(mx_ <= PSH + THRL), 0)) { \
      { auto rr_ = __builtin_amdgcn_permlane32_swap(__float_as_uint(mx_), __float_as_uint(mx_), false, false); mx_ = fmaxf(__uint_as_float(rr_[0]), __uint_as_float(rr_[1])); }     \
      const float dl_ = fmaxf(mx_ - PSH, 0.f); al = __builtin_amdgcn_exp2f(-dl_); raised_ = true; \
      _Pragma("unroll") for (int r = 0; r < 16; ++r) { P0[r] -= dl_; P1[r] -= dl_; negm[r] -= dl_; } } } while (0)
#define EXPS(P, ra, rb) do { asm volatile("" : "+v"(P)); _Pragma("unroll") for (int r = (ra); r < (rb); ++r) P[r] = __builtin_amdgcn_exp2f(P[r]); asm volatile("" : "+v"(P)); } while (0)
#define MPIN(acc) asm volatile("" : "+v"(acc))
#define STEP(BKN, BVC, BW, BKP, DO_QK, DO_WR, DO_LD, DO_KP, tt) do { \
    v8i32 kf[2], vf[3]; float mx_ = 0.f, m0_ = 0.f; bool raised_ = false; \
    SBAR(); \
    if (DO_QK && NG > 2) { kf[0] = KFR(2, (BKN) * SHM_K); kf[1] = KFR(3, (BKN) * SHM_K); } \
    _Pragma("unroll") for (int g = 0; g < NG; ++g) { \
      if (DO_QK && !V_NOQK) { if (g == 0) { P0 = MFMA8(kpf0, qf[0], negm); MPIN(P0); } else if (g == 1) { P1 = MFMA8(kpf1, qf[0], negm); MPIN(P1); } \
        else if ((g & 1) == 0) { P0 = MFMA8(kf[g & 1], qf[g >> 1], P0); MPIN(P0); } else { P1 = MFMA8(kf[g & 1], qf[g >> 1], P1); MPIN(P1); } } \
      SBAR(); \
      if (g == 0 && !V_NOPACK) { PACK1(); }                            \
      if (DO_QK && NG == 2 && g == 1 && !V_NOMAX) { MAX0(); } \
      if (DO_QK && g >= 2 && g + 2 < NG) kf[g & 1] = KFR(g + 2, (BKN) * SHM_K); \
      if (g == NG - 2) vf[0] = VFR(0, (BVC) * SHM_V); if (g == NG - 1) vf[1] = VFR(1, (BVC) * SHM_V); \
      SBAR(); } \
      \
    if (!V_NOPV) { o[0] = MFMA8(pf, vf[0], o[0]); MPIN(o[0]); } SBAR(); if (DO_WR && !V_NOSTG) { SWRITE(BW); } if (DO_LD && !V_NOSTG) { SLOAD(((tt) + 4) * 64); } vf[2] = VFR(2, (BVC) * SHM_V); al = 1.f; \
    if (DO_QK && !V_NOMAX) { if (NG == 2) { MAXFIN(); } else { MAX0(); } } SBAR(); \
      \
    if (!V_NOPV) { o[1] = MFMA8(pf, vf[1], o[1]); MPIN(o[1]); } SBAR(); vf[0] = VFR(3, (BVC) * SHM_V); \
    if (DO_QK && NG == 2 && !V_NOEXP) { EXPS(P0, 0, 8); } if (DO_QK && NG != 2 && !V_NOMAX) { MAXFIN(); } SBAR(); \
    if (STG && grpB && !V_NOBAR) { __syncthreads(); } SBAR();   \
      \
    if (!V_NOPV) { o[2] = MFMA8(pf, vf[2], o[2]); MPIN(o[2]); } SBAR(); if (DO_QK && !V_NOEXP) { if (NG == 2) { EXPS(P0, 8, 16); } else { EXPS(P0, 0, 11); } } SBAR(); \
    if (!V_NOPV) { o[3] = MFMA8(pf, vf[0], o[3]); MPIN(o[3]); } SBAR(); if (DO_QK && !V_NOEXP) { if (NG == 2) { EXPS(P1, 0, 8); } else { EXPS(P0, 11, 16); EXPS(P1, 0, 6); } } \
    if (DO_KP) { kpf0 = KFR(0, (BKP) * SHM_K); kpf1 = KFR(1, (BKP) * SHM_K); } SBAR(); \
    if (!V_NOPV) { ol = MFMA8(pf, ones8, ol); MPIN(ol); } SBAR(); if (DO_QK && !V_NOEXP) { if (NG == 2) { EXPS(P1, 8, 16); } else { EXPS(P1, 6, 16); } } SBAR(); \
    if (DO_QK) { if (!V_NOPACK) { PACK0(); } RESC(al); } \
    if (!V_NOBAR && !(STG && grpB)) __syncthreads(); } while (0)
  __syncthreads();
  SLOAD(0); SWRITE(0); SLOAD(64); SWRITE(1); SLOAD(128); SWRITE(2); SLOAD(192); __syncthreads();
#pragma unroll
  for (int r = 0; r < 16; ++r) negm[r] = 0.f;
#pragma unroll
  for (int c = 0; c < NKC; ++c) { const v8i32 k0_ = KFR(2 * c, 0), k1_ = KFR(2 * c + 1, 0);
    if (c == 0) { P0 = MFMA8(k0_, qf[c], negm); P1 = MFMA8(k1_, qf[c], negm); } else { P0 = MFMA8(k0_, qf[c], P0); P1 = MFMA8(k1_, qf[c], P1); } }
  { float mx_ = P0[0];
#pragma unroll
    for (int r = 1; r < 16; ++r) mx_ = fmaxf(mx_, P0[r]);
#pragma unroll
    for (int r = 0; r < 16; ++r) mx_ = fmaxf(mx_, P1[r]);
    { auto rr_ = __builtin_amdgcn_permlane32_swap(__float_as_uint(mx_), __float_as_uint(mx_), false, false); mx_ = fmaxf(__uint_as_float(rr_[0]), __uint_as_float(rr_[1])); }
#pragma unroll
    for (int r = 0; r < 16; ++r) { P0[r] = __builtin_amdgcn_exp2f(P0[r] - mx_ + PSH); P1[r] = __builtin_amdgcn_exp2f(P1[r] - mx_ + PSH); negm[r] = PSH - mx_; } }
  PACKP();
  kpf0 = KFR(0, 1 * SHM_K); kpf1 = KFR(1, 1 * SHM_K);
  int t = 0;
  WConv wcv; int wc_it = wc_base + __builtin_amdgcn_readfirstlane(wid);
  for (; t + 7 < NT; t += 4) {
    STEP(1, 0, 3, 2, true, true, true, true, t);
    if constexpr (WC) wconv_load(*pp, wc_it, lane, wcv);
    STEP(2, 1, 0, 3, true, true, true, true, t + 1);
    STEP(3, 2, 1, 0, true, true, true, true, t + 2);
    if constexpr (WC) { wconv_store(*pp, wc_it, lane, wcv); wc_it += (int)gridDim.x * 8; }
    STEP(0, 3, 2, 1, true, true, true, true, t + 3);
  }
  STEP(1, 0, 3, 2, true, true, false, true, t);
  STEP(2, 1, 0, 3, true, false, false, true, t + 1);
  STEP(3, 2, 1, 0, true, false, false, false, t + 2);
  STEP(0, 3, 2, 1, false, false, false, false, t + 3);
  float rli[16];
#pragma unroll
  for (int r = 0; r < 16; ++r) rli[r] = __builtin_amdgcn_rcpf(ol[r]);
  if constexpr (OM == 1) {
    unsigned* st = (unsigned*)stash + tid;
#pragma unroll
    for (int r = 0; r < 16; ++r) { st[(2 * r) * 512] = cvt_pk_bf16(o[0][r] * rli[r], o[1][r] * rli[r]); st[(2 * r + 1) * 512] = cvt_pk_bf16(o[2][r] * rli[r], o[3][r] * rli[r]); }
  } else if constexpr (OM == 2) {
    const unsigned* st = (const unsigned*)stash + tid;
    float sw[4];
#pragma unroll
    for (int d0 = 0; d0 < 4; ++d0) sw[d0] = subw[d0 * 32 + r32] * 0.8f;
    bf16_t* Ow = Ob + (long)(wid * 32) * ldo;
#pragma unroll
    for (int r = 0; r < 16; ++r) { const unsigned w01 = st[(2 * r) * 512], w23 = st[(2 * r + 1) * 512];
      const float d0v = bflo(w01) - lam * (o[0][r] * rli[r]), d1v = bfhi(w01) - lam * (o[1][r] * rli[r]), d2v = bflo(w23) - lam * (o[2][r] * rli[r]), d3v = bfhi(w23) - lam * (o[3][r] * rli[r]);
      float ss = (d0v * d0v + d1v * d1v) + (d2v * d2v + d3v * d3v);
      ss += __shfl_xor(ss, 1); ss += __shfl_xor(ss, 2); ss += __shfl_xor(ss, 4); ss += __shfl_xor(ss, 8); ss += __shfl_xor(ss, 16);
      const float rn = rsqrtf(ss * (1.f / 128.f) + EPS); const long ob = (long)crow(r, hi) * ldo + r32;
      Ow[ob] = f2bf(SQ6(d0v * rn * sw[0])); Ow[ob + 32] = f2bf(SQ6(d1v * rn * sw[1])); Ow[ob + 64] = f2bf(SQ6(d2v * rn * sw[2])); Ow[ob + 96] = f2bf(SQ6(d3v * rn * sw[3])); }
  } else {
    bf16_t* Ow = Ob + (long)(wid * 32) * ldo;
#pragma unroll
    for (int r = 0; r < 16; ++r) { const int orow = crow(r, hi);
#pragma unroll
      for (int d0 = 0; d0 < 4; ++d0) Ow[(long)orow * ldo + d0 * 32 + r32] = f2bf(SQ6(o[d0][r] * rli[r] * 32.f) * (1.f / 32.f)); }
  }
#undef BL16
#undef SLOAD
#undef SWRITE
#undef RESC
#undef KFR
#undef VFR
#undef LDP
#undef STEP
#undef PACKP
#undef MPIN
#undef PACK0
#undef PACK1
#undef MAX0
#undef MAXFIN
#undef EXPS
}
#undef OFF8
#undef SBAR
#undef MFMA8
#undef LD32
}
#ifdef HW_XCD_MAP
__device__ __forceinline__ int att_cc(const Params& p, const char* lds, int u) {
    const volatile unsigned* bst = (const volatile unsigned*)(lds + 160 * 1024 - 512); const unsigned* cnt = (const unsigned*)(p.ws + WS_BAR) + 3500;
    bool ok = gridDim.x == 256;
#pragma unroll
    for (int i = 0; i < 8; ++i) ok = ok && (__hip_atomic_load(cnt + i, __ATOMIC_RELAXED, __HIP_MEMORY_SCOPE_AGENT) == 32u);
    return ok ? (int)(bst[2] + 8u * bst[3]) : -1;
}
#define ATT_CC(u) (hwcc_ >= 0 ? hwcc_ : ((u) & 255))
#else
#define ATT_CC(u) ((u) & 255)
#endif
#ifdef HW_XCD_MAP
#define ATT_CC_INIT const int hwcc_ = __builtin_amdgcn_readfirstlane(att_cc(p, lds, 0));
#else
#define ATT_CC_INIT
#endif
__device__ __forceinline__ void p4_attention_diff(const Params& p, char* lds) {
    unsigned char* ws = p.ws;
    const bf16_t* PJ = (const bf16_t*)(ws + WS_PJ); bf16_t* MIX = (bf16_t*)(ws + WS_MIX);
    char* stash = lds + 80 * 1024;
    ATT_CC_INIT
#if ATT_FP8 && WCONV_IN_ATT
    const int wcoff = gridDim.x == 256 ? 0 : attn8::WCONV_ITEMS;
    if (gridDim.x != 256) { const int tid_ = tid_opaque(), lane_ = tid_ & 63, gw_ = blockIdx.x * NWAVES + (tid_ >> 6), NGW_ = gridDim.x * NWAVES;
        for (int it = gw_; it < attn8::WCONV_ITEMS; it += NGW_) { attn8::WConv w_; attn8::wconv_load(p, it, lane_, w_); attn8::wconv_store(p, it, lane_, w_); } }
#else
    const int wcoff = 0;
#endif
    for (int u = blockIdx.x; u < 512 + ATT_EXTRA; u += gridDim.x) {
        const int round = (u >> 8) & 1, cc = ATT_CC(u), x = ATT_X(cc), j = ATT_J(cc);
        const int pd = x * 2 + round, b = pd >> 2, h = pd & 3;
        const size_t krow0 = (size_t)b * RPB, qrow0 = krow0 + CTX + (size_t)j * 256;
#if ATT_EXTRA
        if (u >= 512) { const unsigned char* vtx_ = ws + WS_VT8D + (size_t)(b * 4 + h) * 128 * RPB;
            attn8::attn_unit<1, 0, ATT_VAR>(ws + WS_Q8D + qrow0 * 512 + (2 * h) * 64, 512, ws + WS_K8D + krow0 * 512 + (2 * h) * 64, 512, nullptr, 0, nullptr, 0, vtx_, (bf16_t*)(ws + WS_AO) + qrow0 * 128, 128, RPB, lds);
            attn8::attn_unit<1, 0, ATT_VAR>(ws + WS_Q8D + qrow0 * 512 + (2 * h + 1) * 64, 512, ws + WS_K8D + krow0 * 512 + (2 * h + 1) * 64, 512, nullptr, 0, nullptr, 0, vtx_, (bf16_t*)(ws + WS_AO) + qrow0 * 128, 128, RPB, lds);
            continue; }
#endif
#if ATT_FP8
        const unsigned char* vt_ = ws + WS_VT8D + (size_t)(b * 4 + h) * 128 * RPB;
        const int wcb0 = wcoff + ((u / (int)gridDim.x) * 2 + 0) * 32 * (int)gridDim.x * 8 + (int)blockIdx.x * 8, wcb1 = wcb0 + 32 * (int)gridDim.x * 8;
        if (u < (int)gridDim.x) attn8::attn_unit<1, 1, 0, WCONV_IN_ATT != 0>(ws + WS_Q8D + qrow0 * 512 + (2 * h) * 64, 512, ws + WS_K8D + krow0 * 512 + (2 * h) * 64, 512, nullptr, 0, nullptr, 0, vt_, nullptr, 0, RPB, lds, stash, 0.f, nullptr, &p, wcoff + 131072 + (int)blockIdx.x * 8);
        else attn8::attn_unit<1, 1, 0, false>(ws + WS_Q8D + qrow0 * 512 + (2 * h) * 64, 512, ws + WS_K8D + krow0 * 512 + (2 * h) * 64, 512, nullptr, 0, nullptr, 0, vt_, nullptr, 0, RPB, lds, stash);
#else
        attn::attn_unit<1, 1, 0, 1>(PJ + qrow0 * NPROJ + (2 * h) * 64, NPROJ, PJ + krow0 * NPROJ + 512 + (2 * h) * 64, NPROJ, nullptr, 0, nullptr, 0,
                              PJ + krow0 * NPROJ + 1024 + h * 128, NPROJ, nullptr, 0, RPB, 1.f, lds, stash);
#endif
        const int lane_ = tid_opaque() & 63;
        const float s1 = wave_sum(p.lq1[lane_] * p.lk1[lane_]), s2 = wave_sum(p.lq2[lane_] * p.lk2[lane_]);
        const float lam = __expf(s1) - __expf(s2) + 0.2f;
#if ATT_FP8
        attn8::attn_unit<1, 2, 0, false>(ws + WS_Q8D + qrow0 * 512 + (2 * h + 1) * 64, 512, ws + WS_K8D + krow0 * 512 + (2 * h + 1) * 64, 512, nullptr, 0, nullptr, 0, vt_, MIX + qrow0 * 1024 + h * 128, 1024, RPB, lds, stash, lam, p.subln_w, &p, wcb1);
#else
        attn::attn_unit<1, 1, 0, 2>(PJ + qrow0 * NPROJ + (2 * h + 1) * 64, NPROJ, PJ + krow0 * NPROJ + 512 + (2 * h + 1) * 64, NPROJ, nullptr, 0, nullptr, 0,
                              PJ + krow0 * NPROJ + 1024 + h * 128, NPROJ, MIX + qrow0 * 1024 + h * 128, 1024, RPB, 1.f, lds, stash, lam, p.subln_w);
#endif
    }
}
__device__ __forceinline__ void p4_attention_mla(const Params& p, char* lds) {
    unsigned char* ws = p.ws;
    const bf16_t* PJ = (const bf16_t*)(ws + WS_PJ); const bf16_t* QM = (const bf16_t*)(ws + WS_QM); const bf16_t* KVb = (const bf16_t*)(ws + WS_KV);
    bf16_t* MIX = (bf16_t*)(ws + WS_MIX);
    constexpr float LOG2E = 1.4426950408889634f;
    ATT_CC_INIT
    for (int u = blockIdx.x; u < 512; u += gridDim.x) {
        const int round = u >> 8, cc = ATT_CC(u), x = ATT_X(cc), j = ATT_J(cc);
        const int pd = x * 2 + round, b = pd >> 2, h = pd & 3;
        const size_t krow0 = (size_t)b * RPB, qrow0 = krow0 + CTX + (size_t)j * 256;
#if ATT_FP8
        const int wcb = (gridDim.x == 256 ? 0 : attn8::WCONV_ITEMS) + (u / (int)gridDim.x) * 32 * (int)gridDim.x * 8 + (int)blockIdx.x * 8;
        attn8::attn_unit<3, 0, 0, WCONV_IN_ATT != 0>(ws + WS_Q8M + qrow0 * 768 + h * 192, 768, ws + WS_K8M + krow0 * 512 + h * 128, 512, ws + WS_K8M + krow0 * 512 + h * 128 + 64, 512, ws + WS_KR8 + krow0 * 64, 64,
                               ws + WS_VT8M + (size_t)(b * 4 + h) * 128 * RPB, MIX + qrow0 * 1024 + 512 + h * 128, 1024, RPB, lds, nullptr, 0.f, nullptr, &p, wcb);
#else
        attn::attn_unit<3, MLA_NQR>(QM + qrow0 * 768 + h * 192, 768, KVb + krow0 * 1024 + h * 256, 1024, KVb + krow0 * 1024 + h * 256 + 64, 1024, PJ + krow0 * NPROJ + 1920, NPROJ,
                              KVb + krow0 * 1024 + h * 256 + 128, 1024, MIX + qrow0 * 1024 + 512 + h * 128, 1024, RPB, 0.07216878364870322f * LOG2E, lds);
#endif
    }
}

__device__ __forceinline__ void p5_mix(const Params& p) {
    const int tid = tid_opaque(), lane = tid & 63, wave = tid >> 6;
    const int gw = blockIdx.x * NWAVES + wave, NGW = gridDim.x * NWAVES;
    const bf16_t* AO = (const bf16_t*)(p.ws + WS_AO); bf16_t* MIX = (bf16_t*)(p.ws + WS_MIX);
    const float s1 = wave_sum(p.lq1[lane] * p.lk1[lane]), s2 = wave_sum(p.lq2[lane] * p.lk2[lane]);
    const float lam_init = 0.2f, lam = __expf(s1) - __expf(s2) + lam_init;
    const int hh = lane >> 4, e0 = (lane & 15) * 8;
    float sw[8];
#pragma unroll
    for (int i = 0; i < 8; ++i) sw[i] = p.subln_w[e0 + i] * (1.f - lam_init);
    for (int t = gw; t < T; t += NGW) {
        const int b = t >> 13, row = b * RPB + CTX + (t & 8191);
        const bf16_t* src = AO + (size_t)row * 1536;
        const u32x4 a = *(const u32x4*)(src + hh * 256 + e0), bq = *(const u32x4*)(src + hh * 256 + 128 + e0), mq = *(const u32x4*)(src + 1024 + lane * 8);
        float o[8];
        o[0] = bflo(a.x) - lam * bflo(bq.x); o[1] = bfhi(a.x) - lam * bfhi(bq.x); o[2] = bflo(a.y) - lam * bflo(bq.y); o[3] = bfhi(a.y) - lam * bfhi(bq.y);
        o[4] = bflo(a.z) - lam * bflo(bq.z); o[5] = bfhi(a.z) - lam * bfhi(bq.z); o[6] = bflo(a.w) - lam * bflo(bq.w); o[7] = bfhi(a.w) - lam * bfhi(bq.w);
        float ss = 0.f;
#pragma unroll
        for (int i = 0; i < 8; ++i) ss += o[i] * o[i];
        ss += __shfl_xor(ss, 1); ss += __shfl_xor(ss, 2); ss += __shfl_xor(ss, 4); ss += __shfl_xor(ss, 8);
        const float r = rsqrtf(ss * (1.f / 128.f) + EPS);
        u32x4 w; w.x = cvt_pk_bf16(o[0] * r * sw[0], o[1] * r * sw[1]); w.y = cvt_pk_bf16(o[2] * r * sw[2], o[3] * r * sw[3]);
        w.z = cvt_pk_bf16(o[4] * r * sw[4], o[5] * r * sw[5]); w.w = cvt_pk_bf16(o[6] * r * sw[6], o[7] * r * sw[7]);
        bf16_t* dst = MIX + (size_t)row * 1024;
        *(u32x4*)(dst + hh * 128 + e0) = w; *(u32x4*)(dst + 512 + lane * 8) = mq;
    }
}

typedef short bf16x8_t __attribute__((ext_vector_type(8)));
__device__ __forceinline__ void p7a_route(const Params& p, unsigned char* lds) {
    const int tid = tid_opaque(), lane = tid & 63, wave = tid >> 6, row = lane & 15, kq = lane >> 4;
    int* lcnt = (int*)(lds + 147456); int* lbase = lcnt + 32; int* tok_e = lbase + 32; int* tok_r = tok_e + 1024;
    for (int i = tid; i < 8192; i += NTHREADS) ((u32x4*)lds)[i] = ((const u32x4*)(p.ws + WS_RWF))[i];
    if (tid < 32) lcnt[tid] = 0;
    const int chunk = (T + gridDim.x - 1) / gridDim.x;
    const int t0 = blockIdx.x * chunk, t1 = (t0 + chunk < T) ? t0 + chunk : T;
    float* vab = (float*)(lds + 131072); const int b0 = t0 >> 13;
    { const float* mods_ = (const float*)(p.ws + WS_MODS);
      for (int i = tid; i < 2048; i += NTHREADS) { const int bb = min(b0 + (i >> 10), NB - 1), k = i & 1023; const float* md_ = mods_ + bb * 6144;
          vab[(i >> 10) * 2048 + k] = p.ffn_norm_w[k] * (md_[4 * 1024 + k] + 1.f); vab[(i >> 10) * 2048 + 1024 + k] = md_[3 * 1024 + k]; } }
    __syncthreads();
    const bf16_t* XN = (const bf16_t*)(p.ws + WS_XN); const float* mods = (const float*)(p.ws + WS_MODS);
    unsigned char* HF = p.ws + WS_HF;
    int* TOPI = (int*)(p.ws + WS_TOPI); float* GATE = (float*)(p.ws + WS_GATE); int* RANK = (int*)(p.ws + WS_RANK); int* CNT = (int*)(p.ws + WS_CNT);
    const u32x4* rwf = (const u32x4*)lds + lane;
    for (int tb = t0 + 16 * wave; tb < t1; tb += 16 * NWAVES) {
        const int t = tb + row, b = tb >> 13; const float* md = mods + b * 6144;
        const bf16_t* xr = XN + (size_t)t * DM + 8 * kq;
        const float r = rsqrtf(((const float*)(p.ws + WS_RSX))[t] * (1.f / DM) + EPS);
        f32x4 acc0 = {0.f, 0.f, 0.f, 0.f}, acc1 = {0.f, 0.f, 0.f, 0.f};
        const float* va = vab + ((tb >> 13) - b0) * 2048 + 8 * kq; const float* vb = va + 1024;
        u32x4 xq[4];
#pragma unroll
        for (int j = 0; j < 4; ++j) xq[j] = *(const u32x4*)(xr + 32 * j);
#pragma unroll 4
        for (int s = 0; s < 32; ++s) { const int k0 = 32 * s + 8 * kq;
            const u32x4 xw = xq[s & 3]; if (s + 4 < 32) xq[s & 3] = *(const u32x4*)(xr + 32 * (s + 4));
            const f32x4 xa = {bflo(xw.x), bfhi(xw.x), bflo(xw.y), bfhi(xw.y)}, xc = {bflo(xw.z), bfhi(xw.z), bflo(xw.w), bfhi(xw.w)};
            const f32x4 ha = xa * r * *(const f32x4*)(va + 32 * s) + *(const f32x4*)(vb + 32 * s), hc = xc * r * *(const f32x4*)(va + 32 * s + 4) + *(const f32x4*)(vb + 32 * s + 4);
            u32x4 hi, lo;
            hi.x = cvt_pk_bf16(ha.x, ha.y); hi.y = cvt_pk_bf16(ha.z, ha.w); hi.z = cvt_pk_bf16(hc.x, hc.y); hi.w = cvt_pk_bf16(hc.z, hc.w);
            lo.x = cvt_pk_bf16(ha.x - bflo(hi.x), ha.y - bfhi(hi.x)); lo.y = cvt_pk_bf16(ha.z - bflo(hi.y), ha.w - bfhi(hi.y));
            lo.z = cvt_pk_bf16(hc.x - bflo(hi.z), hc.y - bfhi(hi.z)); lo.w = cvt_pk_bf16(hc.z - bflo(hi.w), hc.w - bfhi(hi.w));
            { u32x2 h8; h8.x = cvt4_fp8(ha.x, ha.y, ha.z, ha.w); h8.y = cvt4_fp8(hc.x, hc.y, hc.z, hc.w); *(u32x2*)(HF + (size_t)t * DM + k0) = h8; }
            const bf16x8_t Ah = __builtin_bit_cast(bf16x8_t, hi), Al = __builtin_bit_cast(bf16x8_t, lo);
            const bf16x8_t Bh0 = __builtin_bit_cast(bf16x8_t, rwf[(s * 4 + 0) * 64]), Bl0 = __builtin_bit_cast(bf16x8_t, rwf[(s * 4 + 1) * 64]);
            const bf16x8_t Bh1 = __builtin_bit_cast(bf16x8_t, rwf[(s * 4 + 2) * 64]), Bl1 = __builtin_bit_cast(bf16x8_t, rwf[(s * 4 + 3) * 64]);
            acc0 = __builtin_amdgcn_mfma_f32_16x16x32_bf16(Ah, Bh0, acc0, 0, 0, 0); acc0 = __builtin_amdgcn_mfma_f32_16x16x32_bf16(Ah, Bl0, acc0, 0, 0, 0); acc0 = __builtin_amdgcn_mfma_f32_16x16x32_bf16(Al, Bh0, acc0, 0, 0, 0);
            acc1 = __builtin_amdgcn_mfma_f32_16x16x32_bf16(Ah, Bh1, acc1, 0, 0, 0); acc1 = __builtin_amdgcn_mfma_f32_16x16x32_bf16(Ah, Bl1, acc1, 0, 0, 0); acc1 = __builtin_amdgcn_mfma_f32_16x16x32_bf16(Al, Bh1, acc1, 0, 0, 0); }
        const float rb0 = p.router_b[row], rb1 = p.router_b[16 + row];
#pragma unroll
        for (int reg = 0; reg < 4; ++reg) { float v0 = acc0[reg] + rb0, v1 = acc1[reg] + rb1; float tv[4]; int ti[4];
#pragma unroll
            for (int k = 0; k < 4; ++k) { float m = fmaxf(v0, v1);
                m = fmaxf(m, __shfl_xor(m, 1)); m = fmaxf(m, __shfl_xor(m, 2)); m = fmaxf(m, __shfl_xor(m, 4)); m = fmaxf(m, __shfl_xor(m, 8));
                int cand = (v0 == m) ? row : ((v1 == m) ? 16 + row : 99);
                cand = min(cand, __shfl_xor(cand, 1)); cand = min(cand, __shfl_xor(cand, 2)); cand = min(cand, __shfl_xor(cand, 4)); cand = min(cand, __shfl_xor(cand, 8));
                tv[k] = m; ti[k] = cand; if (cand == row) v0 = -INFINITY; if (cand == 16 + row) v1 = -INFINITY; }
            const float e1 = __expf(tv[1] - tv[0]), e2 = __expf(tv[2] - tv[0]), e3 = __expf(tv[3] - tv[0]); const float inv = 1.f / (1.f + e1 + e2 + e3);
            const int tt = tb + 4 * kq + reg;
            if (row < 4 && tt < t1) { const int ei = row == 0 ? ti[0] : row == 1 ? ti[1] : row == 2 ? ti[2] : ti[3]; const float gv = (row == 0 ? 1.f : row == 1 ? e1 : row == 2 ? e2 : e3) * inv;
                const int lr = atomicAdd(&lcnt[ei], 1);
                TOPI[tt * 4 + row] = ei; GATE[tt * 4 + row] = gv; tok_e[(tt - t0) * 4 + row] = ei; tok_r[(tt - t0) * 4 + row] = lr; } }
    }
    __syncthreads();
    if (tid < 32) lbase[tid] = atomicAdd(&CNT[tid], lcnt[tid]);
    __syncthreads();
    for (int i = tid; i < (t1 - t0) * 4; i += NTHREADS) RANK[t0 * 4 + i] = lbase[tok_e[i]] + tok_r[i];
}

__device__ __forceinline__ void moe_segments(const Params& p, int* seg) {
    if (threadIdx.x == 0) { const int* CNT = (const int*)(p.ws + WS_CNT); int s = 0;
        for (int e = 0; e < 32; ++e) { seg[e] = s; s += (CNT[e] + 255) & ~255; } seg[32] = s; }
    __syncthreads();
}
__device__ __forceinline__ void p7b_scatter(const Params& p, const int* seg) {
    const int tid = tid_opaque();
    const int gt = blockIdx.x * NTHREADS + tid, NGT = gridDim.x * NTHREADS;
    const int* TOPI = (const int*)(p.ws + WS_TOPI); const float* GATE = (const float*)(p.ws + WS_GATE); const int* RANK = (const int*)(p.ws + WS_RANK);
    int* DEST = (int*)(p.ws + WS_DEST); float* GS = (float*)(p.ws + WS_GSRT); int* RTOK = (int*)(p.ws + WS_RTOK);
    for (int i = gt; i < T * 4; i += NGT) { const int dest = seg[TOPI[i]] + RANK[i]; DEST[i] = dest; GS[dest] = GATE[i]; RTOK[dest] = i >> 2; }
}
__device__ __forceinline__ void p10_final(const Params& p, const bool with_moe) {
    const int tid = tid_opaque(), lane = tid & 63, wave = tid >> 6;
    const int gw = blockIdx.x * NWAVES + wave, NGW = gridDim.x * NWAVES;
    const bf16_t* XN = (const bf16_t*)(p.ws + WS_XN); const float* mods = (const float*)(p.ws + WS_MODS);
    const int* DEST = (const int*)(p.ws + WS_DEST);
    const f32x4* w4 = (const f32x4*)p.final_norm_w;
    for (int tb = gw; tb < T; tb += P10_NT * NGW) {
        int tt[P10_NT]; bool ok[P10_NT]; u32x2 xw[P10_NT][4];
#if YS_FP8
        unsigned yw[P10_NT][4][4];
#else
        u32x2 yw[P10_NT][4][4];
#endif
#pragma unroll
        for (int q = 0; q < P10_NT; ++q) { const int t_ = tb + q * NGW; ok[q] = t_ < T; tt[q] = ok[q] ? t_ : tb; }
#pragma unroll
        for (int q = 0; q < P10_NT; ++q) { const u32x2* xr = (const u32x2*)(XN + (size_t)tt[q] * DM);
#pragma unroll
            for (int j = 0; j < 4; ++j) xw[q][j] = xr[64 * j + lane];
            if (with_moe) {
#pragma unroll
                for (int k = 0; k < 4; ++k) { const int d = DEST[tt[q] * 4 + k];
#if YS_FP8
                    const unsigned* yr = (const unsigned*)(p.ws + WS_XS + (size_t)d * 1024);
#else
                    const u32x2* yr = (const u32x2*)(p.ws + WS_XS + (size_t)d * 2048);
#endif
#pragma unroll
                    for (int j = 0; j < 4; ++j) yw[q][k][j] = yr[64 * j + lane]; } } }
#pragma unroll
        for (int q = 0; q < P10_NT; ++q) { const int t = tt[q], b = t >> 13; const f32x4* g4 = (const f32x4*)(mods + b * 6144 + 5 * 1024);
            f32x4 xv[4];
#pragma unroll
            for (int j = 0; j < 4; ++j) { xv[j] = (f32x4){bflo(xw[q][j].x), bfhi(xw[q][j].x), bflo(xw[q][j].y), bfhi(xw[q][j].y)};
                if (with_moe) { f32x4 y = {0.f, 0.f, 0.f, 0.f};
#pragma unroll
                    for (int k = 0; k < 4; ++k) {
#if YS_FP8
                        const int w_ = (int)yw[q][k][j]; const auto lo_ = __builtin_amdgcn_cvt_pk_f32_fp8(w_, false), hi_ = __builtin_amdgcn_cvt_pk_f32_fp8(w_, true);
                        y += (f32x4){lo_[0], lo_[1], hi_[0], hi_[1]};
#else
                        const u32x2 w_ = yw[q][k][j]; y += (f32x4){bflo(w_.x), bfhi(w_.x), bflo(w_.y), bfhi(w_.y)};
#endif
                    }
                    xv[j] += g4[64 * j + lane] * y * (YS_FP8 ? 1.f / YS_SCALE : 1.f); } }
            float s = 0.f;
#pragma unroll
            for (int j = 0; j < 4; ++j) s += (xv[j].x * xv[j].x + xv[j].y * xv[j].y) + (xv[j].z * xv[j].z + xv[j].w * xv[j].w);
            float r = rsqrtf(wave_sum(s) * (1.f / DM) + EPS);
#if DBG_STAGE
            r *= 1.f + 10.f * fminf(__uint_as_float(((const unsigned*)(p.ws + WS_CNT))[64]), 100.f);
#endif
            if (ok[q]) { f32x4* o = (f32x4*)(p.out + (size_t)t * DM);
#pragma unroll
                for (int j = 0; j < 4; ++j) o[64 * j + lane] = xv[j] * r * w4[64 * j + lane]; }
        }
    }
}
#if DBG_STAGE
__device__ __forceinline__ void dbg_report(const Params& p, float err) {
    if (!(err >= 0.f)) err = 1e6f;
    atomicMax((unsigned*)(p.ws + WS_CNT) + 64, __float_as_uint(err));
}
__device__ __forceinline__ void dbg_rope(float& x1, float& x2, int pv, int pp) {
    const float inv = exp2f(-(float)pp * (13.287712379549449f / 16.f)); float sn, cs; sincosf((float)pv * inv, &sn, &cs);
    const float a = x1 * cs - x2 * sn, b = x2 * cs + x1 * sn; x1 = a; x2 = b;
}
__device__ __forceinline__ void dbg_check_proj(const Params& p) {
    const int gt = blockIdx.x * NTHREADS + threadIdx.x, NGT = gridDim.x * NTHREADS;
    const bf16_t* HB = (const bf16_t*)(p.ws + WS_HB); const bf16_t* PJ = (const bf16_t*)(p.ws + WS_PJ); const bf16_t* QM = (const bf16_t*)(p.ws + WS_QM); const bf16_t* KVb = (const bf16_t*)(p.ws + WS_KV);
    float emax = 0.f;
    for (int it = gt; it < 24 * 224; it += NGT) { const int rs = it / 224, cpi = it % 224; const int row = rs < 6 ? (rs & 3) * RPB + (rs * 37) % CTX : (rs * 1409 + 77) % MALL; const int grp = cpi >> 4, pp = cpi & 15, c0 = 1536 + grp * 32 + pp, c1 = c0 + 16;
        float a0 = 0.f, a1 = 0.f;
        for (int k = 0; k < 1024; ++k) { const float h = bf2f(HB[(size_t)row * 1024 + k]); a0 += h * bf2f(f2bf(p.w_in[(size_t)k * 1984 + c0])); a1 += h * bf2f(f2bf(p.w_in[(size_t)k * 1984 + c1])); }
        const int i = row % RPB; if (i >= CTX && c0 >= 1920) { const int pos = i - CTX, a = (c0 >> 5) & 1; dbg_rope(a0, a1, a ? (pos & 63) : (pos >> 6), pp); }
        const float f0 = bf2f(PJ[(size_t)row * NPROJ + c0]), f1 = bf2f(PJ[(size_t)row * NPROJ + c1]);
        emax = fmaxf(emax, fmaxf(fabsf(f0 - a0), fabsf(f1 - a1))); }
    for (int it = gt; it < 24 * 384; it += NGT) { const int rs = it / 384, cpi = it % 384; const int row = rs < 6 ? (rs & 3) * RPB + (rs * 41) % CTX : (rs * 1409 + 300) % MALL; const int grp = cpi >> 4, pp = cpi & 15, c0 = grp * 32 + pp, c1 = c0 + 16;
        float ss = 0.f, a0 = 0.f, a1 = 0.f;
        for (int k = 0; k < 256; ++k) { const float v = bf2f(PJ[(size_t)row * NPROJ + 1536 + k]); ss += v * v; const float vw = v * p.q_norm_w[k]; a0 += vw * p.w_uq[(size_t)k * 768 + c0]; a1 += vw * p.w_uq[(size_t)k * 768 + c1]; }
        const float r = rsqrtf(ss / 256.f + EPS); a0 *= r; a1 *= r;
        const int i = row % RPB, g6 = grp % 6; if (i >= CTX && g6 >= 4) { const int pos = i - CTX; dbg_rope(a0, a1, g6 == 5 ? (pos & 63) : (pos >> 6), pp); }
        const float f0 = bf2f(QM[(size_t)row * 768 + c0]), f1 = bf2f(QM[(size_t)row * 768 + c1]);
        emax = fmaxf(emax, fmaxf(fabsf(f0 - a0), fabsf(f1 - a1))); }
    for (int it = gt; it < 24 * 1024; it += NGT) { const int rs = it >> 10, c0 = it & 1023; const int row = rs < 6 ? (rs & 3) * RPB + (rs * 43) % CTX : (rs * 1409 + 555) % MALL;
        float ss = 0.f, a0 = 0.f;
        for (int k = 0; k < 128; ++k) { const float v = bf2f(PJ[(size_t)row * NPROJ + 1792 + k]); ss += v * v; a0 += v * p.kv_norm_w[k] * p.w_ukv[(size_t)k * 1024 + c0]; }
        a0 *= rsqrtf(ss / 128.f + EPS);
        emax = fmaxf(emax, fabsf(bf2f(KVb[(size_t)row * 1024 + c0]) - a0)); }
    emax = wave_max(emax);
    if ((threadIdx.x & 63) == 0) dbg_report(p, emax);
}
__device__ __forceinline__ void dbg_check_attn(const Params& p, unsigned char* lds, int kind_sel) {
    const int tid = threadIdx.x;
    const bf16_t* PJ = (const bf16_t*)(p.ws + WS_PJ); const bf16_t* QM = (const bf16_t*)(p.ws + WS_QM); const bf16_t* KVb = (const bf16_t*)(p.ws + WS_KV); const bf16_t* AO = (const bf16_t*)(p.ws + WS_MIX);
    float* sc = (float*)lds; float* red = sc + 8448; float* qv = red + 1024;
    for (int s = blockIdx.x; s < 128; s += gridDim.x) {
        const int kind = s & 1; if (kind_sel >= 0 && kind != kind_sel) continue;
        const int b = (s >> 1) & 3, hh = (s >> 3) & 7, qpos = ((s >> 1) * 2731 + 13) & 8191;
        const size_t krow0 = (size_t)b * RPB, qrow = krow0 + CTX + qpos;
        const int dqk = kind ? 192 : 64; const int h = kind ? (hh & 3) : hh;
#if ATT_FP8
        const float scale = 0.6931471805599453f;
        const unsigned char* W8 = p.ws;
#define F8(ptr) __builtin_amdgcn_cvt_f32_fp8((int)(*(const unsigned char*)(ptr)), 0)
        __syncthreads();
        if (tid < dqk) qv[tid] = kind ? F8(W8 + WS_Q8M + qrow * 768 + h * 192 + tid) : F8(W8 + WS_Q8D + qrow * 512 + h * 64 + tid);
        __syncthreads();
        float lmax = -1e30f;
        for (int k = tid; k < RPB; k += NTHREADS) { float a = 0.f;
            if (kind) { for (int d = 0; d < 128; ++d) a += qv[d] * F8(W8 + WS_K8M + (krow0 + k) * 512 + h * 128 + d); for (int d = 0; d < 64; ++d) a += qv[128 + d] * F8(W8 + WS_KR8 + (krow0 + k) * 64 + d); }
            else { for (int d = 0; d < 64; ++d) a += qv[d] * F8(W8 + WS_K8D + (krow0 + k) * 512 + h * 64 + d); }
            a *= scale; sc[k] = a; lmax = fmaxf(lmax, a); }
#else
        const float scale = kind ? 0.07216878364870322f : 0.6931471805599453f;
        __syncthreads();
        if (tid < dqk) qv[tid] = kind ? bf2f(QM[qrow * 768 + h * 192 + tid]) : bf2f(PJ[qrow * NPROJ + h * 64 + tid]);
        __syncthreads();
        float lmax = -1e30f;
        for (int k = tid; k < RPB; k += NTHREADS) { float a = 0.f;
            if (kind) { for (int d = 0; d < 128; ++d) a += qv[d] * bf2f(KVb[(krow0 + k) * 1024 + h * 256 + d]); for (int d = 0; d < 64; ++d) a += qv[128 + d] * bf2f(PJ[(krow0 + k) * NPROJ + 1920 + d]); }
            else { for (int d = 0; d < 64; ++d) a += qv[d] * bf2f(PJ[(krow0 + k) * NPROJ + 512 + h * 64 + d]); }
            a *= scale; sc[k] = a; lmax = fmaxf(lmax, a); }
#endif
        lmax = wave_max(lmax); if ((tid & 63) == 0) red[tid >> 6] = lmax; __syncthreads();
        float m = red[0]; for (int w = 1; w < 8; ++w) m = fmaxf(m, red[w]); __syncthreads();
        float lsum = 0.f; for (int k = tid; k < RPB; k += NTHREADS) { const float e = __expf(sc[k] - m); sc[k] = e; lsum += e; }
        lsum = wave_sum(lsum); if ((tid & 63) == 0) red[tid >> 6] = lsum; __syncthreads();
        float l = 0.f; for (int w = 0; w < 8; ++w) l += red[w]; __syncthreads();
        const int e = tid & 127, part = tid >> 7; float o = 0.f;
#if ATT_FP8
        for (int k = part; k < RPB; k += 4) { const unsigned char* vt = p.ws + (kind ? WS_VT8M : WS_VT8D) + ((size_t)(b * 4 + (kind ? h : (h >> 1))) * 128 + e) * RPB + (k & ~63) + vt_pos(k & 63); o += sc[k] * F8(vt); }
#else
        for (int k = part; k < RPB; k += 4) { const float v = kind ? bf2f(KVb[(krow0 + k) * 1024 + h * 256 + 128 + e]) : bf2f(PJ[(krow0 + k) * NPROJ + 1024 + (h >> 1) * 128 + e]); o += sc[k] * v; }
#endif
        red[tid] = o; __syncthreads();
        if (tid < 128) { const float on = (red[tid] + red[tid + 128] + red[tid + 256] + red[tid + 384]) / l;
            const float of = bf2f(AO[qrow * 1024 + 512 + h * 128 + tid]);
            float d2 = (of - on) * (of - on), n2 = on * on;
            d2 = wave_sum(d2); n2 = wave_sum(n2); red[512 + (tid >> 6) * 2] = d2; red[512 + (tid >> 6) * 2 + 1] = n2; }
        __syncthreads();
        if (tid == 0) { const float d2 = red[512] + red[514], n2 = red[513] + red[515]; dbg_report(p, sqrtf(d2 / (n2 + 1e-30f))); }
    }
    __syncthreads();
}
#endif
typedef const __attribute__((address_space(4))) Params* ParamsK;
#if defined(__HIP_DEVICE_COMPILE__)
#define LOAD_PARAMS() ({ ParamsK q_ = (ParamsK)__builtin_amdgcn_kernarg_segment_ptr(); asm volatile("" : "+s"(q_)); Params r_ = *q_; r_; })
#else
#define LOAD_PARAMS() (Params{})
#endif
#ifndef FIRST_PHASE
#define FIRST_PHASE 0
#endif
#define PH(k) ((k) >= FIRST_PHASE && (k) <= LAST_PHASE)
#ifndef EPIY_PROBE
#define EPIY_PROBE 0
#endif
#ifndef REP_MASK
#define REP_MASK 0
#endif
#define REP(k) for (int rep_ = 0; rep_ < (((REP_MASK) >> (k)) & 1) + 1; ++rep_)
#define PH_BEGIN { const Params p = LOAD_PARAMS(); unsigned char* ws = p.ws; (void)ws;
#define PH_END }
__global__ void __launch_bounds__(NTHREADS, 2) fwd_kernel(Params p_unused) {
    extern __shared__ __attribute__((aligned(16))) unsigned char lds[];
    cg::grid_group grid = cg::this_grid();
    LAS unsigned char* lds3 = (LAS unsigned char*)lds;
    const int G = gridDim.x, c = blockIdx.x;
    int* seg = (int*)(lds + 160 * 1024 - 256);
    volatile LAS unsigned* bst = (volatile LAS unsigned*)(lds3 + 160 * 1024 - 512);
    if (threadIdx.x < 2) bst[threadIdx.x] = 0u;
    __syncthreads();
    XcdBarrier bar;
    { ParamsK q_ = (ParamsK)__builtin_amdgcn_kernarg_segment_ptr(); bar = xcd_barrier_post((unsigned*)(q_->ws + WS_BAR), bst);
#ifdef HW_XCD_MAP
      if (threadIdx.x == 0) { const unsigned x_ = xb_xcc_id() & 7u; bst[2] = x_; bst[3] = atomicAdd((unsigned*)(q_->ws + WS_BAR) + 3500 + x_, 1u); }
#endif
    }
#ifdef USE_CG_SYNC
#define GRID_SYNC() grid.sync()
#else
#define GRID_SYNC() xcd_barrier(bar)
#endif

#ifdef ONLY4
#ifndef NO_DIFF
    PH_BEGIN p4_attention_diff(p, (char*)lds); PH_END
#endif
#ifndef NO_MLA
    PH_BEGIN p4_attention_mla(p, (char*)lds); PH_END
#endif
    return;
#endif
#ifdef UBENCH
    { typedef int v8i32_ __attribute__((ext_vector_type(8))); typedef float f32x16_ __attribute__((ext_vector_type(16))); typedef int v4i32_ __attribute__((ext_vector_type(4)));
      const int wv_ = __builtin_amdgcn_readfirstlane((int)threadIdx.x >> 6);
      float s_ = 0.f;
      LAS v4i32_* lp_ = (LAS v4i32_*)(lds3 + 65536) + threadIdx.x * 2;
      if (wv_ >= 4) { if (UBENCH != 5) {
          v8i32_ a_ = {(int)threadIdx.x, 1, 2, 3, 4, 5, 6, 7}, b_ = {7, 6, 5, 4, 3, 2, 1, (int)blockIdx.x}; f32x16_ c0 = {}, c1 = {}, c2 = {}, c3 = {}, c4 = {};
          for (int it = 0; it < 10000; ++it) {
              if (UBENCH >= 8) { const v4i32_ x0 = lp_[0], x1 = lp_[1]; b_ = __builtin_shufflevector(x0, x1, 0, 1, 2, 3, 4, 5, 6, 7); }
              c0 = __builtin_amdgcn_mfma_scale_f32_32x32x64_f8f6f4(a_, b_, c0, 0, 0, 0, 0, 0, 0); c1 = __builtin_amdgcn_mfma_scale_f32_32x32x64_f8f6f4(a_, b_, c1, 0, 0, 0, 0, 0, 0);
              c2 = __builtin_amdgcn_mfma_scale_f32_32x32x64_f8f6f4(a_, b_, c2, 0, 0, 0, 0, 0, 0); c3 = __builtin_amdgcn_mfma_scale_f32_32x32x64_f8f6f4(a_, b_, c3, 0, 0, 0, 0, 0, 0);
              c4 = __builtin_amdgcn_mfma_scale_f32_32x32x64_f8f6f4(a_, b_, c4, 0, 0, 0, 0, 0, 0); __builtin_amdgcn_sched_barrier(0);
              if (UBENCH >= 7) __syncthreads(); }
#pragma unroll
          for (int i = 0; i < 16; ++i) s_ += c0[i] + c1[i] + c2[i] + c3[i] + c4[i]; } }
      else if (UBENCH != 6) {
          float e_[32]; unsigned pk_[8];
#pragma unroll
          for (int i = 0; i < 32; ++i) e_[i] = (float)(threadIdx.x + i) * 1e-3f;
#pragma unroll
          for (int i = 0; i < 8; ++i) pk_[i] = 0u;
          for (int it = 0; it < 10000; ++it) {
              float m_ = e_[0];
#pragma unroll
              for (int i = 1; i < 31; i += 2) m_ = __builtin_fmaxf(__builtin_fmaxf(m_, e_[i]), e_[i + 1]);
#pragma unroll
              for (int i = 0; i < 32; ++i) e_[i] = __builtin_amdgcn_exp2f(e_[i] - m_);
#pragma unroll
              for (int i = 0; i < 8; ++i) pk_[i] = cvt4_fp8o((int)pk_[i], e_[4 * i], e_[4 * i + 1], e_[4 * i + 2], e_[4 * i + 3]);
              if (UBENCH >= 8) { lp_[0] = (v4i32_){(int)pk_[0], (int)pk_[1], (int)pk_[2], (int)pk_[3]}; lp_[1] = (v4i32_){(int)pk_[4], (int)pk_[5], (int)pk_[6], (int)pk_[7]}; }
              __builtin_amdgcn_sched_barrier(0);
              if (UBENCH >= 7) __syncthreads(); }
#pragma unroll
          for (int i = 0; i < 8; ++i) s_ += (float)pk_[i]; }
      if (s_ == 123.456f) ((float*)(LOAD_PARAMS().ws + WS_CNT))[100] = s_; }
#endif
#if PH(0)
    REP(0) { PH_BEGIN p0_prologue(p, lds); PH_END
    GRID_SYNC(); }
    if (gridDim.y == 0x7fffffffu) grid.sync();
#endif
    REP(2) {
#if PH(1)
    PH_BEGIN p1_rows(p); PH_END
    GRID_SYNC();
#endif
#if PH(2)
    PH_BEGIN { pg8::Gemm g{(const bf16_t*)(ws + WS_HB), P2_FP8 ? 512 : 1024, (const bf16_t*)(ws + WS_WIN), P2_FP8 ? 512 : 1024}; ProjOrder S; S.init(G, c, 0);
      EpiProj E{(bf16_t*)(ws + WS_PJ), (const f32x2*)(ws + WS_ROPE), (float*)(ws + WS_RSQ), (float*)(ws + WS_RSKV), ws};
      pg8::gemm_phase<EpiProj, ProjOrder, false, P2_FP8 != 0>(lds3, g, S, E); } PH_END
    GRID_SYNC();
#endif
    }
#if PH(3)
    REP(3) {
    const bool p3split = (G == 256); const int G3 = p3split ? G - 32 : G, c3 = p3split ? c - 32 : c;
    if (p3split && c < 32) {
    PH_BEGIN { pg8::Gemm g{(const bf16_t*)(ws + WS_HB), P2_FP8 ? 512 : 1024, (const bf16_t*)(ws + WS_WIN), P2_FP8 ? 512 : 1024}; ProjOrder S; S.init(G, c, 1);
      EpiProj E{(bf16_t*)(ws + WS_PJ), (const f32x2*)(ws + WS_ROPE), (float*)(ws + WS_RSQ), (float*)(ws + WS_RSKV), ws};
      pg8::gemm_phase<EpiProj, ProjOrder, false, P2_FP8 != 0>(lds3, g, S, E); } PH_END
    } else {
#ifndef NO_P3A
    PH_BEGIN { pg8::Gemm g{(const bf16_t*)(ws + WS_PJ) + 1536, NPROJ, (const bf16_t*)(ws + WS_WUQ), 256}; PlainOrder S; S.init(MALL / 256, 3, G3, c3, 0);
      EpiQ E{(bf16_t*)(ws + WS_QM), (const f32x2*)(ws + WS_ROPE), (const float*)(ws + WS_RSQ), ws};
      pg8::gemm_phase<EpiQ, PlainOrder>(lds3, g, S, E); } PH_END
#endif
#ifndef NO_P3B
    PH_BEGIN { pg8::Gemm g{(const bf16_t*)(ws + WS_PJ) + 1792, NPROJ, (const bf16_t*)(ws + WS_WUKV), 256}; PlainOrder S; S.init(MALL / 256, 4, G3, c3, 0);
      EpiKV E{(bf16_t*)(ws + WS_KV), (const float*)(ws + WS_RSKV), ws};
      pg8::gemm_phase<EpiKV, PlainOrder>(lds3, g, S, E); } PH_END
#endif
    }
    GRID_SYNC(); }
#endif
#if PH(4)
    REP(4) { PH_BEGIN p4_attention_diff(p, (char*)lds); PH_END
    PH_BEGIN p4_attention_mla(p, (char*)lds); PH_END
    GRID_SYNC(); }
#endif
#if DBG_STAGE == 1
    PH_BEGIN dbg_check_proj(p); PH_END
#elif DBG_STAGE == 2
    PH_BEGIN dbg_check_attn(p, lds, 0); PH_END
#elif DBG_STAGE == 3
    PH_BEGIN dbg_check_attn(p, lds, 1); PH_END
#endif
#if PH(6)
    REP(6) {
    PH_BEGIN { pg8::Gemm g{(const bf16_t*)(ws + WS_MIX), 1024, (const bf16_t*)(ws + WS_WOUT), 1024}; PlainOrder S; S.init(T / 256, 4, G, c, 1);
      EpiOut E{(bf16_t*)(ws + WS_XN), p.x, (const float*)(ws + WS_MODS), (float*)(ws + WS_RSX)};
      pg8::gemm_phase<EpiOut, PlainOrder>(lds3, g, S, E); } PH_END
    GRID_SYNC(); }
#endif
#if PH(7)
#if (REP_MASK >> 11) & 1
    PH_BEGIN p7a_route(p, lds); PH_END
    GRID_SYNC();
    PH_BEGIN if (blockIdx.x == 0 && threadIdx.x < 32) ((unsigned*)(p.ws + WS_CNT))[threadIdx.x] = 0u; PH_END
    GRID_SYNC();
#endif
    PH_BEGIN p7a_route(p, lds); PH_END
    GRID_SYNC();
    REP(12) { PH_BEGIN moe_segments(p, seg); p7b_scatter(p, seg); PH_END }
    GRID_SYNC();
#endif
#if PH(8)
    REP(8) {
    PH_BEGIN { pg8::Gemm g{(const bf16_t*)(ws + WS_HF), 512, (const bf16_t*)(ws + WS_W1), 512, (const int*)(ws + WS_RTOK)}; MoeOrder S{seg, seg[32] >> 8, 8, G, c};
      EpiAct E{ws + WS_ACT, p.b1};
      pg8::gemm_phase<EpiAct, MoeOrder, true, true>(lds3, g, S, E); } PH_END
    GRID_SYNC(); }
#endif
#if PH(9)
    REP(9) {
    PH_BEGIN { pg8::Gemm g{(const bf16_t*)(ws + WS_ACT), 512, (const bf16_t*)(ws + WS_W2), 512}; MoeOrder S{seg, seg[32] >> 8, 4, G, c};
      EpiY E{(bf16_t*)(ws + WS_XS), p.b2, (const float*)(ws + WS_GSRT), (EPIY_PROBE) ? rep_ : 0};
      pg8::gemm_phase<EpiY, MoeOrder, false, true>(lds3, g, S, E); } PH_END
    GRID_SYNC(); }
#endif
#if LAST_PHASE >= 9
    REP(10) { PH_BEGIN p10_final(p, true); PH_END }
#elif LAST_PHASE >= 6
    PH_BEGIN p10_final(p, false); PH_END
#else
    PH_BEGIN { const int lane = threadIdx.x & 63, wave = threadIdx.x >> 6; const int gw = blockIdx.x * NWAVES + wave, NGW = gridDim.x * NWAVES;
      for (int t = gw; t < T; t += NGW) { const f32x4* xr = (const f32x4*)(p.x + (size_t)t * DM) + lane; f32x4 v[4]; float s = 0.f;
#pragma unroll
        for (int j = 0; j < 4; ++j) { v[j] = xr[64 * j]; s += (v[j].x * v[j].x + v[j].y * v[j].y) + (v[j].z * v[j].z + v[j].w * v[j].w); }
        const float r = rsqrtf(wave_sum(s) * (1.f / DM) + EPS); f32x4* o = (f32x4*)(p.out + (size_t)t * DM) + lane;
#pragma unroll
        for (int j = 0; j < 4; ++j) o[64 * j] = v[j] * r * ((const f32x4*)p.final_norm_w)[lane + 64 * j]; } } PH_END
#endif
}

extern "C" void kernel_launch(void* const* d_in, const int* in_sizes, int n_in, void* d_out, int out_size, void* d_ws, size_t ws_size, hipStream_t stream) {
    static int grid = 0;
    if (grid == 0) {
        if (n_in != 26 || in_sizes[0] != T * DM || out_size != T * DM || ws_size < WS_END) {
            fprintf(stderr, "kernel_launch: unexpected shapes: n_in %d in0 %d out %d ws %zu (need %zu)\n", n_in, n_in > 0 ? in_sizes[0] : -1, out_size, ws_size, (size_t)WS_END);
            grid = -1; return; }
        int dev = 0, cus = 0, per_cu = 0;
        (void)hipGetDevice(&dev);
        (void)hipDeviceGetAttribute(&cus, hipDeviceAttributeMultiprocessorCount, dev);
        if (hipFuncSetAttribute((const void*)fwd_kernel, hipFuncAttributeMaxDynamicSharedMemorySize, LDS_BYTES) != hipSuccess) { fprintf(stderr, "kernel_launch: hipFuncSetAttribute failed\n"); grid = -1; return; }
        if (hipOccupancyMaxActiveBlocksPerMultiprocessor(&per_cu, (const void*)fwd_kernel, NTHREADS, LDS_BYTES) != hipSuccess || per_cu < 1) { fprintf(stderr, "kernel_launch: occupancy query failed (%d)\n", per_cu); (void)hipGetLastError(); grid = -1; return; }
        grid = cus;
        if (grid < 128 || grid > 1024) { fprintf(stderr, "kernel_launch: unsupported CU count %d\n", cus); grid = -1; return; }
    }
    if (grid < 0) return;
    Params p{};
    const float** pp = (const float**)&p;
    for (int i = 0; i < 26; ++i) pp[i] = (const float*)d_in[i];
    p.out = (float*)d_out; p.ws = (unsigned char*)d_ws;
    if (hipMemsetAsync((char*)d_ws + WS_BAR, 0, WS_BAR_BYTES, stream) != hipSuccess) { fprintf(stderr, "kernel_launch: hipMemsetAsync failed\n"); return; }
    void* args[] = {&p};
    hipError_t e = hipLaunchCooperativeKernel((const void*)fwd_kernel, dim3(grid), dim3(NTHREADS), args, LDS_BYTES, stream);
    if (e != hipSuccess) fprintf(stderr, "cooperative launch failed: %s (grid %d)\n", hipGetErrorString(e), grid);
}
```

```cpp
#define MLA_NQR 2
#define STAGGER 0
#include <hip/hip_runtime.h>
#include <hip/hip_cooperative_groups.h>
#include <cstdio>
#include <cstdint>
namespace cg = cooperative_groups;

#ifndef DBG_STAGE
#define DBG_STAGE 0
#endif
#ifndef ATT_EXTRA
#define ATT_EXTRA 0
#define ATT_EXTRA_ROUND0 0
#endif
#ifndef ATT_X
#define ATT_X(cc) ((cc) & 7)
#define ATT_J(cc) ((cc) >> 3)
#endif
#ifndef ATT_FP8
#define ATT_FP8 1
#endif
#ifndef SIM_P2
#define SIM_P2 0
#endif
#ifndef SIM_P6
#define SIM_P6 0
#endif
#ifndef WCONV_IN_ATT
#define WCONV_IN_ATT 1
#endif
#ifndef P7A_VAR
#define P7A_VAR 0
#endif
#ifndef P10_NT
#define P10_NT 4
#endif
#ifndef P2_FP8
#define P2_FP8 1
#endif
#ifndef YS_FP8
#define YS_FP8 1
#endif
constexpr float YS_SCALE = 16.f;
#ifndef STAGGER
#define STAGGER 1
#endif
#ifndef ATT_VAR
#define ATT_VAR 0
#endif
#ifndef LAST_PHASE
#define LAST_PHASE 99
#endif

constexpr int DM = 1024, NB = 4, SEQ = 8192, CTX = 256;
constexpr int T = NB * SEQ;
constexpr int RPB = CTX + SEQ;
constexpr int MALL = NB * RPB;
constexpr int NPROJ = 2048;
constexpr int NEXP = 32, TOPK = 4, DFF = 1024;
constexpr int RMAX = T * TOPK + NEXP * 256;
constexpr float EPS = 1e-6f;
constexpr int NTHREADS = 512, NWAVES = 8;
constexpr float WQ_SCALE = 64.f;
constexpr int LDS_BYTES = 163840;

typedef unsigned short bf16_t;
typedef float f32x4 __attribute__((ext_vector_type(4)));
typedef float f32x2 __attribute__((ext_vector_type(2)));
typedef unsigned u32x4 __attribute__((ext_vector_type(4)));
typedef unsigned u32x2 __attribute__((ext_vector_type(2)));
#define LAS __attribute__((address_space(3)))

constexpr size_t KiB = 1024, MiB = 1u << 20;
constexpr size_t WS_CNT  = 0;
constexpr size_t WS_BAR  = 16 * KiB;
constexpr size_t WS_BAR_BYTES = 16 * KiB;
constexpr size_t WS_MODS = 64 * KiB;
constexpr size_t WS_DUMMY = 192 * KiB;
constexpr size_t WS_ROPE = 256 * KiB;
constexpr size_t WS_RWF  = 320 * KiB;
constexpr size_t WS_RSQ  = 512 * KiB;
constexpr size_t WS_RSKV = 768 * KiB;
constexpr size_t WS_TOPI = 1 * MiB;
constexpr size_t WS_GATE = 1 * MiB + 512 * KiB;
constexpr size_t WS_RANK = 2 * MiB;
constexpr size_t WS_GSRT = 2 * MiB + 512 * KiB;
constexpr size_t WS_RSX  = 3 * MiB + 64 * KiB;
constexpr size_t WS_DEST = 3 * MiB + 256 * KiB;
constexpr size_t WS_WIN  = 4 * MiB;
constexpr size_t WS_WOUT = 8 * MiB;
constexpr size_t WS_WUQ  = 10 * MiB;
constexpr size_t WS_WUKV = 11 * MiB;
constexpr size_t WS_W1   = 12 * MiB;
constexpr size_t WS_W2   = 140 * MiB;
constexpr size_t WS_XN   = 204 * MiB;
constexpr size_t WS_XS   = 332 * MiB;
constexpr size_t WS_ACT  = 604 * MiB;
constexpr size_t WS_HF   = 876 * MiB;
constexpr size_t WS_RTOK = 940 * MiB;
constexpr size_t WS_END  = 941 * MiB;
constexpr size_t WS_HB   = 332 * MiB;
constexpr size_t WS_PJ   = 398 * MiB;
constexpr size_t WS_QM   = 530 * MiB;
constexpr size_t WS_KV   = 580 * MiB;
constexpr size_t WS_AO   = 646 * MiB;
constexpr size_t WS_MIX  = 745 * MiB;
constexpr size_t WS_Q8D  = 646 * MiB;
constexpr size_t WS_K8D  = 663 * MiB;
constexpr size_t WS_VT8D = 680 * MiB;
constexpr size_t WS_KR8  = 697 * MiB;
constexpr size_t WS_Q8M  = 332 * MiB;
constexpr size_t WS_K8M  = 357 * MiB;
constexpr size_t WS_VT8M = 374 * MiB;
static_assert(WS_MIX + (size_t)MALL * 1024 * 2 <= WS_HF && WS_XS + (size_t)RMAX * 2048 <= WS_ACT && WS_ACT + (size_t)RMAX * 2048 <= WS_HF, "ws map");

struct Params {
    const float* x; const float* c; const float* ctx; const float* c_ctx; const float* w_ada; const float* b_ada;
    const float* attn_norm_w; const float* w_in; const float* q_norm_w; const float* kv_norm_w; const float* w_uq; const float* w_ukv;
    const float* lq1; const float* lk1; const float* lq2; const float* lk2; const float* subln_w; const float* w_out;
    const float* ffn_norm_w; const float* router_w; const float* router_b; const float* w1; const float* b1; const float* w2; const float* b2;
    const float* final_norm_w;
    float* out; unsigned char* ws;
};

__device__ __forceinline__ int tid_opaque() { int t = threadIdx.x; asm volatile("" : "+v"(t)); return t; }
__device__ __forceinline__ float wave_sum(float v) {
#pragma unroll
    for (int o = 1; o < 64; o <<= 1) v += __shfl_xor(v, o);
    return v;
}
__device__ __forceinline__ float wave_max(float v) {
#pragma unroll
    for (int o = 1; o < 64; o <<= 1) v = fmaxf(v, __shfl_xor(v, o));
    return v;
}
__device__ __forceinline__ float silu_f(float v) { return v / (1.f + __expf(-v)); }
__device__ __forceinline__ unsigned cvt_pk_bf16(float lo, float hi) { unsigned r; asm volatile("v_cvt_pk_bf16_f32 %0, %1, %2" : "=v"(r) : "v"(lo), "v"(hi)); return r; }
__device__ __forceinline__ unsigned cvt4_fp8o(int old, float a, float b, float c, float d) { int r = __builtin_amdgcn_cvt_pk_fp8_f32(a, b, old, false); r = __builtin_amdgcn_cvt_pk_fp8_f32(c, d, r, true); return (unsigned)r; }
__device__ __forceinline__ unsigned cvt4_fp8(float a, float b, float c, float d) { int r = __builtin_amdgcn_cvt_pk_fp8_f32(a, b, 0, false); r = __builtin_amdgcn_cvt_pk_fp8_f32(c, d, r, true); return (unsigned)r; }
__device__ __forceinline__ float q8(float x) { const int pk = __builtin_amdgcn_cvt_pk_fp8_f32(x, x, 0, false); return __builtin_amdgcn_cvt_f32_fp8(pk, 0); }
#ifdef SIM_FP8_ATT
#define Q8(x) q8(x)
#define PSHIFT 8.f
#else
#define Q8(x) (x)
#define PSHIFT 0.f
#endif
__device__ __forceinline__ unsigned char f2fp8(float x) { return (unsigned char)(__builtin_amdgcn_cvt_pk_fp8_f32(x, x, 0, false) & 0xff); }
__device__ __forceinline__ int vt_pos(int kk) { return ((kk >> 2) & 1) * 32 + (kk >> 5) * 16 + ((kk >> 3) & 3) * 4 + (kk & 3); }
__device__ __forceinline__ unsigned quad_tr_bytes(unsigned w, int j) {
    const unsigned t0 = (unsigned)__builtin_amdgcn_mov_dpp((int)w, 0x00, 0xf, 0xf, true), t1 = (unsigned)__builtin_amdgcn_mov_dpp((int)w, 0x55, 0xf, 0xf, true);
    const unsigned t2 = (unsigned)__builtin_amdgcn_mov_dpp((int)w, 0xaa, 0xf, 0xf, true), t3 = (unsigned)__builtin_amdgcn_mov_dpp((int)w, 0xff, 0xf, 0xf, true);
    const unsigned sel = 0x0c0c0000u | ((4u + (unsigned)j) << 8) | (unsigned)j;
    const unsigned a = __builtin_amdgcn_perm(t1, t0, sel), b = __builtin_amdgcn_perm(t3, t2, sel);
    return __builtin_amdgcn_perm(b, a, 0x05040100u);
}
__device__ __forceinline__ bf16_t f2bf(float f) { return (bf16_t)(cvt_pk_bf16(f, 0.f) & 0xffffu); }
__device__ __forceinline__ float bf2f(bf16_t v) { return __uint_as_float((unsigned)v << 16); }
__device__ __forceinline__ float bflo(unsigned w) { return __uint_as_float(w << 16); }
__device__ __forceinline__ float bfhi(unsigned w) { return __uint_as_float(w & 0xffff0000u); }
#define GAS __attribute__((address_space(1)))
#define RLX_AGENT __ATOMIC_RELAXED, __HIP_MEMORY_SCOPE_AGENT
#define XB_TMO      128
#define XB_XCNT(j)  (256  + 64 * (j))
#define XB_XSUB(j)  (1280 + 64 * (j))
#define XB_XGEN(j)  (2304 + 64 * (j))
#define XB_TOP      3328
#define XB_TOPGEN   3392
#define XCD_BAR_WORDS 3456
#define XB_SPIN_CAP (1u << 18)

__device__ __forceinline__ unsigned xb_ld(unsigned* p)              { return __hip_atomic_load(p, __ATOMIC_RELAXED, __HIP_MEMORY_SCOPE_AGENT); }
__device__ __forceinline__ unsigned xb_add(unsigned* p, unsigned v) { return __hip_atomic_fetch_add(p, v, __ATOMIC_RELAXED, __HIP_MEMORY_SCOPE_AGENT); }
__device__ __forceinline__ unsigned xb_xcc_id() { return (unsigned)__builtin_amdgcn_s_getreg((3 << 11) | 20) & 0xFu; }
#define XB_SPIN(cond, bar) do { unsigned _sp = 0; while (cond) { __builtin_amdgcn_s_sleep(1); \
    if ((++_sp & 255u) == 0u) { if (xb_ld(&(bar)[XB_TMO])) break; if (_sp > XB_SPIN_CAP) { atomicAdd(&(bar)[XB_TMO], 1u); break; } } } } while (0)

struct XcdBarrier {
    unsigned* bar; unsigned x;
    volatile LAS unsigned* st;
};

__device__ __forceinline__ XcdBarrier xcd_barrier_post(unsigned* bar, volatile LAS unsigned* st) {
    XcdBarrier b; b.bar = bar; b.x = xb_xcc_id(); b.st = st;
    if (threadIdx.x == 0) (void)xb_add(&bar[XB_XCNT(b.x)], 1u);
    return b;
}
__device__ __forceinline__ void xcd_barrier_complete(unsigned* bar, unsigned x, unsigned& nloc, unsigned& nx) {
    const unsigned G = gridDim.x * gridDim.y * gridDim.z;
    unsigned sum, cnt, mine, sp = 0u;
    for (;;) {
        sum = 0u; cnt = 0u; mine = 0u;
#pragma unroll
        for (unsigned j = 0; j < 16; ++j) { const unsigned c = xb_ld(&bar[XB_XCNT(j)]); sum += c; cnt += (c > 0u) ? 1u : 0u; mine = (j == x) ? c : mine; }
        if (sum == G) break;
        __builtin_amdgcn_s_sleep(1);
        if ((++sp & 255u) == 0u) { if (xb_ld(&bar[XB_TMO])) break; if (sp > XB_SPIN_CAP) { atomicAdd(&bar[XB_TMO], 1u); break; } }
    }
    nloc = mine > 0u ? mine : 1u; nx = cnt > 0u ? cnt : 1u;
}

__device__ __forceinline__ void xcd_barrier(const XcdBarrier& b) {
    asm volatile("s_waitcnt vmcnt(0)" ::: "memory");
    __syncthreads();
    if (threadIdx.x == 0) {
        unsigned* bar = b.bar;
        __builtin_amdgcn_s_waitcnt(0);
        unsigned nloc = b.st[0], nx = b.st[1];
        if (nloc == 0u) { xcd_barrier_complete(bar, b.x, nloc, nx); b.st[0] = nloc; b.st[1] = nx; }
        const unsigned old = xb_add(&bar[XB_XSUB(b.x)], 1u);
        const unsigned gen = old / nloc;
        if (old + 1u == (gen + 1u) * nloc) {
            __builtin_amdgcn_fence(__ATOMIC_RELEASE, "agent");
            asm volatile("s_waitcnt vmcnt(0)" ::: "memory");
            const unsigned og = xb_add(&bar[XB_TOP], 1u);
            const unsigned tg = og / nx;
            if (og + 1u == (tg + 1u) * nx) xb_add(&bar[XB_TOPGEN], 1u);
            else XB_SPIN(xb_ld(&bar[XB_TOPGEN]) == tg, bar);
            __builtin_amdgcn_fence(__ATOMIC_ACQUIRE, "agent");
            xb_add(&bar[XB_XGEN(b.x)], 1u);
            asm volatile("s_waitcnt vmcnt(0)" ::: "memory");
        } else {
            XB_SPIN(xb_ld(&bar[XB_XGEN(b.x)]) == gen, bar);
            __builtin_amdgcn_fence(__ATOMIC_ACQUIRE, "agent");
            asm volatile("s_waitcnt vmcnt(0)" ::: "memory");
        }
    }
    __syncthreads();
}

__device__ __forceinline__ void p0_mods(const Params& p, float* lds_f, int item) {
    const int tid = tid_opaque();
    float* sc = lds_f;
    float* red = lds_f + 5 * 1024;
    for (int i = tid; i < 5 * 1024; i += NTHREADS) { const int r = i >> 10, k = i & 1023; sc[i] = silu_f(r < 4 ? p.c[r * 1024 + k] : p.c_ctx[k]); }
    __syncthreads();
    const int col = tid & 31, kg = tid >> 5;
    const float* w = p.w_ada + (size_t)(kg * 64) * 6144 + item * 32 + col;
    float a0 = 0, a1 = 0, a2 = 0, a3 = 0, a4 = 0;
#pragma unroll 8
    for (int k = 0; k < 64; ++k) { const float wv = w[(size_t)k * 6144]; const int kk = kg * 64 + k;
        a0 += sc[kk] * wv; a1 += sc[1024 + kk] * wv; a2 += sc[2048 + kk] * wv; a3 += sc[3072 + kk] * wv; a4 += sc[4096 + kk] * wv; }
    red[(kg * 5 + 0) * 32 + col] = a0; red[(kg * 5 + 1) * 32 + col] = a1; red[(kg * 5 + 2) * 32 + col] = a2; red[(kg * 5 + 3) * 32 + col] = a3; red[(kg * 5 + 4) * 32 + col] = a4;
    __syncthreads();
    if (tid < 160) { const int r = tid >> 5, cc = tid & 31; float s = p.b_ada[item * 32 + cc];
        for (int g = 0; g < 16; ++g) s += red[(g * 5 + r) * 32 + cc];
        ((float*)(p.ws + WS_MODS))[r * 6144 + item * 32 + cc] = s; }
    __syncthreads();
}

template <int SIMQ = 0>
__device__ __forceinline__ void p0_tr_item(const float* W, int ldw, bf16_t* WT, int ldk, int k0, int n0, int drow0, const float* kscale, float* scr, int lane) {
    const int nq = (lane & 15) * 4, kr = lane >> 4;
#pragma unroll 4
    for (int i = 0; i < 16; ++i) { const int kk = 4 * i + kr;
        f32x4 v = *(const f32x4*)(W + (size_t)(k0 + kk) * ldw + n0 + nq);
        if (kscale) { const float s = kscale[k0 + kk]; v = v * s; }
        float* d = scr + kk * 65 + nq; d[0] = v.x; d[1] = v.y; d[2] = v.z; d[3] = v.w; }
    asm volatile("s_waitcnt lgkmcnt(0)" ::: "memory");
    const int c = lane & 7;
#pragma unroll
    for (int j = 0; j < 8; ++j) { const int n = (lane >> 3) + 8 * j; const float* s = scr + (8 * c) * 65 + n;
        float w_[8];
#pragma unroll
        for (int i = 0; i < 8; ++i) { w_[i] = s[i * 65]; if (SIMQ) w_[i] = q8(w_[i] * 64.f) * (1.f / 64.f); }
        u32x4 o; o.x = cvt_pk_bf16(w_[0], w_[1]); o.y = cvt_pk_bf16(w_[2], w_[3]); o.z = cvt_pk_bf16(w_[4], w_[5]); o.w = cvt_pk_bf16(w_[6], w_[7]);
        *(u32x4*)(WT + (size_t)(drow0 + n) * ldk + k0 + 8 * c) = o; }
    asm volatile("s_waitcnt lgkmcnt(0)" ::: "memory");
}

__device__ __forceinline__ void p0_tr_item_f8(const float* W, int ldw, unsigned char* WT, int ldk, int k0, int n0, int drow0, const float wscale, float* scr, int lane) {
    const int nq = (lane & 15) * 4, kr = lane >> 4;
#pragma unroll 4
    for (int i = 0; i < 16; ++i) { const int kk = 4 * i + kr;
        const f32x4 v = *(const f32x4*)(W + (size_t)(k0 + kk) * ldw + n0 + nq) * wscale;
        float* d = scr + kk * 65 + nq; d[0] = v.x; d[1] = v.y; d[2] = v.z; d[3] = v.w; }
    asm volatile("s_waitcnt lgkmcnt(0)" ::: "memory");
    const int c = lane & 3;
#pragma unroll
    for (int j = 0; j < 4; ++j) { const int n = (lane >> 2) + 16 * j; const float* s = scr + (16 * c) * 65 + n;
        u32x4 o; o.x = cvt4_fp8(s[0 * 65], s[1 * 65], s[2 * 65], s[3 * 65]); o.y = cvt4_fp8(s[4 * 65], s[5 * 65], s[6 * 65], s[7 * 65]);
        o.z = cvt4_fp8(s[8 * 65], s[9 * 65], s[10 * 65], s[11 * 65]); o.w = cvt4_fp8(s[12 * 65], s[13 * 65], s[14 * 65], s[15 * 65]);
        *(u32x4*)(WT + (size_t)(drow0 + n) * ldk + k0 + 16 * c) = o; }
    asm volatile("s_waitcnt lgkmcnt(0)" ::: "memory");
}

__device__ __forceinline__ void p0_prologue(const Params& p, unsigned char* lds) {
    const int tid = tid_opaque(), lane = tid & 63, wave = tid >> 6;
    unsigned char* ws = p.ws;
    if (blockIdx.x == 0 && tid < 128) ((unsigned*)(ws + WS_CNT))[tid] = 0u;
    if (blockIdx.x == gridDim.x - 1) {
        for (int i = tid; i < 128 * 16; i += NTHREADS) { const int pv = i >> 4, pp = i & 15;
            const float inv = exp2f(-(float)pp * (13.287712379549449f / 16.f));
            const float ang = (float)pv * inv; float sn, cs; sincosf(ang, &sn, &cs);
            ((f32x2*)(ws + WS_ROPE))[i] = (f32x2){cs, sn}; }
    }
    { const int gt = blockIdx.x * NTHREADS + tid;
      if (gt < 4096) { const int l = gt & 63, nb = (gt >> 6) & 1, s = gt >> 7; unsigned hi4[4], lo4[4];
#pragma unroll
        for (int j = 0; j < 4; ++j) { const float w0 = p.router_w[(32 * s + 8 * (l >> 4) + 2 * j) * 32 + 16 * nb + (l & 15)], w1 = p.router_w[(32 * s + 8 * (l >> 4) + 2 * j + 1) * 32 + 16 * nb + (l & 15)];
            const unsigned hw = cvt_pk_bf16(w0, w1); hi4[j] = hw; lo4[j] = cvt_pk_bf16(w0 - bflo(hw), w1 - bfhi(hw)); }
        u32x4* dst = (u32x4*)(ws + WS_RWF) + ((s * 2 + nb) * 2) * 64 + l;
        dst[0] = (u32x4){hi4[0], hi4[1], hi4[2], hi4[3]}; dst[64] = (u32x4){lo4[0], lo4[1], lo4[2], lo4[3]}; } }
    for (int it = blockIdx.x; it < 192; it += gridDim.x) p0_mods(p, (float*)lds, it);
    float* scr = (float*)lds + wave * (64 * 65);
    const int gw = blockIdx.x * NWAVES + wave, NGW = gridDim.x * NWAVES;
    constexpr int I_W1 = WCONV_IN_ATT ? 0 : 32 * 16 * 32, I_W2 = WCONV_IN_ATT ? 0 : 32 * 16 * 16, I_IN = 16 * 31, I_OUT = 16 * 16, I_UQ = 4 * 12, I_UKV = 2 * 16;
    constexpr int NITEMS = I_W1 + I_W2 + I_IN + I_OUT + I_UQ + I_UKV;
    for (int it = gw; it < NITEMS; it += NGW) {
        int r = it;
        if (r < I_W1) { const int e = r >> 9, q = r & 511, kb = q >> 5, nb = q & 31, n0 = nb * 64;
            const int drow = ((n0 & 1023) >> 7) * 256 + (n0 >> 10) * 128 + (n0 & 127);
            p0_tr_item_f8(p.w1 + (size_t)e * 1024 * 2048, 2048, ws + WS_W1 + (size_t)e * 2048 * 1024, 1024, kb * 64, n0, drow, WQ_SCALE, scr, lane); continue; } r -= I_W1;
        if (r < I_W2) { const int e = r >> 8, q = r & 255, kb = q >> 4, nb = q & 15;
            p0_tr_item_f8(p.w2 + (size_t)e * 1024 * 1024, 1024, ws + WS_W2 + (size_t)e * 1024 * 1024, 1024, kb * 64, nb * 64, nb * 64, WQ_SCALE, scr, lane); continue; } r -= I_W2;
        if (r < I_IN) { const int kb = r / 31, nb = r % 31;
#if P2_FP8
            p0_tr_item_f8(p.w_in, 1984, ws + WS_WIN, 1024, kb * 64, nb * 64, nb * 64, WQ_SCALE, scr, lane); continue; } r -= I_IN;
#else
            p0_tr_item<SIM_P2>(p.w_in, 1984, (bf16_t*)(ws + WS_WIN), 1024, kb * 64, nb * 64, nb * 64, nullptr, scr, lane); continue; } r -= I_IN;
#endif
        if (r < I_OUT) { const int kb = r >> 4, nb = r & 15;
            p0_tr_item<SIM_P6>(p.w_out, 1024, (bf16_t*)(ws + WS_WOUT), 1024, kb * 64, nb * 64, nb * 64, nullptr, scr, lane); continue; } r -= I_OUT;
        if (r < I_UQ) { const int kb = r / 12, nb = r % 12;
            p0_tr_item(p.w_uq, 768, (bf16_t*)(ws + WS_WUQ), 256, kb * 64, nb * 64, nb * 64, p.q_norm_w, scr, lane); continue; } r -= I_UQ;
        { const int kb = r >> 4, nb = r & 15;
            p0_tr_item(p.w_ukv, 1024, (bf16_t*)(ws + WS_WUKV), 256, kb * 64, nb * 64, nb * 64, p.kv_norm_w, scr, lane); }
    }
    { const int gt = blockIdx.x * NTHREADS + tid, NGT = gridDim.x * NTHREADS; const u32x4 z = {0u, 0u, 0u, 0u};
      for (int i = gt; i < 64 * (P2_FP8 ? 64 : 128); i += NGT) ((u32x4*)(ws + WS_WIN + (size_t)1984 * (P2_FP8 ? 1024 : 2048)))[i] = z;
      for (int i = gt; i < 1024 * 16; i += NGT) { const int row = i >> 4, ch = i & 15; *(u32x4*)((bf16_t*)(ws + WS_WUKV) + (size_t)row * 256 + 128 + ch * 8) = z; } }
}

__device__ __forceinline__ void p1_rows(const Params& p) {
    const int tid = tid_opaque(), lane = tid & 63, wave = tid >> 6;
    const int gw = blockIdx.x * NWAVES + wave, NGW = gridDim.x * NWAVES;
    const float* mods = (const float*)(p.ws + WS_MODS);
    bf16_t* HB = (bf16_t*)(p.ws + WS_HB);
    { const int gt = blockIdx.x * NTHREADS + tid, NGT = gridDim.x * NTHREADS;
      for (int i = gt; i < MALL; i += NGT) { ((float*)(p.ws + WS_RSQ))[i] = 0.f; ((float*)(p.ws + WS_RSKV))[i] = 0.f; }
      for (int i = gt; i < RMAX; i += NGT) ((int*)(p.ws + WS_RTOK))[i] = 0;
      for (int i = gt; i < T; i += NGT) ((float*)(p.ws + WS_RSX))[i] = 0.f; }
    f32x4 av[4], sv[4]; int curb = -1;
    for (int m0 = __builtin_amdgcn_readfirstlane(gw); m0 < MALL; m0 += 2 * NGW) {
        int mm[2]; bool ok[2]; f32x4 v[2][4];
#pragma unroll
        for (int q = 0; q < 2; ++q) { const int m_ = m0 + q * NGW; ok[q] = m_ < MALL; mm[q] = ok[q] ? m_ : m0;
            const int b = mm[q] / RPB, i = mm[q] - b * RPB; const bool isctx = i < CTX;
            const float* src = isctx ? p.ctx + ((size_t)b * CTX + i) * DM : p.x + ((size_t)b * SEQ + (i - CTX)) * DM;
            const f32x4* xr = (const f32x4*)src + lane;
#pragma unroll
            for (int j = 0; j < 4; ++j) v[q][j] = xr[64 * j]; }
#pragma unroll
        for (int q = 0; q < 2; ++q) { const int m = mm[q], b = m / RPB, i = m - b * RPB; const int bsel = i < CTX ? 4 : b;
            if (bsel != curb) { curb = bsel; const float* md = mods + bsel * 6144;
#pragma unroll
                for (int j = 0; j < 4; ++j) { av[j] = ((const f32x4*)p.attn_norm_w)[lane + 64 * j] * (((const f32x4*)(md + 1024))[lane + 64 * j] + 1.f); sv[j] = ((const f32x4*)md)[lane + 64 * j]; } }
            float s = 0.f;
#pragma unroll
            for (int j = 0; j < 4; ++j) s += (v[q][j].x * v[q][j].x + v[q][j].y * v[q][j].y) + (v[q][j].z * v[q][j].z + v[q][j].w * v[q][j].w);
            const float r = rsqrtf(wave_sum(s) * (1.f / DM) + EPS);
#if P2_FP8
            if (ok[q]) { unsigned* o = (unsigned*)((unsigned char*)HB + (size_t)m * DM) + lane;
#pragma unroll
                for (int j = 0; j < 4; ++j) { const f32x4 h = v[q][j] * r * av[j] + sv[j]; o[64 * j] = cvt4_fp8(h.x, h.y, h.z, h.w); } }
#else
            if (ok[q]) { u32x2* o = (u32x2*)(HB + (size_t)m * DM) + lane;
#pragma unroll
                for (int j = 0; j < 4; ++j) { const f32x4 h = v[q][j] * r * av[j] + sv[j];
                    f32x4 hq = h; if (SIM_P2) hq = (f32x4){q8(h.x), q8(h.y), q8(h.z), q8(h.w)};
                    u32x2 pk; pk.x = cvt_pk_bf16(hq.x, hq.y); pk.y = cvt_pk_bf16(hq.z, hq.w); o[64 * j] = pk; } }
#endif
        }
    }
}
namespace pg8 {
typedef short bf16x8 __attribute__((ext_vector_type(8)));
typedef int v4i32_t __attribute__((ext_vector_type(4)));
typedef int v8i32_t __attribute__((ext_vector_type(8)));
constexpr int BM = 256, BK = 64, HALF = 128, HTB = HALF * BK * 2  , STAGE_BYTES = 8 * HTB;
__host__ __device__ __forceinline__ int lds_byte(int r, int c) { const int st = (r >> 4) * 2 + (c >> 5), rr = r & 15, cc = c & 31, ob = rr * 64 + cc * 2; return st * 1024 + (ob ^ (((ob >> 9) & 1) << 5)); }
__host__ __device__ __forceinline__ void stage_rc(int b, int& R, int& C) { const int st = b / 1024, sb = b % 1024, swz = sb ^ (((sb >> 9) & 1) << 5); R = (st >> 1) * 16 + swz / 64; C = (st & 1) * 32 + (swz % 64) / 2; }

struct Unit { int am, bn, pm, pn, e; };
struct Gemm { const bf16_t* A; int lda; const bf16_t* Bt; int K; const int* rowtok; };

template <class Epi, class Sched, bool GATHER = false, bool FP8 = false, bool ALIGN_EPI = true>
__device__ __forceinline__ void gemm_phase(LAS unsigned char* lds, const Gemm g, const Sched& S, const Epi& E) {
    const int tid = tid_opaque(), wid = __builtin_amdgcn_readfirstlane(tid >> 6), lane = tid & 63, wr = wid >> 2, wc = wid & 3, fr = lane & 15, fq = lane >> 4;
    const int K = g.K, lda = g.lda; int nt = K / BK; asm volatile("" : "+s"(nt));
    unsigned voffA[2], voffB[2];
#pragma unroll
    for (int i = 0; i < 2; ++i) { int R, C; stage_rc(tid * 16 + i * 8192, R, C);
        voffA[i] = (unsigned)(R * lda + C) * 2u; voffB[i] = (unsigned)(R * K + C) * 2u; }
    unsigned vA0[2], vA1[2];
    LAS u32x4* gnx = (LAS u32x4*)(lds + STAGE_BYTES + 4096) + tid;
#define PG8_GOFF(AM, o00, o01, o10, o11) do { int t_ = tid; asm volatile("" : "+v"(t_)); int R0_, C0_, R1_, C1_; stage_rc(t_ * 16, R0_, C0_); stage_rc(t_ * 16 + 8192, R1_, C1_); \
        const int* rt_ = g.rowtok + (AM) * 256; const unsigned lb_ = (unsigned)(lda * 2); \
        o00 = (unsigned)rt_[R0_] * lb_ + (unsigned)(C0_ * 2); o01 = (unsigned)rt_[R1_] * lb_ + (unsigned)(C1_ * 2); o10 = (unsigned)rt_[128 + R0_] * lb_ + (unsigned)(C0_ * 2); o11 = (unsigned)rt_[128 + R1_] * lb_ + (unsigned)(C1_ * 2); } while (0)
#define PG8_STAGE_A(bufoff, soff, h, W0, W1) do { PG8_STAGE(bufoff, rA, soff, ((h) ? W1 : W0)); } while (0)
    const unsigned kstep = (unsigned)(BK * 2);
    const unsigned hstepA = (unsigned)(HALF * lda * 2), hstepB = (unsigned)(HALF * K * 2);
    const unsigned tstepA = 2 * hstepA, tstepB = 2 * hstepB;
    const __amdgpu_buffer_rsrc_t rA = __builtin_amdgcn_make_buffer_rsrc((void*)g.A, 0, 0xffffffff, 0x00020000), rB = __builtin_amdgcn_make_buffer_rsrc((void*)g.Bt, 0, 0xffffffff, 0x00020000);
    const unsigned ldsw = (unsigned)wid * 1024u;
    const int aoff = lds_byte(wr * 64 + fr, fq * 8), boff = lds_byte(wc * 32 + fr, fq * 8);
#define PG8_SA(b, h) (((b) * 2 + (h)) * HTB)
#define PG8_SB(b, h) ((4 + (b) * 2 + (h)) * HTB)
#define PG8_STAGE(bufoff, rs, soff, voff) do { _Pragma("unroll") for (int _i = 0; _i < 2; ++_i) \
        __builtin_amdgcn_raw_ptr_buffer_load_lds(rs, (LAS unsigned*)(lds + (bufoff) + ldsw + _i * 8192), 16, (int)(voff)[_i], (int)(soff), 0, 0); } while (0)
#define PG8_LDA(dst, b, h) do { _Pragma("unroll") for (int m = 0; m < 4; ++m) { const v4i32_t lo_ = *(const LAS v4i32_t*)(lds + PG8_SA(b, h) + aoff + m * 2048), hi_ = *(const LAS v4i32_t*)(lds + PG8_SA(b, h) + aoff + m * 2048 + 1024); \
        dst[m] = __builtin_shufflevector(lo_, hi_, 0, 1, 2, 3, 4, 5, 6, 7); } } while (0)
#define PG8_LDB(dst, b, h) do { _Pragma("unroll") for (int n = 0; n < 2; ++n) { const v4i32_t lo_ = *(const LAS v4i32_t*)(lds + PG8_SB(b, h) + boff + n * 2048), hi_ = *(const LAS v4i32_t*)(lds + PG8_SB(b, h) + boff + n * 2048 + 1024); \
        dst[n] = __builtin_shufflevector(lo_, hi_, 0, 1, 2, 3, 4, 5, 6, 7); } } while (0)
#define PG8_LO(x) __builtin_bit_cast(bf16x8, __builtin_shufflevector(x, x, 0, 1, 2, 3))
#define PG8_HI(x) __builtin_bit_cast(bf16x8, __builtin_shufflevector(x, x, 4, 5, 6, 7))
#define PG8_MMA(ai, bj, At, Bt) do { __builtin_amdgcn_s_setprio(1); _Pragma("unroll") for (int m = 0; m < 4; ++m) _Pragma("unroll") for (int n = 0; n < 2; ++n) { \
        if constexpr (FP8) acc[ai][bj][m][n] = __builtin_amdgcn_mfma_scale_f32_16x16x128_f8f6f4(Bt[n], At[m], acc[ai][bj][m][n], 0, 0, 0, 0, 0, 0)    ; \
        else { acc[ai][bj][m][n] = __builtin_amdgcn_mfma_f32_16x16x32_bf16(PG8_LO(Bt[n]), PG8_LO(At[m]), acc[ai][bj][m][n], 0, 0, 0); \
               acc[ai][bj][m][n] = __builtin_amdgcn_mfma_f32_16x16x32_bf16(PG8_HI(Bt[n]), PG8_HI(At[m]), acc[ai][bj][m][n], 0, 0, 0); } } __builtin_amdgcn_s_setprio(0); } while (0)
#define PG8_WAIT_V(n) asm volatile("s_waitcnt vmcnt(" #n ")" ::: "memory")
#define PG8_STR_(x) #x
#define PG8_XSTR_(x) PG8_STR_(x)
#define PG8_WAIT_V8X() do { if (relax) asm volatile("s_waitcnt vmcnt(%0)" :: "n"(8 + Epi::NST) : "memory"); else asm volatile("s_waitcnt vmcnt(8)" ::: "memory"); } while (0)
#define PG8_WAIT_L(n) asm volatile("s_waitcnt lgkmcnt(" #n ")" ::: "memory")
#define PG8_BAR __builtin_amdgcn_s_barrier()
#define PG8_SCHED __builtin_amdgcn_sched_barrier(0)
    Unit cur, nxt; int ui = 0;
    if (!S.next(0, cur)) return;
    f32x4 acc[2][2][4][2];
#pragma unroll
    for (int a = 0; a < 2; ++a)
#pragma unroll
        for (int b = 0; b < 2; ++b)
#pragma unroll
            for (int m = 0; m < 4; ++m)
#pragma unroll
                for (int n = 0; n < 2; ++n) acc[a][b][m][n] = (f32x4){0.f, 0.f, 0.f, 0.f};
    v8i32_t At[4], B0[2], B1[2];
    unsigned cA = GATHER ? 0u : (unsigned)cur.am * tstepA, cB = (unsigned)cur.bn * tstepB;
    if constexpr (GATHER) { PG8_GOFF(cur.am, vA0[0], vA0[1], vA1[0], vA1[1]); }
    else { vA0[0] = voffA[0]; vA0[1] = voffA[1]; vA1[0] = voffA[0] + hstepA; vA1[1] = voffA[1] + hstepA; }
    PG8_STAGE(PG8_SB(0, 0), rB, cB, voffB); PG8_STAGE(PG8_SB(0, 1), rB, cB + hstepB, voffB); PG8_STAGE_A(PG8_SA(0, 0), cA, 0, vA0, vA1); PG8_STAGE_A(PG8_SA(0, 1), cA, 1, vA0, vA1);
    if (wr == 1) PG8_BAR;
    PG8_WAIT_V(2); PG8_BAR;
    PG8_STAGE(PG8_SB(1, 0), rB, cB + kstep, voffB); PG8_STAGE_A(PG8_SA(1, 0), cA + kstep, 0, vA0, vA1); PG8_STAGE(PG8_SB(1, 1), rB, cB + hstepB + kstep, voffB);
    PG8_WAIT_V(6); PG8_BAR;
    for (;;) {
        const bool has_next = S.next(ui + 1, nxt);
        const unsigned nA = (has_next && !GATHER) ? (unsigned)nxt.am * tstepA : cA, nB = has_next ? (unsigned)nxt.bn * tstepB : cB;
        if constexpr (GATHER) { const int am_ = has_next ? nxt.am : cur.am; u32x4 nv_; PG8_GOFF(am_, nv_.x, nv_.y, nv_.z, nv_.w); *gnx = nv_; }
        for (int t = 0; t < nt; t += 2) {
            const bool last = (t == nt - 2); const bool relax = Epi::NST > 0 && t == 0 && ui > 0;
            const unsigned a1 = cA + (unsigned)(t + 1) * kstep;
            const unsigned a2 = last ? nA : cA + (unsigned)(t + 2) * kstep, b2 = last ? nB : cB + (unsigned)(t + 2) * kstep;
            const unsigned a3 = a2 + kstep, b3 = b2 + kstep;
            if constexpr (GATHER) { if (last) { const u32x4 nv_ = *gnx; vA0[0] = nv_.x; vA0[1] = nv_.y; }
            } else if constexpr (FP8) { if (last) asm volatile("s_nop 0"); }
            PG8_LDB(B0, 0, 0); PG8_LDB(B1, 0, 1); PG8_SCHED; PG8_LDA(At, 0, 0); PG8_STAGE_A(PG8_SA(1, 1), a1, 1, vA0, vA1);
            PG8_WAIT_V8X(); PG8_WAIT_L(0); PG8_BAR; PG8_MMA(0, 0, At, B0); PG8_MMA(0, 1, At, B1); PG8_BAR; PG8_SCHED;
            PG8_LDA(At, 0, 1); PG8_STAGE(PG8_SB(0, 0), rB, b2, voffB); PG8_STAGE(PG8_SB(0, 1), rB, b2 + hstepB, voffB); PG8_STAGE_A(PG8_SA(0, 0), a2, 0, vA0, vA1);
            if constexpr (GATHER) { if (last) { const u32x4 nv_ = *gnx; vA1[0] = nv_.z; vA1[1] = nv_.w; } }
            else if constexpr (FP8) { if (last) asm volatile("s_nop 0"); }
            PG8_WAIT_V8X(); PG8_WAIT_L(0); PG8_BAR; PG8_MMA(1, 0, At, B0); PG8_MMA(1, 1, At, B1); PG8_BAR; PG8_SCHED;
            PG8_LDB(B0, 1, 0); PG8_LDB(B1, 1, 1); PG8_SCHED; PG8_LDA(At, 1, 0); PG8_STAGE_A(PG8_SA(0, 1), a2, 1, vA0, vA1);
            PG8_WAIT_V(8); PG8_WAIT_L(0); PG8_BAR; PG8_MMA(0, 0, At, B0); PG8_MMA(0, 1, At, B1); PG8_BAR; PG8_SCHED;
            PG8_LDA(At, 1, 1); PG8_STAGE(PG8_SB(1, 0), rB, b3, voffB); PG8_STAGE(PG8_SB(1, 1), rB, b3 + hstepB, voffB); PG8_STAGE_A(PG8_SA(1, 0), a3, 0, vA0, vA1);
            PG8_WAIT_V(8); PG8_WAIT_L(0); PG8_BAR; PG8_MMA(1, 0, At, B0); PG8_MMA(1, 1, At, B1); PG8_BAR; PG8_SCHED;
        }
        if constexpr (ALIGN_EPI) { if (wr == 0) PG8_BAR; }
        PG8_SCHED;
        { int fr_ = fr, fq_ = fq; asm volatile("" : "+v"(fr_), "+v"(fq_));
          E(acc, cur, wr, wc, fr_, fq_); }
        if (!has_next) break;
#pragma unroll
        for (int a = 0; a < 2; ++a)
#pragma unroll
            for (int b = 0; b < 2; ++b)
#pragma unroll
                for (int m = 0; m < 4; ++m)
#pragma unroll
                    for (int n = 0; n < 2; ++n) acc[a][b][m][n] = (f32x4){0.f, 0.f, 0.f, 0.f};
        cur = nxt; cA = nA; cB = nB; ++ui;
        if constexpr (ALIGN_EPI) { if (wr == 1) PG8_BAR; }
    }
    PG8_WAIT_V(0);
    if constexpr (!ALIGN_EPI) { if (wr == 0) PG8_BAR; }
    PG8_BAR;
#undef PG8_SA
#undef PG8_SB
#undef PG8_STAGE
#undef PG8_STAGE_A
#undef PG8_GOFF
#undef PG8_LDA
#undef PG8_LDB
#undef PG8_MMA
#undef PG8_LO
#undef PG8_HI
#undef PG8_WAIT_V
#undef PG8_WAIT_V8X
#undef PG8_WAIT_L
#undef PG8_BAR
#undef PG8_SCHED
}
}
struct PlainOrder {
    int nM, nN, nwg, G, c, latent_only;
    __device__ void init(int nM_, int nN_, int G_, int c_, int latent_only_) { nM = nM_; nN = nN_; nwg = nM * nN; G = G_; c = c_; latent_only = latent_only_; }
    __device__ bool next(int i, pg8::Unit& u) const {
        const long L = (long)i * G + c; if (L >= nwg) return false;
        int wgid = (int)L; { const int q = nwg / 8, r = nwg % 8, xcd = wgid % 8, off = wgid / 8; wgid = (xcd < r ? xcd * (q + 1) : r * (q + 1) + (xcd - r) * q) + off; }
        const int WGM = 8, nig = WGM * nN, gid = wgid / nig, fm = gid * WGM, gsz = (nM - fm) < WGM ? (nM - fm) : WGM;
        const int pm = fm + ((wgid % nig) % gsz), pn = (wgid % nig) / gsz;
        u.pm = pm; u.pn = pn; u.e = 0; u.bn = pn;
        u.am = latent_only ? (pm >> 5) * 33 + 1 + (pm & 31) : pm;
        return true;
    }
};
struct ProjOrder {
    PlainOrder P; int G, c, part, split;
    __device__ void init(int G_, int c_, int part_) { G = G_; c = c_; part = part_; split = (G_ == 256); P.init(MALL / 256, 7, G_, c_, 0); }
    __device__ bool next(int i, pg8::Unit& u) const {
        int pm, pn;
        if (part == 0) { const long L = (long)i * G + c; if (L >= (split ? 1024 : 1056)) return false;
            if (L < 924) { if (!P.next(i, u)) return false; pm = u.pm; pn = u.pn + 1; } else { pm = (int)L - 924; pn = 0; } }
        else { if (!split || i > 0 || c >= 32) return false; pm = 100 + c; pn = 0; }
        u.pm = pm; u.pn = pn; u.e = 0; u.bn = pn; u.am = pm; return true;
    }
};
struct MoeOrder {
    const int* seg; int NT, ncol, G, c;
    __device__ bool next(int i, pg8::Unit& u) const {
        int rt, pn;
        if (G == 256) { const int x = c & 7, s = c >> 3;
            if (ncol == 8) { rt = i * 32 + x * 4 + (s >> 3); pn = s & 7; } else { rt = i * 64 + x * 8 + (s >> 2); pn = s & 3; } }
        else { const long L = (long)i * G + c; rt = (int)(L / ncol); pn = (int)(L % ncol); }
        if (rt >= NT) return false;
        const int r0 = rt * 256; int e = 0;
        while (e < 31 && r0 >= seg[e + 1]) ++e;
        u.am = rt; u.pm = rt; u.pn = pn; u.e = e; u.bn = e * ncol + pn; return true;
    }
};

typedef f32x4 AccT[2][2][4][2];
constexpr float QSCALE_DIFF = 0.125f * 1.4426950408889634f;
constexpr float QSCALE_MLA = 0.07216878364870322f * 1.4426950408889634f;
struct EpiProj {
    static constexpr int NST = 0;
    bf16_t* PJ; const f32x2* rope; float* rsq; float* rskv; unsigned char* ws;
    __device__ __forceinline__ void operator()(const AccT& acc, const pg8::Unit& u, int wr, int wc, int fr, int fq) const {
        const int pm = u.pm, pn = u.pn; const bool latent = (pm % 33) != 0;
        const int a = wc & 1;
#pragma unroll
        for (int ai = 0; ai < 2; ++ai)
#pragma unroll
            for (int m = 0; m < 4; ++m) {
                const int row = pm * 256 + ai * 128 + wr * 64 + m * 16 + fr;
                const int i = row % RPB, pos = i - CTX, pv = a ? (pos & 63) : (pos >> 6);
                float ss = 0.f;
#pragma unroll
                for (int bj = 0; bj < 2; ++bj) {
                    f32x4 v0 = acc[ai][bj][m][0] * (P2_FP8 ? 1.f / WQ_SCALE : 1.f), v1 = acc[ai][bj][m][1] * (P2_FP8 ? 1.f / WQ_SCALE : 1.f);
                    if (pn == 6 || (pn == 7 && bj == 0)) ss += (v0.x * v0.x + v0.y * v0.y) + (v0.z * v0.z + v0.w * v0.w) + (v1.x * v1.x + v1.y * v1.y) + (v1.z * v1.z + v1.w * v1.w);
                    if (pn < 2) { v0 = v0 * QSCALE_DIFF; v1 = v1 * QSCALE_DIFF; }
                    const bool rp = latent && (pn < 4 || (pn == 7 && bj == 1 && wc < 2));
                    if (rp) { const f32x4* t = (const f32x4*)(rope + pv * 16 + 4 * fq); const f32x4 t0 = t[0], t1 = t[1];
                        const f32x4 cs = {t0.x, t0.z, t1.x, t1.z}, sn = {t0.y, t0.w, t1.y, t1.w};
                        const f32x4 o0 = v0 * cs - v1 * sn, o1 = v1 * cs + v0 * sn; v0 = o0; v1 = o1; }
#ifdef SIM_FP8_ATT
                    if (pn < 6 || (pn == 7 && bj == 1 && wc < 2)) { v0 = (f32x4){q8(v0.x), q8(v0.y), q8(v0.z), q8(v0.w)}; v1 = (f32x4){q8(v1.x), q8(v1.y), q8(v1.z), q8(v1.w)}; }
#endif
#if ATT_FP8
                    const int cl = (pn & 1) * 256 + bj * 128 + wc * 32 + 4 * fq;
                    if (pn < 4) { unsigned char* d8 = ws + (pn < 2 ? WS_Q8D : WS_K8D) + (size_t)row * 512 + cl;
                        *(unsigned*)d8 = cvt4_fp8(v0.x, v0.y, v0.z, v0.w); *(unsigned*)(d8 + 16) = cvt4_fp8(v1.x, v1.y, v1.z, v1.w); }
                    else if (pn < 6) { const int b_ = row / RPB, i_ = row - b_ * RPB, hh = cl >> 7, e0 = cl & 127;
                        unsigned char* d8 = ws + WS_VT8D + ((size_t)(b_ * 4 + hh) * 128 + e0 + (fr & 3)) * RPB + (i_ & ~63) + vt_pos(i_ & 60);
                        *(unsigned*)d8 = quad_tr_bytes(cvt4_fp8(v0.x, v0.y, v0.z, v0.w), fr & 3); *(unsigned*)(d8 + 16 * RPB) = quad_tr_bytes(cvt4_fp8(v1.x, v1.y, v1.z, v1.w), fr & 3); }
                    else if (pn == 7 && bj == 1 && wc < 2) { unsigned char* d8 = ws + WS_KR8 + (size_t)row * 64 + wc * 32 + 4 * fq;
                        *(unsigned*)d8 = cvt4_fp8(v0.x, v0.y, v0.z, v0.w); *(unsigned*)(d8 + 16) = cvt4_fp8(v1.x, v1.y, v1.z, v1.w); }
                    if (pn >= 6)
#endif
                    { bf16_t* dst = PJ + (size_t)row * NPROJ + pn * 256 + bj * 128 + wc * 32 + 4 * fq;
                    u32x2 w0, w1; w0.x = cvt_pk_bf16(v0.x, v0.y); w0.y = cvt_pk_bf16(v0.z, v0.w); w1.x = cvt_pk_bf16(v1.x, v1.y); w1.y = cvt_pk_bf16(v1.z, v1.w);
                    *(u32x2*)dst = w0; *(u32x2*)(dst + 16) = w1; }
                }
                if (pn >= 6) { ss += __shfl_xor(ss, 16); ss += __shfl_xor(ss, 32); if (fq == 0) atomicAdd((pn == 6 ? rsq : rskv) + row, ss); }
                asm volatile("" ::: "memory");
            }
    }
};
struct EpiQ {
    static constexpr int NST = 0;
    bf16_t* QM; const f32x2* rope; const float* rsq; unsigned char* ws;
    __device__ __forceinline__ void operator()(const AccT& acc, const pg8::Unit& u, int wr, int wc, int fr, int fq) const {
        const int pm = u.pm, pn = u.pn; const bool latent = (pm % 33) != 0;
#pragma unroll
        for (int ai = 0; ai < 2; ++ai)
#pragma unroll
            for (int m = 0; m < 4; ++m) {
                const int row = pm * 256 + ai * 128 + wr * 64 + m * 16 + fr;
                const float rq = rsqrtf(rsq[row] * (1.f / 256.f) + EPS);
                const int i = row % RPB, pos = i - CTX;
#pragma unroll
                for (int bj = 0; bj < 2; ++bj) {
                    f32x4 v0 = acc[ai][bj][m][0] * rq, v1 = acc[ai][bj][m][1] * rq;
                    const int g6 = (pn * 8 + bj * 4 + wc) % 6;
                    if (latent && g6 >= 4) { const int pv = (g6 == 5) ? (pos & 63) : (pos >> 6);
                        const f32x4* t = (const f32x4*)(rope + pv * 16 + 4 * fq); const f32x4 t0 = t[0], t1 = t[1];
                        const f32x4 cs = {t0.x, t0.z, t1.x, t1.z}, sn = {t0.y, t0.w, t1.y, t1.w};
                        const f32x4 o0 = v0 * cs - v1 * sn, o1 = v1 * cs + v0 * sn; v0 = o0; v1 = o1; }
#ifdef SIM_FP8_ATT
                    v0 = (f32x4){q8(v0.x), q8(v0.y), q8(v0.z), q8(v0.w)}; v1 = (f32x4){q8(v1.x), q8(v1.y), q8(v1.z), q8(v1.w)};
#endif
#if ATT_FP8
                    { unsigned char* d8 = ws + WS_Q8M + (size_t)row * 768 + pn * 256 + bj * 128 + wc * 32 + 4 * fq; v0 = v0 * QSCALE_MLA; v1 = v1 * QSCALE_MLA;
                      *(unsigned*)d8 = cvt4_fp8(v0.x, v0.y, v0.z, v0.w); *(unsigned*)(d8 + 16) = cvt4_fp8(v1.x, v1.y, v1.z, v1.w); }
#else
                    bf16_t* dst = QM + (size_t)row * 768 + pn * 256 + bj * 128 + wc * 32 + 4 * fq;
                    u32x2 w0, w1; w0.x = cvt_pk_bf16(v0.x, v0.y); w0.y = cvt_pk_bf16(v0.z, v0.w); w1.x = cvt_pk_bf16(v1.x, v1.y); w1.y = cvt_pk_bf16(v1.z, v1.w);
                    *(u32x2*)dst = w0; *(u32x2*)(dst + 16) = w1;
#endif
                }
            }
    }
};
struct EpiKV {
    static constexpr int NST = 0;
    bf16_t* KV; const float* rskv; unsigned char* ws;
    __device__ __forceinline__ void operator()(const AccT& acc, const pg8::Unit& u, int wr, int wc, int fr, int fq) const {
        const int pm = u.pm, pn = u.pn;
#pragma unroll
        for (int ai = 0; ai < 2; ++ai)
#pragma unroll
            for (int m = 0; m < 4; ++m) {
                const int row = pm * 256 + ai * 128 + wr * 64 + m * 16 + fr;
                const float rk = rsqrtf(rskv[row] * (1.f / 128.f) + EPS);
#pragma unroll
                for (int bj = 0; bj < 2; ++bj) {
                    f32x4 v0 = acc[ai][bj][m][0] * rk, v1 = acc[ai][bj][m][1] * rk;
#ifdef SIM_FP8_ATT
                    v0 = (f32x4){q8(v0.x), q8(v0.y), q8(v0.z), q8(v0.w)}; v1 = (f32x4){q8(v1.x), q8(v1.y), q8(v1.z), q8(v1.w)};
#endif
#if ATT_FP8
                    if (bj == 0) { unsigned char* d8 = ws + WS_K8M + (size_t)row * 512 + pn * 128 + wc * 32 + 4 * fq;
                        *(unsigned*)d8 = cvt4_fp8(v0.x, v0.y, v0.z, v0.w); *(unsigned*)(d8 + 16) = cvt4_fp8(v1.x, v1.y, v1.z, v1.w); }
                    else { const int b_ = row / RPB, i_ = row - b_ * RPB, e0 = wc * 32 + 4 * fq;
                        unsigned char* d8 = ws + WS_VT8M + ((size_t)(b_ * 4 + pn) * 128 + e0 + (fr & 3)) * RPB + (i_ & ~63) + vt_pos(i_ & 60);
                        *(unsigned*)d8 = quad_tr_bytes(cvt4_fp8(v0.x, v0.y, v0.z, v0.w), fr & 3); *(unsigned*)(d8 + 16 * RPB) = quad_tr_bytes(cvt4_fp8(v1.x, v1.y, v1.z, v1.w), fr & 3); }
#else
                    bf16_t* dst = KV + (size_t)row * 1024 + pn * 256 + bj * 128 + wc * 32 + 4 * fq;
                    u32x2 w0, w1; w0.x = cvt_pk_bf16(v0.x, v0.y); w0.y = cvt_pk_bf16(v0.z, v0.w); w1.x = cvt_pk_bf16(v1.x, v1.y); w1.y = cvt_pk_bf16(v1.z, v1.w);
                    *(u32x2*)dst = w0; *(u32x2*)(dst + 16) = w1;
#endif
                }
            }
    }
};
struct EpiOut {
    static constexpr int NST = 0;
    bf16_t* XN; const float* x; const float* mods; float* rsx;
    __device__ __forceinline__ void operator()(const AccT& acc, const pg8::Unit& u, int wr, int wc, int fr, int fq) const {
        const int pm = u.pm, pn = u.pn, b = pm >> 5;
        const float* ga = mods + b * 6144 + 2 * 1024;
        float ssr[2][4];
#pragma unroll
        for (int ai = 0; ai < 2; ++ai)
#pragma unroll
            for (int m = 0; m < 4; ++m) ssr[ai][m] = 0.f;
#pragma unroll
        for (int bj = 0; bj < 2; ++bj) { const int cb = pn * 256 + bj * 128 + wc * 32;
            const f32x4 gv0 = *(const f32x4*)(ga + cb + 4 * fq), gv1 = *(const f32x4*)(ga + cb + 16 + 4 * fq);
#pragma unroll
            for (int ai = 0; ai < 2; ++ai)
#pragma unroll
                for (int m = 0; m < 4; ++m) { const size_t ro = (size_t)(pm * 256 + ai * 128 + wr * 64 + m * 16 + fr) * DM + cb;
                    const f32x4 v0 = *(const f32x4*)(x + ro + 4 * fq) + gv0 * acc[ai][bj][m][0], v1 = *(const f32x4*)(x + ro + 16 + 4 * fq) + gv1 * acc[ai][bj][m][1];
                    ssr[ai][m] += ((v0.x * v0.x + v0.y * v0.y) + (v0.z * v0.z + v0.w * v0.w)) + ((v1.x * v1.x + v1.y * v1.y) + (v1.z * v1.z + v1.w * v1.w));
                    unsigned ax = cvt_pk_bf16(v0.x, v0.y), ay = cvt_pk_bf16(v0.z, v0.w), bx = cvt_pk_bf16(v1.x, v1.y), by = cvt_pk_bf16(v1.z, v1.w);
                    { auto r_ = __builtin_amdgcn_permlane32_swap(ax, bx, false, false); ax = r_[0]; bx = r_[1]; } { auto r_ = __builtin_amdgcn_permlane32_swap(ay, by, false, false); ay = r_[0]; by = r_[1]; }
                    { auto r_ = __builtin_amdgcn_permlane16_swap(ax, bx, false, false); ax = r_[0]; bx = r_[1]; } { auto r_ = __builtin_amdgcn_permlane16_swap(ay, by, false, false); ay = r_[0]; by = r_[1]; }
                    *(u32x4*)(XN + ro + 8 * fq) = (u32x4){ax, ay, bx, by}; } }
#pragma unroll
        for (int ai = 0; ai < 2; ++ai)
#pragma unroll
            for (int m = 0; m < 4; ++m) { float s = ssr[ai][m]; s += __shfl_xor(s, 16); s += __shfl_xor(s, 32);
                if (fq == 0) atomicAdd(rsx + pm * 256 + ai * 128 + wr * 64 + m * 16 + fr, s); }
    }
};
struct EpiAct {
    static constexpr int NST = 16;
    unsigned char* ACT; const float* b1;
    __device__ __forceinline__ void operator()(const AccT& acc, const pg8::Unit& u, int wr, int wc, int fr, int fq) const {
        const int pm = u.pm, pn = u.pn; const float* bb = b1 + (size_t)u.e * 2048;
#pragma unroll
        for (int n = 0; n < 2; ++n) { const int col = pn * 128 + wc * 32 + n * 16 + 4 * fq; const f32x4 bg = *(const f32x4*)(bb + col), bu = *(const f32x4*)(bb + 1024 + col);
#pragma unroll
            for (int ai = 0; ai < 2; ++ai)
#pragma unroll
                for (int m = 0; m < 4; ++m) { const int row = pm * 256 + ai * 128 + wr * 64 + m * 16 + fr;
                    const f32x4 gq = acc[ai][0][m][n] * (1.f / WQ_SCALE) + bg, uq = acc[ai][1][m][n] * (1.f / WQ_SCALE) + bu; float o[4];
#pragma unroll
                    for (int e = 0; e < 4; ++e) { const float gg = fminf(gq[e], 7.f), uu = fminf(fmaxf(uq[e], -7.f), 7.f);
                        o[e] = gg * __builtin_amdgcn_rcpf(1.f + __builtin_amdgcn_exp2f(gg * (-1.702f * 1.4426950408889634f))) * (uu + 1.f); }
                    *(unsigned*)(ACT + (size_t)row * 1024 + col) = cvt4_fp8(o[0], o[1], o[2], o[3]); } }
    }
};
struct EpiY {
    static constexpr int NST = 16;
    bf16_t* YS; const float* b2; const float* gsrt; int mode = 0;
    __device__ __forceinline__ void operator()(const AccT& acc, const pg8::Unit& u, int wr, int wc, int fr, int fq) const {
        const int pm = u.pm, pn = u.pn; const float* bb = b2 + (size_t)u.e * 1024;
        float gt[2][4];
#pragma unroll
        for (int ai = 0; ai < 2; ++ai)
#pragma unroll
            for (int m = 0; m < 4; ++m) gt[ai][m] = gsrt[pm * 256 + ai * 128 + wr * 64 + m * 16 + fr] * (YS_FP8 ? YS_SCALE : 1.f);
#pragma unroll
        for (int bj = 0; bj < 2; ++bj) { const int cb = pn * 256 + bj * 128 + wc * 32;
            const f32x4 bv0 = *(const f32x4*)(bb + cb + 4 * fq), bv1 = *(const f32x4*)(bb + cb + 16 + 4 * fq);
#pragma unroll
            for (int ai = 0; ai < 2; ++ai)
#pragma unroll
                for (int m = 0; m < 4; ++m) { const int row = pm * 256 + ai * 128 + wr * 64 + m * 16 + fr;
                    const f32x4 v0 = (acc[ai][bj][m][0] * (1.f / WQ_SCALE) + bv0) * gt[ai][m], v1 = (acc[ai][bj][m][1] * (1.f / WQ_SCALE) + bv1) * gt[ai][m];
#if YS_FP8
                    unsigned ax = cvt4_fp8(v0.x, v0.y, v0.z, v0.w), bx = cvt4_fp8(v1.x, v1.y, v1.z, v1.w);
                    { auto r_ = __builtin_amdgcn_permlane32_swap(ax, bx, false, false); ax = r_[0]; bx = r_[1]; }
                    { auto r_ = __builtin_amdgcn_permlane16_swap(ax, bx, false, false); ax = r_[0]; bx = r_[1]; }
                    if (mode == 0 || ax == 0x12345678u) *(u32x2*)((unsigned char*)YS + (size_t)row * 1024 + cb + 8 * fq) = (u32x2){ax, bx};
#else
                    unsigned ax = cvt_pk_bf16(v0.x, v0.y), ay = cvt_pk_bf16(v0.z, v0.w), bx = cvt_pk_bf16(v1.x, v1.y), by = cvt_pk_bf16(v1.z, v1.w);
                    { auto r_ = __builtin_amdgcn_permlane32_swap(ax, bx, false, false); ax = r_[0]; bx = r_[1]; } { auto r_ = __builtin_amdgcn_permlane32_swap(ay, by, false, false); ay = r_[0]; by = r_[1]; }
                    { auto r_ = __builtin_amdgcn_permlane16_swap(ax, bx, false, false); ax = r_[0]; bx = r_[1]; } { auto r_ = __builtin_amdgcn_permlane16_swap(ay, by, false, false); ay = r_[0]; by = r_[1]; }
                    if (mode == 0 || ax == 0x12345678u) *(u32x4*)(YS + (size_t)row * 1024 + cb + 8 * fq) = (u32x4){ax, ay, bx, by};
#endif
                } }
    }
};
namespace attn {
using bf16x8 = __attribute__((ext_vector_type(8))) short;
using s16x4  = __attribute__((ext_vector_type(4))) short;
using f32x16 = __attribute__((ext_vector_type(16))) float;
constexpr int QBLK = 32, KVBLK = 64;
constexpr int SHM_V = KVBLK * 128 * 2;
#ifndef ATT_THR
#define ATT_THR 8.f
#endif
constexpr float THR = ATT_THR;
#define KOFF(row, ch) ((row) * 128 + ((((ch) ^ ((row) >> 1)) & 7) << 4))
#define SBAR() __builtin_amdgcn_sched_barrier(0)
__device__ __forceinline__ int crow(int r, int hi) { return (r & 3) + 8 * (r >> 2) + 4 * hi; }

template <int VAR = 0>
__device__ __forceinline__ void partialSM(f32x16& p0, f32x16& p1, float& m_reg, float& mn, float& alpha, const float C, const float thr_raw) {
  if constexpr (VAR == 1) { mn = m_reg; alpha = 1.f;
    _Pragma("unroll") for (int r = 0; r < 16; ++r) { p0[r] = p0[r] * C; p1[r] = p1[r] * C; } return; }
  float pmax = p0[0];
#pragma unroll
  for (int r = 1; r < 16; ++r) pmax = fmaxf(pmax, p0[r]);
#pragma unroll
  for (int r = 0; r < 16; ++r) pmax = fmaxf(pmax, p1[r]);
  { auto rr = __builtin_amdgcn_permlane32_swap(__float_as_uint(pmax), __float_as_uint(pmax), false, false);
    pmax = fmaxf(__uint_as_float(rr[0]), __uint_as_float(rr[1])); }
  if (__builtin_expect(__all(pmax - m_reg <= thr_raw), 1)) { mn = m_reg; alpha = 1.f; }
  else { mn = fmaxf(m_reg, pmax); alpha = __builtin_amdgcn_exp2f((m_reg - mn) * C); m_reg = mn; }
  const float mnC = -mn * C + PSHIFT;
#pragma unroll
  for (int r = 0; r < 16; ++r) p0[r] = fmaf(p0[r], C, mnC);
#pragma unroll
  for (int r = 0; r < 16; ++r) p1[r] = fmaf(p1[r], C, mnC);
#pragma unroll
  for (int r = 0; r < 16; ++r) p0[r] = __builtin_amdgcn_exp2f(p0[r]);
}
template <int VAR = 0>
__device__ __forceinline__ void finishSM(f32x16& p0, f32x16& p1, float alpha, float& l_reg, bf16x8& pa0, bf16x8& pa1, bf16x8& pa2, bf16x8& pa3) {
  if constexpr (VAR != 1) {
#pragma unroll
  for (int r = 0; r < 16; ++r) p1[r] = __builtin_amdgcn_exp2f(p1[r]); }
  float ps = 0;
#pragma unroll
  for (int r = 0; r < 16; ++r) ps += p0[r];
#pragma unroll
  for (int r = 0; r < 16; ++r) ps += p1[r];
  { auto rr = __builtin_amdgcn_permlane32_swap(__float_as_uint(ps), __float_as_uint(ps), false, false);
    ps = __uint_as_float(rr[0]) + __uint_as_float(rr[1]); }
  l_reg = l_reg * alpha + ps;
#define PK4(P, BASE, OUT) do { unsigned a0 = cvt_pk_bf16(P[BASE + 0], P[BASE + 1]), a1 = cvt_pk_bf16(P[BASE + 2], P[BASE + 3]);   \
    unsigned b0 = cvt_pk_bf16(P[BASE + 4], P[BASE + 5]), b1 = cvt_pk_bf16(P[BASE + 6], P[BASE + 7]);                              \
    auto r0 = __builtin_amdgcn_permlane32_swap(a0, b0, false, false); auto r1 = __builtin_amdgcn_permlane32_swap(a1, b1, false, false); \
    u32x4 w = {r0[0], r1[0], r0[1], r1[1]}; OUT = *reinterpret_cast<bf16x8*>(&w); } while (0)
  PK4(p0, 0, pa0); PK4(p0, 8, pa1); PK4(p1, 0, pa2); PK4(p1, 8, pa3);
#undef PK4
}
template <int NKC, int NQR, int KBOFF>
__device__ __forceinline__ void qkt(f32x16& p0, f32x16& p1, const int* kb, const bf16x8* qr, int ql) {
  p0 = f32x16{}; p1 = f32x16{};
  if constexpr (NQR != NKC) asm volatile("" : "+v"(ql));
#pragma unroll
  for (int c = 0; c < NKC; ++c)
#pragma unroll
    for (int d0 = 0; d0 < 4; ++d0) {
      const bf16x8 b0 = *(const LAS bf16x8*)(uintptr_t)(unsigned)(kb[d0] + (KBOFF + c * 8192));
      const bf16x8 b1 = *(const LAS bf16x8*)(uintptr_t)(unsigned)(kb[d0] + (KBOFF + c * 8192 + 4096));
      bf16x8 qf; if constexpr (NQR == NKC) qf = qr[c * 4 + d0]; else { if (c < NQR) qf = qr[(c < NQR ? c : 0) * 4 + d0]; else qf = *(const LAS bf16x8*)(uintptr_t)(unsigned)(ql + ((c - NQR) * 4 + d0) * 1024); }
      p0 = __builtin_amdgcn_mfma_f32_32x32x16_bf16(b0, qf, p0, 0, 0, 0);
      p1 = __builtin_amdgcn_mfma_f32_32x32x16_bf16(b1, qf, p1, 0, 0, 0); }
}
__device__ __forceinline__ int v_st(int k, int c) { const int kk = (k & ~0xC) | ((k & 4) << 1) | ((k & 8) >> 1); return ((kk >> 3) * 4 + (c >> 5)) * 512 + ((kk & 7) * 32 + (c & 31)) * 2; }
__device__ __forceinline__ int v_rd_base(int lane) { return ((lane & 3) << 3) | (((lane >> 2) & 3) << 6) | (((lane >> 4) & 1) << 5) | (((lane >> 5) & 1) << 8); }
constexpr int v_rd_off(int d0, int ks, int half) { return d0 * 512 + ks * 4096 + half * 2048; }
template <int OFF> __device__ __forceinline__ s16x4 tr_read(int vb) {
  s16x4 r; asm volatile("ds_read_b64_tr_b16 %0, %1 offset:%2" : "=&v"(r) : "v"(vb), "i"(OFF) : "memory"); return r;
}
template <int D0> __device__ __forceinline__ void pv_one(f32x16& od, int vb, bf16x8 pa0, bf16x8 pa1, bf16x8 pa2, bf16x8 pa3) {
  const s16x4 l0 = tr_read<v_rd_off(D0, 0, 0)>(vb), h0 = tr_read<v_rd_off(D0, 0, 1)>(vb), l1 = tr_read<v_rd_off(D0, 1, 0)>(vb), h1 = tr_read<v_rd_off(D0, 1, 1)>(vb);
  const s16x4 l2 = tr_read<v_rd_off(D0, 2, 0)>(vb), h2 = tr_read<v_rd_off(D0, 2, 1)>(vb), l3 = tr_read<v_rd_off(D0, 3, 0)>(vb), h3 = tr_read<v_rd_off(D0, 3, 1)>(vb);
  asm volatile("s_waitcnt lgkmcnt(0)" ::: "memory"); SBAR();
#define PK(L, H) (bf16x8){L[0], L[1], L[2], L[3], H[0], H[1], H[2], H[3]}
  od = __builtin_amdgcn_mfma_f32_32x32x16_bf16(pa0, PK(l0, h0), od, 0, 0, 0);
  od = __builtin_amdgcn_mfma_f32_32x32x16_bf16(pa1, PK(l1, h1), od, 0, 0, 0);
  od = __builtin_amdgcn_mfma_f32_32x32x16_bf16(pa2, PK(l2, h2), od, 0, 0, 0);
  od = __builtin_amdgcn_mfma_f32_32x32x16_bf16(pa3, PK(l3, h3), od, 0, 0, 0);
#undef PK
}
__device__ __forceinline__ void pv_d0(f32x16* o, int vb, bf16x8 pa0, bf16x8 pa1, bf16x8 pa2, bf16x8 pa3) {
  pv_one<0>(o[0], vb, pa0, pa1, pa2, pa3); pv_one<1>(o[1], vb, pa0, pa1, pa2, pa3); pv_one<2>(o[2], vb, pa0, pa1, pa2, pa3); pv_one<3>(o[3], vb, pa0, pa1, pa2, pa3);
}

typedef short v4i16 __attribute__((ext_vector_type(4)));
template <int OFF> __device__ __forceinline__ bf16x8 vfrag(int vb) {
  const v4i16 l = __builtin_amdgcn_ds_read_tr16_b64_v4i16((LAS v4i16*)(uintptr_t)(unsigned)(vb + OFF));
  const v4i16 h = __builtin_amdgcn_ds_read_tr16_b64_v4i16((LAS v4i16*)(uintptr_t)(unsigned)(vb + OFF + 2048));
  return (bf16x8){l[0], l[1], l[2], l[3], h[0], h[1], h[2], h[3]};
}
__device__ __forceinline__ float max3f(float a, float b, float c) { return __builtin_fmaxf(__builtin_fmaxf(a, b), c); }
#define PK4X(P, BASE, OUT) do { unsigned a0 = cvt_pk_bf16(Q8(P[BASE + 0]), Q8(P[BASE + 1])), a1 = cvt_pk_bf16(Q8(P[BASE + 2]), Q8(P[BASE + 3]));   \
    unsigned b0 = cvt_pk_bf16(Q8(P[BASE + 4]), Q8(P[BASE + 5])), b1 = cvt_pk_bf16(Q8(P[BASE + 6]), Q8(P[BASE + 7]));                              \
    auto r0 = __builtin_amdgcn_permlane32_swap(a0, b0, false, false); auto r1 = __builtin_amdgcn_permlane32_swap(a1, b1, false, false); \
    u32x4 w = {r0[0], r1[0], r0[1], r1[1]}; OUT = *reinterpret_cast<bf16x8*>(&w); } while (0)

template <int NKC, int NQR, int VAR = 0, int OM = 0>
__device__ __forceinline__ void attn_unit(const bf16_t* __restrict__ Qb, int ldq, const bf16_t* kp0, int kld0, const bf16_t* kp1, int kld1, const bf16_t* kp2, int kld2,
                                          const bf16_t* __restrict__ Vh, int ldv, bf16_t* __restrict__ Ob, int ldo, int seq, const float C, char* lds,
                                          char* stash = nullptr, const float lam = 0.f, const float* __restrict__ subw = nullptr) {
  constexpr int SHM_K = NKC * 8192, NG = NKC * 8;
  const int tid = tid_opaque(), wid = tid >> 6, lane = tid & 63, r32 = lane & 31, hi = lane >> 5;
  const float thr_raw = THR * 1.4426950408889634f / C;
  char* V_lds = lds; char* K_lds = lds + 3 * SHM_V;
  float* ws = (float*)(lds + 3 * SHM_V + 3 * SHM_K) + wid * 64; float* li_l = ws; float* al_l = ws + 32;
  float m_reg = -1e30f, l_reg = 0; f32x16 o[4] = {}; bf16x8 qr[NQR * 4];
  const bf16_t* Qw = Qb + (long)(wid * QBLK + r32) * ldq + hi * 8;
  int ql = (int)(uintptr_t)(lds + 3 * SHM_V + 3 * SHM_K + 2048) + wid * ((NKC - NQR) * 4096) + lane * 16;
  int kb[4];
#pragma unroll
  for (int d0 = 0; d0 < 4; ++d0) kb[d0] = (int)(uintptr_t)K_lds + KOFF(r32, d0 * 2 + hi);
  __syncthreads();
#pragma unroll
  for (int d0 = 0; d0 < NQR * 4; ++d0) qr[d0] = *reinterpret_cast<const bf16x8*>(Qw + d0 * 16);
#pragma unroll
  for (int d0 = NQR * 4; d0 < NKC * 4; ++d0) *(LAS bf16x8*)(uintptr_t)(unsigned)(ql + (d0 - NQR * 4) * 1024) = *reinterpret_cast<const bf16x8*>(Qw + d0 * 16);
  const int sr = tid >> 4, sc = (tid & 15) * 8, vst0 = v_st(sr, sc), vst1 = v_st(32 + sr, sc);
  const int krow = tid >> 3, kch = tid & 7, kst = KOFF(krow, kch);
  const int vb0 = (int)(uintptr_t)V_lds + v_rd_base(lane);
  const unsigned vo0 = (unsigned)(sr * ldv + sc) * 2u, vo1 = (unsigned)((32 + sr) * ldv + sc) * 2u;
  const unsigned ko0 = (unsigned)(krow * kld0 + kch * 8) * 2u, ko1 = (unsigned)(krow * kld1 + kch * 8) * 2u, ko2 = (unsigned)(krow * kld2 + kch * 8) * 2u;
  struct { bf16x8 vs0, vs1, k0, k1, k2; } sg;
  const __amdgpu_buffer_rsrc_t rV = __builtin_amdgcn_make_buffer_rsrc((void*)Vh, 0, 0xffffffff, 0x00020000);
  const __amdgpu_buffer_rsrc_t rK0 = __builtin_amdgcn_make_buffer_rsrc((void*)kp0, 0, 0xffffffff, 0x00020000);
  const __amdgpu_buffer_rsrc_t rK1 = __builtin_amdgcn_make_buffer_rsrc((void*)(NKC > 1 ? kp1 : kp0), 0, 0xffffffff, 0x00020000);
  const __amdgpu_buffer_rsrc_t rK2 = __builtin_amdgcn_make_buffer_rsrc((void*)(NKC > 2 ? kp2 : kp0), 0, 0xffffffff, 0x00020000);
#define BL128(r, vo, so) __builtin_bit_cast(bf16x8, __builtin_amdgcn_raw_buffer_load_b128(r, (int)(vo), (int)(so), 0))
#define SLOAD(kb_) do { const int so_ = (kb_) * (ldv * 2); \
    sg.vs0 = BL128(rV, vo0, so_); sg.vs1 = BL128(rV, vo1, so_); \
    sg.k0 = BL128(rK0, ko0, (kb_) * (kld0 * 2)); \
    if constexpr (NKC > 1) sg.k1 = BL128(rK1, ko1, (kb_) * (kld1 * 2)); \
    if constexpr (NKC > 2) sg.k2 = BL128(rK2, ko2, (kb_) * (kld2 * 2)); } while (0)
#define SWRITE(b) do { *(bf16x8*)(V_lds + (b) * SHM_V + vst0) = sg.vs0; *(bf16x8*)(V_lds + (b) * SHM_V + vst1) = sg.vs1; \
    *(bf16x8*)(K_lds + (b) * SHM_K + kst) = sg.k0; \
    if constexpr (NKC > 1) *(bf16x8*)(K_lds + (b) * SHM_K + 8192 + kst) = sg.k1; \
    if constexpr (NKC > 2) *(bf16x8*)(K_lds + (b) * SHM_K + 16384 + kst) = sg.k2; } while (0)
#define RESC(a) do { if (__any((a) < 1.f)) { if (hi == 0) al_l[r32] = (a); asm volatile("s_waitcnt lgkmcnt(0)" ::: "memory"); \
    _Pragma("unroll") for (int d = 0; d < 4; ++d) _Pragma("unroll") for (int r = 0; r < 16; ++r) o[d][r] *= al_l[crow(r, hi)]; } } while (0)
#define KLD(g, KB) (*(const LAS bf16x8*)(uintptr_t)(unsigned)(kb[((g) & 7) >> 1] + ((KB) + ((g) >> 3) * 8192 + ((g) & 1) * 4096)))
#define QLD(j) (*(const LAS bf16x8*)(uintptr_t)(unsigned)(ql + (j) * 1024))
  f32x16 pA0, pA1, pB0, pB1; float alA, alB; bf16x8 pa[4]; const int NT = seq / KVBLK;
  constexpr bool NEGM = (NKC == 1); f32x16 negm = {}; const float thr2 = THR * 1.4426950408889634f;
#define STEP(PN0, PN1, alN, PC0, PC1, alC, BKN, BVC, BW, DO_QK, DO_WR, DO_LD, tt) do { \
    bf16x8 kf[3], vf[3], qlf[2]; float ps = 0.f, mxa = 0.f, mxb = 0.f, mnC = 0.f; \
    SBAR(); \
    if (DO_QK) { if constexpr (NQR != NKC) asm volatile("" : "+v"(ql)); kf[0] = KLD(0, (BKN) * SHM_K); kf[1] = KLD(1, (BKN) * SHM_K); } \
    _Pragma("unroll") for (int g = 0; g < NG; ++g) { \
      const int c_ = g >> 3, d0_ = (g & 7) >> 1, s_ = g / NKC; const bool fs_ = (g % NKC) == 0; \
      if (DO_QK) { bf16x8 qf_; if (c_ < NQR) qf_ = qr[(c_ < NQR ? c_ : 0) * 4 + d0_]; else { if ((g & 1) == 0) qlf[d0_ & 1] = QLD((c_ - NQR) * 4 + d0_); qf_ = qlf[d0_ & 1]; } \
        if ((g & 1) == 0) { if (g == 0) PN0 = __builtin_amdgcn_mfma_f32_32x32x16_bf16(kf[g % 3], qf_, NEGM ? negm : (f32x16){}, 0, 0, 0); else PN0 = __builtin_amdgcn_mfma_f32_32x32x16_bf16(kf[g % 3], qf_, PN0, 0, 0, 0); } \
        else { if (g == 1) PN1 = __builtin_amdgcn_mfma_f32_32x32x16_bf16(kf[g % 3], qf_, NEGM ? negm : (f32x16){}, 0, 0, 0); else PN1 = __builtin_amdgcn_mfma_f32_32x32x16_bf16(kf[g % 3], qf_, PN1, 0, 0, 0); } } \
      if (fs_ && VAR < 4) {   \
        if (!NEGM && s_ < 7) { PC1[2 * s_] = __builtin_amdgcn_exp2f(PC1[2 * s_]); PC1[2 * s_ + 1] = __builtin_amdgcn_exp2f(PC1[2 * s_ + 1]); } \
        if (!NEGM && s_ == 4) { PC1[14] = __builtin_amdgcn_exp2f(PC1[14]); PC1[15] = __builtin_amdgcn_exp2f(PC1[15]); } \
        if (s_ == 0) { ps = (PC0[0] + PC0[1]) + (PC0[2] + PC0[3]); PK4X(PC0, 0, pa[0]); } \
        if (s_ == 1) { ps += (PC0[4] + PC0[5]) + (PC0[6] + PC0[7]); PK4X(PC0, 8, pa[1]); } \
        if (s_ == 2) { ps += (PC0[8] + PC0[9]) + (PC0[10] + PC0[11]); ps += (PC0[12] + PC0[13]) + (PC0[14] + PC0[15]); } \
        if (s_ == 3) { ps += (PC1[0] + PC1[1]) + (PC1[2] + PC1[3]); } \
        if (s_ == 4) { ps += (PC1[4] + PC1[5]) + (PC1[6] + PC1[7]); } \
        if (s_ == 5) { ps += (PC1[8] + PC1[9]); PK4X(PC1, 0, pa[2]); } \
        if (s_ == 6) { ps += (PC1[10] + PC1[11]) + (PC1[12] + PC1[13]); } \
        if (s_ == 7) { ps += (PC1[14] + PC1[15]); PK4X(PC1, 8, pa[3]); \
          auto rr_ = __builtin_amdgcn_permlane32_swap(__float_as_uint(ps), __float_as_uint(ps), false, false); ps = __uint_as_float(rr_[0]) + __uint_as_float(rr_[1]); l_reg = l_reg * (alC) + ps; } } \
      if (DO_QK && g + 2 < NG) kf[(g + 2) % 3] = KLD(g + 2, (BKN) * SHM_K); \
      if (g == NG - 2) vf[0] = vfrag<v_rd_off(0, 0, 0)>(vb0 + (BVC) * (int)SHM_V); \
      if (g == NG - 1) vf[1] = vfrag<v_rd_off(1, 0, 0)>(vb0 + (BVC) * (int)SHM_V); \
      SBAR(); } \
    _Pragma("unroll") for (int g = 0; g < 16; ++g) { \
      const int ks_ = g >> 2, d0_ = g & 3; \
      o[d0_] = __builtin_amdgcn_mfma_f32_32x32x16_bf16(pa[ks_], vf[g % 3], o[d0_], 0, 0, 0); \
      if (g == 0 && (DO_WR) && VAR != 5) { SWRITE(BW); } \
      if (g == 1 && (DO_LD) && VAR != 5) { SLOAD(((tt) + 3) * KVBLK); } \
      if (DO_QK && VAR < 4) {   \
        if (g == 2) { mxa = max3f(PN0[0], PN0[1], PN0[2]); mxa = max3f(mxa, PN0[3], PN0[4]); mxb = max3f(PN0[5], PN0[6], PN0[7]); mxb = max3f(mxb, PN0[8], PN0[9]); } \
        if (g == 3) { mxa = max3f(mxa, PN0[10], PN0[11]); mxb = max3f(mxb, PN0[12], PN0[13]); mxa = max3f(mxa, PN0[14], PN0[15]); mxb = max3f(mxb, PN1[0], PN1[1]); } \
        if (g == 4) { mxa = max3f(mxa, PN1[2], PN1[3]); mxb = max3f(mxb, PN1[4], PN1[5]); mxa = max3f(mxa, PN1[6], PN1[7]); mxb = max3f(mxb, PN1[8], PN1[9]); } \
        if (g == 5) { mxa = max3f(mxa, PN1[10], PN1[11]); mxb = max3f(mxb, PN1[12], PN1[13]); mxa = max3f(mxa, PN1[14], PN1[15]); mxa = __builtin_fmaxf(mxa, mxb); } \
        if (g == 6) { auto rr_ = __builtin_amdgcn_permlane32_swap(__float_as_uint(mxa), __float_as_uint(mxa), false, false); const float pmax_ = __builtin_fmaxf(__uint_as_float(rr_[0]), __uint_as_float(rr_[1])); \
          if constexpr (NEGM) { alN = 1.f; if (__builtin_expect(!__all(pmax_ <= thr2 + PSHIFT), 0)) { const float dl_ = __builtin_fmaxf(pmax_ - PSHIFT, 0.f); alN = __builtin_amdgcn_exp2f(-dl_); \
              _Pragma("unroll") for (int r = 0; r < 16; ++r) { PN0[r] -= dl_; PN1[r] -= dl_; negm[r] -= dl_; } } } \
          else { const bool ok_ = __all(pmax_ - m_reg <= thr_raw); const float mn_ = ok_ ? m_reg : __builtin_fmaxf(m_reg, pmax_); \
            alN = __builtin_amdgcn_exp2f((m_reg - mn_) * C); m_reg = mn_; mnC = -mn_ * C + PSHIFT; } } \
        if (g >= 7) { const int i_ = g - 7; \
          if constexpr (NEGM) {   \
            if (i_ < 4) { _Pragma("unroll") for (int r = 4 * i_; r < 4 * i_ + 4; ++r) PN0[r] = __builtin_amdgcn_exp2f(PN0[r]); } \
            else if (i_ < 8) { _Pragma("unroll") for (int r = 4 * (i_ - 4); r < 4 * (i_ - 4) + 4; ++r) PN1[r] = __builtin_amdgcn_exp2f(PN1[r]); } } \
          else {   \
          if (i_ < 4) { _Pragma("unroll") for (int r = 4 * i_; r < 4 * i_ + 4; ++r) PN0[r] = fmaf(PN0[r], C, mnC); } \
          else if (i_ < 8) { _Pragma("unroll") for (int r = 4 * (i_ - 4); r < 4 * (i_ - 4) + 4; ++r) PN1[r] = fmaf(PN1[r], C, mnC); } \
          if (i_ >= 1) { PN0[2 * (i_ - 1)] = __builtin_amdgcn_exp2f(PN0[2 * (i_ - 1)]); PN0[2 * (i_ - 1) + 1] = __builtin_amdgcn_exp2f(PN0[2 * (i_ - 1) + 1]); } } \
          asm volatile("" : "+v"(PN0), "+v"(PN1));   } } \
      if (g + 2 < 16) { constexpr int dummy_ = 0; (void)dummy_; \
        if (g + 2 == 2) vf[2] = vfrag<v_rd_off(2, 0, 0)>(vb0 + (BVC) * (int)SHM_V); if (g + 2 == 3) vf[0] = vfrag<v_rd_off(3, 0, 0)>(vb0 + (BVC) * (int)SHM_V); \
        if (g + 2 == 4) vf[1] = vfrag<v_rd_off(0, 1, 0)>(vb0 + (BVC) * (int)SHM_V); if (g + 2 == 5) vf[2] = vfrag<v_rd_off(1, 1, 0)>(vb0 + (BVC) * (int)SHM_V); \
        if (g + 2 == 6) vf[0] = vfrag<v_rd_off(2, 1, 0)>(vb0 + (BVC) * (int)SHM_V); if (g + 2 == 7) vf[1] = vfrag<v_rd_off(3, 1, 0)>(vb0 + (BVC) * (int)SHM_V); \
        if (g + 2 == 8) vf[2] = vfrag<v_rd_off(0, 2, 0)>(vb0 + (BVC) * (int)SHM_V); if (g + 2 == 9) vf[0] = vfrag<v_rd_off(1, 2, 0)>(vb0 + (BVC) * (int)SHM_V); \
        if (g + 2 == 10) vf[1] = vfrag<v_rd_off(2, 2, 0)>(vb0 + (BVC) * (int)SHM_V); if (g + 2 == 11) vf[2] = vfrag<v_rd_off(3, 2, 0)>(vb0 + (BVC) * (int)SHM_V); \
        if (g + 2 == 12) vf[0] = vfrag<v_rd_off(0, 3, 0)>(vb0 + (BVC) * (int)SHM_V); if (g + 2 == 13) vf[1] = vfrag<v_rd_off(1, 3, 0)>(vb0 + (BVC) * (int)SHM_V); \
        if (g + 2 == 14) vf[2] = vfrag<v_rd_off(2, 3, 0)>(vb0 + (BVC) * (int)SHM_V); if (g + 2 == 15) vf[0] = vfrag<v_rd_off(3, 3, 0)>(vb0 + (BVC) * (int)SHM_V); } \
      SBAR(); } \
    if (VAR >= 4) { asm volatile("" : "+v"(PN0), "+v"(PN1)); pa[0] = __builtin_bit_cast(bf16x8, (u32x4){(unsigned)tt, 1u, 2u, 3u}); pa[1] = pa[0]; pa[2] = pa[0]; pa[3] = pa[0]; } \
    if (DO_QK && VAR < 4) { RESC(alN); } \
    if (VAR != 5) __syncthreads(); } while (0)
  SLOAD(0); SWRITE(0); SLOAD(KVBLK); SWRITE(1); SLOAD(2 * KVBLK); __syncthreads();
  { float mn0_; qkt<NKC, NQR, 0>(pA0, pA1, kb, qr, ql);
    if constexpr (NEGM) { float pm_ = pA0[0];
      _Pragma("unroll") for (int r = 1; r < 16; ++r) pm_ = fmaxf(pm_, pA0[r]);
      _Pragma("unroll") for (int r = 0; r < 16; ++r) pm_ = fmaxf(pm_, pA1[r]);
      { auto rr_ = __builtin_amdgcn_permlane32_swap(__float_as_uint(pm_), __float_as_uint(pm_), false, false); pm_ = fmaxf(__uint_as_float(rr_[0]), __uint_as_float(rr_[1])); }
      _Pragma("unroll") for (int r = 0; r < 16; ++r) { pA0[r] = __builtin_amdgcn_exp2f(pA0[r] - pm_ + PSHIFT); pA1[r] = __builtin_amdgcn_exp2f(pA1[r] - pm_ + PSHIFT); negm[r] = -pm_ + PSHIFT; }
      alA = 1.f; (void)mn0_; }
    else partialSM(pA0, pA1, m_reg, mn0_, alA, C, thr_raw); }
#ifdef ATT_STATIC_PRIO
  if (__builtin_amdgcn_readfirstlane(tid) >= 256) __builtin_amdgcn_s_setprio(1);
#endif
  int t = 0;
  for (; t + 6 < NT; t += 6) {
    STEP(pB0, pB1, alB, pA0, pA1, alA, 1, 0, 2, true, true, true, t);
    STEP(pA0, pA1, alA, pB0, pB1, alB, 2, 1, 0, true, true, true, t + 1);
    STEP(pB0, pB1, alB, pA0, pA1, alA, 0, 2, 1, true, true, true, t + 2);
    STEP(pA0, pA1, alA, pB0, pB1, alB, 1, 0, 2, true, true, true, t + 3);
    STEP(pB0, pB1, alB, pA0, pA1, alA, 2, 1, 0, true, true, true, t + 4);
    STEP(pA0, pA1, alA, pB0, pB1, alB, 0, 2, 1, true, true, true, t + 5);
  }
  STEP(pB0, pB1, alB, pA0, pA1, alA, 1, 0, 2, true, true, true, t);
  STEP(pA0, pA1, alA, pB0, pB1, alB, 2, 1, 0, true, true, true, t + 1);
  STEP(pB0, pB1, alB, pA0, pA1, alA, 0, 2, 1, true, true, true, t + 2);
  STEP(pA0, pA1, alA, pB0, pB1, alB, 1, 0, 2, true, true, false, t + 3);
  STEP(pB0, pB1, alB, pA0, pA1, alA, 2, 1, 0, true, false, false, t + 4);
  STEP(pA0, pA1, alA, pB0, pB1, alB, 0, 2, 1, false, false, false, t + 5);
#ifdef ATT_STATIC_PRIO
  __builtin_amdgcn_s_setprio(0);
#endif
  if (hi == 0) li_l[r32] = l_reg; asm volatile("s_waitcnt lgkmcnt(0)" ::: "memory");
  float rli[16];
#pragma unroll
  for (int r = 0; r < 16; ++r) rli[r] = __builtin_amdgcn_rcpf(li_l[crow(r, hi)]);
  if constexpr (OM == 1) {
    unsigned* st = (unsigned*)stash + tid;
#pragma unroll
    for (int r = 0; r < 16; ++r) { st[(2 * r) * 512] = cvt_pk_bf16(o[0][r] * rli[r], o[1][r] * rli[r]); st[(2 * r + 1) * 512] = cvt_pk_bf16(o[2][r] * rli[r], o[3][r] * rli[r]); }
  } else if constexpr (OM == 2) {
    const unsigned* st = (const unsigned*)stash + tid;
    float sw[4];
#pragma unroll
    for (int d0 = 0; d0 < 4; ++d0) sw[d0] = subw[d0 * 32 + r32] * 0.8f;
    bf16_t* Ow = Ob + (long)(wid * QBLK) * ldo;
#pragma unroll
    for (int r = 0; r < 16; ++r) { const unsigned w01 = st[(2 * r) * 512], w23 = st[(2 * r + 1) * 512];
      const float d0v = bflo(w01) - lam * (o[0][r] * rli[r]), d1v = bfhi(w01) - lam * (o[1][r] * rli[r]), d2v = bflo(w23) - lam * (o[2][r] * rli[r]), d3v = bfhi(w23) - lam * (o[3][r] * rli[r]);
      float ss = (d0v * d0v + d1v * d1v) + (d2v * d2v + d3v * d3v);
      ss += __shfl_xor(ss, 1); ss += __shfl_xor(ss, 2); ss += __shfl_xor(ss, 4); ss += __shfl_xor(ss, 8); ss += __shfl_xor(ss, 16);
      const float rn = rsqrtf(ss * (1.f / 128.f) + EPS); const long ob = (long)crow(r, hi) * ldo + r32;
      Ow[ob] = f2bf(d0v * rn * sw[0]); Ow[ob + 32] = f2bf(d1v * rn * sw[1]); Ow[ob + 64] = f2bf(d2v * rn * sw[2]); Ow[ob + 96] = f2bf(d3v * rn * sw[3]); }
  } else {
  bf16_t* Ow = Ob + (long)(wid * QBLK) * ldo;
#pragma unroll
  for (int r = 0; r < 16; ++r) { const int orow = crow(r, hi);
#pragma unroll
    for (int d0 = 0; d0 < 4; ++d0) Ow[(long)orow * ldo + d0 * 32 + r32] = f2bf(o[d0][r] * rli[r]); }
  }
#undef SLOAD
#undef BL128
#undef SWRITE
#undef RESC
#undef STEP
#undef KLD
#undef QLD
}
#undef PK4X
#undef KOFF
#undef SBAR
}
namespace attn8 {
#if SIM_P6
#define SQ6(x) q8(x)
#else
#define SQ6(x) (x)
#endif
using attn::f32x16; using attn::crow; using attn::max3f;
typedef int v8i32 __attribute__((ext_vector_type(8)));
typedef int v4i32 __attribute__((ext_vector_type(4)));
#ifndef ATT8_THRL
#define ATT8_THRL 3.5f
#endif
constexpr float PSH = 5.f, THRL = ATT8_THRL;
#define OFF8(row, piece) ((row) * 64 + ((((piece) ^ ((row) >> 2)) & 3) << 4))
#define SBAR() __builtin_amdgcn_sched_barrier(0)
#define MFMA8(a, b, c) __builtin_amdgcn_mfma_scale_f32_32x32x64_f8f6f4(a, b, c, 0, 0, 0, 0, 0, 0)
#define LD32(addr0, addr1) __builtin_shufflevector(*(const LAS v4i32*)(uintptr_t)(unsigned)(addr0), *(const LAS v4i32*)(uintptr_t)(unsigned)(addr1), 0, 1, 2, 3, 4, 5, 6, 7)

constexpr int WCONV_I1 = 32 * 128 * 32, WCONV_I2 = 32 * 128 * 16, WCONV_ITEMS = WCONV_I1 + WCONV_I2;
struct WConv { float v[8]; };
__device__ __forceinline__ void wconv_load(const Params& p, int it, int lane, WConv& w) {
    it = min(it, WCONV_ITEMS - 1);
    const bool m1 = it < WCONV_I1; const int i2 = m1 ? it : it - WCONV_I1;
    const int e = m1 ? (i2 >> 12) : (i2 >> 11), kb = m1 ? ((i2 >> 5) & 127) : ((i2 >> 4) & 127), nb = m1 ? (i2 & 31) : (i2 & 15), ldn = m1 ? 2048 : 1024;
    const __amdgpu_buffer_rsrc_t r = __builtin_amdgcn_make_buffer_rsrc((void*)(m1 ? p.w1 : p.w2), 0, 0xffffffff, 0x00020000);
    const int so = ((e * 1024 + kb * 8) * ldn + nb * 64) * 4;
#pragma unroll
    for (int j = 0; j < 8; ++j) w.v[j] = __builtin_bit_cast(float, __builtin_amdgcn_raw_buffer_load_b32(r, lane * 4, so + j * ldn * 4, 0));
}
__device__ __forceinline__ void wconv_store(const Params& p, int it0, int lane, const WConv& w) {
    const int it = min(it0, WCONV_ITEMS - 1);
    const bool m1 = it < WCONV_I1; const int i2 = m1 ? it : it - WCONV_I1;
    const int e = m1 ? (i2 >> 12) : (i2 >> 11), kb = m1 ? ((i2 >> 5) & 127) : ((i2 >> 4) & 127), nb = m1 ? (i2 & 31) : (i2 & 15);
    const int n = nb * 64 + lane;
    const int drow = m1 ? (e * 2048 + ((n & 1023) >> 7) * 256 + (n >> 10) * 128 + (n & 127)) : (e * 1024 + n);
    unsigned char* dst = it0 < WCONV_ITEMS ? p.ws + (m1 ? WS_W1 : WS_W2) + (size_t)drow * 1024 + kb * 8 : p.ws + WS_DUMMY + lane * 8;
    u32x2 o; o.x = cvt4_fp8(w.v[0] * WQ_SCALE, w.v[1] * WQ_SCALE, w.v[2] * WQ_SCALE, w.v[3] * WQ_SCALE); o.y = cvt4_fp8(w.v[4] * WQ_SCALE, w.v[5] * WQ_SCALE, w.v[6] * WQ_SCALE, w.v[7] * WQ_SCALE);
    *(u32x2*)dst = o;
}
template <int NKC, int OM, int VAR = 0, bool WC = false>
__device__ __forceinline__ void attn_unit(const unsigned char* __restrict__ Qb, int ldq, const unsigned char* kp0, int kld0, const unsigned char* kp1, int kld1, const unsigned char* kp2, int kld2,
                                          const unsigned char* __restrict__ VT, bf16_t* __restrict__ Ob, int ldo, int seq, char* lds,
                                          char* stash = nullptr, const float lam = 0.f, const float* __restrict__ subw = nullptr, const Params* pp = nullptr, int wc_base = 0) {
  constexpr int SHM_K = NKC * 4096, SHM_V = 8192, NG = 2 * NKC;
  constexpr bool STG = ((STAGGER) >> (NKC == 1 ? 0 : 1)) & 1;
  constexpr bool V_M = VAR >= 32, V_NOLDS = VAR == 6 || VAR == 9 || V_M, V_NOSTG = VAR == 2 || VAR == 3 || VAR == 9 || V_M, V_NOBAR = VAR == 3 || VAR == 9 || V_M;
  constexpr bool V_NOEXP = VAR == 1 || VAR == 7 || (V_M && (VAR & 1)), V_NOMAX = VAR == 1 || VAR == 7 || (V_M && (VAR & 2)), V_NOPACK = V_M && (VAR & 4);
  constexpr bool V_NOPV = VAR == 4 || VAR == 7 || (V_M && (VAR & 8)), V_NOQK = VAR == 5 || (V_M && (VAR & 16));
  const int tid = tid_opaque(), wid = tid >> 6, lane = tid & 63, r32 = lane & 31, hi = lane >> 5;
  char* V_lds = lds; char* K_lds = lds + 4 * SHM_V;
  float* ws = (float*)(lds + 4 * SHM_V + 4 * SHM_K) + wid * 64; float* al_l = ws + 32;
  f32x16 o[4] = {}, ol = {}; v8i32 qf[NKC];
  v8i32 ones8 = {0x38383838, 0x38383838, 0x38383838, 0x38383838, 0x38383838, 0x38383838, 0x38383838, 0x38383838};
  asm volatile("" : "+v"(ones8));
  { const unsigned char* Qw = Qb + (long)(wid * 32 + r32) * ldq + hi * 32;
#pragma unroll
    for (int c = 0; c < NKC; ++c) qf[c] = __builtin_shufflevector(*(const v4i32*)(Qw + c * 64), *(const v4i32*)(Qw + c * 64 + 16), 0, 1, 2, 3, 4, 5, 6, 7); }
  const int fa0 = OFF8(r32, 2 * hi), fa1 = OFF8(r32, 2 * hi + 1);
  const LAS char* kA = (const LAS char*)(uintptr_t)(unsigned)((int)(uintptr_t)K_lds + fa0); const LAS char* kB = (const LAS char*)(uintptr_t)(unsigned)((int)(uintptr_t)K_lds + fa1);
  const LAS char* vA = (const LAS char*)(uintptr_t)(unsigned)((int)(uintptr_t)V_lds + fa0); const LAS char* vB = (const LAS char*)(uintptr_t)(unsigned)((int)(uintptr_t)V_lds + fa1);
  const int ve = tid >> 2, pc = tid & 3, krow = (tid & 255) >> 2;
  const int vst = OFF8(ve, pc), kst = OFF8(krow, pc);
  const bool lowhalf = tid < 256;
  const bool grpB = __builtin_amdgcn_readfirstlane(wid) >= 4;
  const unsigned vo = (unsigned)(ve * RPB + pc * 16);
  const unsigned ko0 = (unsigned)(krow * kld0 + pc * 16), ko1 = (unsigned)(krow * kld1 + pc * 16), ko2 = (unsigned)(krow * kld2 + pc * 16);
  const __amdgpu_buffer_rsrc_t rV = __builtin_amdgcn_make_buffer_rsrc((void*)VT, 0, 0xffffffff, 0x00020000);
  const __amdgpu_buffer_rsrc_t rK0 = __builtin_amdgcn_make_buffer_rsrc((void*)kp0, 0, 0xffffffff, 0x00020000);
  const __amdgpu_buffer_rsrc_t rK1 = __builtin_amdgcn_make_buffer_rsrc((void*)(NKC > 1 ? kp1 : kp0), 0, 0xffffffff, 0x00020000);
  const __amdgpu_buffer_rsrc_t rK2 = __builtin_amdgcn_make_buffer_rsrc((void*)(NKC > 2 ? kp2 : kp0), 0, 0xffffffff, 0x00020000);
  struct { v4i32 v, ka, kc; } sg;
#define BL16(r, vo_, so_) __builtin_bit_cast(v4i32, __builtin_amdgcn_raw_buffer_load_b128(r, (int)(vo_), (int)(so_), 0))
#define SLOAD(k0) do { sg.v = BL16(rV, vo, (k0)); \
    if constexpr (NKC == 1) { if (lowhalf) sg.ka = BL16(rK0, ko0, (k0) * kld0); } \
    else { if (lowhalf) { sg.ka = BL16(rK0, ko0, (k0) * kld0); sg.kc = BL16(rK2, ko2, (k0) * kld2); } else sg.ka = BL16(rK1, ko1, (k0) * kld1); } } while (0)
#define SWRITE(b) do { *(v4i32*)(V_lds + (b) * SHM_V + vst) = sg.v; \
    if constexpr (NKC == 1) { if (lowhalf) *(v4i32*)(K_lds + (b) * SHM_K + kst) = sg.ka; } \
    else { if (lowhalf) { *(v4i32*)(K_lds + (b) * SHM_K + kst) = sg.ka; *(v4i32*)(K_lds + (b) * SHM_K + 8192 + kst) = sg.kc; } else *(v4i32*)(K_lds + (b) * SHM_K + 4096 + kst) = sg.ka; } } while (0)
#define RESC(a) do { if (raised_) { if (hi == 0) al_l[r32] = (a); asm volatile("s_waitcnt lgkmcnt(0)" ::: "memory"); \
    _Pragma("unroll") for (int r = 0; r < 16; ++r) { const float a_ = al_l[crow(r, hi)]; o[0][r] *= a_; o[1][r] *= a_; o[2][r] *= a_; o[3][r] *= a_; ol[r] *= a_; } } } while (0)
#define LDP(pa, pb, off) __builtin_shufflevector(*(const LAS v4i32*)((pa) + (off)), *(const LAS v4i32*)((pb) + (off)), 0, 1, 2, 3, 4, 5, 6, 7)
#define KFR(g, KB) (V_NOLDS ? qf[0] : LDP(kA, kB, (KB) + ((g) >> 1) * 4096 + ((g) & 1) * 2048))
#define VFR(d0, VB) (V_NOLDS ? qf[0] : LDP(vA, vB, (VB) + (d0) * 2048))
  f32x16 P0, P1, negm; float al = 1.f; const int NT = seq / 64;
  v8i32 kpf0, kpf1;
  v8i32 pf;
#define PACKP() do { pf = (v8i32){(int)cvt4_fp8(P0[0], P0[1], P0[2], P0[3]), (int)cvt4_fp8(P0[4], P0[5], P0[6], P0[7]), (int)cvt4_fp8(P0[8], P0[9], P0[10], P0[11]), (int)cvt4_fp8(P0[12], P0[13], P0[14], P0[15]), \
    (int)cvt4_fp8(P1[0], P1[1], P1[2], P1[3]), (int)cvt4_fp8(P1[4], P1[5], P1[6], P1[7]), (int)cvt4_fp8(P1[8], P1[9], P1[10], P1[11]), (int)cvt4_fp8(P1[12], P1[13], P1[14], P1[15])}; } while (0)
#define PACK0() do { asm volatile("" : "+v"(P0)); pf[0] = (int)cvt4_fp8o(pf[0], P0[0], P0[1], P0[2], P0[3]); pf[1] = (int)cvt4_fp8o(pf[1], P0[4], P0[5], P0[6], P0[7]); \
    pf[2] = (int)cvt4_fp8o(pf[2], P0[8], P0[9], P0[10], P0[11]); pf[3] = (int)cvt4_fp8o(pf[3], P0[12], P0[13], P0[14], P0[15]); asm volatile("" : "+v"(pf)); } while (0)
#define PACK1() do { asm volatile("" : "+v"(P1)); pf[4] = (int)cvt4_fp8o(pf[4], P1[0], P1[1], P1[2], P1[3]); pf[5] = (int)cvt4_fp8o(pf[5], P1[4], P1[5], P1[6], P1[7]); \
    pf[6] = (int)cvt4_fp8o(pf[6], P1[8], P1[9], P1[10], P1[11]); pf[7] = (int)cvt4_fp8o(pf[7], P1[12], P1[13], P1[14], P1[15]); asm volatile("" : "+v"(pf)); } while (0)
#define MAX0() do { m0_ = max3f(P0[0], P0[1], P0[2]); m0_ = max3f(m0_, P0[3], P0[4]); m0_ = max3f(m0_, P0[5], P0[6]); m0_ = max3f(m0_, P0[7], P0[8]); m0_ = max3f(m0_, P0[9], P0[10]); \
    m0_ = max3f(m0_, P0[11], P0[12]); m0_ = max3f(m0_, P0[13], P0[14]); asm volatile("" : "+v"(m0_)); } while (0)
#define MAXFIN() do { float m1_ = max3f(P1[0], P1[1], P1[2]); m1_ = max3f(m1_, P1[3], P1[4]); m1_ = max3f(m1_, P1[5], P1[6]); m1_ = max3f(m1_, P1[7], P1[8]); m1_ = max3f(m1_, P1[9], P1[10]); \
    m1_ = max3f(m1_, P1[11], P1[12]); m1_ = max3f(m1_, P1[13], P1[14]); m1_ = max3f(m1_, P1[15], P0[15]); mx_ = fmaxf(m1_, m0_);          \
    if (__builtin_expect(!__all(mx_ <= PSH + THRL), 0)) { \
      { auto rr_ = __builtin_amdgcn_permlane32_swap(__float_as_uint(mx_), __float_as_uint(mx_), false, false); mx_ = fmaxf(__uint_as_float(rr_[0]), __uint_as_float(rr_[1])); }     \
      const float dl_ = fmaxf(mx_ - PSH, 0.f); al = __builtin_amdgcn_exp2f(-dl_); raised_ = true; \
      _Pragma("unroll") for (int r = 0; r < 16; ++r) { P0[r] -= dl_; P1[r] -= dl_; negm[r] -= dl_; } } } while (0)
#define EXPS(P, ra, rb) do { asm volatile("" : "+v"(P)); _Pragma("unroll") for (int r = (ra); r < (rb); ++r) P[r] = __builtin_amdgcn_exp2f(P[r]); asm volatile("" : "+v"(P)); } while (0)
#define MPIN(acc) asm volatile("" : "+v"(acc))
#define STEP(BKN, BVC, BW, BKP, DO_QK, DO_WR, DO_LD, DO_KP, tt) do { \
    v8i32 kf[2], vf[3]; float mx_ = 0.f, m0_ = 0.f; bool raised_ = false; \
    SBAR(); \
    if (DO_QK && NG > 2) { kf[0] = KFR(2, (BKN) * SHM_K); kf[1] = KFR(3, (BKN) * SHM_K); } \
    _Pragma("unroll") for (int g = 0; g < NG; ++g) { \
      if (DO_QK && !V_NOQK) { if (g == 0) { P0 = MFMA8(kpf0, qf[0], negm); MPIN(P0); } else if (g == 1) { P1 = MFMA8(kpf1, qf[0], negm); MPIN(P1); } \
        else if ((g & 1) == 0) { P0 = MFMA8(kf[g & 1], qf[g >> 1], P0); MPIN(P0); } else { P1 = MFMA8(kf[g & 1], qf[g >> 1], P1); MPIN(P1); } } \
      SBAR(); \
      if (g == 0 && !V_NOPACK) { PACK1(); }                            \
      if (DO_QK && NG == 2 && g == 1 && !V_NOMAX) { MAX0(); } \
      if (DO_QK && g >= 2 && g + 2 < NG) kf[g & 1] = KFR(g + 2, (BKN) * SHM_K); \
      if (g == NG - 2) vf[0] = VFR(0, (BVC) * SHM_V); if (g == NG - 1) vf[1] = VFR(1, (BVC) * SHM_V); \
      SBAR(); } \
      \
    if (!V_NOPV) { o[0] = MFMA8(pf, vf[0], o[0]); MPIN(o[0]); } SBAR(); if (DO_WR && !V_NOSTG) { SWRITE(BW); } if (DO_LD && !V_NOSTG) { SLOAD(((tt) + 4) * 64); } vf[2] = VFR(2, (BVC) * SHM_V); al = 1.f; \
    if (DO_QK && !V_NOMAX) { if (NG == 2) { MAXFIN(); } else { MAX0(); } } SBAR(); \
      \
    if (!V_NOPV) { o[1] = MFMA8(pf, vf[1], o[1]); MPIN(o[1]); } SBAR(); vf[0] = VFR(3, (BVC) * SHM_V); \
    if (DO_QK && NG == 2 && !V_NOEXP) { EXPS(P0, 0, 8); } if (DO_QK && NG != 2 && !V_NOMAX) { MAXFIN(); } SBAR(); \
    if (STG && grpB && !V_NOBAR) { __syncthreads(); } SBAR();   \
      \
    if (!V_NOPV) { o[2] = MFMA8(pf, vf[2], o[2]); MPIN(o[2]); } SBAR(); if (DO_QK && !V_NOEXP) { if (NG == 2) { EXPS(P0, 8, 16); } else { EXPS(P0, 0, 11); } } SBAR(); \
    if (!V_NOPV) { o[3] = MFMA8(pf, vf[0], o[3]); MPIN(o[3]); } SBAR(); if (DO_QK && !V_NOEXP) { if (NG == 2) { EXPS(P1, 0, 8); } else { EXPS(P0, 11, 16); EXPS(P1, 0, 6); } } \
    if (DO_KP) { kpf0 = KFR(0, (BKP) * SHM_K); kpf1 = KFR(1, (BKP) * SHM_K); } SBAR(); \
    if (!V_NOPV) { ol = MFMA8(pf, ones8, ol); MPIN(ol); } SBAR(); if (DO_QK && !V_NOEXP) { if (NG == 2) { EXPS(P1, 8, 16); } else { EXPS(P1, 6, 16); } } SBAR(); \
    if (DO_QK) { if (!V_NOPACK) { PACK0(); } RESC(al); } \
    if (!V_NOBAR && !(STG && grpB)) __syncthreads(); } while (0)
  __syncthreads();
  SLOAD(0); SWRITE(0); SLOAD(64); SWRITE(1); SLOAD(128); SWRITE(2); SLOAD(192); __syncthreads();
#pragma unroll
  for (int r = 0; r < 16; ++r) negm[r] = 0.f;
#pragma unroll
  for (int c = 0; c < NKC; ++c) { const v8i32 k0_ = KFR(2 * c, 0), k1_ = KFR(2 * c + 1, 0);
    if (c == 0) { P0 = MFMA8(k0_, qf[c], negm); P1 = MFMA8(k1_, qf[c], negm); } else { P0 = MFMA8(k0_, qf[c], P0); P1 = MFMA8(k1_, qf[c], P1); } }
  { float mx_ = P0[0];
#pragma unroll
    for (int r = 1; r < 16; ++r) mx_ = fmaxf(mx_, P0[r]);
#pragma unroll
    for (int r = 0; r < 16; ++r) mx_ = fmaxf(mx_, P1[r]);
    { auto rr_ = __builtin_amdgcn_permlane32_swap(__float_as_uint(mx_), __float_as_uint(mx_), false, false); mx_ = fmaxf(__uint_as_float(rr_[0]), __uint_as_float(rr_[1])); }
#pragma unroll
    for (int r = 0; r < 16; ++r) { P0[r] = __builtin_amdgcn_exp2f(P0[r] - mx_ + PSH); P1[r] = __builtin_amdgcn_exp2f(P1[r] - mx_ + PSH); negm[r] = PSH - mx_; } }
  PACKP();
  kpf0 = KFR(0, 1 * SHM_K); kpf1 = KFR(1, 1 * SHM_K);
  int t = 0;
  WConv wcv; int wc_it = wc_base + __builtin_amdgcn_readfirstlane(wid);
  for (; t + 7 < NT; t += 4) {
    STEP(1, 0, 3, 2, true, true, true, true, t);
    if constexpr (WC) wconv_load(*pp, wc_it, lane, wcv);
    STEP(2, 1, 0, 3, true, true, true, true, t + 1);
    STEP(3, 2, 1, 0, true, true, true, true, t + 2);
    if constexpr (WC) { wconv_store(*pp, wc_it, lane, wcv); wc_it += (int)gridDim.x * 8; }
    STEP(0, 3, 2, 1, true, true, true, true, t + 3);
  }
  STEP(1, 0, 3, 2, true, true, false, true, t);
  STEP(2, 1, 0, 3, true, false, false, true, t + 1);
  STEP(3, 2, 1, 0, true, false, false, false, t + 2);
  STEP(0, 3, 2, 1, false, false, false, false, t + 3);
  float rli[16];
#pragma unroll
  for (int r = 0; r < 16; ++r) rli[r] = __builtin_amdgcn_rcpf(ol[r]);
  if constexpr (OM == 1) {
    unsigned* st = (unsigned*)stash + tid;
#pragma unroll
    for (int r = 0; r < 16; ++r) { st[(2 * r) * 512] = cvt_pk_bf16(o[0][r] * rli[r], o[1][r] * rli[r]); st[(2 * r + 1) * 512] = cvt_pk_bf16(o[2][r] * rli[r], o[3][r] * rli[r]); }
  } else if constexpr (OM == 2) {
    const unsigned* st = (const unsigned*)stash + tid;
    float sw[4];
#pragma unroll
    for (int d0 = 0; d0 < 4; ++d0) sw[d0] = subw[d0 * 32 + r32] * 0.8f;
    bf16_t* Ow = Ob + (long)(wid * 32) * ldo;
#pragma unroll
    for (int r = 0; r < 16; ++r) { const unsigned w01 = st[(2 * r) * 512], w23 = st[(2 * r + 1) * 512];
      const float d0v = bflo(w01) - lam * (o[0][r] * rli[r]), d1v = bfhi(w01) - lam * (o[1][r] * rli[r]), d2v = bflo(w23) - lam * (o[2][r] * rli[r]), d3v = bfhi(w23) - lam * (o[3][r] * rli[r]);
      float ss = (d0v * d0v + d1v * d1v) + (d2v * d2v + d3v * d3v);
      ss += __shfl_xor(ss, 1); ss += __shfl_xor(ss, 2); ss += __shfl_xor(ss, 4); ss += __shfl_xor(ss, 8); ss += __shfl_xor(ss, 16);
      const float rn = rsqrtf(ss * (1.f / 128.f) + EPS); const long ob = (long)crow(r, hi) * ldo + r32;
      Ow[ob] = f2bf(SQ6(d0v * rn * sw[0])); Ow[ob + 32] = f2bf(SQ6(d1v * rn * sw[1])); Ow[ob + 64] = f2bf(SQ6(d2v * rn * sw[2])); Ow[ob + 96] = f2bf(SQ6(d3v * rn * sw[3])); }
  } else {
    bf16_t* Ow = Ob + (long)(wid * 32) * ldo;
#pragma unroll
    for (int r = 0; r < 16; ++r) { const int orow = crow(r, hi);
#pragma unroll
      for (int d0 = 0; d0 < 4; ++d0) Ow[(long)orow * ldo + d0 * 32 + r32] = f2bf(SQ6(o[d0][r] * rli[r] * 32.f) * (1.f / 32.f)); }
  }
#undef BL16
#undef SLOAD
#undef SWRITE
#undef RESC
#undef KFR
#undef VFR
#undef LDP
#undef STEP
#undef PACKP
#undef MPIN
#undef PACK0
#undef PACK1
#undef MAX0
#undef MAXFIN
#undef EXPS
}
#undef OFF8
#undef SBAR
#undef MFMA8
#undef LD32
}
#ifdef HW_XCD_MAP
__device__ __forceinline__ int att_cc(const Params& p, const char* lds, int u) {
    const volatile unsigned* bst = (const volatile unsigned*)(lds + 160 * 1024 - 512); const unsigned* cnt = (const unsigned*)(p.ws + WS_BAR) + 3500;
    bool ok = gridDim.x == 256;
#pragma unroll
    for (int i = 0; i < 8; ++i) ok = ok && (__hip_atomic_load(cnt + i, __ATOMIC_RELAXED, __HIP_MEMORY_SCOPE_AGENT) == 32u);
    return ok ? (int)(bst[2] + 8u * bst[3]) : -1;
}
#define ATT_CC(u) (hwcc_ >= 0 ? hwcc_ : ((u) & 255))
#else
#define ATT_CC(u) ((u) & 255)
#endif
#ifdef HW_XCD_MAP
#define ATT_CC_INIT const int hwcc_ = __builtin_amdgcn_readfirstlane(att_cc(p, lds, 0));
#else
#define ATT_CC_INIT
#endif
__device__ __forceinline__ void p4_attention_diff(const Params& p, char* lds) {
    unsigned char* ws = p.ws;
    const bf16_t* PJ = (const bf16_t*)(ws + WS_PJ); bf16_t* MIX = (bf16_t*)(ws + WS_MIX);
    char* stash = lds + 80 * 1024;
    ATT_CC_INIT
#if ATT_FP8 && WCONV_IN_ATT
    const int wcoff = gridDim.x == 256 ? 0 : attn8::WCONV_ITEMS;
    if (gridDim.x != 256) { const int tid_ = tid_opaque(), lane_ = tid_ & 63, gw_ = blockIdx.x * NWAVES + (tid_ >> 6), NGW_ = gridDim.x * NWAVES;
        for (int it = gw_; it < attn8::WCONV_ITEMS; it += NGW_) { attn8::WConv w_; attn8::wconv_load(p, it, lane_, w_); attn8::wconv_store(p, it, lane_, w_); } }
#else
    const int wcoff = 0;
#endif
    for (int u = blockIdx.x; u < 512 + ATT_EXTRA; u += gridDim.x) {
        const int round = (u >> 8) & 1, cc = ATT_CC(u), x = ATT_X(cc), j = ATT_J(cc);
        const int pd = x * 2 + round, b = pd >> 2, h = pd & 3;
        const size_t krow0 = (size_t)b * RPB, qrow0 = krow0 + CTX + (size_t)j * 256;
#if ATT_EXTRA
        if (u >= 512) { const unsigned char* vtx_ = ws + WS_VT8D + (size_t)(b * 4 + h) * 128 * RPB;
            attn8::attn_unit<1, 0, ATT_VAR>(ws + WS_Q8D + qrow0 * 512 + (2 * h) * 64, 512, ws + WS_K8D + krow0 * 512 + (2 * h) * 64, 512, nullptr, 0, nullptr, 0, vtx_, (bf16_t*)(ws + WS_AO) + qrow0 * 128, 128, RPB, lds);
            attn8::attn_unit<1, 0, ATT_VAR>(ws + WS_Q8D + qrow0 * 512 + (2 * h + 1) * 64, 512, ws + WS_K8D + krow0 * 512 + (2 * h + 1) * 64, 512, nullptr, 0, nullptr, 0, vtx_, (bf16_t*)(ws + WS_AO) + qrow0 * 128, 128, RPB, lds);
            continue; }
#endif
#if ATT_FP8
        const unsigned char* vt_ = ws + WS_VT8D + (size_t)(b * 4 + h) * 128 * RPB;
        const int wcb0 = wcoff + ((u / (int)gridDim.x) * 2 + 0) * 32 * (int)gridDim.x * 8 + (int)blockIdx.x * 8, wcb1 = wcb0 + 32 * (int)gridDim.x * 8;
        if (u < (int)gridDim.x) attn8::attn_unit<1, 1, 0, WCONV_IN_ATT != 0>(ws + WS_Q8D + qrow0 * 512 + (2 * h) * 64, 512, ws + WS_K8D + krow0 * 512 + (2 * h) * 64, 512, nullptr, 0, nullptr, 0, vt_, nullptr, 0, RPB, lds, stash, 0.f, nullptr, &p, wcoff + 131072 + (int)blockIdx.x * 8);
        else attn8::attn_unit<1, 1, 0, false>(ws + WS_Q8D + qrow0 * 512 + (2 * h) * 64, 512, ws + WS_K8D + krow0 * 512 + (2 * h) * 64, 512, nullptr, 0, nullptr, 0, vt_, nullptr, 0, RPB, lds, stash);
#else
        attn::attn_unit<1, 1, 0, 1>(PJ + qrow0 * NPROJ + (2 * h) * 64, NPROJ, PJ + krow0 * NPROJ + 512 + (2 * h) * 64, NPROJ, nullptr, 0, nullptr, 0,
                              PJ + krow0 * NPROJ + 1024 + h * 128, NPROJ, nullptr, 0, RPB, 1.f, lds, stash);
#endif
        const int lane_ = tid_opaque() & 63;
        const float s1 = wave_sum(p.lq1[lane_] * p.lk1[lane_]), s2 = wave_sum(p.lq2[lane_] * p.lk2[lane_]);
        const float lam = __expf(s1) - __expf(s2) + 0.2f;
#if ATT_FP8
        attn8::attn_unit<1, 2, 0, false>(ws + WS_Q8D + qrow0 * 512 + (2 * h + 1) * 64, 512, ws + WS_K8D + krow0 * 512 + (2 * h + 1) * 64, 512, nullptr, 0, nullptr, 0, vt_, MIX + qrow0 * 1024 + h * 128, 1024, RPB, lds, stash, lam, p.subln_w, &p, wcb1);
#else
        attn::attn_unit<1, 1, 0, 2>(PJ + qrow0 * NPROJ + (2 * h + 1) * 64, NPROJ, PJ + krow0 * NPROJ + 512 + (2 * h + 1) * 64, NPROJ, nullptr, 0, nullptr, 0,
                              PJ + krow0 * NPROJ + 1024 + h * 128, NPROJ, MIX + qrow0 * 1024 + h * 128, 1024, RPB, 1.f, lds, stash, lam, p.subln_w);
#endif
    }
}
__device__ __forceinline__ void p4_attention_mla(const Params& p, char* lds) {
    unsigned char* ws = p.ws;
    const bf16_t* PJ = (const bf16_t*)(ws + WS_PJ); const bf16_t* QM = (const bf16_t*)(ws + WS_QM); const bf16_t* KVb = (const bf16_t*)(ws + WS_KV);
    bf16_t* MIX = (bf16_t*)(ws + WS_MIX);
    constexpr float LOG2E = 1.4426950408889634f;
    ATT_CC_INIT
    for (int u = blockIdx.x; u < 512; u += gridDim.x) {
        const int round = u >> 8, cc = ATT_CC(u), x = ATT_X(cc), j = ATT_J(cc);
        const int pd = x * 2 + round, b = pd >> 2, h = pd & 3;
        const size_t krow0 = (size_t)b * RPB, qrow0 = krow0 + CTX + (size_t)j * 256;
#if ATT_FP8
        const int wcb = (gridDim.x == 256 ? 0 : attn8::WCONV_ITEMS) + (u / (int)gridDim.x) * 32 * (int)gridDim.x * 8 + (int)blockIdx.x * 8;
        attn8::attn_unit<3, 0, 0, WCONV_IN_ATT != 0>(ws + WS_Q8M + qrow0 * 768 + h * 192, 768, ws + WS_K8M + krow0 * 512 + h * 128, 512, ws + WS_K8M + krow0 * 512 + h * 128 + 64, 512, ws + WS_KR8 + krow0 * 64, 64,
                               ws + WS_VT8M + (size_t)(b * 4 + h) * 128 * RPB, MIX + qrow0 * 1024 + 512 + h * 128, 1024, RPB, lds, nullptr, 0.f, nullptr, &p, wcb);
#else
        attn::attn_unit<3, MLA_NQR>(QM + qrow0 * 768 + h * 192, 768, KVb + krow0 * 1024 + h * 256, 1024, KVb + krow0 * 1024 + h * 256 + 64, 1024, PJ + krow0 * NPROJ + 1920, NPROJ,
                              KVb + krow0 * 1024 + h * 256 + 128, 1024, MIX + qrow0 * 1024 + 512 + h * 128, 1024, RPB, 0.07216878364870322f * LOG2E, lds);
#endif
    }
}

__device__ __forceinline__ void p5_mix(const Params& p) {
    const int tid = tid_opaque(), lane = tid & 63, wave = tid >> 6;
    const int gw = blockIdx.x * NWAVES + wave, NGW = gridDim.x * NWAVES;
    const bf16_t* AO = (const bf16_t*)(p.ws + WS_AO); bf16_t* MIX = (bf16_t*)(p.ws + WS_MIX);
    const float s1 = wave_sum(p.lq1[lane] * p.lk1[lane]), s2 = wave_sum(p.lq2[lane] * p.lk2[lane]);
    const float lam_init = 0.2f, lam = __expf(s1) - __expf(s2) + lam_init;
    const int hh = lane >> 4, e0 = (lane & 15) * 8;
    float sw[8];
#pragma unroll
    for (int i = 0; i < 8; ++i) sw[i] = p.subln_w[e0 + i] * (1.f - lam_init);
    for (int t = gw; t < T; t += NGW) {
        const int b = t >> 13, row = b * RPB + CTX + (t & 8191);
        const bf16_t* src = AO + (size_t)row * 1536;
        const u32x4 a = *(const u32x4*)(src + hh * 256 + e0), bq = *(const u32x4*)(src + hh * 256 + 128 + e0), mq = *(const u32x4*)(src + 1024 + lane * 8);
        float o[8];
        o[0] = bflo(a.x) - lam * bflo(bq.x); o[1] = bfhi(a.x) - lam * bfhi(bq.x); o[2] = bflo(a.y) - lam * bflo(bq.y); o[3] = bfhi(a.y) - lam * bfhi(bq.y);
        o[4] = bflo(a.z) - lam * bflo(bq.z); o[5] = bfhi(a.z) - lam * bfhi(bq.z); o[6] = bflo(a.w) - lam * bflo(bq.w); o[7] = bfhi(a.w) - lam * bfhi(bq.w);
        float ss = 0.f;
#pragma unroll
        for (int i = 0; i < 8; ++i) ss += o[i] * o[i];
        ss += __shfl_xor(ss, 1); ss += __shfl_xor(ss, 2); ss += __shfl_xor(ss, 4); ss += __shfl_xor(ss, 8);
        const float r = rsqrtf(ss * (1.f / 128.f) + EPS);
        u32x4 w; w.x = cvt_pk_bf16(o[0] * r * sw[0], o[1] * r * sw[1]); w.y = cvt_pk_bf16(o[2] * r * sw[2], o[3] * r * sw[3]);
        w.z = cvt_pk_bf16(o[4] * r * sw[4], o[5] * r * sw[5]); w.w = cvt_pk_bf16(o[6] * r * sw[6], o[7] * r * sw[7]);
        bf16_t* dst = MIX + (size_t)row * 1024;
        *(u32x4*)(dst + hh * 128 + e0) = w; *(u32x4*)(dst + 512 + lane * 8) = mq;
    }
}

typedef short bf16x8_t __attribute__((ext_vector_type(8)));
__device__ __forceinline__ void p7a_route(const Params& p, unsigned char* lds) {
    const int tid = tid_opaque(), lane = tid & 63, wave = tid >> 6, row = lane & 15, kq = lane >> 4;
    int* lcnt = (int*)(lds + 147456); int* lbase = lcnt + 32; int* tok_e = lbase + 32; int* tok_r = tok_e + 1024;
    for (int i = tid; i < 8192; i += NTHREADS) ((u32x4*)lds)[i] = ((const u32x4*)(p.ws + WS_RWF))[i];
    if (tid < 32) lcnt[tid] = 0;
    const int chunk = (T + gridDim.x - 1) / gridDim.x;
    const int t0 = blockIdx.x * chunk, t1 = (t0 + chunk < T) ? t0 + chunk : T;
    float* vab = (float*)(lds + 131072); const int b0 = t0 >> 13;
    { const float* mods_ = (const float*)(p.ws + WS_MODS);
      for (int i = tid; i < 2048; i += NTHREADS) { const int bb = min(b0 + (i >> 10), NB - 1), k = i & 1023; const float* md_ = mods_ + bb * 6144;
          vab[(i >> 10) * 2048 + k] = p.ffn_norm_w[k] * (md_[4 * 1024 + k] + 1.f); vab[(i >> 10) * 2048 + 1024 + k] = md_[3 * 1024 + k]; } }
    __syncthreads();
    const bf16_t* XN = (const bf16_t*)(p.ws + WS_XN); const float* mods = (const float*)(p.ws + WS_MODS);
    unsigned char* HF = p.ws + WS_HF;
    int* TOPI = (int*)(p.ws + WS_TOPI); float* GATE = (float*)(p.ws + WS_GATE); int* RANK = (int*)(p.ws + WS_RANK); int* CNT = (int*)(p.ws + WS_CNT);
    const u32x4* rwf = (const u32x4*)lds + lane;
    for (int tb = t0 + 16 * wave; tb < t1; tb += 16 * NWAVES) {
        const int t = tb + row, b = tb >> 13; const float* md = mods + b * 6144;
        const bf16_t* xr = XN + (size_t)t * DM + 8 * kq;
        const float r = rsqrtf(((const float*)(p.ws + WS_RSX))[t] * (1.f / DM) + EPS);
        f32x4 acc0 = {0.f, 0.f, 0.f, 0.f}, acc1 = {0.f, 0.f, 0.f, 0.f};
        const float* va = vab + ((tb >> 13) - b0) * 2048 + 8 * kq; const float* vb = va + 1024;
        u32x4 xq[4];
#pragma unroll
        for (int j = 0; j < 4; ++j) xq[j] = *(const u32x4*)(xr + 32 * j);
#pragma unroll 4
        for (int s = 0; s < 32; ++s) { const int k0 = 32 * s + 8 * kq;
            const u32x4 xw = xq[s & 3]; if (s + 4 < 32) xq[s & 3] = *(const u32x4*)(xr + 32 * (s + 4));
            const f32x4 xa = {bflo(xw.x), bfhi(xw.x), bflo(xw.y), bfhi(xw.y)}, xc = {bflo(xw.z), bfhi(xw.z), bflo(xw.w), bfhi(xw.w)};
            const f32x4 ha = xa * r * *(const f32x4*)(va + 32 * s) + *(const f32x4*)(vb + 32 * s), hc = xc * r * *(const f32x4*)(va + 32 * s + 4) + *(const f32x4*)(vb + 32 * s + 4);
            u32x4 hi, lo;
            hi.x = cvt_pk_bf16(ha.x, ha.y); hi.y = cvt_pk_bf16(ha.z, ha.w); hi.z = cvt_pk_bf16(hc.x, hc.y); hi.w = cvt_pk_bf16(hc.z, hc.w);
            lo.x = cvt_pk_bf16(ha.x - bflo(hi.x), ha.y - bfhi(hi.x)); lo.y = cvt_pk_bf16(ha.z - bflo(hi.y), ha.w - bfhi(hi.y));
            lo.z = cvt_pk_bf16(hc.x - bflo(hi.z), hc.y - bfhi(hi.z)); lo.w = cvt_pk_bf16(hc.z - bflo(hi.w), hc.w - bfhi(hi.w));
            { u32x2 h8; h8.x = cvt4_fp8(ha.x, ha.y, ha.z, ha.w); h8.y = cvt4_fp8(hc.x, hc.y, hc.z, hc.w); *(u32x2*)(HF + (size_t)t * DM + k0) = h8; }
            const bf16x8_t Ah = __builtin_bit_cast(bf16x8_t, hi), Al = __builtin_bit_cast(bf16x8_t, lo);
            const bf16x8_t Bh0 = __builtin_bit_cast(bf16x8_t, rwf[(s * 4 + 0) * 64]), Bl0 = __builtin_bit_cast(bf16x8_t, rwf[(s * 4 + 1) * 64]);
            const bf16x8_t Bh1 = __builtin_bit_cast(bf16x8_t, rwf[(s * 4 + 2) * 64]), Bl1 = __builtin_bit_cast(bf16x8_t, rwf[(s * 4 + 3) * 64]);
            acc0 = __builtin_amdgcn_mfma_f32_16x16x32_bf16(Ah, Bh0, acc0, 0, 0, 0); acc0 = __builtin_amdgcn_mfma_f32_16x16x32_bf16(Ah, Bl0, acc0, 0, 0, 0); acc0 = __builtin_amdgcn_mfma_f32_16x16x32_bf16(Al, Bh0, acc0, 0, 0, 0);
            acc1 = __builtin_amdgcn_mfma_f32_16x16x32_bf16(Ah, Bh1, acc1, 0, 0, 0); acc1 = __builtin_amdgcn_mfma_f32_16x16x32_bf16(Ah, Bl1, acc1, 0, 0, 0); acc1 = __builtin_amdgcn_mfma_f32_16x16x32_bf16(Al, Bh1, acc1, 0, 0, 0); }
        const float rb0 = p.router_b[row], rb1 = p.router_b[16 + row];
#pragma unroll
        for (int reg = 0; reg < 4; ++reg) { float v0 = acc0[reg] + rb0, v1 = acc1[reg] + rb1; float tv[4]; int ti[4];
#pragma unroll
            for (int k = 0; k < 4; ++k) { float m = fmaxf(v0, v1);
                m = fmaxf(m, __shfl_xor(m, 1)); m = fmaxf(m, __shfl_xor(m, 2)); m = fmaxf(m, __shfl_xor(m, 4)); m = fmaxf(m, __shfl_xor(m, 8));
                int cand = (v0 == m) ? row : ((v1 == m) ? 16 + row : 99);
                cand = min(cand, __shfl_xor(cand, 1)); cand = min(cand, __shfl_xor(cand, 2)); cand = min(cand, __shfl_xor(cand, 4)); cand = min(cand, __shfl_xor(cand, 8));
                tv[k] = m; ti[k] = cand; if (cand == row) v0 = -INFINITY; if (cand == 16 + row) v1 = -INFINITY; }
            const float e1 = __expf(tv[1] - tv[0]), e2 = __expf(tv[2] - tv[0]), e3 = __expf(tv[3] - tv[0]); const float inv = 1.f / (1.f + e1 + e2 + e3);
            const int tt = tb + 4 * kq + reg;
            if (row < 4 && tt < t1) { const int ei = row == 0 ? ti[0] : row == 1 ? ti[1] : row == 2 ? ti[2] : ti[3]; const float gv = (row == 0 ? 1.f : row == 1 ? e1 : row == 2 ? e2 : e3) * inv;
                const int lr = atomicAdd(&lcnt[ei], 1);
                TOPI[tt * 4 + row] = ei; GATE[tt * 4 + row] = gv; tok_e[(tt - t0) * 4 + row] = ei; tok_r[(tt - t0) * 4 + row] = lr; } }
    }
    __syncthreads();
    if (tid < 32) lbase[tid] = atomicAdd(&CNT[tid], lcnt[tid]);
    __syncthreads();
    for (int i = tid; i < (t1 - t0) * 4; i += NTHREADS) RANK[t0 * 4 + i] = lbase[tok_e[i]] + tok_r[i];
}

__device__ __forceinline__ void moe_segments(const Params& p, int* seg) {
    if (threadIdx.x == 0) { const int* CNT = (const int*)(p.ws + WS_CNT); int s = 0;
        for (int e = 0; e < 32; ++e) { seg[e] = s; s += (CNT[e] + 255) & ~255; } seg[32] = s; }
    __syncthreads();
}
__device__ __forceinline__ void p7b_scatter(const Params& p, const int* seg) {
    const int tid = tid_opaque();
    const int gt = blockIdx.x * NTHREADS + tid, NGT = gridDim.x * NTHREADS;
    const int* TOPI = (const int*)(p.ws + WS_TOPI); const float* GATE = (const float*)(p.ws + WS_GATE); const int* RANK = (const int*)(p.ws + WS_RANK);
    int* DEST = (int*)(p.ws + WS_DEST); float* GS = (float*)(p.ws + WS_GSRT); int* RTOK = (int*)(p.ws + WS_RTOK);
    for (int i = gt; i < T * 4; i += NGT) { const int dest = seg[TOPI[i]] + RANK[i]; DEST[i] = dest; GS[dest] = GATE[i]; RTOK[dest] = i >> 2; }
}
__device__ __forceinline__ void p10_final(const Params& p, const bool with_moe) {
    const int tid = tid_opaque(), lane = tid & 63, wave = tid >> 6;
    const int gw = blockIdx.x * NWAVES + wave, NGW = gridDim.x * NWAVES;
    const bf16_t* XN = (const bf16_t*)(p.ws + WS_XN); const float* mods = (const float*)(p.ws + WS_MODS);
    const int* DEST = (const int*)(p.ws + WS_DEST);
    const f32x4* w4 = (const f32x4*)p.final_norm_w;
    for (int tb = gw; tb < T; tb += P10_NT * NGW) {
        int tt[P10_NT]; bool ok[P10_NT]; u32x2 xw[P10_NT][4];
#if YS_FP8
        unsigned yw[P10_NT][4][4];
#else
        u32x2 yw[P10_NT][4][4];
#endif
#pragma unroll
        for (int q = 0; q < P10_NT; ++q) { const int t_ = tb + q * NGW; ok[q] = t_ < T; tt[q] = ok[q] ? t_ : tb; }
#pragma unroll
        for (int q = 0; q < P10_NT; ++q) { const u32x2* xr = (const u32x2*)(XN + (size_t)tt[q] * DM);
#pragma unroll
            for (int j = 0; j < 4; ++j) xw[q][j] = xr[64 * j + lane];
            if (with_moe) {
#pragma unroll
                for (int k = 0; k < 4; ++k) { const int d = DEST[tt[q] * 4 + k];
#if YS_FP8
                    const unsigned* yr = (const unsigned*)(p.ws + WS_XS + (size_t)d * 1024);
#else
                    const u32x2* yr = (const u32x2*)(p.ws + WS_XS + (size_t)d * 2048);
#endif
#pragma unroll
                    for (int j = 0; j < 4; ++j) yw[q][k][j] = yr[64 * j + lane]; } } }
#pragma unroll
        for (int q = 0; q < P10_NT; ++q) { const int t = tt[q], b = t >> 13; const f32x4* g4 = (const f32x4*)(mods + b * 6144 + 5 * 1024);
            f32x4 xv[4];
#pragma unroll
            for (int j = 0; j < 4; ++j) { xv[j] = (f32x4){bflo(xw[q][j].x), bfhi(xw[q][j].x), bflo(xw[q][j].y), bfhi(xw[q][j].y)};
                if (with_moe) { f32x4 y = {0.f, 0.f, 0.f, 0.f};
#pragma unroll
                    for (int k = 0; k < 4; ++k) {
#if YS_FP8
                        const int w_ = (int)yw[q][k][j]; const auto lo_ = __builtin_amdgcn_cvt_pk_f32_fp8(w_, false), hi_ = __builtin_amdgcn_cvt_pk_f32_fp8(w_, true);
                        y += (f32x4){lo_[0], lo_[1], hi_[0], hi_[1]};
#else
                        const u32x2 w_ = yw[q][k][j]; y += (f32x4){bflo(w_.x), bfhi(w_.x), bflo(w_.y), bfhi(w_.y)};
#endif
                    }
                    xv[j] += g4[64 * j + lane] * y * (YS_FP8 ? 1.f / YS_SCALE : 1.f); } }
            float s = 0.f;
#pragma unroll
            for (int j = 0; j < 4; ++j) s += (xv[j].x * xv[j].x + xv[j].y * xv[j].y) + (xv[j].z * xv[j].z + xv[j].w * xv[j].w);
            float r = rsqrtf(wave_sum(s) * (1.f / DM) + EPS);
#if DBG_STAGE
            r *= 1.f + 10.f * fminf(__uint_as_float(((const unsigned*)(p.ws + WS_CNT))[64]), 100.f);
#endif
            if (ok[q]) { f32x4* o = (f32x4*)(p.out + (size_t)t * DM);
#pragma unroll
                for (int j = 0; j < 4; ++j) o[64 * j + lane] = xv[j] * r * w4[64 * j + lane]; }
        }
    }
}
#if DBG_STAGE
__device__ __forceinline__ void dbg_report(const Params& p, float err) {
    if (!(err >= 0.f)) err = 1e6f;
    atomicMax((unsigned*)(p.ws + WS_CNT) + 64, __float_as_uint(err));
}
__device__ __forceinline__ void dbg_rope(float& x1, float& x2, int pv, int pp) {
    const float inv = exp2f(-(float)pp * (13.287712379549449f / 16.f)); float sn, cs; sincosf((float)pv * inv, &sn, &cs);
    const float a = x1 * cs - x2 * sn, b = x2 * cs + x1 * sn; x1 = a; x2 = b;
}
__device__ __forceinline__ void dbg_check_proj(const Params& p) {
    const int gt = blockIdx.x * NTHREADS + threadIdx.x, NGT = gridDim.x * NTHREADS;
    const bf16_t* HB = (const bf16_t*)(p.ws + WS_HB); const bf16_t* PJ = (const bf16_t*)(p.ws + WS_PJ); const bf16_t* QM = (const bf16_t*)(p.ws + WS_QM); const bf16_t* KVb = (const bf16_t*)(p.ws + WS_KV);
    float emax = 0.f;
    for (int it = gt; it < 24 * 224; it += NGT) { const int rs = it / 224, cpi = it % 224; const int row = rs < 6 ? (rs & 3) * RPB + (rs * 37) % CTX : (rs * 1409 + 77) % MALL; const int grp = cpi >> 4, pp = cpi & 15, c0 = 1536 + grp * 32 + pp, c1 = c0 + 16;
        float a0 = 0.f, a1 = 0.f;
        for (int k = 0; k < 1024; ++k) { const float h = bf2f(HB[(size_t)row * 1024 + k]); a0 += h * bf2f(f2bf(p.w_in[(size_t)k * 1984 + c0])); a1 += h * bf2f(f2bf(p.w_in[(size_t)k * 1984 + c1])); }
        const int i = row % RPB; if (i >= CTX && c0 >= 1920) { const int pos = i - CTX, a = (c0 >> 5) & 1; dbg_rope(a0, a1, a ? (pos & 63) : (pos >> 6), pp); }
        const float f0 = bf2f(PJ[(size_t)row * NPROJ + c0]), f1 = bf2f(PJ[(size_t)row * NPROJ + c1]);
        emax = fmaxf(emax, fmaxf(fabsf(f0 - a0), fabsf(f1 - a1))); }
    for (int it = gt; it < 24 * 384; it += NGT) { const int rs = it / 384, cpi = it % 384; const int row = rs < 6 ? (rs & 3) * RPB + (rs * 41) % CTX : (rs * 1409 + 300) % MALL; const int grp = cpi >> 4, pp = cpi & 15, c0 = grp * 32 + pp, c1 = c0 + 16;
        float ss = 0.f, a0 = 0.f, a1 = 0.f;
        for (int k = 0; k < 256; ++k) { const float v = bf2f(PJ[(size_t)row * NPROJ + 1536 + k]); ss += v * v; const float vw = v * p.q_norm_w[k]; a0 += vw * p.w_uq[(size_t)k * 768 + c0]; a1 += vw * p.w_uq[(size_t)k * 768 + c1]; }
        const float r = rsqrtf(ss / 256.f + EPS); a0 *= r; a1 *= r;
        const int i = row % RPB, g6 = grp % 6; if (i >= CTX && g6 >= 4) { const int pos = i - CTX; dbg_rope(a0, a1, g6 == 5 ? (pos & 63) : (pos >> 6), pp); }
        const float f0 = bf2f(QM[(size_t)row * 768 + c0]), f1 = bf2f(QM[(size_t)row * 768 + c1]);
        emax = fmaxf(emax, fmaxf(fabsf(f0 - a0), fabsf(f1 - a1))); }
    for (int it = gt; it < 24 * 1024; it += NGT) { const int rs = it >> 10, c0 = it & 1023; const int row = rs < 6 ? (rs & 3) * RPB + (rs * 43) % CTX : (rs * 1409 + 555) % MALL;
        float ss = 0.f, a0 = 0.f;
        for (int k = 0; k < 128; ++k) { const float v = bf2f(PJ[(size_t)row * NPROJ + 1792 + k]); ss += v * v; a0 += v * p.kv_norm_w[k] * p.w_ukv[(size_t)k * 1024 + c0]; }
        a0 *= rsqrtf(ss / 128.f + EPS);
        emax = fmaxf(emax, fabsf(bf2f(KVb[(size_t)row * 1024 + c0]) - a0)); }
    emax = wave_max(emax);
    if ((threadIdx.x & 63) == 0) dbg_report(p, emax);
}
__device__ __forceinline__ void dbg_check_attn(const Params& p, unsigned char* lds, int kind_sel) {
    const int tid = threadIdx.x;
    const bf16_t* PJ = (const bf16_t*)(p.ws + WS_PJ); const bf16_t* QM = (const bf16_t*)(p.ws + WS_QM); const bf16_t* KVb = (const bf16_t*)(p.ws + WS_KV); const bf16_t* AO = (const bf16_t*)(p.ws + WS_MIX);
    float* sc = (float*)lds; float* red = sc + 8448; float* qv = red + 1024;
    for (int s = blockIdx.x; s < 128; s += gridDim.x) {
        const int kind = s & 1; if (kind_sel >= 0 && kind != kind_sel) continue;
        const int b = (s >> 1) & 3, hh = (s >> 3) & 7, qpos = ((s >> 1) * 2731 + 13) & 8191;
        const size_t krow0 = (size_t)b * RPB, qrow = krow0 + CTX + qpos;
        const int dqk = kind ? 192 : 64; const int h = kind ? (hh & 3) : hh;
#if ATT_FP8
        const float scale = 0.6931471805599453f;
        const unsigned char* W8 = p.ws;
#define F8(ptr) __builtin_amdgcn_cvt_f32_fp8((int)(*(const unsigned char*)(ptr)), 0)
        __syncthreads();
        if (tid < dqk) qv[tid] = kind ? F8(W8 + WS_Q8M + qrow * 768 + h * 192 + tid) : F8(W8 + WS_Q8D + qrow * 512 + h * 64 + tid);
        __syncthreads();
        float lmax = -1e30f;
        for (int k = tid; k < RPB; k += NTHREADS) { float a = 0.f;
            if (kind) { for (int d = 0; d < 128; ++d) a += qv[d] * F8(W8 + WS_K8M + (krow0 + k) * 512 + h * 128 + d); for (int d = 0; d < 64; ++d) a += qv[128 + d] * F8(W8 + WS_KR8 + (krow0 + k) * 64 + d); }
            else { for (int d = 0; d < 64; ++d) a += qv[d] * F8(W8 + WS_K8D + (krow0 + k) * 512 + h * 64 + d); }
            a *= scale; sc[k] = a; lmax = fmaxf(lmax, a); }
#else
        const float scale = kind ? 0.07216878364870322f : 0.6931471805599453f;
        __syncthreads();
        if (tid < dqk) qv[tid] = kind ? bf2f(QM[qrow * 768 + h * 192 + tid]) : bf2f(PJ[qrow * NPROJ + h * 64 + tid]);
        __syncthreads();
        float lmax = -1e30f;
        for (int k = tid; k < RPB; k += NTHREADS) { float a = 0.f;
            if (kind) { for (int d = 0; d < 128; ++d) a += qv[d] * bf2f(KVb[(krow0 + k) * 1024 + h * 256 + d]); for (int d = 0; d < 64; ++d) a += qv[128 + d] * bf2f(PJ[(krow0 + k) * NPROJ + 1920 + d]); }
            else { for (int d = 0; d < 64; ++d) a += qv[d] * bf2f(PJ[(krow0 + k) * NPROJ + 512 + h * 64 + d]); }
            a *= scale; sc[k] = a; lmax = fmaxf(lmax, a); }
#endif
        lmax = wave_max(lmax); if ((tid & 63) == 0) red[tid >> 6] = lmax; __syncthreads();
        float m = red[0]; for (int w = 1; w < 8; ++w) m = fmaxf(m, red[w]); __syncthreads();
        float lsum = 0.f; for (int k = tid; k < RPB; k += NTHREADS) { const float e = __expf(sc[k] - m); sc[k] = e; lsum += e; }
        lsum = wave_sum(lsum); if ((tid & 63) == 0) red[tid >> 6] = lsum; __syncthreads();
        float l = 0.f; for (int w = 0; w < 8; ++w) l += red[w]; __syncthreads();
        const int e = tid & 127, part = tid >> 7; float o = 0.f;
#if ATT_FP8
        for (int k = part; k < RPB; k += 4) { const unsigned char* vt = p.ws + (kind ? WS_VT8M : WS_VT8D) + ((size_t)(b * 4 + (kind ? h : (h >> 1))) * 128 + e) * RPB + (k & ~63) + vt_pos(k & 63); o += sc[k] * F8(vt); }
#else
        for (int k = part; k < RPB; k += 4) { const float v = kind ? bf2f(KVb[(krow0 + k) * 1024 + h * 256 + 128 + e]) : bf2f(PJ[(krow0 + k) * NPROJ + 1024 + (h >> 1) * 128 + e]); o += sc[k] * v; }
#endif
        red[tid] = o; __syncthreads();
        if (tid < 128) { const float on = (red[tid] + red[tid + 128] + red[tid + 256] + red[tid + 384]) / l;
            const float of = bf2f(AO[qrow * 1024 + 512 + h * 128 + tid]);
            float d2 = (of - on) * (of - on), n2 = on * on;
            d2 = wave_sum(d2); n2 = wave_sum(n2); red[512 + (tid >> 6) * 2] = d2; red[512 + (tid >> 6) * 2 + 1] = n2; }
        __syncthreads();
        if (tid == 0) { const float d2 = red[512] + red[514], n2 = red[513] + red[515]; dbg_report(p, sqrtf(d2 / (n2 + 1e-30f))); }
    }
    __syncthreads();
}
#endif
typedef const __attribute__((address_space(4))) Params* ParamsK;
#if defined(__HIP_DEVICE_COMPILE__)
#define LOAD_PARAMS() ({ ParamsK q_ = (ParamsK)__builtin_amdgcn_kernarg_segment_ptr(); asm volatile("" : "+s"(q_)); Params r_ = *q_; r_; })
#else
#define LOAD_PARAMS() (Params{})
#endif
#ifndef FIRST_PHASE
#define FIRST_PHASE 0
#endif
#define PH(k) ((k) >= FIRST_PHASE && (k) <= LAST_PHASE)
#ifndef EPIY_PROBE
#define EPIY_PROBE 0
#endif
#ifndef REP_MASK
#define REP_MASK 0
#endif
#define REP(k) for (int rep_ = 0; rep_ < (((REP_MASK) >> (k)) & 1) + 1; ++rep_)
#define PH_BEGIN { const Params p = LOAD_PARAMS(); unsigned char* ws = p.ws; (void)ws;
#define PH_END }
__global__ void __launch_bounds__(NTHREADS, 2) fwd_kernel(Params p_unused) {
    extern __shared__ __attribute__((aligned(16))) unsigned char lds[];
    cg::grid_group grid = cg::this_grid();
    LAS unsigned char* lds3 = (LAS unsigned char*)lds;
    const int G = gridDim.x, c = blockIdx.x;
    int* seg = (int*)(lds + 160 * 1024 - 256);
    volatile LAS unsigned* bst = (volatile LAS unsigned*)(lds3 + 160 * 1024 - 512);
    if (threadIdx.x < 2) bst[threadIdx.x] = 0u;
    __syncthreads();
    XcdBarrier bar;
    { ParamsK q_ = (ParamsK)__builtin_amdgcn_kernarg_segment_ptr(); bar = xcd_barrier_post((unsigned*)(q_->ws + WS_BAR), bst);
#ifdef HW_XCD_MAP
      if (threadIdx.x == 0) { const unsigned x_ = xb_xcc_id() & 7u; bst[2] = x_; bst[3] = atomicAdd((unsigned*)(q_->ws + WS_BAR) + 3500 + x_, 1u); }
#endif
    }
#ifdef USE_CG_SYNC
#define GRID_SYNC() grid.sync()
#else
#define GRID_SYNC() xcd_barrier(bar)
#endif

#ifdef ONLY4
#ifndef NO_DIFF
    PH_BEGIN p4_attention_diff(p, (char*)lds); PH_END
#endif
#ifndef NO_MLA
    PH_BEGIN p4_attention_mla(p, (char*)lds); PH_END
#endif
    return;
#endif
#ifdef UBENCH
    { typedef int v8i32_ __attribute__((ext_vector_type(8))); typedef float f32x16_ __attribute__((ext_vector_type(16))); typedef int v4i32_ __attribute__((ext_vector_type(4)));
      const int wv_ = __builtin_amdgcn_readfirstlane((int)threadIdx.x >> 6);
      float s_ = 0.f;
      LAS v4i32_* lp_ = (LAS v4i32_*)(lds3 + 65536) + threadIdx.x * 2;
      if (wv_ >= 4) { if (UBENCH != 5) {
          v8i32_ a_ = {(int)threadIdx.x, 1, 2, 3, 4, 5, 6, 7}, b_ = {7, 6, 5, 4, 3, 2, 1, (int)blockIdx.x}; f32x16_ c0 = {}, c1 = {}, c2 = {}, c3 = {}, c4 = {};
          for (int it = 0; it < 10000; ++it) {
              if (UBENCH >= 8) { const v4i32_ x0 = lp_[0], x1 = lp_[1]; b_ = __builtin_shufflevector(x0, x1, 0, 1, 2, 3, 4, 5, 6, 7); }
              c0 = __builtin_amdgcn_mfma_scale_f32_32x32x64_f8f6f4(a_, b_, c0, 0, 0, 0, 0, 0, 0); c1 = __builtin_amdgcn_mfma_scale_f32_32x32x64_f8f6f4(a_, b_, c1, 0, 0, 0, 0, 0, 0);
              c2 = __builtin_amdgcn_mfma_scale_f32_32x32x64_f8f6f4(a_, b_, c2, 0, 0, 0, 0, 0, 0); c3 = __builtin_amdgcn_mfma_scale_f32_32x32x64_f8f6f4(a_, b_, c3, 0, 0, 0, 0, 0, 0);
              c4 = __builtin_amdgcn_mfma_scale_f32_32x32x64_f8f6f4(a_, b_, c4, 0, 0, 0, 0, 0, 0); __builtin_amdgcn_sched_barrier(0);
              if (UBENCH >= 7) __syncthreads(); }
#pragma unroll
          for (int i = 0; i < 16; ++i) s_ += c0[i] + c1[i] + c2[i] + c3[i] + c4[i]; } }
      else if (UBENCH != 6) {
          float e_[32]; unsigned pk_[8];
#pragma unroll
          for (int i = 0; i < 32; ++i) e_[i] = (float)(threadIdx.x + i) * 1e-3f;
#pragma unroll
          for (int i = 0; i < 8; ++i) pk_[i] = 0u;
          for (int it = 0; it < 10000; ++it) {
              float m_ = e_[0];
#pragma unroll
              for (int i = 1; i < 31; i += 2) m_ = __builtin_fmaxf(__builtin_fmaxf(m_, e_[i]), e_[i + 1]);
#pragma unroll
              for (int i = 0; i < 32; ++i) e_[i] = __builtin_amdgcn_exp2f(e_[i] - m_);
#pragma unroll
              for (int i = 0; i < 8; ++i) pk_[i] = cvt4_fp8o((int)pk_[i], e_[4 * i], e_[4 * i + 1], e_[4 * i + 2], e_[4 * i + 3]);
              if (UBENCH >= 8) { lp_[0] = (v4i32_){(int)pk_[0], (int)pk_[1], (int)pk_[2], (int)pk_[3]}; lp_[1] = (v4i32_){(int)pk_[4], (int)pk_[5], (int)pk_[6], (int)pk_[7]}; }
              __builtin_amdgcn_sched_barrier(0);
              if (UBENCH >= 7) __syncthreads(); }
#pragma unroll
          for (int i = 0; i < 8; ++i) s_ += (float)pk_[i]; }
      if (s_ == 123.456f) ((float*)(LOAD_PARAMS().ws + WS_CNT))[100] = s_; }
#endif
#if PH(0)
    REP(0) { PH_BEGIN p0_prologue(p, lds); PH_END
    GRID_SYNC(); }
    if (gridDim.y == 0x7fffffffu) grid.sync();
#endif
    REP(2) {
#if PH(1)
    PH_BEGIN p1_rows(p); PH_END
    GRID_SYNC();
#endif
#if PH(2)
    PH_BEGIN { pg8::Gemm g{(const bf16_t*)(ws + WS_HB), P2_FP8 ? 512 : 1024, (const bf16_t*)(ws + WS_WIN), P2_FP8 ? 512 : 1024}; ProjOrder S; S.init(G, c, 0);
      EpiProj E{(bf16_t*)(ws + WS_PJ), (const f32x2*)(ws + WS_ROPE), (float*)(ws + WS_RSQ), (float*)(ws + WS_RSKV), ws};
      pg8::gemm_phase<EpiProj, ProjOrder, false, P2_FP8 != 0>(lds3, g, S, E); } PH_END
    GRID_SYNC();
#endif
    }
#if PH(3)
    REP(3) {
    const bool p3split = (G == 256); const int G3 = p3split ? G - 32 : G, c3 = p3split ? c - 32 : c;
    if (p3split && c < 32) {
    PH_BEGIN { pg8::Gemm g{(const bf16_t*)(ws + WS_HB), P2_FP8 ? 512 : 1024, (const bf16_t*)(ws + WS_WIN), P2_FP8 ? 512 : 1024}; ProjOrder S; S.init(G, c, 1);
      EpiProj E{(bf16_t*)(ws + WS_PJ), (const f32x2*)(ws + WS_ROPE), (float*)(ws + WS_RSQ), (float*)(ws + WS_RSKV), ws};
      pg8::gemm_phase<EpiProj, ProjOrder, false, P2_FP8 != 0>(lds3, g, S, E); } PH_END
    } else {
#ifndef NO_P3A
    PH_BEGIN { pg8::Gemm g{(const bf16_t*)(ws + WS_PJ) + 1536, NPROJ, (const bf16_t*)(ws + WS_WUQ), 256}; PlainOrder S; S.init(MALL / 256, 3, G3, c3, 0);
      EpiQ E{(bf16_t*)(ws + WS_QM), (const f32x2*)(ws + WS_ROPE), (const float*)(ws + WS_RSQ), ws};
      pg8::gemm_phase<EpiQ, PlainOrder>(lds3, g, S, E); } PH_END
#endif
#ifndef NO_P3B
    PH_BEGIN { pg8::Gemm g{(const bf16_t*)(ws + WS_PJ) + 1792, NPROJ, (const bf16_t*)(ws + WS_WUKV), 256}; PlainOrder S; S.init(MALL / 256, 4, G3, c3, 0);
      EpiKV E{(bf16_t*)(ws + WS_KV), (const float*)(ws + WS_RSKV), ws};
      pg8::gemm_phase<EpiKV, PlainOrder>(lds3, g, S, E); } PH_END
#endif
    }
    GRID_SYNC(); }
#endif
#if PH(4)
    REP(4) { PH_BEGIN p4_attention_diff(p, (char*)lds); PH_END
    PH_BEGIN p4_attention_mla(p, (char*)lds); PH_END
    GRID_SYNC(); }
#endif
#if DBG_STAGE == 1
    PH_BEGIN dbg_check_proj(p); PH_END
#elif DBG_STAGE == 2
    PH_BEGIN dbg_check_attn(p, lds, 0); PH_END
#elif DBG_STAGE == 3
    PH_BEGIN dbg_check_attn(p, lds, 1); PH_END
#endif
#if PH(6)
    REP(6) {
    PH_BEGIN { pg8::Gemm g{(const bf16_t*)(ws + WS_MIX), 1024, (const bf16_t*)(ws + WS_WOUT), 1024}; PlainOrder S; S.init(T / 256, 4, G, c, 1);
      EpiOut E{(bf16_t*)(ws + WS_XN), p.x, (const float*)(ws + WS_MODS), (float*)(ws + WS_RSX)};
      pg8::gemm_phase<EpiOut, PlainOrder>(lds3, g, S, E); } PH_END
    GRID_SYNC(); }
#endif
#if PH(7)
#if (REP_MASK >> 11) & 1
    PH_BEGIN p7a_route(p, lds); PH_END
    GRID_SYNC();
    PH_BEGIN if (blockIdx.x == 0 && threadIdx.x < 32) ((unsigned*)(p.ws + WS_CNT))[threadIdx.x] = 0u; PH_END
    GRID_SYNC();
#endif
    PH_BEGIN p7a_route(p, lds); PH_END
    GRID_SYNC();
    REP(12) { PH_BEGIN moe_segments(p, seg); p7b_scatter(p, seg); PH_END }
    GRID_SYNC();
#endif
#if PH(8)
    REP(8) {
    PH_BEGIN { pg8::Gemm g{(const bf16_t*)(ws + WS_HF), 512, (const bf16_t*)(ws + WS_W1), 512, (const int*)(ws + WS_RTOK)}; MoeOrder S{seg, seg[32] >> 8, 8, G, c};
      EpiAct E{ws + WS_ACT, p.b1};
      pg8::gemm_phase<EpiAct, MoeOrder, true, true>(lds3, g, S, E); } PH_END
    GRID_SYNC(); }
#endif
#if PH(9)
    REP(9) {
    PH_BEGIN { pg8::Gemm g{(const bf16_t*)(ws + WS_ACT), 512, (const bf16_t*)(ws + WS_W2), 512}; MoeOrder S{seg, seg[32] >> 8, 4, G, c};
      EpiY E{(bf16_t*)(ws + WS_XS), p.b2, (const float*)(ws + WS_GSRT), (EPIY_PROBE) ? rep_ : 0};
      pg8::gemm_phase<EpiY, MoeOrder, false, true>(lds3, g, S, E); } PH_END
    GRID_SYNC(); }
#endif
#if LAST_PHASE >= 9
    REP(10) { PH_BEGIN p10_final(p, true); PH_END }
#elif LAST_PHASE >= 6
    PH_BEGIN p10_final(p, false); PH_END
#else
    PH_BEGIN { const int lane = threadIdx.x & 63, wave = threadIdx.x >> 6; const int gw = blockIdx.x * NWAVES + wave, NGW = gridDim.x * NWAVES;
      for (int t = gw; t < T; t += NGW) { const f32x4* xr = (const f32x4*)(p.x + (size_t)t * DM) + lane; f32x4 v[4]; float s = 0.f;
#pragma unroll
        for (int j = 0; j < 4; ++j) { v[j] = xr[64 * j]; s += (v[j].x * v[j].x + v[j].y * v[j].y) + (v[j].z * v[j].z + v[j].w * v[j].w); }
        const float r = rsqrtf(wave_sum(s) * (1.f / DM) + EPS); f32x4* o = (f32x4*)(p.out + (size_t)t * DM) + lane;
#pragma unroll
        for (int j = 0; j < 4; ++j) o[64 * j] = v[j] * r * ((const f32x4*)p.final_norm_w)[lane + 64 * j]; } } PH_END
#endif
}

extern "C" void kernel_launch(void* const* d_in, const int* in_sizes, int n_in, void* d_out, int out_size, void* d_ws, size_t ws_size, hipStream_t stream) {
    static int grid = 0;
    if (grid == 0) {
        if (n_in != 26 || in_sizes[0] != T * DM || out_size != T * DM || ws_size < WS_END) {
            fprintf(stderr, "kernel_launch: unexpected shapes: n_in %d in0 %d out %d ws %zu (need %zu)\n", n_in, n_in > 0 ? in_sizes[0] : -1, out_size, ws_size, (size_t)WS_END);
            grid = -1; return; }
        int dev = 0, cus = 0, per_cu = 0;
        (void)hipGetDevice(&dev);
        (void)hipDeviceGetAttribute(&cus, hipDeviceAttributeMultiprocessorCount, dev);
        if (hipFuncSetAttribute((const void*)fwd_kernel, hipFuncAttributeMaxDynamicSharedMemorySize, LDS_BYTES) != hipSuccess) { fprintf(stderr, "kernel_launch: hipFuncSetAttribute failed\n"); grid = -1; return; }
        if (hipOccupancyMaxActiveBlocksPerMultiprocessor(&per_cu, (const void*)fwd_kernel, NTHREADS, LDS_BYTES) != hipSuccess || per_cu < 1) { fprintf(stderr, "kernel_launch: occupancy query failed (%d)\n", per_cu); (void)hipGetLastError(); grid = -1; return; }
        grid = cus;
        if (grid < 128 || grid > 1024) { fprintf(stderr, "kernel_launch: unsupported CU count %d\n", cus); grid = -1; return; }
    }
    if (grid < 0) return;
    Params p{};
    const float** pp = (const float**)&p;
    for (int i = 0; i < 26; ++i) pp[i] = (const float*)d_in[i];
    p.out = (float*)d_out; p.ws = (unsigned char*)d_ws;
    if (hipMemsetAsync((char*)d_ws + WS_BAR, 0, WS_BAR_BYTES, stream) != hipSuccess) { fprintf(stderr, "kernel_launch: hipMemsetAsync failed\n"); return; }
    void* args[] = {&p};
    hipError_t e = hipLaunchCooperativeKernel((const void*)fwd_kernel, dim3(grid), dim3(NTHREADS), args, LDS_BYTES, stream);
    if (e != hipSuccess) fprintf(stderr, "cooperative launch failed: %s (grid %d)\n", hipGetErrorString(e), grid);
}
```

```cpp
#define MLA_NQR 2
#define STAGGER 0
#define ATT8_THRL 3.75f
#include <hip/hip_runtime.h>
#include <hip/hip_cooperative_groups.h>
#include <cstdio>
#include <cstdint>
namespace cg = cooperative_groups;

#ifndef DBG_STAGE
#define DBG_STAGE 0
#endif
#ifndef ATT_EXTRA
#define ATT_EXTRA 0
#define ATT_EXTRA_ROUND0 0
#endif
#ifndef ATT_X
#define ATT_X(cc) ((cc) & 7)
#define ATT_J(cc) ((cc) >> 3)
#endif
#ifndef ATT_FP8
#define ATT_FP8 1
#endif
#ifndef SIM_P2
#define SIM_P2 0
#endif
#ifndef SIM_P6
#define SIM_P6 0
#endif
#ifndef WCONV_IN_ATT
#define WCONV_IN_ATT 1
#endif
#ifndef P7A_VAR
#define P7A_VAR 0
#endif
#ifndef P10_NT
#define P10_NT 4
#endif
#ifndef P2_FP8
#define P2_FP8 1
#endif
#ifndef YS_FP8
#define YS_FP8 1
#endif
constexpr float YS_SCALE = 16.f;
#ifndef STAGGER
#define STAGGER 1
#endif
#ifndef ATT_VAR
#define ATT_VAR 0
#endif
#ifndef LAST_PHASE
#define LAST_PHASE 99
#endif

constexpr int DM = 1024, NB = 4, SEQ = 8192, CTX = 256;
constexpr int T = NB * SEQ;
constexpr int RPB = CTX + SEQ;
constexpr int MALL = NB * RPB;
constexpr int NPROJ = 2048;
constexpr int NEXP = 32, TOPK = 4, DFF = 1024;
constexpr int RMAX = T * TOPK + NEXP * 256;
constexpr float EPS = 1e-6f;
constexpr int NTHREADS = 512, NWAVES = 8;
constexpr float WQ_SCALE = 64.f;
constexpr int LDS_BYTES = 163840;

typedef unsigned short bf16_t;
typedef float f32x4 __attribute__((ext_vector_type(4)));
typedef float f32x2 __attribute__((ext_vector_type(2)));
typedef unsigned u32x4 __attribute__((ext_vector_type(4)));
typedef unsigned u32x2 __attribute__((ext_vector_type(2)));
#define LAS __attribute__((address_space(3)))

constexpr size_t KiB = 1024, MiB = 1u << 20;
constexpr size_t WS_CNT  = 0;
constexpr size_t WS_BAR  = 16 * KiB;
constexpr size_t WS_BAR_BYTES = 16 * KiB;
constexpr size_t WS_MODS = 64 * KiB;
constexpr size_t WS_DUMMY = 192 * KiB;
constexpr size_t WS_ROPE = 256 * KiB;
constexpr size_t WS_RWF  = 320 * KiB;
constexpr size_t WS_RSQ  = 512 * KiB;
constexpr size_t WS_RSKV = 768 * KiB;
constexpr size_t WS_TOPI = 1 * MiB;
constexpr size_t WS_GATE = 1 * MiB + 512 * KiB;
constexpr size_t WS_RANK = 2 * MiB;
constexpr size_t WS_GSRT = 2 * MiB + 512 * KiB;
constexpr size_t WS_RSX  = 3 * MiB + 64 * KiB;
constexpr size_t WS_DEST = 3 * MiB + 256 * KiB;
constexpr size_t WS_WIN  = 4 * MiB;
constexpr size_t WS_WOUT = 8 * MiB;
constexpr size_t WS_WUQ  = 10 * MiB;
constexpr size_t WS_WUKV = 11 * MiB;
constexpr size_t WS_W1   = 12 * MiB;
constexpr size_t WS_W2   = 140 * MiB;
constexpr size_t WS_XN   = 204 * MiB;
constexpr size_t WS_XS   = 332 * MiB;
constexpr size_t WS_ACT  = 604 * MiB;
constexpr size_t WS_HF   = 876 * MiB;
constexpr size_t WS_RTOK = 940 * MiB;
constexpr size_t WS_END  = 941 * MiB;
constexpr size_t WS_HB   = 332 * MiB;
constexpr size_t WS_PJ   = 398 * MiB;
constexpr size_t WS_QM   = 530 * MiB;
constexpr size_t WS_KV   = 580 * MiB;
constexpr size_t WS_AO   = 646 * MiB;
constexpr size_t WS_MIX  = 745 * MiB;
constexpr size_t WS_Q8D  = 646 * MiB;
constexpr size_t WS_K8D  = 663 * MiB;
constexpr size_t WS_VT8D = 680 * MiB;
constexpr size_t WS_KR8  = 697 * MiB;
constexpr size_t WS_Q8M  = 332 * MiB;
constexpr size_t WS_K8M  = 357 * MiB;
constexpr size_t WS_VT8M = 374 * MiB;
static_assert(WS_MIX + (size_t)MALL * 1024 * 2 <= WS_HF && WS_XS + (size_t)RMAX * 2048 <= WS_ACT && WS_ACT + (size_t)RMAX * 2048 <= WS_HF, "ws map");

struct Params {
    const float* x; const float* c; const float* ctx; const float* c_ctx; const float* w_ada; const float* b_ada;
    const float* attn_norm_w; const float* w_in; const float* q_norm_w; const float* kv_norm_w; const float* w_uq; const float* w_ukv;
    const float* lq1; const float* lk1; const float* lq2; const float* lk2; const float* subln_w; const float* w_out;
    const float* ffn_norm_w; const float* router_w; const float* router_b; const float* w1; const float* b1; const float* w2; const float* b2;
    const float* final_norm_w;
    float* out; unsigned char* ws;
};

__device__ __forceinline__ int tid_opaque() { int t = threadIdx.x; asm volatile("" : "+v"(t)); return t; }
__device__ __forceinline__ float wave_sum(float v) {
#pragma unroll
    for (int o = 1; o < 64; o <<= 1) v += __shfl_xor(v, o);
    return v;
}
__device__ __forceinline__ float wave_max(float v) {
#pragma unroll
    for (int o = 1; o < 64; o <<= 1) v = fmaxf(v, __shfl_xor(v, o));
    return v;
}
__device__ __forceinline__ float silu_f(float v) { return v / (1.f + __expf(-v)); }
__device__ __forceinline__ unsigned cvt_pk_bf16(float lo, float hi) { unsigned r; asm volatile("v_cvt_pk_bf16_f32 %0, %1, %2" : "=v"(r) : "v"(lo), "v"(hi)); return r; }
__device__ __forceinline__ unsigned cvt4_fp8o(int old, float a, float b, float c, float d) { int r = __builtin_amdgcn_cvt_pk_fp8_f32(a, b, old, false); r = __builtin_amdgcn_cvt_pk_fp8_f32(c, d, r, true); return (unsigned)r; }
__device__ __forceinline__ unsigned cvt4_fp8(float a, float b, float c, float d) { int r = __builtin_amdgcn_cvt_pk_fp8_f32(a, b, 0, false); r = __builtin_amdgcn_cvt_pk_fp8_f32(c, d, r, true); return (unsigned)r; }
__device__ __forceinline__ float q8(float x) { const int pk = __builtin_amdgcn_cvt_pk_fp8_f32(x, x, 0, false); return __builtin_amdgcn_cvt_f32_fp8(pk, 0); }
#ifdef SIM_FP8_ATT
#define Q8(x) q8(x)
#define PSHIFT 8.f
#else
#define Q8(x) (x)
#define PSHIFT 0.f
#endif
__device__ __forceinline__ unsigned char f2fp8(float x) { return (unsigned char)(__builtin_amdgcn_cvt_pk_fp8_f32(x, x, 0, false) & 0xff); }
__device__ __forceinline__ int vt_pos(int kk) { return ((kk >> 2) & 1) * 32 + (kk >> 5) * 16 + ((kk >> 3) & 3) * 4 + (kk & 3); }
__device__ __forceinline__ unsigned quad_tr_bytes(unsigned w, int j) {
    const unsigned t0 = (unsigned)__builtin_amdgcn_mov_dpp((int)w, 0x00, 0xf, 0xf, true), t1 = (unsigned)__builtin_amdgcn_mov_dpp((int)w, 0x55, 0xf, 0xf, true);
    const unsigned t2 = (unsigned)__builtin_amdgcn_mov_dpp((int)w, 0xaa, 0xf, 0xf, true), t3 = (unsigned)__builtin_amdgcn_mov_dpp((int)w, 0xff, 0xf, 0xf, true);
    const unsigned sel = 0x0c0c0000u | ((4u + (unsigned)j) << 8) | (unsigned)j;
    const unsigned a = __builtin_amdgcn_perm(t1, t0, sel), b = __builtin_amdgcn_perm(t3, t2, sel);
    return __builtin_amdgcn_perm(b, a, 0x05040100u);
}
__device__ __forceinline__ bf16_t f2bf(float f) { return (bf16_t)(cvt_pk_bf16(f, 0.f) & 0xffffu); }
__device__ __forceinline__ float bf2f(bf16_t v) { return __uint_as_float((unsigned)v << 16); }
__device__ __forceinline__ float bflo(unsigned w) { return __uint_as_float(w << 16); }
__device__ __forceinline__ float bfhi(unsigned w) { return __uint_as_float(w & 0xffff0000u); }
#define GAS __attribute__((address_space(1)))
#define RLX_AGENT __ATOMIC_RELAXED, __HIP_MEMORY_SCOPE_AGENT
#define XB_TMO      128
#define XB_XCNT(j)  (256  + 64 * (j))
#define XB_XSUB(j)  (1280 + 64 * (j))
#define XB_XGEN(j)  (2304 + 64 * (j))
#define XB_TOP      3328
#define XB_TOPGEN   3392
#define XCD_BAR_WORDS 3456
#define XB_SPIN_CAP (1u << 18)

__device__ __forceinline__ unsigned xb_ld(unsigned* p)              { return __hip_atomic_load(p, __ATOMIC_RELAXED, __HIP_MEMORY_SCOPE_AGENT); }
__device__ __forceinline__ unsigned xb_add(unsigned* p, unsigned v) { return __hip_atomic_fetch_add(p, v, __ATOMIC_RELAXED, __HIP_MEMORY_SCOPE_AGENT); }
__device__ __forceinline__ unsigned xb_xcc_id() { return (unsigned)__builtin_amdgcn_s_getreg((3 << 11) | 20) & 0xFu; }
#define XB_SPIN(cond, bar) do { unsigned _sp = 0; while (cond) { __builtin_amdgcn_s_sleep(1); \
    if ((++_sp & 255u) == 0u) { if (xb_ld(&(bar)[XB_TMO])) break; if (_sp > XB_SPIN_CAP) { atomicAdd(&(bar)[XB_TMO], 1u); break; } } } } while (0)

struct XcdBarrier {
    unsigned* bar; unsigned x;
    volatile LAS unsigned* st;
};

__device__ __forceinline__ XcdBarrier xcd_barrier_post(unsigned* bar, volatile LAS unsigned* st) {
    XcdBarrier b; b.bar = bar; b.x = xb_xcc_id(); b.st = st;
    if (threadIdx.x == 0) (void)xb_add(&bar[XB_XCNT(b.x)], 1u);
    return b;
}
__device__ __forceinline__ void xcd_barrier_complete(unsigned* bar, unsigned x, unsigned& nloc, unsigned& nx) {
    const unsigned G = gridDim.x * gridDim.y * gridDim.z;
    unsigned sum, cnt, mine, sp = 0u;
    for (;;) {
        sum = 0u; cnt = 0u; mine = 0u;
#pragma unroll
        for (unsigned j = 0; j < 16; ++j) { const unsigned c = xb_ld(&bar[XB_XCNT(j)]); sum += c; cnt += (c > 0u) ? 1u : 0u; mine = (j == x) ? c : mine; }
        if (sum == G) break;
        __builtin_amdgcn_s_sleep(1);
        if ((++sp & 255u) == 0u) { if (xb_ld(&bar[XB_TMO])) break; if (sp > XB_SPIN_CAP) { atomicAdd(&bar[XB_TMO], 1u); break; } }
    }
    nloc = mine > 0u ? mine : 1u; nx = cnt > 0u ? cnt : 1u;
}

__device__ __forceinline__ void xcd_barrier(const XcdBarrier& b) {
    asm volatile("s_waitcnt vmcnt(0)" ::: "memory");
    __syncthreads();
    if (threadIdx.x == 0) {
        unsigned* bar = b.bar;
        __builtin_amdgcn_s_waitcnt(0);
        unsigned nloc = b.st[0], nx = b.st[1];
        if (nloc == 0u) { xcd_barrier_complete(bar, b.x, nloc, nx); b.st[0] = nloc; b.st[1] = nx; }
        const unsigned old = xb_add(&bar[XB_XSUB(b.x)], 1u);
        const unsigned gen = old / nloc;
        if (old + 1u == (gen + 1u) * nloc) {
            __builtin_amdgcn_fence(__ATOMIC_RELEASE, "agent");
            asm volatile("s_waitcnt vmcnt(0)" ::: "memory");
            const unsigned og = xb_add(&bar[XB_TOP], 1u);
            const unsigned tg = og / nx;
            if (og + 1u == (tg + 1u) * nx) xb_add(&bar[XB_TOPGEN], 1u);
            else XB_SPIN(xb_ld(&bar[XB_TOPGEN]) == tg, bar);
            __builtin_amdgcn_fence(__ATOMIC_ACQUIRE, "agent");
            xb_add(&bar[XB_XGEN(b.x)], 1u);
            asm volatile("s_waitcnt vmcnt(0)" ::: "memory");
        } else {
            XB_SPIN(xb_ld(&bar[XB_XGEN(b.x)]) == gen, bar);
            __builtin_amdgcn_fence(__ATOMIC_ACQUIRE, "agent");
            asm volatile("s_waitcnt vmcnt(0)" ::: "memory");
        }
    }
    __syncthreads();
}

__device__ __forceinline__ void p0_mods(const Params& p, float* lds_f, int item) {
    const int tid = tid_opaque();
    float* sc = lds_f;
    float* red = lds_f + 5 * 1024;
    for (int i = tid; i < 5 * 1024; i += NTHREADS) { const int r = i >> 10, k = i & 1023; sc[i] = silu_f(r < 4 ? p.c[r * 1024 + k] : p.c_ctx[k]); }
    __syncthreads();
    const int col = tid & 31, kg = tid >> 5;
    const float* w = p.w_ada + (size_t)(kg * 64) * 6144 + item * 32 + col;
    float a0 = 0, a1 = 0, a2 = 0, a3 = 0, a4 = 0;
#pragma unroll 8
    for (int k = 0; k < 64; ++k) { const float wv = w[(size_t)k * 6144]; const int kk = kg * 64 + k;
        a0 += sc[kk] * wv; a1 += sc[1024 + kk] * wv; a2 += sc[2048 + kk] * wv; a3 += sc[3072 + kk] * wv; a4 += sc[4096 + kk] * wv; }
    red[(kg * 5 + 0) * 32 + col] = a0; red[(kg * 5 + 1) * 32 + col] = a1; red[(kg * 5 + 2) * 32 + col] = a2; red[(kg * 5 + 3) * 32 + col] = a3; red[(kg * 5 + 4) * 32 + col] = a4;
    __syncthreads();
    if (tid < 160) { const int r = tid >> 5, cc = tid & 31; float s = p.b_ada[item * 32 + cc];
        for (int g = 0; g < 16; ++g) s += red[(g * 5 + r) * 32 + cc];
        ((float*)(p.ws + WS_MODS))[r * 6144 + item * 32 + cc] = s; }
    __syncthreads();
}

template <int SIMQ = 0>
__device__ __forceinline__ void p0_tr_item(const float* W, int ldw, bf16_t* WT, int ldk, int k0, int n0, int drow0, const float* kscale, float* scr, int lane) {
    const int nq = (lane & 15) * 4, kr = lane >> 4;
#pragma unroll 4
    for (int i = 0; i < 16; ++i) { const int kk = 4 * i + kr;
        f32x4 v = *(const f32x4*)(W + (size_t)(k0 + kk) * ldw + n0 + nq);
        if (kscale) { const float s = kscale[k0 + kk]; v = v * s; }
        float* d = scr + kk * 65 + nq; d[0] = v.x; d[1] = v.y; d[2] = v.z; d[3] = v.w; }
    asm volatile("s_waitcnt lgkmcnt(0)" ::: "memory");
    const int c = lane & 7;
#pragma unroll
    for (int j = 0; j < 8; ++j) { const int n = (lane >> 3) + 8 * j; const float* s = scr + (8 * c) * 65 + n;
        float w_[8];
#pragma unroll
        for (int i = 0; i < 8; ++i) { w_[i] = s[i * 65]; if (SIMQ) w_[i] = q8(w_[i] * 64.f) * (1.f / 64.f); }
        u32x4 o; o.x = cvt_pk_bf16(w_[0], w_[1]); o.y = cvt_pk_bf16(w_[2], w_[3]); o.z = cvt_pk_bf16(w_[4], w_[5]); o.w = cvt_pk_bf16(w_[6], w_[7]);
        *(u32x4*)(WT + (size_t)(drow0 + n) * ldk + k0 + 8 * c) = o; }
    asm volatile("s_waitcnt lgkmcnt(0)" ::: "memory");
}

__device__ __forceinline__ void p0_tr_item_f8(const float* W, int ldw, unsigned char* WT, int ldk, int k0, int n0, int drow0, const float wscale, float* scr, int lane) {
    const int nq = (lane & 15) * 4, kr = lane >> 4;
#pragma unroll 4
    for (int i = 0; i < 16; ++i) { const int kk = 4 * i + kr;
        const f32x4 v = *(const f32x4*)(W + (size_t)(k0 + kk) * ldw + n0 + nq) * wscale;
        float* d = scr + kk * 65 + nq; d[0] = v.x; d[1] = v.y; d[2] = v.z; d[3] = v.w; }
    asm volatile("s_waitcnt lgkmcnt(0)" ::: "memory");
    const int c = lane & 3;
#pragma unroll
    for (int j = 0; j < 4; ++j) { const int n = (lane >> 2) + 16 * j; const float* s = scr + (16 * c) * 65 + n;
        u32x4 o; o.x = cvt4_fp8(s[0 * 65], s[1 * 65], s[2 * 65], s[3 * 65]); o.y = cvt4_fp8(s[4 * 65], s[5 * 65], s[6 * 65], s[7 * 65]);
        o.z = cvt4_fp8(s[8 * 65], s[9 * 65], s[10 * 65], s[11 * 65]); o.w = cvt4_fp8(s[12 * 65], s[13 * 65], s[14 * 65], s[15 * 65]);
        *(u32x4*)(WT + (size_t)(drow0 + n) * ldk + k0 + 16 * c) = o; }
    asm volatile("s_waitcnt lgkmcnt(0)" ::: "memory");
}

__device__ __forceinline__ void p0_prologue(const Params& p, unsigned char* lds) {
    const int tid = tid_opaque(), lane = tid & 63, wave = tid >> 6;
    unsigned char* ws = p.ws;
    if (blockIdx.x == 0 && tid < 128) ((unsigned*)(ws + WS_CNT))[tid] = 0u;
    if (blockIdx.x == gridDim.x - 1) {
        for (int i = tid; i < 128 * 16; i += NTHREADS) { const int pv = i >> 4, pp = i & 15;
            const float inv = exp2f(-(float)pp * (13.287712379549449f / 16.f));
            const float ang = (float)pv * inv; float sn, cs; sincosf(ang, &sn, &cs);
            ((f32x2*)(ws + WS_ROPE))[i] = (f32x2){cs, sn}; }
    }
    { const int gt = blockIdx.x * NTHREADS + tid;
      if (gt < 4096) { const int l = gt & 63, nb = (gt >> 6) & 1, s = gt >> 7; unsigned hi4[4], lo4[4];
#pragma unroll
        for (int j = 0; j < 4; ++j) { const float w0 = p.router_w[(32 * s + 8 * (l >> 4) + 2 * j) * 32 + 16 * nb + (l & 15)], w1 = p.router_w[(32 * s + 8 * (l >> 4) + 2 * j + 1) * 32 + 16 * nb + (l & 15)];
            const unsigned hw = cvt_pk_bf16(w0, w1); hi4[j] = hw; lo4[j] = cvt_pk_bf16(w0 - bflo(hw), w1 - bfhi(hw)); }
        u32x4* dst = (u32x4*)(ws + WS_RWF) + ((s * 2 + nb) * 2) * 64 + l;
        dst[0] = (u32x4){hi4[0], hi4[1], hi4[2], hi4[3]}; dst[64] = (u32x4){lo4[0], lo4[1], lo4[2], lo4[3]}; } }
    for (int it = blockIdx.x; it < 192; it += gridDim.x) p0_mods(p, (float*)lds, it);
    float* scr = (float*)lds + wave * (64 * 65);
    const int gw = blockIdx.x * NWAVES + wave, NGW = gridDim.x * NWAVES;
    constexpr int I_W1 = WCONV_IN_ATT ? 0 : 32 * 16 * 32, I_W2 = WCONV_IN_ATT ? 0 : 32 * 16 * 16, I_IN = 16 * 31, I_OUT = 16 * 16, I_UQ = 4 * 12, I_UKV = 2 * 16;
    constexpr int NITEMS = I_W1 + I_W2 + I_IN + I_OUT + I_UQ + I_UKV;
    for (int it = gw; it < NITEMS; it += NGW) {
        int r = it;
        if (r < I_W1) { const int e = r >> 9, q = r & 511, kb = q >> 5, nb = q & 31, n0 = nb * 64;
            const int drow = ((n0 & 1023) >> 7) * 256 + (n0 >> 10) * 128 + (n0 & 127);
            p0_tr_item_f8(p.w1 + (size_t)e * 1024 * 2048, 2048, ws + WS_W1 + (size_t)e * 2048 * 1024, 1024, kb * 64, n0, drow, WQ_SCALE, scr, lane); continue; } r -= I_W1;
        if (r < I_W2) { const int e = r >> 8, q = r & 255, kb = q >> 4, nb = q & 15;
            p0_tr_item_f8(p.w2 + (size_t)e * 1024 * 1024, 1024, ws + WS_W2 + (size_t)e * 1024 * 1024, 1024, kb * 64, nb * 64, nb * 64, WQ_SCALE, scr, lane); continue; } r -= I_W2;
        if (r < I_IN) { const int kb = r / 31, nb = r % 31;
#if P2_FP8
            p0_tr_item_f8(p.w_in, 1984, ws + WS_WIN, 1024, kb * 64, nb * 64, nb * 64, WQ_SCALE, scr, lane); continue; } r -= I_IN;
#else
            p0_tr_item<SIM_P2>(p.w_in, 1984, (bf16_t*)(ws + WS_WIN), 1024, kb * 64, nb * 64, nb * 64, nullptr, scr, lane); continue; } r -= I_IN;
#endif
        if (r < I_OUT) { const int kb = r >> 4, nb = r & 15;
            p0_tr_item<SIM_P6>(p.w_out, 1024, (bf16_t*)(ws + WS_WOUT), 1024, kb * 64, nb * 64, nb * 64, nullptr, scr, lane); continue; } r -= I_OUT;
        if (r < I_UQ) { const int kb = r / 12, nb = r % 12;
            p0_tr_item(p.w_uq, 768, (bf16_t*)(ws + WS_WUQ), 256, kb * 64, nb * 64, nb * 64, p.q_norm_w, scr, lane); continue; } r -= I_UQ;
        { const int kb = r >> 4, nb = r & 15;
            p0_tr_item(p.w_ukv, 1024, (bf16_t*)(ws + WS_WUKV), 256, kb * 64, nb * 64, nb * 64, p.kv_norm_w, scr, lane); }
    }
    { const int gt = blockIdx.x * NTHREADS + tid, NGT = gridDim.x * NTHREADS; const u32x4 z = {0u, 0u, 0u, 0u};
      for (int i = gt; i < 64 * (P2_FP8 ? 64 : 128); i += NGT) ((u32x4*)(ws + WS_WIN + (size_t)1984 * (P2_FP8 ? 1024 : 2048)))[i] = z;
      for (int i = gt; i < 1024 * 16; i += NGT) { const int row = i >> 4, ch = i & 15; *(u32x4*)((bf16_t*)(ws + WS_WUKV) + (size_t)row * 256 + 128 + ch * 8) = z; } }
}

__device__ __forceinline__ void p1_rows(const Params& p) {
    const int tid = tid_opaque(), lane = tid & 63, wave = tid >> 6;
    const int gw = blockIdx.x * NWAVES + wave, NGW = gridDim.x * NWAVES;
    const float* mods = (const float*)(p.ws + WS_MODS);
    bf16_t* HB = (bf16_t*)(p.ws + WS_HB);
    { const int gt = blockIdx.x * NTHREADS + tid, NGT = gridDim.x * NTHREADS;
      for (int i = gt; i < MALL; i += NGT) { ((float*)(p.ws + WS_RSQ))[i] = 0.f; ((float*)(p.ws + WS_RSKV))[i] = 0.f; }
      for (int i = gt; i < RMAX; i += NGT) ((int*)(p.ws + WS_RTOK))[i] = 0;
      for (int i = gt; i < T; i += NGT) ((float*)(p.ws + WS_RSX))[i] = 0.f; }
    f32x4 av[4], sv[4]; int curb = -1;
    for (int m0 = __builtin_amdgcn_readfirstlane(gw); m0 < MALL; m0 += 2 * NGW) {
        int mm[2]; bool ok[2]; f32x4 v[2][4];
#pragma unroll
        for (int q = 0; q < 2; ++q) { const int m_ = m0 + q * NGW; ok[q] = m_ < MALL; mm[q] = ok[q] ? m_ : m0;
            const int b = mm[q] / RPB, i = mm[q] - b * RPB; const bool isctx = i < CTX;
            const float* src = isctx ? p.ctx + ((size_t)b * CTX + i) * DM : p.x + ((size_t)b * SEQ + (i - CTX)) * DM;
            const f32x4* xr = (const f32x4*)src + lane;
#pragma unroll
            for (int j = 0; j < 4; ++j) v[q][j] = xr[64 * j]; }
#pragma unroll
        for (int q = 0; q < 2; ++q) { const int m = mm[q], b = m / RPB, i = m - b * RPB; const int bsel = i < CTX ? 4 : b;
            if (bsel != curb) { curb = bsel; const float* md = mods + bsel * 6144;
#pragma unroll
                for (int j = 0; j < 4; ++j) { av[j] = ((const f32x4*)p.attn_norm_w)[lane + 64 * j] * (((const f32x4*)(md + 1024))[lane + 64 * j] + 1.f); sv[j] = ((const f32x4*)md)[lane + 64 * j]; } }
            float s = 0.f;
#pragma unroll
            for (int j = 0; j < 4; ++j) s += (v[q][j].x * v[q][j].x + v[q][j].y * v[q][j].y) + (v[q][j].z * v[q][j].z + v[q][j].w * v[q][j].w);
            const float r = rsqrtf(wave_sum(s) * (1.f / DM) + EPS);
#if P2_FP8
            if (ok[q]) { unsigned* o = (unsigned*)((unsigned char*)HB + (size_t)m * DM) + lane;
#pragma unroll
                for (int j = 0; j < 4; ++j) { const f32x4 h = v[q][j] * r * av[j] + sv[j]; o[64 * j] = cvt4_fp8(h.x, h.y, h.z, h.w); } }
#else
            if (ok[q]) { u32x2* o = (u32x2*)(HB + (size_t)m * DM) + lane;
#pragma unroll
                for (int j = 0; j < 4; ++j) { const f32x4 h = v[q][j] * r * av[j] + sv[j];
                    f32x4 hq = h; if (SIM_P2) hq = (f32x4){q8(h.x), q8(h.y), q8(h.z), q8(h.w)};
                    u32x2 pk; pk.x = cvt_pk_bf16(hq.x, hq.y); pk.y = cvt_pk_bf16(hq.z, hq.w); o[64 * j] = pk; } }
#endif
        }
    }
}
namespace pg8 {
typedef short bf16x8 __attribute__((ext_vector_type(8)));
typedef int v4i32_t __attribute__((ext_vector_type(4)));
typedef int v8i32_t __attribute__((ext_vector_type(8)));
constexpr int BM = 256, BK = 64, HALF = 128, HTB = HALF * BK * 2  , STAGE_BYTES = 8 * HTB;
__host__ __device__ __forceinline__ int lds_byte(int r, int c) { const int st = (r >> 4) * 2 + (c >> 5), rr = r & 15, cc = c & 31, ob = rr * 64 + cc * 2; return st * 1024 + (ob ^ (((ob >> 9) & 1) << 5)); }
__host__ __device__ __forceinline__ void stage_rc(int b, int& R, int& C) { const int st = b / 1024, sb = b % 1024, swz = sb ^ (((sb >> 9) & 1) << 5); R = (st >> 1) * 16 + swz / 64; C = (st & 1) * 32 + (swz % 64) / 2; }

struct Unit { int am, bn, pm, pn, e; };
struct Gemm { const bf16_t* A; int lda; const bf16_t* Bt; int K; const int* rowtok; };

template <class Epi, class Sched, bool GATHER = false, bool FP8 = false, bool ALIGN_EPI = true>
__device__ __forceinline__ void gemm_phase(LAS unsigned char* lds, const Gemm g, const Sched& S, const Epi& E) {
    const int tid = tid_opaque(), wid = __builtin_amdgcn_readfirstlane(tid >> 6), lane = tid & 63, wr = wid >> 2, wc = wid & 3, fr = lane & 15, fq = lane >> 4;
    const int K = g.K, lda = g.lda; int nt = K / BK; asm volatile("" : "+s"(nt));
    unsigned voffA[2], voffB[2];
#pragma unroll
    for (int i = 0; i < 2; ++i) { int R, C; stage_rc(tid * 16 + i * 8192, R, C);
        voffA[i] = (unsigned)(R * lda + C) * 2u; voffB[i] = (unsigned)(R * K + C) * 2u; }
    unsigned vA0[2], vA1[2];
    LAS u32x4* gnx = (LAS u32x4*)(lds + STAGE_BYTES + 4096) + tid;
#define PG8_GOFF(AM, o00, o01, o10, o11) do { int t_ = tid; asm volatile("" : "+v"(t_)); int R0_, C0_, R1_, C1_; stage_rc(t_ * 16, R0_, C0_); stage_rc(t_ * 16 + 8192, R1_, C1_); \
        const int* rt_ = g.rowtok + (AM) * 256; const unsigned lb_ = (unsigned)(lda * 2); \
        o00 = (unsigned)rt_[R0_] * lb_ + (unsigned)(C0_ * 2); o01 = (unsigned)rt_[R1_] * lb_ + (unsigned)(C1_ * 2); o10 = (unsigned)rt_[128 + R0_] * lb_ + (unsigned)(C0_ * 2); o11 = (unsigned)rt_[128 + R1_] * lb_ + (unsigned)(C1_ * 2); } while (0)
#define PG8_STAGE_A(bufoff, soff, h, W0, W1) do { PG8_STAGE(bufoff, rA, soff, ((h) ? W1 : W0)); } while (0)
    const unsigned kstep = (unsigned)(BK * 2);
    const unsigned hstepA = (unsigned)(HALF * lda * 2), hstepB = (unsigned)(HALF * K * 2);
    const unsigned tstepA = 2 * hstepA, tstepB = 2 * hstepB;
    const __amdgpu_buffer_rsrc_t rA = __builtin_amdgcn_make_buffer_rsrc((void*)g.A, 0, 0xffffffff, 0x00020000), rB = __builtin_amdgcn_make_buffer_rsrc((void*)g.Bt, 0, 0xffffffff, 0x00020000);
    const unsigned ldsw = (unsigned)wid * 1024u;
    const int aoff = lds_byte(wr * 64 + fr, fq * 8), boff = lds_byte(wc * 32 + fr, fq * 8);
#define PG8_SA(b, h) (((b) * 2 + (h)) * HTB)
#define PG8_SB(b, h) ((4 + (b) * 2 + (h)) * HTB)
#define PG8_STAGE(bufoff, rs, soff, voff) do { _Pragma("unroll") for (int _i = 0; _i < 2; ++_i) \
        __builtin_amdgcn_raw_ptr_buffer_load_lds(rs, (LAS unsigned*)(lds + (bufoff) + ldsw + _i * 8192), 16, (int)(voff)[_i], (int)(soff), 0, 0); } while (0)
#define PG8_LDA(dst, b, h) do { _Pragma("unroll") for (int m = 0; m < 4; ++m) { const v4i32_t lo_ = *(const LAS v4i32_t*)(lds + PG8_SA(b, h) + aoff + m * 2048), hi_ = *(const LAS v4i32_t*)(lds + PG8_SA(b, h) + aoff + m * 2048 + 1024); \
        dst[m] = __builtin_shufflevector(lo_, hi_, 0, 1, 2, 3, 4, 5, 6, 7); } } while (0)
#define PG8_LDB(dst, b, h) do { _Pragma("unroll") for (int n = 0; n < 2; ++n) { const v4i32_t lo_ = *(const LAS v4i32_t*)(lds + PG8_SB(b, h) + boff + n * 2048), hi_ = *(const LAS v4i32_t*)(lds + PG8_SB(b, h) + boff + n * 2048 + 1024); \
        dst[n] = __builtin_shufflevector(lo_, hi_, 0, 1, 2, 3, 4, 5, 6, 7); } } while (0)
#define PG8_LO(x) __builtin_bit_cast(bf16x8, __builtin_shufflevector(x, x, 0, 1, 2, 3))
#define PG8_HI(x) __builtin_bit_cast(bf16x8, __builtin_shufflevector(x, x, 4, 5, 6, 7))
#define PG8_MMA(ai, bj, At, Bt) do { __builtin_amdgcn_s_setprio(1); _Pragma("unroll") for (int m = 0; m < 4; ++m) _Pragma("unroll") for (int n = 0; n < 2; ++n) { \
        if constexpr (FP8) acc[ai][bj][m][n] = __builtin_amdgcn_mfma_scale_f32_16x16x128_f8f6f4(Bt[n], At[m], acc[ai][bj][m][n], 0, 0, 0, 0, 0, 0)    ; \
        else { acc[ai][bj][m][n] = __builtin_amdgcn_mfma_f32_16x16x32_bf16(PG8_LO(Bt[n]), PG8_LO(At[m]), acc[ai][bj][m][n], 0, 0, 0); \
               acc[ai][bj][m][n] = __builtin_amdgcn_mfma_f32_16x16x32_bf16(PG8_HI(Bt[n]), PG8_HI(At[m]), acc[ai][bj][m][n], 0, 0, 0); } } __builtin_amdgcn_s_setprio(0); } while (0)
#define PG8_WAIT_V(n) asm volatile("s_waitcnt vmcnt(" #n ")" ::: "memory")
#define PG8_STR_(x) #x
#define PG8_XSTR_(x) PG8_STR_(x)
#define PG8_WAIT_V8X() do { if (relax) asm volatile("s_waitcnt vmcnt(%0)" :: "n"(8 + Epi::NST) : "memory"); else asm volatile("s_waitcnt vmcnt(8)" ::: "memory"); } while (0)
#define PG8_WAIT_L(n) asm volatile("s_waitcnt lgkmcnt(" #n ")" ::: "memory")
#define PG8_BAR __builtin_amdgcn_s_barrier()
#define PG8_SCHED __builtin_amdgcn_sched_barrier(0)
    Unit cur, nxt; int ui = 0;
    if (!S.next(0, cur)) return;
    f32x4 acc[2][2][4][2];
#pragma unroll
    for (int a = 0; a < 2; ++a)
#pragma unroll
        for (int b = 0; b < 2; ++b)
#pragma unroll
            for (int m = 0; m < 4; ++m)
#pragma unroll
                for (int n = 0; n < 2; ++n) acc[a][b][m][n] = (f32x4){0.f, 0.f, 0.f, 0.f};
    v8i32_t At[4], B0[2], B1[2];
    unsigned cA = GATHER ? 0u : (unsigned)cur.am * tstepA, cB = (unsigned)cur.bn * tstepB;
    if constexpr (GATHER) { PG8_GOFF(cur.am, vA0[0], vA0[1], vA1[0], vA1[1]); }
    else { vA0[0] = voffA[0]; vA0[1] = voffA[1]; vA1[0] = voffA[0] + hstepA; vA1[1] = voffA[1] + hstepA; }
    PG8_STAGE(PG8_SB(0, 0), rB, cB, voffB); PG8_STAGE(PG8_SB(0, 1), rB, cB + hstepB, voffB); PG8_STAGE_A(PG8_SA(0, 0), cA, 0, vA0, vA1); PG8_STAGE_A(PG8_SA(0, 1), cA, 1, vA0, vA1);
    if (wr == 1) PG8_BAR;
    PG8_WAIT_V(2); PG8_BAR;
    PG8_STAGE(PG8_SB(1, 0), rB, cB + kstep, voffB); PG8_STAGE_A(PG8_SA(1, 0), cA + kstep, 0, vA0, vA1); PG8_STAGE(PG8_SB(1, 1), rB, cB + hstepB + kstep, voffB);
    PG8_WAIT_V(6); PG8_BAR;
    for (;;) {
        const bool has_next = S.next(ui + 1, nxt);
        const unsigned nA = (has_next && !GATHER) ? (unsigned)nxt.am * tstepA : cA, nB = has_next ? (unsigned)nxt.bn * tstepB : cB;
        if constexpr (GATHER) { const int am_ = has_next ? nxt.am : cur.am; u32x4 nv_; PG8_GOFF(am_, nv_.x, nv_.y, nv_.z, nv_.w); *gnx = nv_; }
        for (int t = 0; t < nt; t += 2) {
            const bool last = (t == nt - 2); const bool relax = Epi::NST > 0 && t == 0 && ui > 0;
            const unsigned a1 = cA + (unsigned)(t + 1) * kstep;
            const unsigned a2 = last ? nA : cA + (unsigned)(t + 2) * kstep, b2 = last ? nB : cB + (unsigned)(t + 2) * kstep;
            const unsigned a3 = a2 + kstep, b3 = b2 + kstep;
            if constexpr (GATHER) { if (last) { const u32x4 nv_ = *gnx; vA0[0] = nv_.x; vA0[1] = nv_.y; }
            } else if constexpr (FP8) { if (last) asm volatile("s_nop 0"); }
            PG8_LDB(B0, 0, 0); PG8_LDB(B1, 0, 1); PG8_SCHED; PG8_LDA(At, 0, 0); PG8_STAGE_A(PG8_SA(1, 1), a1, 1, vA0, vA1);
            PG8_WAIT_V8X(); PG8_WAIT_L(0); PG8_BAR; PG8_MMA(0, 0, At, B0); PG8_MMA(0, 1, At, B1); PG8_BAR; PG8_SCHED;
            PG8_LDA(At, 0, 1); PG8_STAGE(PG8_SB(0, 0), rB, b2, voffB); PG8_STAGE(PG8_SB(0, 1), rB, b2 + hstepB, voffB); PG8_STAGE_A(PG8_SA(0, 0), a2, 0, vA0, vA1);
            if constexpr (GATHER) { if (last) { const u32x4 nv_ = *gnx; vA1[0] = nv_.z; vA1[1] = nv_.w; } }
            else if constexpr (FP8) { if (last) asm volatile("s_nop 0"); }
            PG8_WAIT_V8X(); PG8_WAIT_L(0); PG8_BAR; PG8_MMA(1, 0, At, B0); PG8_MMA(1, 1, At, B1); PG8_BAR; PG8_SCHED;
            PG8_LDB(B0, 1, 0); PG8_LDB(B1, 1, 1); PG8_SCHED; PG8_LDA(At, 1, 0); PG8_STAGE_A(PG8_SA(0, 1), a2, 1, vA0, vA1);
            PG8_WAIT_V(8); PG8_WAIT_L(0); PG8_BAR; PG8_MMA(0, 0, At, B0); PG8_MMA(0, 1, At, B1); PG8_BAR; PG8_SCHED;
            PG8_LDA(At, 1, 1); PG8_STAGE(PG8_SB(1, 0), rB, b3, voffB); PG8_STAGE(PG8_SB(1, 1), rB, b3 + hstepB, voffB); PG8_STAGE_A(PG8_SA(1, 0), a3, 0, vA0, vA1);
            PG8_WAIT_V(8); PG8_WAIT_L(0); PG8_BAR; PG8_MMA(1, 0, At, B0); PG8_MMA(1, 1, At, B1); PG8_BAR; PG8_SCHED;
        }
        if constexpr (ALIGN_EPI) { if (wr == 0) PG8_BAR; }
        PG8_SCHED;
        { int fr_ = fr, fq_ = fq; asm volatile("" : "+v"(fr_), "+v"(fq_));
          E(acc, cur, wr, wc, fr_, fq_); }
        if (!has_next) break;
#pragma unroll
        for (int a = 0; a < 2; ++a)
#pragma unroll
            for (int b = 0; b < 2; ++b)
#pragma unroll
                for (int m = 0; m < 4; ++m)
#pragma unroll
                    for (int n = 0; n < 2; ++n) acc[a][b][m][n] = (f32x4){0.f, 0.f, 0.f, 0.f};
        cur = nxt; cA = nA; cB = nB; ++ui;
        if constexpr (ALIGN_EPI) { if (wr == 1) PG8_BAR; }
    }
    PG8_WAIT_V(0);
    if constexpr (!ALIGN_EPI) { if (wr == 0) PG8_BAR; }
    PG8_BAR;
#undef PG8_SA
#undef PG8_SB
#undef PG8_STAGE
#undef PG8_STAGE_A
#undef PG8_GOFF
#undef PG8_LDA
#undef PG8_LDB
#undef PG8_MMA
#undef PG8_LO
#undef PG8_HI
#undef PG8_WAIT_V
#undef PG8_WAIT_V8X
#undef PG8_WAIT_L
#undef PG8_BAR
#undef PG8_SCHED
}
}
struct PlainOrder {
    int nM, nN, nwg, G, c, latent_only;
    __device__ void init(int nM_, int nN_, int G_, int c_, int latent_only_) { nM = nM_; nN = nN_; nwg = nM * nN; G = G_; c = c_; latent_only = latent_only_; }
    __device__ bool next(int i, pg8::Unit& u) const {
        const long L = (long)i * G + c; if (L >= nwg) return false;
        int wgid = (int)L; { const int q = nwg / 8, r = nwg % 8, xcd = wgid % 8, off = wgid / 8; wgid = (xcd < r ? xcd * (q + 1) : r * (q + 1) + (xcd - r) * q) + off; }
        const int WGM = 8, nig = WGM * nN, gid = wgid / nig, fm = gid * WGM, gsz = (nM - fm) < WGM ? (nM - fm) : WGM;
        const int pm = fm + ((wgid % nig) % gsz), pn = (wgid % nig) / gsz;
        u.pm = pm; u.pn = pn; u.e = 0; u.bn = pn;
        u.am = latent_only ? (pm >> 5) * 33 + 1 + (pm & 31) : pm;
        return true;
    }
};
struct ProjOrder {
    PlainOrder P; int G, c, part, split;
    __device__ void init(int G_, int c_, int part_) { G = G_; c = c_; part = part_; split = (G_ == 256); P.init(MALL / 256, 7, G_, c_, 0); }
    __device__ bool next(int i, pg8::Unit& u) const {
        int pm, pn;
        if (part == 0) { const long L = (long)i * G + c; if (L >= (split ? 1024 : 1056)) return false;
            if (L < 924) { if (!P.next(i, u)) return false; pm = u.pm; pn = u.pn + 1; } else { pm = (int)L - 924; pn = 0; } }
        else { if (!split || i > 0 || c >= 32) return false; pm = 100 + c; pn = 0; }
        u.pm = pm; u.pn = pn; u.e = 0; u.bn = pn; u.am = pm; return true;
    }
};
struct MoeOrder {
    const int* seg; int NT, ncol, G, c;
    __device__ bool next(int i, pg8::Unit& u) const {
        int rt, pn;
        if (G == 256) { const int x = c & 7, s = c >> 3;
            if (ncol == 8) { rt = i * 32 + x * 4 + (s >> 3); pn = s & 7; } else { rt = i * 64 + x * 8 + (s >> 2); pn = s & 3; } }
        else { const long L = (long)i * G + c; rt = (int)(L / ncol); pn = (int)(L % ncol); }
        if (rt >= NT) return false;
        const int r0 = rt * 256; int e = 0;
        while (e < 31 && r0 >= seg[e + 1]) ++e;
        u.am = rt; u.pm = rt; u.pn = pn; u.e = e; u.bn = e * ncol + pn; return true;
    }
};

typedef f32x4 AccT[2][2][4][2];
constexpr float QSCALE_DIFF = 0.125f * 1.4426950408889634f;
constexpr float QSCALE_MLA = 0.07216878364870322f * 1.4426950408889634f;
struct EpiProj {
    static constexpr int NST = 0;
    bf16_t* PJ; const f32x2* rope; float* rsq; float* rskv; unsigned char* ws;
    __device__ __forceinline__ void operator()(const AccT& acc, const pg8::Unit& u, int wr, int wc, int fr, int fq) const {
        const int pm = u.pm, pn = u.pn; const bool latent = (pm % 33) != 0;
        const int a = wc & 1;
#pragma unroll
        for (int ai = 0; ai < 2; ++ai)
#pragma unroll
            for (int m = 0; m < 4; ++m) {
                const int row = pm * 256 + ai * 128 + wr * 64 + m * 16 + fr;
                const int i = row % RPB, pos = i - CTX, pv = a ? (pos & 63) : (pos >> 6);
                float ss = 0.f;
#pragma unroll
                for (int bj = 0; bj < 2; ++bj) {
                    f32x4 v0 = acc[ai][bj][m][0] * (P2_FP8 ? 1.f / WQ_SCALE : 1.f), v1 = acc[ai][bj][m][1] * (P2_FP8 ? 1.f / WQ_SCALE : 1.f);
                    if (pn == 6 || (pn == 7 && bj == 0)) ss += (v0.x * v0.x + v0.y * v0.y) + (v0.z * v0.z + v0.w * v0.w) + (v1.x * v1.x + v1.y * v1.y) + (v1.z * v1.z + v1.w * v1.w);
                    if (pn < 2) { v0 = v0 * QSCALE_DIFF; v1 = v1 * QSCALE_DIFF; }
                    const bool rp = latent && (pn < 4 || (pn == 7 && bj == 1 && wc < 2));
                    if (rp) { const f32x4* t = (const f32x4*)(rope + pv * 16 + 4 * fq); const f32x4 t0 = t[0], t1 = t[1];
                        const f32x4 cs = {t0.x, t0.z, t1.x, t1.z}, sn = {t0.y, t0.w, t1.y, t1.w};
                        const f32x4 o0 = v0 * cs - v1 * sn, o1 = v1 * cs + v0 * sn; v0 = o0; v1 = o1; }
#ifdef SIM_FP8_ATT
                    if (pn < 6 || (pn == 7 && bj == 1 && wc < 2)) { v0 = (f32x4){q8(v0.x), q8(v0.y), q8(v0.z), q8(v0.w)}; v1 = (f32x4){q8(v1.x), q8(v1.y), q8(v1.z), q8(v1.w)}; }
#endif
#if ATT_FP8
                    const int cl = (pn & 1) * 256 + bj * 128 + wc * 32 + 4 * fq;
                    if (pn < 4) { unsigned char* d8 = ws + (pn < 2 ? WS_Q8D : WS_K8D) + (size_t)row * 512 + cl;
                        *(unsigned*)d8 = cvt4_fp8(v0.x, v0.y, v0.z, v0.w); *(unsigned*)(d8 + 16) = cvt4_fp8(v1.x, v1.y, v1.z, v1.w); }
                    else if (pn < 6) { const int b_ = row / RPB, i_ = row - b_ * RPB, hh = cl >> 7, e0 = cl & 127;
                        unsigned char* d8 = ws + WS_VT8D + ((size_t)(b_ * 4 + hh) * 128 + e0 + (fr & 3)) * RPB + (i_ & ~63) + vt_pos(i_ & 60);
                        *(unsigned*)d8 = quad_tr_bytes(cvt4_fp8(v0.x, v0.y, v0.z, v0.w), fr & 3); *(unsigned*)(d8 + 16 * RPB) = quad_tr_bytes(cvt4_fp8(v1.x, v1.y, v1.z, v1.w), fr & 3); }
                    else if (pn == 7 && bj == 1 && wc < 2) { unsigned char* d8 = ws + WS_KR8 + (size_t)row * 64 + wc * 32 + 4 * fq;
                        *(unsigned*)d8 = cvt4_fp8(v0.x, v0.y, v0.z, v0.w); *(unsigned*)(d8 + 16) = cvt4_fp8(v1.x, v1.y, v1.z, v1.w); }
                    if (pn >= 6)
#endif
                    { bf16_t* dst = PJ + (size_t)row * NPROJ + pn * 256 + bj * 128 + wc * 32 + 4 * fq;
                    u32x2 w0, w1; w0.x = cvt_pk_bf16(v0.x, v0.y); w0.y = cvt_pk_bf16(v0.z, v0.w); w1.x = cvt_pk_bf16(v1.x, v1.y); w1.y = cvt_pk_bf16(v1.z, v1.w);
                    *(u32x2*)dst = w0; *(u32x2*)(dst + 16) = w1; }
                }
                if (pn >= 6) { ss += __shfl_xor(ss, 16); ss += __shfl_xor(ss, 32); if (fq == 0) atomicAdd((pn == 6 ? rsq : rskv) + row, ss); }
                asm volatile("" ::: "memory");
            }
    }
};
struct EpiQ {
    static constexpr int NST = 0;
    bf16_t* QM; const f32x2* rope; const float* rsq; unsigned char* ws;
    __device__ __forceinline__ void operator()(const AccT& acc, const pg8::Unit& u, int wr, int wc, int fr, int fq) const {
        const int pm = u.pm, pn = u.pn; const bool latent = (pm % 33) != 0;
#pragma unroll
        for (int ai = 0; ai < 2; ++ai)
#pragma unroll
            for (int m = 0; m < 4; ++m) {
                const int row = pm * 256 + ai * 128 + wr * 64 + m * 16 + fr;
                const float rq = rsqrtf(rsq[row] * (1.f / 256.f) + EPS);
                const int i = row % RPB, pos = i - CTX;
#pragma unroll
                for (int bj = 0; bj < 2; ++bj) {
                    f32x4 v0 = acc[ai][bj][m][0] * rq, v1 = acc[ai][bj][m][1] * rq;
                    const int g6 = (pn * 8 + bj * 4 + wc) % 6;
                    if (latent && g6 >= 4) { const int pv = (g6 == 5) ? (pos & 63) : (pos >> 6);
                        const f32x4* t = (const f32x4*)(rope + pv * 16 + 4 * fq); const f32x4 t0 = t[0], t1 = t[1];
                        const f32x4 cs = {t0.x, t0.z, t1.x, t1.z}, sn = {t0.y, t0.w, t1.y, t1.w};
                        const f32x4 o0 = v0 * cs - v1 * sn, o1 = v1 * cs + v0 * sn; v0 = o0; v1 = o1; }
#ifdef SIM_FP8_ATT
                    v0 = (f32x4){q8(v0.x), q8(v0.y), q8(v0.z), q8(v0.w)}; v1 = (f32x4){q8(v1.x), q8(v1.y), q8(v1.z), q8(v1.w)};
#endif
#if ATT_FP8
                    { unsigned char* d8 = ws + WS_Q8M + (size_t)row * 768 + pn * 256 + bj * 128 + wc * 32 + 4 * fq; v0 = v0 * QSCALE_MLA; v1 = v1 * QSCALE_MLA;
                      *(unsigned*)d8 = cvt4_fp8(v0.x, v0.y, v0.z, v0.w); *(unsigned*)(d8 + 16) = cvt4_fp8(v1.x, v1.y, v1.z, v1.w); }
#else
                    bf16_t* dst = QM + (size_t)row * 768 + pn * 256 + bj * 128 + wc * 32 + 4 * fq;
                    u32x2 w0, w1; w0.x = cvt_pk_bf16(v0.x, v0.y); w0.y = cvt_pk_bf16(v0.z, v0.w); w1.x = cvt_pk_bf16(v1.x, v1.y); w1.y = cvt_pk_bf16(v1.z, v1.w);
                    *(u32x2*)dst = w0; *(u32x2*)(dst + 16) = w1;
#endif
                }
            }
    }
};
struct EpiKV {
    static constexpr int NST = 0;
    bf16_t* KV; const float* rskv; unsigned char* ws;
    __device__ __forceinline__ void operator()(const AccT& acc, const pg8::Unit& u, int wr, int wc, int fr, int fq) const {
        const int pm = u.pm, pn = u.pn;
#pragma unroll
        for (int ai = 0; ai < 2; ++ai)
#pragma unroll
            for (int m = 0; m < 4; ++m) {
                const int row = pm * 256 + ai * 128 + wr * 64 + m * 16 + fr;
                const float rk = rsqrtf(rskv[row] * (1.f / 128.f) + EPS);
#pragma unroll
                for (int bj = 0; bj < 2; ++bj) {
                    f32x4 v0 = acc[ai][bj][m][0] * rk, v1 = acc[ai][bj][m][1] * rk;
#ifdef SIM_FP8_ATT
                    v0 = (f32x4){q8(v0.x), q8(v0.y), q8(v0.z), q8(v0.w)}; v1 = (f32x4){q8(v1.x), q8(v1.y), q8(v1.z), q8(v1.w)};
#endif
#if ATT_FP8
                    if (bj == 0) { unsigned char* d8 = ws + WS_K8M + (size_t)row * 512 + pn * 128 + wc * 32 + 4 * fq;
                        *(unsigned*)d8 = cvt4_fp8(v0.x, v0.y, v0.z, v0.w); *(unsigned*)(d8 + 16) = cvt4_fp8(v1.x, v1.y, v1.z, v1.w); }
                    else { const int b_ = row / RPB, i_ = row - b_ * RPB, e0 = wc * 32 + 4 * fq;
                        unsigned char* d8 = ws + WS_VT8M + ((size_t)(b_ * 4 + pn) * 128 + e0 + (fr & 3)) * RPB + (i_ & ~63) + vt_pos(i_ & 60);
                        *(unsigned*)d8 = quad_tr_bytes(cvt4_fp8(v0.x, v0.y, v0.z, v0.w), fr & 3); *(unsigned*)(d8 + 16 * RPB) = quad_tr_bytes(cvt4_fp8(v1.x, v1.y, v1.z, v1.w), fr & 3); }
#else
                    bf16_t* dst = KV + (size_t)row * 1024 + pn * 256 + bj * 128 + wc * 32 + 4 * fq;
                    u32x2 w0, w1; w0.x = cvt_pk_bf16(v0.x, v0.y); w0.y = cvt_pk_bf16(v0.z, v0.w); w1.x = cvt_pk_bf16(v1.x, v1.y); w1.y = cvt_pk_bf16(v1.z, v1.w);
                    *(u32x2*)dst = w0; *(u32x2*)(dst + 16) = w1;
#endif
                }
            }
    }
};
struct EpiOut {
    static constexpr int NST = 0;
    bf16_t* XN; const float* x; const float* mods; float* rsx;
    __device__ __forceinline__ void operator()(const AccT& acc, const pg8::Unit& u, int wr, int wc, int fr, int fq) const {
        const int pm = u.pm, pn = u.pn, b = pm >> 5;
        const float* ga = mods + b * 6144 + 2 * 1024;
        float ssr[2][4];
#pragma unroll
        for (int ai = 0; ai < 2; ++ai)
#pragma unroll
            for (int m = 0; m < 4; ++m) ssr[ai][m] = 0.f;
#pragma unroll
        for (int bj = 0; bj < 2; ++bj) { const int cb = pn * 256 + bj * 128 + wc * 32;
            const f32x4 gv0 = *(const f32x4*)(ga + cb + 4 * fq), gv1 = *(const f32x4*)(ga + cb + 16 + 4 * fq);
#pragma unroll
            for (int ai = 0; ai < 2; ++ai)
#pragma unroll
                for (int m = 0; m < 4; ++m) { const size_t ro = (size_t)(pm * 256 + ai * 128 + wr * 64 + m * 16 + fr) * DM + cb;
                    const f32x4 v0 = *(const f32x4*)(x + ro + 4 * fq) + gv0 * acc[ai][bj][m][0], v1 = *(const f32x4*)(x + ro + 16 + 4 * fq) + gv1 * acc[ai][bj][m][1];
                    ssr[ai][m] += ((v0.x * v0.x + v0.y * v0.y) + (v0.z * v0.z + v0.w * v0.w)) + ((v1.x * v1.x + v1.y * v1.y) + (v1.z * v1.z + v1.w * v1.w));
                    unsigned ax = cvt_pk_bf16(v0.x, v0.y), ay = cvt_pk_bf16(v0.z, v0.w), bx = cvt_pk_bf16(v1.x, v1.y), by = cvt_pk_bf16(v1.z, v1.w);
                    { auto r_ = __builtin_amdgcn_permlane32_swap(ax, bx, false, false); ax = r_[0]; bx = r_[1]; } { auto r_ = __builtin_amdgcn_permlane32_swap(ay, by, false, false); ay = r_[0]; by = r_[1]; }
                    { auto r_ = __builtin_amdgcn_permlane16_swap(ax, bx, false, false); ax = r_[0]; bx = r_[1]; } { auto r_ = __builtin_amdgcn_permlane16_swap(ay, by, false, false); ay = r_[0]; by = r_[1]; }
                    *(u32x4*)(XN + ro + 8 * fq) = (u32x4){ax, ay, bx, by}; } }
#pragma unroll
        for (int ai = 0; ai < 2; ++ai)
#pragma unroll
            for (int m = 0; m < 4; ++m) { float s = ssr[ai][m]; s += __shfl_xor(s, 16); s += __shfl_xor(s, 32);
                if (fq == 0) atomicAdd(rsx + pm * 256 + ai * 128 + wr * 64 + m * 16 + fr, s); }
    }
};
struct EpiAct {
    static constexpr int NST = 16;
    unsigned char* ACT; const float* b1;
    __device__ __forceinline__ void operator()(const AccT& acc, const pg8::Unit& u, int wr, int wc, int fr, int fq) const {
        const int pm = u.pm, pn = u.pn; const float* bb = b1 + (size_t)u.e * 2048;
#pragma unroll
        for (int n = 0; n < 2; ++n) { const int col = pn * 128 + wc * 32 + n * 16 + 4 * fq; const f32x4 bg = *(const f32x4*)(bb + col), bu = *(const f32x4*)(bb + 1024 + col);
#pragma unroll
            for (int ai = 0; ai < 2; ++ai)
#pragma unroll
                for (int m = 0; m < 4; ++m) { const int row = pm * 256 + ai * 128 + wr * 64 + m * 16 + fr;
                    const f32x4 gq = acc[ai][0][m][n] * (1.f / WQ_SCALE) + bg, uq = acc[ai][1][m][n] * (1.f / WQ_SCALE) + bu; float o[4];
#pragma unroll
                    for (int e = 0; e < 4; ++e) { const float gg = fminf(gq[e], 7.f), uu = fminf(fmaxf(uq[e], -7.f), 7.f);
                        o[e] = gg * __builtin_amdgcn_rcpf(1.f + __builtin_amdgcn_exp2f(gg * (-1.702f * 1.4426950408889634f))) * (uu + 1.f); }
                    *(unsigned*)(ACT + (size_t)row * 1024 + col) = cvt4_fp8(o[0], o[1], o[2], o[3]); } }
    }
};
struct EpiY {
    static constexpr int NST = 16;
    bf16_t* YS; const float* b2; const float* gsrt; int mode = 0;
    __device__ __forceinline__ void operator()(const AccT& acc, const pg8::Unit& u, int wr, int wc, int fr, int fq) const {
        const int pm = u.pm, pn = u.pn; const float* bb = b2 + (size_t)u.e * 1024;
        float gt[2][4];
#pragma unroll
        for (int ai = 0; ai < 2; ++ai)
#pragma unroll
            for (int m = 0; m < 4; ++m) gt[ai][m] = gsrt[pm * 256 + ai * 128 + wr * 64 + m * 16 + fr] * (YS_FP8 ? YS_SCALE : 1.f);
#pragma unroll
        for (int bj = 0; bj < 2; ++bj) { const int cb = pn * 256 + bj * 128 + wc * 32;
            const f32x4 bv0 = *(const f32x4*)(bb + cb + 4 * fq), bv1 = *(const f32x4*)(bb + cb + 16 + 4 * fq);
#pragma unroll
            for (int ai = 0; ai < 2; ++ai)
#pragma unroll
                for (int m = 0; m < 4; ++m) { const int row = pm * 256 + ai * 128 + wr * 64 + m * 16 + fr;
                    const f32x4 v0 = (acc[ai][bj][m][0] * (1.f / WQ_SCALE) + bv0) * gt[ai][m], v1 = (acc[ai][bj][m][1] * (1.f / WQ_SCALE) + bv1) * gt[ai][m];
#if YS_FP8
                    unsigned ax = cvt4_fp8(v0.x, v0.y, v0.z, v0.w), bx = cvt4_fp8(v1.x, v1.y, v1.z, v1.w);
                    { auto r_ = __builtin_amdgcn_permlane32_swap(ax, bx, false, false); ax = r_[0]; bx = r_[1]; }
                    { auto r_ = __builtin_amdgcn_permlane16_swap(ax, bx, false, false); ax = r_[0]; bx = r_[1]; }
                    if (mode == 0 || ax == 0x12345678u) *(u32x2*)((unsigned char*)YS + (size_t)row * 1024 + cb + 8 * fq) = (u32x2){ax, bx};
#else
                    unsigned ax = cvt_pk_bf16(v0.x, v0.y), ay = cvt_pk_bf16(v0.z, v0.w), bx = cvt_pk_bf16(v1.x, v1.y), by = cvt_pk_bf16(v1.z, v1.w);
                    { auto r_ = __builtin_amdgcn_permlane32_swap(ax, bx, false, false); ax = r_[0]; bx = r_[1]; } { auto r_ = __builtin_amdgcn_permlane32_swap(ay, by, false, false); ay = r_[0]; by = r_[1]; }
                    { auto r_ = __builtin_amdgcn_permlane16_swap(ax, bx, false, false); ax = r_[0]; bx = r_[1]; } { auto r_ = __builtin_amdgcn_permlane16_swap(ay, by, false, false); ay = r_[0]; by = r_[1]; }
                    if (mode == 0 || ax == 0x12345678u) *(u32x4*)(YS + (size_t)row * 1024 + cb + 8 * fq) = (u32x4){ax, ay, bx, by};
#endif
                } }
    }
};
namespace attn {
using bf16x8 = __attribute__((ext_vector_type(8))) short;
using s16x4  = __attribute__((ext_vector_type(4))) short;
using f32x16 = __attribute__((ext_vector_type(16))) float;
constexpr int QBLK = 32, KVBLK = 64;
constexpr int SHM_V = KVBLK * 128 * 2;
#ifndef ATT_THR
#define ATT_THR 8.f
#endif
constexpr float THR = ATT_THR;
#define KOFF(row, ch) ((row) * 128 + ((((ch) ^ ((row) >> 1)) & 7) << 4))
#define SBAR() __builtin_amdgcn_sched_barrier(0)
__device__ __forceinline__ int crow(int r, int hi) { return (r & 3) + 8 * (r >> 2) + 4 * hi; }

template <int VAR = 0>
__device__ __forceinline__ void partialSM(f32x16& p0, f32x16& p1, float& m_reg, float& mn, float& alpha, const float C, const float thr_raw) {
  if constexpr (VAR == 1) { mn = m_reg; alpha = 1.f;
    _Pragma("unroll") for (int r = 0; r < 16; ++r) { p0[r] = p0[r] * C; p1[r] = p1[r] * C; } return; }
  float pmax = p0[0];
#pragma unroll
  for (int r = 1; r < 16; ++r) pmax = fmaxf(pmax, p0[r]);
#pragma unroll
  for (int r = 0; r < 16; ++r) pmax = fmaxf(pmax, p1[r]);
  { auto rr = __builtin_amdgcn_permlane32_swap(__float_as_uint(pmax), __float_as_uint(pmax), false, false);
    pmax = fmaxf(__uint_as_float(rr[0]), __uint_as_float(rr[1])); }
  if (__builtin_expect(__all(pmax - m_reg <= thr_raw), 1)) { mn = m_reg; alpha = 1.f; }
  else { mn = fmaxf(m_reg, pmax); alpha = __builtin_amdgcn_exp2f((m_reg - mn) * C); m_reg = mn; }
  const float mnC = -mn * C + PSHIFT;
#pragma unroll
  for (int r = 0; r < 16; ++r) p0[r] = fmaf(p0[r], C, mnC);
#pragma unroll
  for (int r = 0; r < 16; ++r) p1[r] = fmaf(p1[r], C, mnC);
#pragma unroll
  for (int r = 0; r < 16; ++r) p0[r] = __builtin_amdgcn_exp2f(p0[r]);
}
template <int VAR = 0>
__device__ __forceinline__ void finishSM(f32x16& p0, f32x16& p1, float alpha, float& l_reg, bf16x8& pa0, bf16x8& pa1, bf16x8& pa2, bf16x8& pa3) {
  if constexpr (VAR != 1) {
#pragma unroll
  for (int r = 0; r < 16; ++r) p1[r] = __builtin_amdgcn_exp2f(p1[r]); }
  float ps = 0;
#pragma unroll
  for (int r = 0; r < 16; ++r) ps += p0[r];
#pragma unroll
  for (int r = 0; r < 16; ++r) ps += p1[r];
  { auto rr = __builtin_amdgcn_permlane32_swap(__float_as_uint(ps), __float_as_uint(ps), false, false);
    ps = __uint_as_float(rr[0]) + __uint_as_float(rr[1]); }
  l_reg = l_reg * alpha + ps;
#define PK4(P, BASE, OUT) do { unsigned a0 = cvt_pk_bf16(P[BASE + 0], P[BASE + 1]), a1 = cvt_pk_bf16(P[BASE + 2], P[BASE + 3]);   \
    unsigned b0 = cvt_pk_bf16(P[BASE + 4], P[BASE + 5]), b1 = cvt_pk_bf16(P[BASE + 6], P[BASE + 7]);                              \
    auto r0 = __builtin_amdgcn_permlane32_swap(a0, b0, false, false); auto r1 = __builtin_amdgcn_permlane32_swap(a1, b1, false, false); \
    u32x4 w = {r0[0], r1[0], r0[1], r1[1]}; OUT = *reinterpret_cast<bf16x8*>(&w); } while (0)
  PK4(p0, 0, pa0); PK4(p0, 8, pa1); PK4(p1, 0, pa2); PK4(p1, 8, pa3);
#undef PK4
}
template <int NKC, int NQR, int KBOFF>
__device__ __forceinline__ void qkt(f32x16& p0, f32x16& p1, const int* kb, const bf16x8* qr, int ql) {
  p0 = f32x16{}; p1 = f32x16{};
  if constexpr (NQR != NKC) asm volatile("" : "+v"(ql));
#pragma unroll
  for (int c = 0; c < NKC; ++c)
#pragma unroll
    for (int d0 = 0; d0 < 4; ++d0) {
      const bf16x8 b0 = *(const LAS bf16x8*)(uintptr_t)(unsigned)(kb[d0] + (KBOFF + c * 8192));
      const bf16x8 b1 = *(const LAS bf16x8*)(uintptr_t)(unsigned)(kb[d0] + (KBOFF + c * 8192 + 4096));
      bf16x8 qf; if constexpr (NQR == NKC) qf = qr[c * 4 + d0]; else { if (c < NQR) qf = qr[(c < NQR ? c : 0) * 4 + d0]; else qf = *(const LAS bf16x8*)(uintptr_t)(unsigned)(ql + ((c - NQR) * 4 + d0) * 1024); }
      p0 = __builtin_amdgcn_mfma_f32_32x32x16_bf16(b0, qf, p0, 0, 0, 0);
      p1 = __builtin_amdgcn_mfma_f32_32x32x16_bf16(b1, qf, p1, 0, 0, 0); }
}
__device__ __forceinline__ int v_st(int k, int c) { const int kk = (k & ~0xC) | ((k & 4) << 1) | ((k & 8) >> 1); return ((kk >> 3) * 4 + (c >> 5)) * 512 + ((kk & 7) * 32 + (c & 31)) * 2; }
__device__ __forceinline__ int v_rd_base(int lane) { return ((lane & 3) << 3) | (((lane >> 2) & 3) << 6) | (((lane >> 4) & 1) << 5) | (((lane >> 5) & 1) << 8); }
constexpr int v_rd_off(int d0, int ks, int half) { return d0 * 512 + ks * 4096 + half * 2048; }
template <int OFF> __device__ __forceinline__ s16x4 tr_read(int vb) {
  s16x4 r; asm volatile("ds_read_b64_tr_b16 %0, %1 offset:%2" : "=&v"(r) : "v"(vb), "i"(OFF) : "memory"); return r;
}
template <int D0> __device__ __forceinline__ void pv_one(f32x16& od, int vb, bf16x8 pa0, bf16x8 pa1, bf16x8 pa2, bf16x8 pa3) {
  const s16x4 l0 = tr_read<v_rd_off(D0, 0, 0)>(vb), h0 = tr_read<v_rd_off(D0, 0, 1)>(vb), l1 = tr_read<v_rd_off(D0, 1, 0)>(vb), h1 = tr_read<v_rd_off(D0, 1, 1)>(vb);
  const s16x4 l2 = tr_read<v_rd_off(D0, 2, 0)>(vb), h2 = tr_read<v_rd_off(D0, 2, 1)>(vb), l3 = tr_read<v_rd_off(D0, 3, 0)>(vb), h3 = tr_read<v_rd_off(D0, 3, 1)>(vb);
  asm volatile("s_waitcnt lgkmcnt(0)" ::: "memory"); SBAR();
#define PK(L, H) (bf16x8){L[0], L[1], L[2], L[3], H[0], H[1], H[2], H[3]}
  od = __builtin_amdgcn_mfma_f32_32x32x16_bf16(pa0, PK(l0, h0), od, 0, 0, 0);
  od = __builtin_amdgcn_mfma_f32_32x32x16_bf16(pa1, PK(l1, h1), od, 0, 0, 0);
  od = __builtin_amdgcn_mfma_f32_32x32x16_bf16(pa2, PK(l2, h2), od, 0, 0, 0);
  od = __builtin_amdgcn_mfma_f32_32x32x16_bf16(pa3, PK(l3, h3), od, 0, 0, 0);
#undef PK
}
__device__ __forceinline__ void pv_d0(f32x16* o, int vb, bf16x8 pa0, bf16x8 pa1, bf16x8 pa2, bf16x8 pa3) {
  pv_one<0>(o[0], vb, pa0, pa1, pa2, pa3); pv_one<1>(o[1], vb, pa0, pa1, pa2, pa3); pv_one<2>(o[2], vb, pa0, pa1, pa2, pa3); pv_one<3>(o[3], vb, pa0, pa1, pa2, pa3);
}

typedef short v4i16 __attribute__((ext_vector_type(4)));
template <int OFF> __device__ __forceinline__ bf16x8 vfrag(int vb) {
  const v4i16 l = __builtin_amdgcn_ds_read_tr16_b64_v4i16((LAS v4i16*)(uintptr_t)(unsigned)(vb + OFF));
  const v4i16 h = __builtin_amdgcn_ds_read_tr16_b64_v4i16((LAS v4i16*)(uintptr_t)(unsigned)(vb + OFF + 2048));
  return (bf16x8){l[0], l[1], l[2], l[3], h[0], h[1], h[2], h[3]};
}
__device__ __forceinline__ float max3f(float a, float b, float c) { return __builtin_fmaxf(__builtin_fmaxf(a, b), c); }
#define PK4X(P, BASE, OUT) do { unsigned a0 = cvt_pk_bf16(Q8(P[BASE + 0]), Q8(P[BASE + 1])), a1 = cvt_pk_bf16(Q8(P[BASE + 2]), Q8(P[BASE + 3]));   \
    unsigned b0 = cvt_pk_bf16(Q8(P[BASE + 4]), Q8(P[BASE + 5])), b1 = cvt_pk_bf16(Q8(P[BASE + 6]), Q8(P[BASE + 7]));                              \
    auto r0 = __builtin_amdgcn_permlane32_swap(a0, b0, false, false); auto r1 = __builtin_amdgcn_permlane32_swap(a1, b1, false, false); \
    u32x4 w = {r0[0], r1[0], r0[1], r1[1]}; OUT = *reinterpret_cast<bf16x8*>(&w); } while (0)

template <int NKC, int NQR, int VAR = 0, int OM = 0>
__device__ __forceinline__ void attn_unit(const bf16_t* __restrict__ Qb, int ldq, const bf16_t* kp0, int kld0, const bf16_t* kp1, int kld1, const bf16_t* kp2, int kld2,
                                          const bf16_t* __restrict__ Vh, int ldv, bf16_t* __restrict__ Ob, int ldo, int seq, const float C, char* lds,
                                          char* stash = nullptr, const float lam = 0.f, const float* __restrict__ subw = nullptr) {
  constexpr int SHM_K = NKC * 8192, NG = NKC * 8;
  const int tid = tid_opaque(), wid = tid >> 6, lane = tid & 63, r32 = lane & 31, hi = lane >> 5;
  const float thr_raw = THR * 1.4426950408889634f / C;
  char* V_lds = lds; char* K_lds = lds + 3 * SHM_V;
  float* ws = (float*)(lds + 3 * SHM_V + 3 * SHM_K) + wid * 64; float* li_l = ws; float* al_l = ws + 32;
  float m_reg = -1e30f, l_reg = 0; f32x16 o[4] = {}; bf16x8 qr[NQR * 4];
  const bf16_t* Qw = Qb + (long)(wid * QBLK + r32) * ldq + hi * 8;
  int ql = (int)(uintptr_t)(lds + 3 * SHM_V + 3 * SHM_K + 2048) + wid * ((NKC - NQR) * 4096) + lane * 16;
  int kb[4];
#pragma unroll
  for (int d0 = 0; d0 < 4; ++d0) kb[d0] = (int)(uintptr_t)K_lds + KOFF(r32, d0 * 2 + hi);
  __syncthreads();
#pragma unroll
  for (int d0 = 0; d0 < NQR * 4; ++d0) qr[d0] = *reinterpret_cast<const bf16x8*>(Qw + d0 * 16);
#pragma unroll
  for (int d0 = NQR * 4; d0 < NKC * 4; ++d0) *(LAS bf16x8*)(uintptr_t)(unsigned)(ql + (d0 - NQR * 4) * 1024) = *reinterpret_cast<const bf16x8*>(Qw + d0 * 16);
  const int sr = tid >> 4, sc = (tid & 15) * 8, vst0 = v_st(sr, sc), vst1 = v_st(32 + sr, sc);
  const int krow = tid >> 3, kch = tid & 7, kst = KOFF(krow, kch);
  const int vb0 = (int)(uintptr_t)V_lds + v_rd_base(lane);
  const unsigned vo0 = (unsigned)(sr * ldv + sc) * 2u, vo1 = (unsigned)((32 + sr) * ldv + sc) * 2u;
  const unsigned ko0 = (unsigned)(krow * kld0 + kch * 8) * 2u, ko1 = (unsigned)(krow * kld1 + kch * 8) * 2u, ko2 = (unsigned)(krow * kld2 + kch * 8) * 2u;
  struct { bf16x8 vs0, vs1, k0, k1, k2; } sg;
  const __amdgpu_buffer_rsrc_t rV = __builtin_amdgcn_make_buffer_rsrc((void*)Vh, 0, 0xffffffff, 0x00020000);
  const __amdgpu_buffer_rsrc_t rK0 = __builtin_amdgcn_make_buffer_rsrc((void*)kp0, 0, 0xffffffff, 0x00020000);
  const __amdgpu_buffer_rsrc_t rK1 = __builtin_amdgcn_make_buffer_rsrc((void*)(NKC > 1 ? kp1 : kp0), 0, 0xffffffff, 0x00020000);
  const __amdgpu_buffer_rsrc_t rK2 = __builtin_amdgcn_make_buffer_rsrc((void*)(NKC > 2 ? kp2 : kp0), 0, 0xffffffff, 0x00020000);
#define BL128(r, vo, so) __builtin_bit_cast(bf16x8, __builtin_amdgcn_raw_buffer_load_b128(r, (int)(vo), (int)(so), 0))
#define SLOAD(kb_) do { const int so_ = (kb_) * (ldv * 2); \
    sg.vs0 = BL128(rV, vo0, so_); sg.vs1 = BL128(rV, vo1, so_); \
    sg.k0 = BL128(rK0, ko0, (kb_) * (kld0 * 2)); \
    if constexpr (NKC > 1) sg.k1 = BL128(rK1, ko1, (kb_) * (kld1 * 2)); \
    if constexpr (NKC > 2) sg.k2 = BL128(rK2, ko2, (kb_) * (kld2 * 2)); } while (0)
#define SWRITE(b) do { *(bf16x8*)(V_lds + (b) * SHM_V + vst0) = sg.vs0; *(bf16x8*)(V_lds + (b) * SHM_V + vst1) = sg.vs1; \
    *(bf16x8*)(K_lds + (b) * SHM_K + kst) = sg.k0; \
    if constexpr (NKC > 1) *(bf16x8*)(K_lds + (b) * SHM_K + 8192 + kst) = sg.k1; \
    if constexpr (NKC > 2) *(bf16x8*)(K_lds + (b) * SHM_K + 16384 + kst) = sg.k2; } while (0)
#define RESC(a) do { if (__any((a) < 1.f)) { if (hi == 0) al_l[r32] = (a); asm volatile("s_waitcnt lgkmcnt(0)" ::: "memory"); \
    _Pragma("unroll") for (int d = 0; d < 4; ++d) _Pragma("unroll") for (int r = 0; r < 16; ++r) o[d][r] *= al_l[crow(r, hi)]; } } while (0)
#define KLD(g, KB) (*(const LAS bf16x8*)(uintptr_t)(unsigned)(kb[((g) & 7) >> 1] + ((KB) + ((g) >> 3) * 8192 + ((g) & 1) * 4096)))
#define QLD(j) (*(const LAS bf16x8*)(uintptr_t)(unsigned)(ql + (j) * 1024))
  f32x16 pA0, pA1, pB0, pB1; float alA, alB; bf16x8 pa[4]; const int NT = seq / KVBLK;
  constexpr bool NEGM = (NKC == 1); f32x16 negm = {}; const float thr2 = THR * 1.4426950408889634f;
#define STEP(PN0, PN1, alN, PC0, PC1, alC, BKN, BVC, BW, DO_QK, DO_WR, DO_LD, tt) do { \
    bf16x8 kf[3], vf[3], qlf[2]; float ps = 0.f, mxa = 0.f, mxb = 0.f, mnC = 0.f; \
    SBAR(); \
    if (DO_QK) { if constexpr (NQR != NKC) asm volatile("" : "+v"(ql)); kf[0] = KLD(0, (BKN) * SHM_K); kf[1] = KLD(1, (BKN) * SHM_K); } \
    _Pragma("unroll") for (int g = 0; g < NG; ++g) { \
      const int c_ = g >> 3, d0_ = (g & 7) >> 1, s_ = g / NKC; const bool fs_ = (g % NKC) == 0; \
      if (DO_QK) { bf16x8 qf_; if (c_ < NQR) qf_ = qr[(c_ < NQR ? c_ : 0) * 4 + d0_]; else { if ((g & 1) == 0) qlf[d0_ & 1] = QLD((c_ - NQR) * 4 + d0_); qf_ = qlf[d0_ & 1]; } \
        if ((g & 1) == 0) { if (g == 0) PN0 = __builtin_amdgcn_mfma_f32_32x32x16_bf16(kf[g % 3], qf_, NEGM ? negm : (f32x16){}, 0, 0, 0); else PN0 = __builtin_amdgcn_mfma_f32_32x32x16_bf16(kf[g % 3], qf_, PN0, 0, 0, 0); } \
        else { if (g == 1) PN1 = __builtin_amdgcn_mfma_f32_32x32x16_bf16(kf[g % 3], qf_, NEGM ? negm : (f32x16){}, 0, 0, 0); else PN1 = __builtin_amdgcn_mfma_f32_32x32x16_bf16(kf[g % 3], qf_, PN1, 0, 0, 0); } } \
      if (fs_ && VAR < 4) {   \
        if (!NEGM && s_ < 7) { PC1[2 * s_] = __builtin_amdgcn_exp2f(PC1[2 * s_]); PC1[2 * s_ + 1] = __builtin_amdgcn_exp2f(PC1[2 * s_ + 1]); } \
        if (!NEGM && s_ == 4) { PC1[14] = __builtin_amdgcn_exp2f(PC1[14]); PC1[15] = __builtin_amdgcn_exp2f(PC1[15]); } \
        if (s_ == 0) { ps = (PC0[0] + PC0[1]) + (PC0[2] + PC0[3]); PK4X(PC0, 0, pa[0]); } \
        if (s_ == 1) { ps += (PC0[4] + PC0[5]) + (PC0[6] + PC0[7]); PK4X(PC0, 8, pa[1]); } \
        if (s_ == 2) { ps += (PC0[8] + PC0[9]) + (PC0[10] + PC0[11]); ps += (PC0[12] + PC0[13]) + (PC0[14] + PC0[15]); } \
        if (s_ == 3) { ps += (PC1[0] + PC1[1]) + (PC1[2] + PC1[3]); } \
        if (s_ == 4) { ps += (PC1[4] + PC1[5]) + (PC1[6] + PC1[7]); } \
        if (s_ == 5) { ps += (PC1[8] + PC1[9]); PK4X(PC1, 0, pa[2]); } \
        if (s_ == 6) { ps += (PC1[10] + PC1[11]) + (PC1[12] + PC1[13]); } \
        if (s_ == 7) { ps += (PC1[14] + PC1[15]); PK4X(PC1, 8, pa[3]); \
          auto rr_ = __builtin_amdgcn_permlane32_swap(__float_as_uint(ps), __float_as_uint(ps), false, false); ps = __uint_as_float(rr_[0]) + __uint_as_float(rr_[1]); l_reg = l_reg * (alC) + ps; } } \
      if (DO_QK && g + 2 < NG) kf[(g + 2) % 3] = KLD(g + 2, (BKN) * SHM_K); \
      if (g == NG - 2) vf[0] = vfrag<v_rd_off(0, 0, 0)>(vb0 + (BVC) * (int)SHM_V); \
      if (g == NG - 1) vf[1] = vfrag<v_rd_off(1, 0, 0)>(vb0 + (BVC) * (int)SHM_V); \
      SBAR(); } \
    _Pragma("unroll") for (int g = 0; g < 16; ++g) { \
      const int ks_ = g >> 2, d0_ = g & 3; \
      o[d0_] = __builtin_amdgcn_mfma_f32_32x32x16_bf16(pa[ks_], vf[g % 3], o[d0_], 0, 0, 0); \
      if (g == 0 && (DO_WR) && VAR != 5) { SWRITE(BW); } \
      if (g == 1 && (DO_LD) && VAR != 5) { SLOAD(((tt) + 3) * KVBLK); } \
      if (DO_QK && VAR < 4) {   \
        if (g == 2) { mxa = max3f(PN0[0], PN0[1], PN0[2]); mxa = max3f(mxa, PN0[3], PN0[4]); mxb = max3f(PN0[5], PN0[6], PN0[7]); mxb = max3f(mxb, PN0[8], PN0[9]); } \
        if (g == 3) { mxa = max3f(mxa, PN0[10], PN0[11]); mxb = max3f(mxb, PN0[12], PN0[13]); mxa = max3f(mxa, PN0[14], PN0[15]); mxb = max3f(mxb, PN1[0], PN1[1]); } \
        if (g == 4) { mxa = max3f(mxa, PN1[2], PN1[3]); mxb = max3f(mxb, PN1[4], PN1[5]); mxa = max3f(mxa, PN1[6], PN1[7]); mxb = max3f(mxb, PN1[8], PN1[9]); } \
        if (g == 5) { mxa = max3f(mxa, PN1[10], PN1[11]); mxb = max3f(mxb, PN1[12], PN1[13]); mxa = max3f(mxa, PN1[14], PN1[15]); mxa = __builtin_fmaxf(mxa, mxb); } \
        if (g == 6) { auto rr_ = __builtin_amdgcn_permlane32_swap(__float_as_uint(mxa), __float_as_uint(mxa), false, false); const float pmax_ = __builtin_fmaxf(__uint_as_float(rr_[0]), __uint_as_float(rr_[1])); \
          if constexpr (NEGM) { alN = 1.f; if (__builtin_expect(!__all(pmax_ <= thr2 + PSHIFT), 0)) { const float dl_ = __builtin_fmaxf(pmax_ - PSHIFT, 0.f); alN = __builtin_amdgcn_exp2f(-dl_); \
              _Pragma("unroll") for (int r = 0; r < 16; ++r) { PN0[r] -= dl_; PN1[r] -= dl_; negm[r] -= dl_; } } } \
          else { const bool ok_ = __all(pmax_ - m_reg <= thr_raw); const float mn_ = ok_ ? m_reg : __builtin_fmaxf(m_reg, pmax_); \
            alN = __builtin_amdgcn_exp2f((m_reg - mn_) * C); m_reg = mn_; mnC = -mn_ * C + PSHIFT; } } \
        if (g >= 7) { const int i_ = g - 7; \
          if constexpr (NEGM) {   \
            if (i_ < 4) { _Pragma("unroll") for (int r = 4 * i_; r < 4 * i_ + 4; ++r) PN0[r] = __builtin_amdgcn_exp2f(PN0[r]); } \
            else if (i_ < 8) { _Pragma("unroll") for (int r = 4 * (i_ - 4); r < 4 * (i_ - 4) + 4; ++r) PN1[r] = __builtin_amdgcn_exp2f(PN1[r]); } } \
          else {   \
          if (i_ < 4) { _Pragma("unroll") for (int r = 4 * i_; r < 4 * i_ + 4; ++r) PN0[r] = fmaf(PN0[r], C, mnC); } \
          else if (i_ < 8) { _Pragma("unroll") for (int r = 4 * (i_ - 4); r < 4 * (i_ - 4) + 4; ++r) PN1[r] = fmaf(PN1[r], C, mnC); } \
          if (i_ >= 1) { PN0[2 * (i_ - 1)] = __builtin_amdgcn_exp2f(PN0[2 * (i_ - 1)]); PN0[2 * (i_ - 1) + 1] = __builtin_amdgcn_exp2f(PN0[2 * (i_ - 1) + 1]); } } \
          asm volatile("" : "+v"(PN0), "+v"(PN1));   } } \
      if (g + 2 < 16) { constexpr int dummy_ = 0; (void)dummy_; \
        if (g + 2 == 2) vf[2] = vfrag<v_rd_off(2, 0, 0)>(vb0 + (BVC) * (int)SHM_V); if (g + 2 == 3) vf[0] = vfrag<v_rd_off(3, 0, 0)>(vb0 + (BVC) * (int)SHM_V); \
        if (g + 2 == 4) vf[1] = vfrag<v_rd_off(0, 1, 0)>(vb0 + (BVC) * (int)SHM_V); if (g + 2 == 5) vf[2] = vfrag<v_rd_off(1, 1, 0)>(vb0 + (BVC) * (int)SHM_V); \
        if (g + 2 == 6) vf[0] = vfrag<v_rd_off(2, 1, 0)>(vb0 + (BVC) * (int)SHM_V); if (g + 2 == 7) vf[1] = vfrag<v_rd_off(3, 1, 0)>(vb0 + (BVC) * (int)SHM_V); \
        if (g + 2 == 8) vf[2] = vfrag<v_rd_off(0, 2, 0)>(vb0 + (BVC) * (int)SHM_V); if (g + 2 == 9) vf[0] = vfrag<v_rd_off(1, 2, 0)>(vb0 + (BVC) * (int)SHM_V); \
        if (g + 2 == 10) vf[1] = vfrag<v_rd_off(2, 2, 0)>(vb0 + (BVC) * (int)SHM_V); if (g + 2 == 11) vf[2] = vfrag<v_rd_off(3, 2, 0)>(vb0 + (BVC) * (int)SHM_V); \
        if (g + 2 == 12) vf[0] = vfrag<v_rd_off(0, 3, 0)>(vb0 + (BVC) * (int)SHM_V); if (g + 2 == 13) vf[1] = vfrag<v_rd_off(1, 3, 0)>(vb0 + (BVC) * (int)SHM_V); \
        if (g + 2 == 14) vf[2] = vfrag<v_rd_off(2, 3, 0)>(vb0 + (BVC) * (int)SHM_V); if (g + 2 == 15) vf[0] = vfrag<v_rd_off(3, 3, 0)>(vb0 + (BVC) * (int)SHM_V); } \
      SBAR(); } \
    if (VAR >= 4) { asm volatile("" : "+v"(PN0), "+v"(PN1)); pa[0] = __builtin_bit_cast(bf16x8, (u32x4){(unsigned)tt, 1u, 2u, 3u}); pa[1] = pa[0]; pa[2] = pa[0]; pa[3] = pa[0]; } \
    if (DO_QK && VAR < 4) { RESC(alN); } \
    if (VAR != 5) __syncthreads(); } while (0)
  SLOAD(0); SWRITE(0); SLOAD(KVBLK); SWRITE(1); SLOAD(2 * KVBLK); __syncthreads();
  { float mn0_; qkt<NKC, NQR, 0>(pA0, pA1, kb, qr, ql);
    if constexpr (NEGM) { float pm_ = pA0[0];
      _Pragma("unroll") for (int r = 1; r < 16; ++r) pm_ = fmaxf(pm_, pA0[r]);
      _Pragma("unroll") for (int r = 0; r < 16; ++r) pm_ = fmaxf(pm_, pA1[r]);
      { auto rr_ = __builtin_amdgcn_permlane32_swap(__float_as_uint(pm_), __float_as_uint(pm_), false, false); pm_ = fmaxf(__uint_as_float(rr_[0]), __uint_as_float(rr_[1])); }
      _Pragma("unroll") for (int r = 0; r < 16; ++r) { pA0[r] = __builtin_amdgcn_exp2f(pA0[r] - pm_ + PSHIFT); pA1[r] = __builtin_amdgcn_exp2f(pA1[r] - pm_ + PSHIFT); negm[r] = -pm_ + PSHIFT; }
      alA = 1.f; (void)mn0_; }
    else partialSM(pA0, pA1, m_reg, mn0_, alA, C, thr_raw); }
#ifdef ATT_STATIC_PRIO
  if (__builtin_amdgcn_readfirstlane(tid) >= 256) __builtin_amdgcn_s_setprio(1);
#endif
  int t = 0;
  for (; t + 6 < NT; t += 6) {
    STEP(pB0, pB1, alB, pA0, pA1, alA, 1, 0, 2, true, true, true, t);
    STEP(pA0, pA1, alA, pB0, pB1, alB, 2, 1, 0, true, true, true, t + 1);
    STEP(pB0, pB1, alB, pA0, pA1, alA, 0, 2, 1, true, true, true, t + 2);
    STEP(pA0, pA1, alA, pB0, pB1, alB, 1, 0, 2, true, true, true, t + 3);
    STEP(pB0, pB1, alB, pA0, pA1, alA, 2, 1, 0, true, true, true, t + 4);
    STEP(pA0, pA1, alA, pB0, pB1, alB, 0, 2, 1, true, true, true, t + 5);
  }
  STEP(pB0, pB1, alB, pA0, pA1, alA, 1, 0, 2, true, true, true, t);
  STEP(pA0, pA1, alA, pB0, pB1, alB, 2, 1, 0, true, true, true, t + 1);
  STEP(pB0, pB1, alB, pA0, pA1, alA, 0, 2, 1, true, true, true, t + 2);
  STEP(pA0, pA1, alA, pB0, pB1, alB, 1, 0, 2, true, true, false, t + 3);
  STEP(pB0, pB1, alB, pA0, pA1, alA, 2, 1, 0, true, false, false, t + 4);
  STEP(pA0, pA1, alA, pB0, pB1, alB, 0, 2, 1, false, false, false, t + 5);
#ifdef ATT_STATIC_PRIO
  __builtin_amdgcn_s_setprio(0);
#endif
  if (hi == 0) li_l[r32] = l_reg; asm volatile("s_waitcnt lgkmcnt(0)" ::: "memory");
  float rli[16];
#pragma unroll
  for (int r = 0; r < 16; ++r) rli[r] = __builtin_amdgcn_rcpf(li_l[crow(r, hi)]);
  if constexpr (OM == 1) {
    unsigned* st = (unsigned*)stash + tid;
#pragma unroll
    for (int r = 0; r < 16; ++r) { st[(2 * r) * 512] = cvt_pk_bf16(o[0][r] * rli[r], o[1][r] * rli[r]); st[(2 * r + 1) * 512] = cvt_pk_bf16(o[2][r] * rli[r], o[3][r] * rli[r]); }
  } else if constexpr (OM == 2) {
    const unsigned* st = (const unsigned*)stash + tid;
    float sw[4];
#pragma unroll
    for (int d0 = 0; d0 < 4; ++d0) sw[d0] = subw[d0 * 32 + r32] * 0.8f;
    bf16_t* Ow = Ob + (long)(wid * QBLK) * ldo;
#pragma unroll
    for (int r = 0; r < 16; ++r) { const unsigned w01 = st[(2 * r) * 512], w23 = st[(2 * r + 1) * 512];
      const float d0v = bflo(w01) - lam * (o[0][r] * rli[r]), d1v = bfhi(w01) - lam * (o[1][r] * rli[r]), d2v = bflo(w23) - lam * (o[2][r] * rli[r]), d3v = bfhi(w23) - lam * (o[3][r] * rli[r]);
      float ss = (d0v * d0v + d1v * d1v) + (d2v * d2v + d3v * d3v);
      ss += __shfl_xor(ss, 1); ss += __shfl_xor(ss, 2); ss += __shfl_xor(ss, 4); ss += __shfl_xor(ss, 8); ss += __shfl_xor(ss, 16);
      const float rn = rsqrtf(ss * (1.f / 128.f) + EPS); const long ob = (long)crow(r, hi) * ldo + r32;
      Ow[ob] = f2bf(d0v * rn * sw[0]); Ow[ob + 32] = f2bf(d1v * rn * sw[1]); Ow[ob + 64] = f2bf(d2v * rn * sw[2]); Ow[ob + 96] = f2bf(d3v * rn * sw[3]); }
  } else {
  bf16_t* Ow = Ob + (long)(wid * QBLK) * ldo;
#pragma unroll
  for (int r = 0; r < 16; ++r) { const int orow = crow(r, hi);
#pragma unroll
    for (int d0 = 0; d0 < 4; ++d0) Ow[(long)orow * ldo + d0 * 32 + r32] = f2bf(o[d0][r] * rli[r]); }
  }
#undef SLOAD
#undef BL128
#undef SWRITE
#undef RESC
#undef STEP
#undef KLD
#undef QLD
}
#undef PK4X
#undef KOFF
#undef SBAR
}
namespace attn8 {
#if SIM_P6
#define SQ6(x) q8(x)
#else
#define SQ6(x) (x)
#endif
using attn::f32x16; using attn::crow; using attn::max3f;
typedef int v8i32 __attribute__((ext_vector_type(8)));
typedef int v4i32 __attribute__((ext_vector_type(4)));
#ifndef ATT8_THRL
#define ATT8_THRL 3.5f
#endif
constexpr float PSH = 5.f, THRL = ATT8_THRL;
#define OFF8(row, piece) ((row) * 64 + ((((piece) ^ ((row) >> 2)) & 3) << 4))
#define SBAR() __builtin_amdgcn_sched_barrier(0)
#define MFMA8(a, b, c) __builtin_amdgcn_mfma_scale_f32_32x32x64_f8f6f4(a, b, c, 0, 0, 0, 0, 0, 0)
#define LD32(addr0, addr1) __builtin_shufflevector(*(const LAS v4i32*)(uintptr_t)(unsigned)(addr0), *(const LAS v4i32*)(uintptr_t)(unsigned)(addr1), 0, 1, 2, 3, 4, 5, 6, 7)

constexpr int WCONV_I1 = 32 * 128 * 32, WCONV_I2 = 32 * 128 * 16, WCONV_ITEMS = WCONV_I1 + WCONV_I2;
struct WConv { float v[8]; };
__device__ __forceinline__ void wconv_load(const Params& p, int it, int lane, WConv& w) {
    it = min(it, WCONV_ITEMS - 1);
    const bool m1 = it < WCONV_I1; const int i2 = m1 ? it : it - WCONV_I1;
    const int e = m1 ? (i2 >> 12) : (i2 >> 11), kb = m1 ? ((i2 >> 5) & 127) : ((i2 >> 4) & 127), nb = m1 ? (i2 & 31) : (i2 & 15), ldn = m1 ? 2048 : 1024;
    const __amdgpu_buffer_rsrc_t r = __builtin_amdgcn_make_buffer_rsrc((void*)(m1 ? p.w1 : p.w2), 0, 0xffffffff, 0x00020000);
    const int so = ((e * 1024 + kb * 8) * ldn + nb * 64) * 4;
#pragma unroll
    for (int j = 0; j < 8; ++j) w.v[j] = __builtin_bit_cast(float, __builtin_amdgcn_raw_buffer_load_b32(r, lane * 4, so + j * ldn * 4, 0));
}
__device__ __forceinline__ void wconv_store(const Params& p, int it0, int lane, const WConv& w) {
    const int it = min(it0, WCONV_ITEMS - 1);
    const bool m1 = it < WCONV_I1; const int i2 = m1 ? it : it - WCONV_I1;
    const int e = m1 ? (i2 >> 12) : (i2 >> 11), kb = m1 ? ((i2 >> 5) & 127) : ((i2 >> 4) & 127), nb = m1 ? (i2 & 31) : (i2 & 15);
    const int n = nb * 64 + lane;
    const int drow = m1 ? (e * 2048 + ((n & 1023) >> 7) * 256 + (n >> 10) * 128 + (n & 127)) : (e * 1024 + n);
    unsigned char* dst = it0 < WCONV_ITEMS ? p.ws + (m1 ? WS_W1 : WS_W2) + (size_t)drow * 1024 + kb * 8 : p.ws + WS_DUMMY + lane * 8;
    u32x2 o; o.x = cvt4_fp8(w.v[0] * WQ_SCALE, w.v[1] * WQ_SCALE, w.v[2] * WQ_SCALE, w.v[3] * WQ_SCALE); o.y = cvt4_fp8(w.v[4] * WQ_SCALE, w.v[5] * WQ_SCALE, w.v[6] * WQ_SCALE, w.v[7] * WQ_SCALE);
    *(u32x2*)dst = o;
}
template <int NKC, int OM, int VAR = 0, bool WC = false>
__device__ __forceinline__ void attn_unit(const unsigned char* __restrict__ Qb, int ldq, const unsigned char* kp0, int kld0, const unsigned char* kp1, int kld1, const unsigned char* kp2, int kld2,
                                          const unsigned char* __restrict__ VT, bf16_t* __restrict__ Ob, int ldo, int seq, char* lds,
                                          char* stash = nullptr, const float lam = 0.f, const float* __restrict__ subw = nullptr, const Params* pp = nullptr, int wc_base = 0) {
  constexpr int SHM_K = NKC * 4096, SHM_V = 8192, NG = 2 * NKC;
  constexpr bool STG = ((STAGGER) >> (NKC == 1 ? 0 : 1)) & 1;
  constexpr bool V_M = VAR >= 32, V_NOLDS = VAR == 6 || VAR == 9 || V_M, V_NOSTG = VAR == 2 || VAR == 3 || VAR == 9 || V_M, V_NOBAR = VAR == 3 || VAR == 9 || V_M;
  constexpr bool V_NOEXP = VAR == 1 || VAR == 7 || (V_M && (VAR & 1)), V_NOMAX = VAR == 1 || VAR == 7 || (V_M && (VAR & 2)), V_NOPACK = V_M && (VAR & 4);
  constexpr bool V_NOPV = VAR == 4 || VAR == 7 || (V_M && (VAR & 8)), V_NOQK = VAR == 5 || (V_M && (VAR & 16));
  const int tid = tid_opaque(), wid = tid >> 6, lane = tid & 63, r32 = lane & 31, hi = lane >> 5;
  char* V_lds = lds; char* K_lds = lds + 4 * SHM_V;
  float* ws = (float*)(lds + 4 * SHM_V + 4 * SHM_K) + wid * 64; float* al_l = ws + 32;
  f32x16 o[4] = {}, ol = {}; v8i32 qf[NKC];
  v8i32 ones8 = {0x38383838, 0x38383838, 0x38383838, 0x38383838, 0x38383838, 0x38383838, 0x38383838, 0x38383838};
  asm volatile("" : "+v"(ones8));
  { const unsigned char* Qw = Qb + (long)(wid * 32 + r32) * ldq + hi * 32;
#pragma unroll
    for (int c = 0; c < NKC; ++c) qf[c] = __builtin_shufflevector(*(const v4i32*)(Qw + c * 64), *(const v4i32*)(Qw + c * 64 + 16), 0, 1, 2, 3, 4, 5, 6, 7); }
  const int fa0 = OFF8(r32, 2 * hi), fa1 = OFF8(r32, 2 * hi + 1);
  const LAS char* kA = (const LAS char*)(uintptr_t)(unsigned)((int)(uintptr_t)K_lds + fa0); const LAS char* kB = (const LAS char*)(uintptr_t)(unsigned)((int)(uintptr_t)K_lds + fa1);
  const LAS char* vA = (const LAS char*)(uintptr_t)(unsigned)((int)(uintptr_t)V_lds + fa0); const LAS char* vB = (const LAS char*)(uintptr_t)(unsigned)((int)(uintptr_t)V_lds + fa1);
  const int ve = tid >> 2, pc = tid & 3, krow = (tid & 255) >> 2;
  const int vst = OFF8(ve, pc), kst = OFF8(krow, pc);
  const bool lowhalf = tid < 256;
  const bool grpB = __builtin_amdgcn_readfirstlane(wid) >= 4;
  const unsigned vo = (unsigned)(ve * RPB + pc * 16);
  const unsigned ko0 = (unsigned)(krow * kld0 + pc * 16), ko1 = (unsigned)(krow * kld1 + pc * 16), ko2 = (unsigned)(krow * kld2 + pc * 16);
  const __amdgpu_buffer_rsrc_t rV = __builtin_amdgcn_make_buffer_rsrc((void*)VT, 0, 0xffffffff, 0x00020000);
  const __amdgpu_buffer_rsrc_t rK0 = __builtin_amdgcn_make_buffer_rsrc((void*)kp0, 0, 0xffffffff, 0x00020000);
  const __amdgpu_buffer_rsrc_t rK1 = __builtin_amdgcn_make_buffer_rsrc((void*)(NKC > 1 ? kp1 : kp0), 0, 0xffffffff, 0x00020000);
  const __amdgpu_buffer_rsrc_t rK2 = __builtin_amdgcn_make_buffer_rsrc((void*)(NKC > 2 ? kp2 : kp0), 0, 0xffffffff, 0x00020000);
  struct { v4i32 v, ka, kc; } sg;
#define BL16(r, vo_, so_) __builtin_bit_cast(v4i32, __builtin_amdgcn_raw_buffer_load_b128(r, (int)(vo_), (int)(so_), 0))
#define SLOAD(k0) do { sg.v = BL16(rV, vo, (k0)); \
    if constexpr (NKC == 1) { if (lowhalf) sg.ka = BL16(rK0, ko0, (k0) * kld0); } \
    else { if (lowhalf) { sg.ka = BL16(rK0, ko0, (k0) * kld0); sg.kc = BL16(rK2, ko2, (k0) * kld2); } else sg.ka = BL16(rK1, ko1, (k0) * kld1); } } while (0)
#define SWRITE(b) do { *(v4i32*)(V_lds + (b) * SHM_V + vst) = sg.v; \
    if constexpr (NKC == 1) { if (lowhalf) *(v4i32*)(K_lds + (b) * SHM_K + kst) = sg.ka; } \
    else { if (lowhalf) { *(v4i32*)(K_lds + (b) * SHM_K + kst) = sg.ka; *(v4i32*)(K_lds + (b) * SHM_K + 8192 + kst) = sg.kc; } else *(v4i32*)(K_lds + (b) * SHM_K + 4096 + kst) = sg.ka; } } while (0)
#define RESC(a) do { if (raised_) { if (hi == 0) al_l[r32] = (a); asm volatile("s_waitcnt lgkmcnt(0)" ::: "memory"); \
    _Pragma("unroll") for (int r = 0; r < 16; ++r) { const float a_ = al_l[crow(r, hi)]; o[0][r] *= a_; o[1][r] *= a_; o[2][r] *= a_; o[3][r] *= a_; ol[r] *= a_; } } } while (0)
#define LDP(pa, pb, off) __builtin_shufflevector(*(const LAS v4i32*)((pa) + (off)), *(const LAS v4i32*)((pb) + (off)), 0, 1, 2, 3, 4, 5, 6, 7)
#define KFR(g, KB) (V_NOLDS ? qf[0] : LDP(kA, kB, (KB) + ((g) >> 1) * 4096 + ((g) & 1) * 2048))
#define VFR(d0, VB) (V_NOLDS ? qf[0] : LDP(vA, vB, (VB) + (d0) * 2048))
  f32x16 P0, P1, negm; float al = 1.f; const int NT = seq / 64;
  v8i32 kpf0, kpf1;
  v8i32 pf;
#define PACKP() do { pf = (v8i32){(int)cvt4_fp8(P0[0], P0[1], P0[2], P0[3]), (int)cvt4_fp8(P0[4], P0[5], P0[6], P0[7]), (int)cvt4_fp8(P0[8], P0[9], P0[10], P0[11]), (int)cvt4_fp8(P0[12], P0[13], P0[14], P0[15]), \
    (int)cvt4_fp8(P1[0], P1[1], P1[2], P1[3]), (int)cvt4_fp8(P1[4], P1[5], P1[6], P1[7]), (int)cvt4_fp8(P1[8], P1[9], P1[10], P1[11]), (int)cvt4_fp8(P1[12], P1[13], P1[14], P1[15])}; } while (0)
#define PACK0() do { asm volatile("" : "+v"(P0)); pf[0] = (int)cvt4_fp8o(pf[0], P0[0], P0[1], P0[2], P0[3]); pf[1] = (int)cvt4_fp8o(pf[1], P0[4], P0[5], P0[6], P0[7]); \
    pf[2] = (int)cvt4_fp8o(pf[2], P0[8], P0[9], P0[10], P0[11]); pf[3] = (int)cvt4_fp8o(pf[3], P0[12], P0[13], P0[14], P0[15]); asm volatile("" : "+v"(pf)); } while (0)
#define PACK1() do { asm volatile("" : "+v"(P1)); pf[4] = (int)cvt4_fp8o(pf[4], P1[0], P1[1], P1[2], P1[3]); pf[5] = (int)cvt4_fp8o(pf[5], P1[4], P1[5], P1[6], P1[7]); \
    pf[6] = (int)cvt4_fp8o(pf[6], P1[8], P1[9], P1[10], P1[11]); pf[7] = (int)cvt4_fp8o(pf[7], P1[12], P1[13], P1[14], P1[15]); asm volatile("" : "+v"(pf)); } while (0)
#define MAX0() do { m0_ = max3f(P0[0], P0[1], P0[2]); m0_ = max3f(m0_, P0[3], P0[4]); m0_ = max3f(m0_, P0[5], P0[6]); m0_ = max3f(m0_, P0[7], P0[8]); m0_ = max3f(m0_, P0[9], P0[10]); \
    m0_ = max3f(m0_, P0[11], P0[12]); m0_ = max3f(m0_, P0[13], P0[14]); asm volatile("" : "+v"(m0_)); } while (0)
#define MAXFIN() do { float m1_ = max3f(P1[0], P1[1], P1[2]); m1_ = max3f(m1_, P1[3], P1[4]); m1_ = max3f(m1_, P1[5], P1[6]); m1_ = max3f(m1_, P1[7], P1[8]); m1_ = max3f(m1_, P1[9], P1[10]); \
    m1_ = max3f(m1_, P1[11], P1[12]); m1_ = max3f(m1_, P1[13], P1[14]); m1_ = max3f(m1_, P1[15], P0[15]); mx_ = fmaxf(m1_, m0_);          \
    if (__builtin_expect(!__all(mx_ <= PSH + THRL), 0)) { \
      { auto rr_ = __builtin_amdgcn_permlane32_swap(__float_as_uint(mx_), __float_as_uint(mx_), false, false); mx_ = fmaxf(__uint_as_float(rr_[0]), __uint_as_float(rr_[1])); }     \
      const float dl_ = fmaxf(mx_ - PSH, 0.f); al = __builtin_amdgcn_exp2f(-dl_); raised_ = true; \
      _Pragma("unroll") for (int r = 0; r < 16; ++r) { P0[r] -= dl_; P1[r] -= dl_; negm[r] -= dl_; } } } while (0)
#define EXPS(P, ra, rb) do { asm volatile("" : "+v"(P)); _Pragma("unroll") for (int r = (ra); r < (rb); ++r) P[r] = __builtin_amdgcn_exp2f(P[r]); asm volatile("" : "+v"(P)); } while (0)
#define MPIN(acc) asm volatile("" : "+v"(acc))
#define STEP(BKN, BVC, BW, BKP, DO_QK, DO_WR, DO_LD, DO_KP, tt) do { \
    v8i32 kf[2], vf[3]; float mx_ = 0.f, m0_ = 0.f; bool raised_ = false; \
    SBAR(); \
    if (DO_QK && NG > 2) { kf[0] = KFR(2, (BKN) * SHM_K); kf[1] = KFR(3, (BKN) * SHM_K); } \
    _Pragma("unroll") for (int g = 0; g < NG; ++g) { \
      if (DO_QK && !V_NOQK) { if (g == 0) { P0 = MFMA8(kpf0, qf[0], negm); MPIN(P0); } else if (g == 1) { P1 = MFMA8(kpf1, qf[0], negm); MPIN(P1); } \
        else if ((g & 1) == 0) { P0 = MFMA8(kf[g & 1], qf[g >> 1], P0); MPIN(P0); } else { P1 = MFMA8(kf[g & 1], qf[g >> 1], P1); MPIN(P1); } } \
      SBAR(); \
      if (g == 0 && !V_NOPACK) { PACK1(); }                            \
      if (DO_QK && NG == 2 && g == 1 && !V_NOMAX) { MAX0(); } \
      if (DO_QK && g >= 2 && g + 2 < NG) kf[g & 1] = KFR(g + 2, (BKN) * SHM_K); \
      if (g == NG - 2) vf[0] = VFR(0, (BVC) * SHM_V); if (g == NG - 1) vf[1] = VFR(1, (BVC) * SHM_V); \
      SBAR(); } \
      \
    if (!V_NOPV) { o[0] = MFMA8(pf, vf[0], o[0]); MPIN(o[0]); } SBAR(); if (DO_WR && !V_NOSTG) { SWRITE(BW); } if (DO_LD && !V_NOSTG) { SLOAD(((tt) + 4) * 64); } vf[2] = VFR(2, (BVC) * SHM_V); al = 1.f; \
    if (DO_QK && !V_NOMAX) { if (NG == 2) { MAXFIN(); } else { MAX0(); } } SBAR(); \
      \
    if (!V_NOPV) { o[1] = MFMA8(pf, vf[1], o[1]); MPIN(o[1]); } SBAR(); vf[0] = VFR(3, (BVC) * SHM_V); \
    if (DO_QK && NG == 2 && !V_NOEXP) { EXPS(P0, 0, 8); } if (DO_QK && NG != 2 && !V_NOMAX) { MAXFIN(); } SBAR(); \
    if (STG && grpB && !V_NOBAR) { __syncthreads(); } SBAR();   \
      \
    if (!V_NOPV) { o[2] = MFMA8(pf, vf[2], o[2]); MPIN(o[2]); } SBAR(); if (DO_QK && !V_NOEXP) { if (NG == 2) { EXPS(P0, 8, 16); } else { EXPS(P0, 0, 11); } } SBAR(); \
    if (!V_NOPV) { o[3] = MFMA8(pf, vf[0], o[3]); MPIN(o[3]); } SBAR(); if (DO_QK && !V_NOEXP) { if (NG == 2) { EXPS(P1, 0, 8); } else { EXPS(P0, 11, 16); EXPS(P1, 0, 6); } } \
    if (DO_KP) { kpf0 = KFR(0, (BKP) * SHM_K); kpf1 = KFR(1, (BKP) * SHM_K); } SBAR(); \
    if (!V_NOPV) { ol = MFMA8(pf, ones8, ol); MPIN(ol); } SBAR(); if (DO_QK && !V_NOEXP) { if (NG == 2) { EXPS(P1, 8, 16); } else { EXPS(P1, 6, 16); } } SBAR(); \
    if (DO_QK) { if (!V_NOPACK) { PACK0(); } RESC(al); } \
    if (!V_NOBAR && !(STG && grpB)) __syncthreads(); } while (0)
  __syncthreads();
  SLOAD(0); SWRITE(0); SLOAD(64); SWRITE(1); SLOAD(128); SWRITE(2); SLOAD(192); __syncthreads();
#pragma unroll
  for (int r = 0; r < 16; ++r) negm[r] = 0.f;
#pragma unroll
  for (int c = 0; c < NKC; ++c) { const v8i32 k0_ = KFR(2 * c, 0), k1_ = KFR(2 * c + 1, 0);
    if (c == 0) { P0 = MFMA8(k0_, qf[c], negm); P1 = MFMA8(k1_, qf[c], negm); } else { P0 = MFMA8(k0_, qf[c], P0); P1 = MFMA8(k1_, qf[c], P1); } }
  { float mx_ = P0[0];
#pragma unroll
    for (int r = 1; r < 16; ++r) mx_ = fmaxf(mx_, P0[r]);
#pragma unroll
    for (int r = 0; r < 16; ++r) mx_ = fmaxf(mx_, P1[r]);
    { auto rr_ = __builtin_amdgcn_permlane32_swap(__float_as_uint(mx_), __float_as_uint(mx_), false, false); mx_ = fmaxf(__uint_as_float(rr_[0]), __uint_as_float(rr_[1])); }
#pragma unroll
    for (int r = 0; r < 16; ++r) { P0[r] = __builtin_amdgcn_exp2f(P0[r] - mx_ + PSH); P1[r] = __builtin_amdgcn_exp2f(P1[r] - mx_ + PSH); negm[r] = PSH - mx_; } }
  PACKP();
  kpf0 = KFR(0, 1 * SHM_K); kpf1 = KFR(1, 1 * SHM_K);
  int t = 0;
  WConv wcv; int wc_it = wc_base + __builtin_amdgcn_readfirstlane(wid);
  for (; t + 7 < NT; t += 4) {
    STEP(1, 0, 3, 2, true, true, true, true, t);
    if constexpr (WC) wconv_load(*pp, wc_it, lane, wcv);
    STEP(2, 1, 0, 3, true, true, true, true, t + 1);
    STEP(3, 2, 1, 0, true, true, true, true, t + 2);
    if constexpr (WC) { wconv_store(*pp, wc_it, lane, wcv); wc_it += (int)gridDim.x * 8; }
    STEP(0, 3, 2, 1, true, true, true, true, t + 3);
  }
  STEP(1, 0, 3, 2, true, true, false, true, t);
  STEP(2, 1, 0, 3, true, false, false, true, t + 1);
  STEP(3, 2, 1, 0, true, false, false, false, t + 2);
  STEP(0, 3, 2, 1, false, false, false, false, t + 3);
  float rli[16];
#pragma unroll
  for (int r = 0; r < 16; ++r) rli[r] = __builtin_amdgcn_rcpf(ol[r]);
  if constexpr (OM == 1) {
    unsigned* st = (unsigned*)stash + tid;
#pragma unroll
    for (int r = 0; r < 16; ++r) { st[(2 * r) * 512] = cvt_pk_bf16(o[0][r] * rli[r], o[1][r] * rli[r]); st[(2 * r + 1) * 512] = cvt_pk_bf16(o[2][r] * rli[r], o[3][r] * rli[r]); }
  } else if constexpr (OM == 2) {
    const unsigned* st = (const unsigned*)stash + tid;
    float sw[4];
#pragma unroll
    for (int d0 = 0; d0 < 4; ++d0) sw[d0] = subw[d0 * 32 + r32] * 0.8f;
    bf16_t* Ow = Ob + (long)(wid * 32) * ldo;
#pragma unroll
    for (int r = 0; r < 16; ++r) { const unsigned w01 = st[(2 * r) * 512], w23 = st[(2 * r + 1) * 512];
      const float d0v = bflo(w01) - lam * (o[0][r] * rli[r]), d1v = bfhi(w01) - lam * (o[1][r] * rli[r]), d2v = bflo(w23) - lam * (o[2][r] * rli[r]), d3v = bfhi(w23) - lam * (o[3][r] * rli[r]);
      float ss = (d0v * d0v + d1v * d1v) + (d2v * d2v + d3v * d3v);
      ss += __shfl_xor(ss, 1); ss += __shfl_xor(ss, 2); ss += __shfl_xor(ss, 4); ss += __shfl_xor(ss, 8); ss += __shfl_xor(ss, 16);
      const float rn = rsqrtf(ss * (1.f / 128.f) + EPS); const long ob = (long)crow(r, hi) * ldo + r32;
      Ow[ob] = f2bf(SQ6(d0v * rn * sw[0])); Ow[ob + 32] = f2bf(SQ6(d1v * rn * sw[1])); Ow[ob + 64] = f2bf(SQ6(d2v * rn * sw[2])); Ow[ob + 96] = f2bf(SQ6(d3v * rn * sw[3])); }
  } else {
    bf16_t* Ow = Ob + (long)(wid * 32) * ldo;
#pragma unroll
    for (int r = 0; r < 16; ++r) { const int orow = crow(r, hi);
#pragma unroll
      for (int d0 = 0; d0 < 4; ++d0) Ow[(long)orow * ldo + d0 * 32 + r32] = f2bf(SQ6(o[d0][r] * rli[r] * 32.f) * (1.f / 32.f)); }
  }
#undef BL16
#undef SLOAD
#undef SWRITE
#undef RESC
#undef KFR
#undef VFR
#undef LDP
#undef STEP
#undef PACKP
#undef MPIN
#undef PACK0
#undef PACK1
#undef MAX0
#undef MAXFIN
#undef EXPS
}
#undef OFF8
#undef SBAR
#undef MFMA8
#undef LD32
}
#ifdef HW_XCD_MAP
__device__ __forceinline__ int att_cc(const Params& p, const char* lds, int u) {
    const volatile unsigned* bst = (const volatile unsigned*)(lds + 160 * 1024 - 512); const unsigned* cnt = (const unsigned*)(p.ws + WS_BAR) + 3500;
    bool ok = gridDim.x == 256;
#pragma unroll
    for (int i = 0; i < 8; ++i) ok = ok && (__hip_atomic_load(cnt + i, __ATOMIC_RELAXED, __HIP_MEMORY_SCOPE_AGENT) == 32u);
    return ok ? (int)(bst[2] + 8u * bst[3]) : -1;
}
#define ATT_CC(u) (hwcc_ >= 0 ? hwcc_ : ((u) & 255))
#else
#define ATT_CC(u) ((u) & 255)
#endif
#ifdef HW_XCD_MAP
#define ATT_CC_INIT const int hwcc_ = __builtin_amdgcn_readfirstlane(att_cc(p, lds, 0));
#else
#define ATT_CC_INIT
#endif
__device__ __forceinline__ void p4_attention_diff(const Params& p, char* lds) {
    unsigned char* ws = p.ws;
    const bf16_t* PJ = (const bf16_t*)(ws + WS_PJ); bf16_t* MIX = (bf16_t*)(ws + WS_MIX);
    char* stash = lds + 80 * 1024;
    ATT_CC_INIT
#if ATT_FP8 && WCONV_IN_ATT
    const int wcoff = gridDim.x == 256 ? 0 : attn8::WCONV_ITEMS;
    if (gridDim.x != 256) { const int tid_ = tid_opaque(), lane_ = tid_ & 63, gw_ = blockIdx.x * NWAVES + (tid_ >> 6), NGW_ = gridDim.x * NWAVES;
        for (int it = gw_; it < attn8::WCONV_ITEMS; it += NGW_) { attn8::WConv w_; attn8::wconv_load(p, it, lane_, w_); attn8::wconv_store(p, it, lane_, w_); } }
#else
    const int wcoff = 0;
#endif
    for (int u = blockIdx.x; u < 512 + ATT_EXTRA; u += gridDim.x) {
        const int round = (u >> 8) & 1, cc = ATT_CC(u), x = ATT_X(cc), j = ATT_J(cc);
        const int pd = x * 2 + round, b = pd >> 2, h = pd & 3;
        const size_t krow0 = (size_t)b * RPB, qrow0 = krow0 + CTX + (size_t)j * 256;
#if ATT_EXTRA
        if (u >= 512) { const unsigned char* vtx_ = ws + WS_VT8D + (size_t)(b * 4 + h) * 128 * RPB;
            attn8::attn_unit<1, 0, ATT_VAR>(ws + WS_Q8D + qrow0 * 512 + (2 * h) * 64, 512, ws + WS_K8D + krow0 * 512 + (2 * h) * 64, 512, nullptr, 0, nullptr, 0, vtx_, (bf16_t*)(ws + WS_AO) + qrow0 * 128, 128, RPB, lds);
            attn8::attn_unit<1, 0, ATT_VAR>(ws + WS_Q8D + qrow0 * 512 + (2 * h + 1) * 64, 512, ws + WS_K8D + krow0 * 512 + (2 * h + 1) * 64, 512, nullptr, 0, nullptr, 0, vtx_, (bf16_t*)(ws + WS_AO) + qrow0 * 128, 128, RPB, lds);
            continue; }
#endif
#if ATT_FP8
        const unsigned char* vt_ = ws + WS_VT8D + (size_t)(b * 4 + h) * 128 * RPB;
        const int wcb0 = wcoff + ((u / (int)gridDim.x) * 2 + 0) * 32 * (int)gridDim.x * 8 + (int)blockIdx.x * 8, wcb1 = wcb0 + 32 * (int)gridDim.x * 8;
        if (u < (int)gridDim.x) attn8::attn_unit<1, 1, 0, WCONV_IN_ATT != 0>(ws + WS_Q8D + qrow0 * 512 + (2 * h) * 64, 512, ws + WS_K8D + krow0 * 512 + (2 * h) * 64, 512, nullptr, 0, nullptr, 0, vt_, nullptr, 0, RPB, lds, stash, 0.f, nullptr, &p, wcoff + 131072 + (int)blockIdx.x * 8);
        else attn8::attn_unit<1, 1, 0, false>(ws + WS_Q8D + qrow0 * 512 + (2 * h) * 64, 512, ws + WS_K8D + krow0 * 512 + (2 * h) * 64, 512, nullptr, 0, nullptr, 0, vt_, nullptr, 0, RPB, lds, stash);
#else
        attn::attn_unit<1, 1, 0, 1>(PJ + qrow0 * NPROJ + (2 * h) * 64, NPROJ, PJ + krow0 * NPROJ + 512 + (2 * h) * 64, NPROJ, nullptr, 0, nullptr, 0,
                              PJ + krow0 * NPROJ + 1024 + h * 128, NPROJ, nullptr, 0, RPB, 1.f, lds, stash);
#endif
        const int lane_ = tid_opaque() & 63;
        const float s1 = wave_sum(p.lq1[lane_] * p.lk1[lane_]), s2 = wave_sum(p.lq2[lane_] * p.lk2[lane_]);
        const float lam = __expf(s1) - __expf(s2) + 0.2f;
#if ATT_FP8
        attn8::attn_unit<1, 2, 0, false>(ws + WS_Q8D + qrow0 * 512 + (2 * h + 1) * 64, 512, ws + WS_K8D + krow0 * 512 + (2 * h + 1) * 64, 512, nullptr, 0, nullptr, 0, vt_, MIX + qrow0 * 1024 + h * 128, 1024, RPB, lds, stash, lam, p.subln_w, &p, wcb1);
#else
        attn::attn_unit<1, 1, 0, 2>(PJ + qrow0 * NPROJ + (2 * h + 1) * 64, NPROJ, PJ + krow0 * NPROJ + 512 + (2 * h + 1) * 64, NPROJ, nullptr, 0, nullptr, 0,
                              PJ + krow0 * NPROJ + 1024 + h * 128, NPROJ, MIX + qrow0 * 1024 + h * 128, 1024, RPB, 1.f, lds, stash, lam, p.subln_w);
#endif
    }
}
__device__ __forceinline__ void p4_attention_mla(const Params& p, char* lds) {
    unsigned char* ws = p.ws;
    const bf16_t* PJ = (const bf16_t*)(ws + WS_PJ); const bf16_t* QM = (const bf16_t*)(ws + WS_QM); const bf16_t* KVb = (const bf16_t*)(ws + WS_KV);
    bf16_t* MIX = (bf16_t*)(ws + WS_MIX);
    constexpr float LOG2E = 1.4426950408889634f;
    ATT_CC_INIT
    for (int u = blockIdx.x; u < 512; u += gridDim.x) {
        const int round = u >> 8, cc = ATT_CC(u), x = ATT_X(cc), j = ATT_J(cc);
        const int pd = x * 2 + round, b = pd >> 2, h = pd & 3;
        const size_t krow0 = (size_t)b * RPB, qrow0 = krow0 + CTX + (size_t)j * 256;
#if ATT_FP8
        const int wcb = (gridDim.x == 256 ? 0 : attn8::WCONV_ITEMS) + (u / (int)gridDim.x) * 32 * (int)gridDim.x * 8 + (int)blockIdx.x * 8;
        attn8::attn_unit<3, 0, 0, WCONV_IN_ATT != 0>(ws + WS_Q8M + qrow0 * 768 + h * 192, 768, ws + WS_K8M + krow0 * 512 + h * 128, 512, ws + WS_K8M + krow0 * 512 + h * 128 + 64, 512, ws + WS_KR8 + krow0 * 64, 64,
                               ws + WS_VT8M + (size_t)(b * 4 + h) * 128 * RPB, MIX + qrow0 * 1024 + 512 + h * 128, 1024, RPB, lds, nullptr, 0.f, nullptr, &p, wcb);
#else
        attn::attn_unit<3, MLA_NQR>(QM + qrow0 * 768 + h * 192, 768, KVb + krow0 * 1024 + h * 256, 1024, KVb + krow0 * 1024 + h * 256 + 64, 1024, PJ + krow0 * NPROJ + 1920, NPROJ,
                              KVb + krow0 * 1024 + h * 256 + 128, 1024, MIX + qrow0 * 1024 + 512 + h * 128, 1024, RPB, 0.07216878364870322f * LOG2E, lds);
#endif
    }
}

__device__ __forceinline__ void p5_mix(const Params& p) {
    const int tid = tid_opaque(), lane = tid & 63, wave = tid >> 6;
    const int gw = blockIdx.x * NWAVES + wave, NGW = gridDim.x * NWAVES;
    const bf16_t* AO = (const bf16_t*)(p.ws + WS_AO); bf16_t* MIX = (bf16_t*)(p.ws + WS_MIX);
    const float s1 = wave_sum(p.lq1[lane] * p.lk1[lane]), s2 = wave_sum(p.lq2[lane] * p.lk2[lane]);
    const float lam_init = 0.2f, lam = __expf(s1) - __expf(s2) + lam_init;
    const int hh = lane >> 4, e0 = (lane & 15) * 8;
    float sw[8];
#pragma unroll
    for (int i = 0; i < 8; ++i) sw[i] = p.subln_w[e0 + i] * (1.f - lam_init);
    for (int t = gw; t < T; t += NGW) {
        const int b = t >> 13, row = b * RPB + CTX + (t & 8191);
        const bf16_t* src = AO + (size_t)row * 1536;
        const u32x4 a = *(const u32x4*)(src + hh * 256 + e0), bq = *(const u32x4*)(src + hh * 256 + 128 + e0), mq = *(const u32x4*)(src + 1024 + lane * 8);
        float o[8];
        o[0] = bflo(a.x) - lam * bflo(bq.x); o[1] = bfhi(a.x) - lam * bfhi(bq.x); o[2] = bflo(a.y) - lam * bflo(bq.y); o[3] = bfhi(a.y) - lam * bfhi(bq.y);
        o[4] = bflo(a.z) - lam * bflo(bq.z); o[5] = bfhi(a.z) - lam * bfhi(bq.z); o[6] = bflo(a.w) - lam * bflo(bq.w); o[7] = bfhi(a.w) - lam * bfhi(bq.w);
        float ss = 0.f;
#pragma unroll
        for (int i = 0; i < 8; ++i) ss += o[i] * o[i];
        ss += __shfl_xor(ss, 1); ss += __shfl_xor(ss, 2); ss += __shfl_xor(ss, 4); ss += __shfl_xor(ss, 8);
        const float r = rsqrtf(ss * (1.f / 128.f) + EPS);
        u32x4 w; w.x = cvt_pk_bf16(o[0] * r * sw[0], o[1] * r * sw[1]); w.y = cvt_pk_bf16(o[2] * r * sw[2], o[3] * r * sw[3]);
        w.z = cvt_pk_bf16(o[4] * r * sw[4], o[5] * r * sw[5]); w.w = cvt_pk_bf16(o[6] * r * sw[6], o[7] * r * sw[7]);
        bf16_t* dst = MIX + (size_t)row * 1024;
        *(u32x4*)(dst + hh * 128 + e0) = w; *(u32x4*)(dst + 512 + lane * 8) = mq;
    }
}

typedef short bf16x8_t __attribute__((ext_vector_type(8)));
__device__ __forceinline__ void p7a_route(const Params& p, unsigned char* lds) {
    const int tid = tid_opaque(), lane = tid & 63, wave = tid >> 6, row = lane & 15, kq = lane >> 4;
    int* lcnt = (int*)(lds + 147456); int* lbase = lcnt + 32; int* tok_e = lbase + 32; int* tok_r = tok_e + 1024;
    for (int i = tid; i < 8192; i += NTHREADS) ((u32x4*)lds)[i] = ((const u32x4*)(p.ws + WS_RWF))[i];
    if (tid < 32) lcnt[tid] = 0;
    const int chunk = (T + gridDim.x - 1) / gridDim.x;
    const int t0 = blockIdx.x * chunk, t1 = (t0 + chunk < T) ? t0 + chunk : T;
    float* vab = (float*)(lds + 131072); const int b0 = t0 >> 13;
    { const float* mods_ = (const float*)(p.ws + WS_MODS);
      for (int i = tid; i < 2048; i += NTHREADS) { const int bb = min(b0 + (i >> 10), NB - 1), k = i & 1023; const float* md_ = mods_ + bb * 6144;
          vab[(i >> 10) * 2048 + k] = p.ffn_norm_w[k] * (md_[4 * 1024 + k] + 1.f); vab[(i >> 10) * 2048 + 1024 + k] = md_[3 * 1024 + k]; } }
    __syncthreads();
    const bf16_t* XN = (const bf16_t*)(p.ws + WS_XN); const float* mods = (const float*)(p.ws + WS_MODS);
    unsigned char* HF = p.ws + WS_HF;
    int* TOPI = (int*)(p.ws + WS_TOPI); float* GATE = (float*)(p.ws + WS_GATE); int* RANK = (int*)(p.ws + WS_RANK); int* CNT = (int*)(p.ws + WS_CNT);
    const u32x4* rwf = (const u32x4*)lds + lane;
    for (int tb = t0 + 16 * wave; tb < t1; tb += 16 * NWAVES) {
        const int t = tb + row, b = tb >> 13; const float* md = mods + b * 6144;
        const bf16_t* xr = XN + (size_t)t * DM + 8 * kq;
        const float r = rsqrtf(((const float*)(p.ws + WS_RSX))[t] * (1.f / DM) + EPS);
        f32x4 acc0 = {0.f, 0.f, 0.f, 0.f}, acc1 = {0.f, 0.f, 0.f, 0.f};
        const float* va = vab + ((tb >> 13) - b0) * 2048 + 8 * kq; const float* vb = va + 1024;
        u32x4 xq[4];
#pragma unroll
        for (int j = 0; j < 4; ++j) xq[j] = *(const u32x4*)(xr + 32 * j);
#pragma unroll 4
        for (int s = 0; s < 32; ++s) { const int k0 = 32 * s + 8 * kq;
            const u32x4 xw = xq[s & 3]; if (s + 4 < 32) xq[s & 3] = *(const u32x4*)(xr + 32 * (s + 4));
            const f32x4 xa = {bflo(xw.x), bfhi(xw.x), bflo(xw.y), bfhi(xw.y)}, xc = {bflo(xw.z), bfhi(xw.z), bflo(xw.w), bfhi(xw.w)};
            const f32x4 ha = xa * r * *(const f32x4*)(va + 32 * s) + *(const f32x4*)(vb + 32 * s), hc = xc * r * *(const f32x4*)(va + 32 * s + 4) + *(const f32x4*)(vb + 32 * s + 4);
            u32x4 hi, lo;
            hi.x = cvt_pk_bf16(ha.x, ha.y); hi.y = cvt_pk_bf16(ha.z, ha.w); hi.z = cvt_pk_bf16(hc.x, hc.y); hi.w = cvt_pk_bf16(hc.z, hc.w);
            lo.x = cvt_pk_bf16(ha.x - bflo(hi.x), ha.y - bfhi(hi.x)); lo.y = cvt_pk_bf16(ha.z - bflo(hi.y), ha.w - bfhi(hi.y));
            lo.z = cvt_pk_bf16(hc.x - bflo(hi.z), hc.y - bfhi(hi.z)); lo.w = cvt_pk_bf16(hc.z - bflo(hi.w), hc.w - bfhi(hi.w));
            { u32x2 h8; h8.x = cvt4_fp8(ha.x, ha.y, ha.z, ha.w); h8.y = cvt4_fp8(hc.x, hc.y, hc.z, hc.w); *(u32x2*)(HF + (size_t)t * DM + k0) = h8; }
            const bf16x8_t Ah = __builtin_bit_cast(bf16x8_t, hi), Al = __builtin_bit_cast(bf16x8_t, lo);
            const bf16x8_t Bh0 = __builtin_bit_cast(bf16x8_t, rwf[(s * 4 + 0) * 64]), Bl0 = __builtin_bit_cast(bf16x8_t, rwf[(s * 4 + 1) * 64]);
            const bf16x8_t Bh1 = __builtin_bit_cast(bf16x8_t, rwf[(s * 4 + 2) * 64]), Bl1 = __builtin_bit_cast(bf16x8_t, rwf[(s * 4 + 3) * 64]);
            acc0 = __builtin_amdgcn_mfma_f32_16x16x32_bf16(Ah, Bh0, acc0, 0, 0, 0); acc0 = __builtin_amdgcn_mfma_f32_16x16x32_bf16(Ah, Bl0, acc0, 0, 0, 0); acc0 = __builtin_amdgcn_mfma_f32_16x16x32_bf16(Al, Bh0, acc0, 0, 0, 0);
            acc1 = __builtin_amdgcn_mfma_f32_16x16x32_bf16(Ah, Bh1, acc1, 0, 0, 0); acc1 = __builtin_amdgcn_mfma_f32_16x16x32_bf16(Ah, Bl1, acc1, 0, 0, 0); acc1 = __builtin_amdgcn_mfma_f32_16x16x32_bf16(Al, Bh1, acc1, 0, 0, 0); }
        const float rb0 = p.router_b[row], rb1 = p.router_b[16 + row];
#pragma unroll
        for (int reg = 0; reg < 4; ++reg) { float v0 = acc0[reg] + rb0, v1 = acc1[reg] + rb1; float tv[4]; int ti[4];
#pragma unroll
            for (int k = 0; k < 4; ++k) { float m = fmaxf(v0, v1);
                m = fmaxf(m, __shfl_xor(m, 1)); m = fmaxf(m, __shfl_xor(m, 2)); m = fmaxf(m, __shfl_xor(m, 4)); m = fmaxf(m, __shfl_xor(m, 8));
                int cand = (v0 == m) ? row : ((v1 == m) ? 16 + row : 99);
                cand = min(cand, __shfl_xor(cand, 1)); cand = min(cand, __shfl_xor(cand, 2)); cand = min(cand, __shfl_xor(cand, 4)); cand = min(cand, __shfl_xor(cand, 8));
                tv[k] = m; ti[k] = cand; if (cand == row) v0 = -INFINITY; if (cand == 16 + row) v1 = -INFINITY; }
            const float e1 = __expf(tv[1] - tv[0]), e2 = __expf(tv[2] - tv[0]), e3 = __expf(tv[3] - tv[0]); const float inv = 1.f / (1.f + e1 + e2 + e3);
            const int tt = tb + 4 * kq + reg;
            if (row < 4 && tt < t1) { const int ei = row == 0 ? ti[0] : row == 1 ? ti[1] : row == 2 ? ti[2] : ti[3]; const float gv = (row == 0 ? 1.f : row == 1 ? e1 : row == 2 ? e2 : e3) * inv;
                const int lr = atomicAdd(&lcnt[ei], 1);
                TOPI[tt * 4 + row] = ei; GATE[tt * 4 + row] = gv; tok_e[(tt - t0) * 4 + row] = ei; tok_r[(tt - t0) * 4 + row] = lr; } }
    }
    __syncthreads();
    if (tid < 32) lbase[tid] = atomicAdd(&CNT[tid], lcnt[tid]);
    __syncthreads();
    for (int i = tid; i < (t1 - t0) * 4; i += NTHREADS) RANK[t0 * 4 + i] = lbase[tok_e[i]] + tok_r[i];
}

__device__ __forceinline__ void moe_segments(const Params& p, int* seg) {
    if (threadIdx.x == 0) { const int* CNT = (const int*)(p.ws + WS_CNT); int s = 0;
        for (int e = 0; e < 32; ++e) { seg[e] = s; s += (CNT[e] + 255) & ~255; } seg[32] = s; }
    __syncthreads();
}
__device__ __forceinline__ void p7b_scatter(const Params& p, const int* seg) {
    const int tid = tid_opaque();
    const int gt = blockIdx.x * NTHREADS + tid, NGT = gridDim.x * NTHREADS;
    const int* TOPI = (const int*)(p.ws + WS_TOPI); const float* GATE = (const float*)(p.ws + WS_GATE); const int* RANK = (const int*)(p.ws + WS_RANK);
    int* DEST = (int*)(p.ws + WS_DEST); float* GS = (float*)(p.ws + WS_GSRT); int* RTOK = (int*)(p.ws + WS_RTOK);
    for (int i = gt; i < T * 4; i += NGT) { const int dest = seg[TOPI[i]] + RANK[i]; DEST[i] = dest; GS[dest] = GATE[i]; RTOK[dest] = i >> 2; }
}
__device__ __forceinline__ void p10_final(const Params& p, const bool with_moe) {
    const int tid = tid_opaque(), lane = tid & 63, wave = tid >> 6;
    const int gw = blockIdx.x * NWAVES + wave, NGW = gridDim.x * NWAVES;
    const bf16_t* XN = (const bf16_t*)(p.ws + WS_XN); const float* mods = (const float*)(p.ws + WS_MODS);
    const int* DEST = (const int*)(p.ws + WS_DEST);
    const f32x4* w4 = (const f32x4*)p.final_norm_w;
    for (int tb = gw; tb < T; tb += P10_NT * NGW) {
        int tt[P10_NT]; bool ok[P10_NT]; u32x2 xw[P10_NT][4];
#if YS_FP8
        unsigned yw[P10_NT][4][4];
#else
        u32x2 yw[P10_NT][4][4];
#endif
#pragma unroll
        for (int q = 0; q < P10_NT; ++q) { const int t_ = tb + q * NGW; ok[q] = t_ < T; tt[q] = ok[q] ? t_ : tb; }
#pragma unroll
        for (int q = 0; q < P10_NT; ++q) { const u32x2* xr = (const u32x2*)(XN + (size_t)tt[q] * DM);
#pragma unroll
            for (int j = 0; j < 4; ++j) xw[q][j] = xr[64 * j + lane];
            if (with_moe) {
#pragma unroll
                for (int k = 0; k < 4; ++k) { const int d = DEST[tt[q] * 4 + k];
#if YS_FP8
                    const unsigned* yr = (const unsigned*)(p.ws + WS_XS + (size_t)d * 1024);
#else
                    const u32x2* yr = (const u32x2*)(p.ws + WS_XS + (size_t)d * 2048);
#endif
#pragma unroll
                    for (int j = 0; j < 4; ++j) yw[q][k][j] = yr[64 * j + lane]; } } }
#pragma unroll
        for (int q = 0; q < P10_NT; ++q) { const int t = tt[q], b = t >> 13; const f32x4* g4 = (const f32x4*)(mods + b * 6144 + 5 * 1024);
            f32x4 xv[4];
#pragma unroll
            for (int j = 0; j < 4; ++j) { xv[j] = (f32x4){bflo(xw[q][j].x), bfhi(xw[q][j].x), bflo(xw[q][j].y), bfhi(xw[q][j].y)};
                if (with_moe) { f32x4 y = {0.f, 0.f, 0.f, 0.f};
#pragma unroll
                    for (int k = 0; k < 4; ++k) {
#if YS_FP8
                        const int w_ = (int)yw[q][k][j]; const auto lo_ = __builtin_amdgcn_cvt_pk_f32_fp8(w_, false), hi_ = __builtin_amdgcn_cvt_pk_f32_fp8(w_, true);
                        y += (f32x4){lo_[0], lo_[1], hi_[0], hi_[1]};
#else
                        const u32x2 w_ = yw[q][k][j]; y += (f32x4){bflo(w_.x), bfhi(w_.x), bflo(w_.y), bfhi(w_.y)};
#endif
                    }
                    xv[j] += g4[64 * j + lane] * y * (YS_FP8 ? 1.f / YS_SCALE : 1.f); } }
            float s = 0.f;
#pragma unroll
            for (int j = 0; j < 4; ++j) s += (xv[j].x * xv[j].x + xv[j].y * xv[j].y) + (xv[j].z * xv[j].z + xv[j].w * xv[j].w);
            float r = rsqrtf(wave_sum(s) * (1.f / DM) + EPS);
#if DBG_STAGE
            r *= 1.f + 10.f * fminf(__uint_as_float(((const unsigned*)(p.ws + WS_CNT))[64]), 100.f);
#endif
            if (ok[q]) { f32x4* o = (f32x4*)(p.out + (size_t)t * DM);
#pragma unroll
                for (int j = 0; j < 4; ++j) o[64 * j + lane] = xv[j] * r * w4[64 * j + lane]; }
        }
    }
}
#if DBG_STAGE
__device__ __forceinline__ void dbg_report(const Params& p, float err) {
    if (!(err >= 0.f)) err = 1e6f;
    atomicMax((unsigned*)(p.ws + WS_CNT) + 64, __float_as_uint(err));
}
__device__ __forceinline__ void dbg_rope(float& x1, float& x2, int pv, int pp) {
    const float inv = exp2f(-(float)pp * (13.287712379549449f / 16.f)); float sn, cs; sincosf((float)pv * inv, &sn, &cs);
    const float a = x1 * cs - x2 * sn, b = x2 * cs + x1 * sn; x1 = a; x2 = b;
}
__device__ __forceinline__ void dbg_check_proj(const Params& p) {
    const int gt = blockIdx.x * NTHREADS + threadIdx.x, NGT = gridDim.x * NTHREADS;
    const bf16_t* HB = (const bf16_t*)(p.ws + WS_HB); const bf16_t* PJ = (const bf16_t*)(p.ws + WS_PJ); const bf16_t* QM = (const bf16_t*)(p.ws + WS_QM); const bf16_t* KVb = (const bf16_t*)(p.ws + WS_KV);
    float emax = 0.f;
    for (int it = gt; it < 24 * 224; it += NGT) { const int rs = it / 224, cpi = it % 224; const int row = rs < 6 ? (rs & 3) * RPB + (rs * 37) % CTX : (rs * 1409 + 77) % MALL; const int grp = cpi >> 4, pp = cpi & 15, c0 = 1536 + grp * 32 + pp, c1 = c0 + 16;
        float a0 = 0.f, a1 = 0.f;
        for (int k = 0; k < 1024; ++k) { const float h = bf2f(HB[(size_t)row * 1024 + k]); a0 += h * bf2f(f2bf(p.w_in[(size_t)k * 1984 + c0])); a1 += h * bf2f(f2bf(p.w_in[(size_t)k * 1984 + c1])); }
        const int i = row % RPB; if (i >= CTX && c0 >= 1920) { const int pos = i - CTX, a = (c0 >> 5) & 1; dbg_rope(a0, a1, a ? (pos & 63) : (pos >> 6), pp); }
        const float f0 = bf2f(PJ[(size_t)row * NPROJ + c0]), f1 = bf2f(PJ[(size_t)row * NPROJ + c1]);
        emax = fmaxf(emax, fmaxf(fabsf(f0 - a0), fabsf(f1 - a1))); }
    for (int it = gt; it < 24 * 384; it += NGT) { const int rs = it / 384, cpi = it % 384; const int row = rs < 6 ? (rs & 3) * RPB + (rs * 41) % CTX : (rs * 1409 + 300) % MALL; const int grp = cpi >> 4, pp = cpi & 15, c0 = grp * 32 + pp, c1 = c0 + 16;
        float ss = 0.f, a0 = 0.f, a1 = 0.f;
        for (int k = 0; k < 256; ++k) { const float v = bf2f(PJ[(size_t)row * NPROJ + 1536 + k]); ss += v * v; const float vw = v * p.q_norm_w[k]; a0 += vw * p.w_uq[(size_t)k * 768 + c0]; a1 += vw * p.w_uq[(size_t)k * 768 + c1]; }
        const float r = rsqrtf(ss / 256.f + EPS); a0 *= r; a1 *= r;
        const int i = row % RPB, g6 = grp % 6; if (i >= CTX && g6 >= 4) { const int pos = i - CTX; dbg_rope(a0, a1, g6 == 5 ? (pos & 63) : (pos >> 6), pp); }
        const float f0 = bf2f(QM[(size_t)row * 768 + c0]), f1 = bf2f(QM[(size_t)row * 768 + c1]);
        emax = fmaxf(emax, fmaxf(fabsf(f0 - a0), fabsf(f1 - a1))); }
    for (int it = gt; it < 24 * 1024; it += NGT) { const int rs = it >> 10, c0 = it & 1023; const int row = rs < 6 ? (rs & 3) * RPB + (rs * 43) % CTX : (rs * 1409 + 555) % MALL;
        float ss = 0.f, a0 = 0.f;
        for (int k = 0; k < 128; ++k) { const float v = bf2f(PJ[(size_t)row * NPROJ + 1792 + k]); ss += v * v; a0 += v * p.kv_norm_w[k] * p.w_ukv[(size_t)k * 1024 + c0]; }
        a0 *= rsqrtf(ss / 128.f + EPS);
        emax = fmaxf(emax, fabsf(bf2f(KVb[(size_t)row * 1024 + c0]) - a0)); }
    emax = wave_max(emax);
    if ((threadIdx.x & 63) == 0) dbg_report(p, emax);
}
__device__ __forceinline__ void dbg_check_attn(const Params& p, unsigned char* lds, int kind_sel) {
    const int tid = threadIdx.x;
    const bf16_t* PJ = (const bf16_t*)(p.ws + WS_PJ); const bf16_t* QM = (const bf16_t*)(p.ws + WS_QM); const bf16_t* KVb = (const bf16_t*)(p.ws + WS_KV); const bf16_t* AO = (const bf16_t*)(p.ws + WS_MIX);
    float* sc = (float*)lds; float* red = sc + 8448; float* qv = red + 1024;
    for (int s = blockIdx.x; s < 128; s += gridDim.x) {
        const int kind = s & 1; if (kind_sel >= 0 && kind != kind_sel) continue;
        const int b = (s >> 1) & 3, hh = (s >> 3) & 7, qpos = ((s >> 1) * 2731 + 13) & 8191;
        const size_t krow0 = (size_t)b * RPB, qrow = krow0 + CTX + qpos;
        const int dqk = kind ? 192 : 64; const int h = kind ? (hh & 3) : hh;
#if ATT_FP8
        const float scale = 0.6931471805599453f;
        const unsigned char* W8 = p.ws;
#define F8(ptr) __builtin_amdgcn_cvt_f32_fp8((int)(*(const unsigned char*)(ptr)), 0)
        __syncthreads();
        if (tid < dqk) qv[tid] = kind ? F8(W8 + WS_Q8M + qrow * 768 + h * 192 + tid) : F8(W8 + WS_Q8D + qrow * 512 + h * 64 + tid);
        __syncthreads();
        float lmax = -1e30f;
        for (int k = tid; k < RPB; k += NTHREADS) { float a = 0.f;
            if (kind) { for (int d = 0; d < 128; ++d) a += qv[d] * F8(W8 + WS_K8M + (krow0 + k) * 512 + h * 128 + d); for (int d = 0; d < 64; ++d) a += qv[128 + d] * F8(W8 + WS_KR8 + (krow0 + k) * 64 + d); }
            else { for (int d = 0; d < 64; ++d) a += qv[d] * F8(W8 + WS_K8D + (krow0 + k) * 512 + h * 64 + d); }
            a *= scale; sc[k] = a; lmax = fmaxf(lmax, a); }
#else
        const float scale = kind ? 0.07216878364870322f : 0.6931471805599453f;
        __syncthreads();
        if (tid < dqk) qv[tid] = kind ? bf2f(QM[qrow * 768 + h * 192 + tid]) : bf2f(PJ[qrow * NPROJ + h * 64 + tid]);
        __syncthreads();
        float lmax = -1e30f;
        for (int k = tid; k < RPB; k += NTHREADS) { float a = 0.f;
            if (kind) { for (int d = 0; d < 128; ++d) a += qv[d] * bf2f(KVb[(krow0 + k) * 1024 + h * 256 + d]); for (int d = 0; d < 64; ++d) a += qv[128 + d] * bf2f(PJ[(krow0 + k) * NPROJ + 1920 + d]); }
            else { for (int d = 0; d < 64; ++d) a += qv[d] * bf2f(PJ[(krow0 + k) * NPROJ + 512 + h * 64 + d]); }
            a *= scale; sc[k] = a; lmax = fmaxf(lmax, a); }
#endif
        lmax = wave_max(lmax); if ((tid & 63) == 0) red[tid >> 6] = lmax; __syncthreads();
        float m = red[0]; for (int w = 1; w < 8; ++w) m = fmaxf(m, red[w]); __syncthreads();
        float lsum = 0.f; for (int k = tid; k < RPB; k += NTHREADS) { const float e = __expf(sc[k] - m); sc[k] = e; lsum += e; }
        lsum = wave_sum(lsum); if ((tid & 63) == 0) red[tid >> 6] = lsum; __syncthreads();
        float l = 0.f; for (int w = 0; w < 8; ++w) l += red[w]; __syncthreads();
        const int e = tid & 127, part = tid >> 7; float o = 0.f;
#if ATT_FP8
        for (int k = part; k < RPB; k += 4) { const unsigned char* vt = p.ws + (kind ? WS_VT8M : WS_VT8D) + ((size_t)(b * 4 + (kind ? h : (h >> 1))) * 128 + e) * RPB + (k & ~63) + vt_pos(k & 63); o += sc[k] * F8(vt); }
#else
        for (int k = part; k < RPB; k += 4) { const float v = kind ? bf2f(KVb[(krow0 + k) * 1024 + h * 256 + 128 + e]) : bf2f(PJ[(krow0 + k) * NPROJ + 1024 + (h >> 1) * 128 + e]); o += sc[k] * v; }
#endif
        red[tid] = o; __syncthreads();
        if (tid < 128) { const float on = (red[tid] + red[tid + 128] + red[tid + 256] + red[tid + 384]) / l;
            const float of = bf2f(AO[qrow * 1024 + 512 + h * 128 + tid]);
            float d2 = (of - on) * (of - on), n2 = on * on;
            d2 = wave_sum(d2); n2 = wave_sum(n2); red[512 + (tid >> 6) * 2] = d2; red[512 + (tid >> 6) * 2 + 1] = n2; }
        __syncthreads();
        if (tid == 0) { const float d2 = red[512] + red[514], n2 = red[513] + red[515]; dbg_report(p, sqrtf(d2 / (n2 + 1e-30f))); }
    }
    __syncthreads();
}
#endif
typedef const __attribute__((address_space(4))) Params* ParamsK;
#if defined(__HIP_DEVICE_COMPILE__)
#define LOAD_PARAMS() ({ ParamsK q_ = (ParamsK)__builtin_amdgcn_kernarg_segment_ptr(); asm volatile("" : "+s"(q_)); Params r_ = *q_; r_; })
#else
#define LOAD_PARAMS() (Params{})
#endif
#ifndef FIRST_PHASE
#define FIRST_PHASE 0
#endif
#define PH(k) ((k) >= FIRST_PHASE && (k) <= LAST_PHASE)
#ifndef EPIY_PROBE
#define EPIY_PROBE 0
#endif
#ifndef REP_MASK
#define REP_MASK 0
#endif
#define REP(k) for (int rep_ = 0; rep_ < (((REP_MASK) >> (k)) & 1) + 1; ++rep_)
#define PH_BEGIN { const Params p = LOAD_PARAMS(); unsigned char* ws = p.ws; (void)ws;
#define PH_END }
__global__ void __launch_bounds__(NTHREADS, 2) fwd_kernel(Params p_unused) {
    extern __shared__ __attribute__((aligned(16))) unsigned char lds[];
    cg::grid_group grid = cg::this_grid();
    LAS unsigned char* lds3 = (LAS unsigned char*)lds;
    const int G = gridDim.x, c = blockIdx.x;
    int* seg = (int*)(lds + 160 * 1024 - 256);
    volatile LAS unsigned* bst = (volatile LAS unsigned*)(lds3 + 160 * 1024 - 512);
    if (threadIdx.x < 2) bst[threadIdx.x] = 0u;
    __syncthreads();
    XcdBarrier bar;
    { ParamsK q_ = (ParamsK)__builtin_amdgcn_kernarg_segment_ptr(); bar = xcd_barrier_post((unsigned*)(q_->ws + WS_BAR), bst);
#ifdef HW_XCD_MAP
      if (threadIdx.x == 0) { const unsigned x_ = xb_xcc_id() & 7u; bst[2] = x_; bst[3] = atomicAdd((unsigned*)(q_->ws + WS_BAR) + 3500 + x_, 1u); }
#endif
    }
#ifdef USE_CG_SYNC
#define GRID_SYNC() grid.sync()
#else
#define GRID_SYNC() xcd_barrier(bar)
#endif

#ifdef ONLY4
#ifndef NO_DIFF
    PH_BEGIN p4_attention_diff(p, (char*)lds); PH_END
#endif
#ifndef NO_MLA
    PH_BEGIN p4_attention_mla(p, (char*)lds); PH_END
#endif
    return;
#endif
#ifdef UBENCH
    { typedef int v8i32_ __attribute__((ext_vector_type(8))); typedef float f32x16_ __attribute__((ext_vector_type(16))); typedef int v4i32_ __attribute__((ext_vector_type(4)));
      const int wv_ = __builtin_amdgcn_readfirstlane((int)threadIdx.x >> 6);
      float s_ = 0.f;
      LAS v4i32_* lp_ = (LAS v4i32_*)(lds3 + 65536) + threadIdx.x * 2;
      if (wv_ >= 4) { if (UBENCH != 5) {
          v8i32_ a_ = {(int)threadIdx.x, 1, 2, 3, 4, 5, 6, 7}, b_ = {7, 6, 5, 4, 3, 2, 1, (int)blockIdx.x}; f32x16_ c0 = {}, c1 = {}, c2 = {}, c3 = {}, c4 = {};
          for (int it = 0; it < 10000; ++it) {
              if (UBENCH >= 8) { const v4i32_ x0 = lp_[0], x1 = lp_[1]; b_ = __builtin_shufflevector(x0, x1, 0, 1, 2, 3, 4, 5, 6, 7); }
              c0 = __builtin_amdgcn_mfma_scale_f32_32x32x64_f8f6f4(a_, b_, c0, 0, 0, 0, 0, 0, 0); c1 = __builtin_amdgcn_mfma_scale_f32_32x32x64_f8f6f4(a_, b_, c1, 0, 0, 0, 0, 0, 0);
              c2 = __builtin_amdgcn_mfma_scale_f32_32x32x64_f8f6f4(a_, b_, c2, 0, 0, 0, 0, 0, 0); c3 = __builtin_amdgcn_mfma_scale_f32_32x32x64_f8f6f4(a_, b_, c3, 0, 0, 0, 0, 0, 0);
              c4 = __builtin_amdgcn_mfma_scale_f32_32x32x64_f8f6f4(a_, b_, c4, 0, 0, 0, 0, 0, 0); __builtin_amdgcn_sched_barrier(0);
              if (UBENCH >= 7) __syncthreads(); }
#pragma unroll
          for (int i = 0; i < 16; ++i) s_ += c0[i] + c1[i] + c2[i] + c3[i] + c4[i]; } }
      else if (UBENCH != 6) {
          float e_[32]; unsigned pk_[8];
#pragma unroll
          for (int i = 0; i < 32; ++i) e_[i] = (float)(threadIdx.x + i) * 1e-3f;
#pragma unroll
          for (int i = 0; i < 8; ++i) pk_[i] = 0u;
          for (int it = 0; it < 10000; ++it) {
              float m_ = e_[0];
#pragma unroll
              for (int i = 1; i < 31; i += 2) m_ = __builtin_fmaxf(__builtin_fmaxf(m_, e_[i]), e_[i + 1]);
#pragma unroll
              for (int i = 0; i < 32; ++i) e_[i] = __builtin_amdgcn_exp2f(e_[i] - m_);
#pragma unroll
              for (int i = 0; i < 8; ++i) pk_[i] = cvt4_fp8o((int)pk_[i], e_[4 * i], e_[4 * i + 1], e_[4 * i + 2], e_[4 * i + 3]);
              if (UBENCH >= 8) { lp_[0] = (v4i32_){(int)pk_[0], (int)pk_[1], (int)pk_[2], (int)pk_[3]}; lp_[1] = (v4i32_){(int)pk_[4], (int)pk_[5], (int)pk_[6], (int)pk_[7]}; }
              __builtin_amdgcn_sched_barrier(0);
              if (UBENCH >= 7) __syncthreads(); }
#pragma unroll
          for (int i = 0; i < 8; ++i) s_ += (float)pk_[i]; }
      if (s_ == 123.456f) ((float*)(LOAD_PARAMS().ws + WS_CNT))[100] = s_; }
#endif
#if PH(0)
    REP(0) { PH_BEGIN p0_prologue(p, lds); PH_END
    GRID_SYNC(); }
    if (gridDim.y == 0x7fffffffu) grid.sync();
#endif
    REP(2) {
#if PH(1)
    PH_BEGIN p1_rows(p); PH_END
    GRID_SYNC();
#endif
#if PH(2)
    PH_BEGIN { pg8::Gemm g{(const bf16_t*)(ws + WS_HB), P2_FP8 ? 512 : 1024, (const bf16_t*)(ws + WS_WIN), P2_FP8 ? 512 : 1024}; ProjOrder S; S.init(G, c, 0);
      EpiProj E{(bf16_t*)(ws + WS_PJ), (const f32x2*)(ws + WS_ROPE), (float*)(ws + WS_RSQ), (float*)(ws + WS_RSKV), ws};
      pg8::gemm_phase<EpiProj, ProjOrder, false, P2_FP8 != 0>(lds3, g, S, E); } PH_END
    GRID_SYNC();
#endif
    }
#if PH(3)
    REP(3) {
    const bool p3split = (G == 256); const int G3 = p3split ? G - 32 : G, c3 = p3split ? c - 32 : c;
    if (p3split && c < 32) {
    PH_BEGIN { pg8::Gemm g{(const bf16_t*)(ws + WS_HB), P2_FP8 ? 512 : 1024, (const bf16_t*)(ws + WS_WIN), P2_FP8 ? 512 : 1024}; ProjOrder S; S.init(G, c, 1);
      EpiProj E{(bf16_t*)(ws + WS_PJ), (const f32x2*)(ws + WS_ROPE), (float*)(ws + WS_RSQ), (float*)(ws + WS_RSKV), ws};
      pg8::gemm_phase<EpiProj, ProjOrder, false, P2_FP8 != 0>(lds3, g, S, E); } PH_END
    } else {
#ifndef NO_P3A
    PH_BEGIN { pg8::Gemm g{(const bf16_t*)(ws + WS_PJ) + 1536, NPROJ, (const bf16_t*)(ws + WS_WUQ), 256}; PlainOrder S; S.init(MALL / 256, 3, G3, c3, 0);
      EpiQ E{(bf16_t*)(ws + WS_QM), (const f32x2*)(ws + WS_ROPE), (const float*)(ws + WS_RSQ), ws};
      pg8::gemm_phase<EpiQ, PlainOrder>(lds3, g, S, E); } PH_END
#endif
#ifndef NO_P3B
    PH_BEGIN { pg8::Gemm g{(const bf16_t*)(ws + WS_PJ) + 1792, NPROJ, (const bf16_t*)(ws + WS_WUKV), 256}; PlainOrder S; S.init(MALL / 256, 4, G3, c3, 0);
      EpiKV E{(bf16_t*)(ws + WS_KV), (const float*)(ws + WS_RSKV), ws};
      pg8::gemm_phase<EpiKV, PlainOrder>(lds3, g, S, E); } PH_END
#endif
    }
    GRID_SYNC(); }
#endif
#if PH(4)
    REP(4) { PH_BEGIN p4_attention_diff(p, (char*)lds); PH_END
    PH_BEGIN p4_attention_mla(p, (char*)lds); PH_END
    GRID_SYNC(); }
#endif
#if DBG_STAGE == 1
    PH_BEGIN dbg_check_proj(p); PH_END
#elif DBG_STAGE == 2
    PH_BEGIN dbg_check_attn(p, lds, 0); PH_END
#elif DBG_STAGE == 3
    PH_BEGIN dbg_check_attn(p, lds, 1); PH_END
#endif
#if PH(6)
    REP(6) {
    PH_BEGIN { pg8::Gemm g{(const bf16_t*)(ws + WS_MIX), 1024, (const bf16_t*)(ws + WS_WOUT), 1024}; PlainOrder S; S.init(T / 256, 4, G, c, 1);
      EpiOut E{(bf16_t*)(ws + WS_XN), p.x, (const float*)(ws + WS_MODS), (float*)(ws + WS_RSX)};
      pg8::gemm_phase<EpiOut, PlainOrder>(lds3, g, S, E); } PH_END
    GRID_SYNC(); }
#endif
#if PH(7)
#if (REP_MASK >> 11) & 1
    PH_BEGIN p7a_route(p, lds); PH_END
    GRID_SYNC();
    PH_BEGIN if (blockIdx.x == 0 && threadIdx.x < 32) ((unsigned*)(p.ws + WS_CNT))[threadIdx.x] = 0u; PH_END
    GRID_SYNC();
#endif
    PH_BEGIN p7a_route(p, lds); PH_END
    GRID_SYNC();
    REP(12) { PH_BEGIN moe_segments(p, seg); p7b_scatter(p, seg); PH_END }
    GRID_SYNC();
#endif
#if PH(8)
    REP(8) {
    PH_BEGIN { pg8::Gemm g{(const bf16_t*)(ws + WS_HF), 512, (const bf16_t*)(ws + WS_W1), 512, (const int*)(ws + WS_RTOK)}; MoeOrder S{seg, seg[32] >> 8, 8, G, c};
      EpiAct E{ws + WS_ACT, p.b1};
      pg8::gemm_phase<EpiAct, MoeOrder, true, true>(lds3, g, S, E); } PH_END
    GRID_SYNC(); }
#endif
#if PH(9)
    REP(9) {
    PH_BEGIN { pg8::Gemm g{(const bf16_t*)(ws + WS_ACT), 512, (const bf16_t*)(ws + WS_W2), 512}; MoeOrder S{seg, seg[32] >> 8, 4, G, c};
      EpiY E{(bf16_t*)(ws + WS_XS), p.b2, (const float*)(ws + WS_GSRT), (EPIY_PROBE) ? rep_ : 0};
      pg8::gemm_phase<EpiY, MoeOrder, false, true>(lds3, g, S, E); } PH_END
    GRID_SYNC(); }
#endif
#if LAST_PHASE >= 9
    REP(10) { PH_BEGIN p10_final(p, true); PH_END }
#elif LAST_PHASE >= 6
    PH_BEGIN p10_final(p, false); PH_END
#else
    PH_BEGIN { const int lane = threadIdx.x & 63, wave = threadIdx.x >> 6; const int gw = blockIdx.x * NWAVES + wave, NGW = gridDim.x * NWAVES;
      for (int t = gw; t < T; t += NGW) { const f32x4* xr = (const f32x4*)(p.x + (size_t)t * DM) + lane; f32x4 v[4]; float s = 0.f;
#pragma unroll
        for (int j = 0; j < 4; ++j) { v[j] = xr[64 * j]; s += (v[j].x * v[j].x + v[j].y * v[j].y) + (v[j].z * v[j].z + v[j].w * v[j].w); }
        const float r = rsqrtf(wave_sum(s) * (1.f / DM) + EPS); f32x4* o = (f32x4*)(p.out + (size_t)t * DM) + lane;
#pragma unroll
        for (int j = 0; j < 4; ++j) o[64 * j] = v[j] * r * ((const f32x4*)p.final_norm_w)[lane + 64 * j]; } } PH_END
#endif
}

extern "C" void kernel_launch(void* const* d_in, const int* in_sizes, int n_in, void* d_out, int out_size, void* d_ws, size_t ws_size, hipStream_t stream) {
    static int grid = 0;
    if (grid == 0) {
        if (n_in != 26 || in_sizes[0] != T * DM || out_size != T * DM || ws_size < WS_END) {
            fprintf(stderr, "kernel_launch: unexpected shapes: n_in %d in0 %d out %d ws %zu (need %zu)\n", n_in, n_in > 0 ? in_sizes[0] : -1, out_size, ws_size, (size_t)WS_END);
            grid = -1; return; }
        int dev = 0, cus = 0, per_cu = 0;
        (void)hipGetDevice(&dev);
        (void)hipDeviceGetAttribute(&cus, hipDeviceAttributeMultiprocessorCount, dev);
        if (hipFuncSetAttribute((const void*)fwd_kernel, hipFuncAttributeMaxDynamicSharedMemorySize, LDS_BYTES) != hipSuccess) { fprintf(stderr, "kernel_launch: hipFuncSetAttribute failed\n"); grid = -1; return; }
        if (hipOccupancyMaxActiveBlocksPerMultiprocessor(&per_cu, (const void*)fwd_kernel, NTHREADS, LDS_BYTES) != hipSuccess || per_cu < 1) { fprintf(stderr, "kernel_launch: occupancy query failed (%d)\n", per_cu); (void)hipGetLastError(); grid = -1; return; }
        grid = cus;
        if (grid < 128 || grid > 1024) { fprintf(stderr, "kernel_launch: unsupported CU count %d\n", cus); grid = -1; return; }
    }
    if (grid < 0) return;
    Params p{};
    const float** pp = (const float**)&p;
    for (int i = 0; i < 26; ++i) pp[i] = (const float*)d_in[i];
    p.out = (float*)d_out; p.ws = (unsigned char*)d_ws;
    if (hipMemsetAsync((char*)d_ws + WS_BAR, 0, WS_BAR_BYTES, stream) != hipSuccess) { fprintf(stderr, "kernel_launch: hipMemsetAsync failed\n"); return; }
    void* args[] = {&p};
    hipError_t e = hipLaunchCooperativeKernel((const void*)fwd_kernel, dim3(grid), dim3(NTHREADS), args, LDS_BYTES, stream);
    if (e != hipSuccess) fprintf(stderr, "cooperative launch failed: %s (grid %d)\n", hipGetErrorString(e), grid);
}
```

```cpp
#define MLA_NQR 2
#define STAGGER 0
#define ATT8_THRL 3.75f
#include <hip/hip_runtime.h>
#include <hip/hip_cooperative_groups.h>
#include <cstdio>
#include <cstdint>
namespace cg = cooperative_groups;

#ifndef DBG_STAGE
#define DBG_STAGE 0
#endif
#ifndef ATT_EXTRA
#define ATT_EXTRA 0
#define ATT_EXTRA_ROUND0 0
#endif
#ifndef ATT_X
#define ATT_X(cc) ((cc) & 7)
#define ATT_J(cc) ((cc) >> 3)
#endif
#ifndef ATT_FP8
#define ATT_FP8 1
#endif
#ifndef SIM_P2
#define SIM_P2 0
#endif
#ifndef SIM_P6
#define SIM_P6 0
#endif
#ifndef WCONV_IN_ATT
#define WCONV_IN_ATT 1
#endif
#ifndef P7A_VAR
#define P7A_VAR 0
#endif
#ifndef P10_NT
#define P10_NT 4
#endif
#ifndef P2_FP8
#define P2_FP8 1
#endif
#ifndef YS_FP8
#define YS_FP8 1
#endif
constexpr float YS_SCALE = 16.f;
#ifndef STAGGER
#define STAGGER 1
#endif
#ifndef ATT_VAR
#define ATT_VAR 0
#endif
#ifndef LAST_PHASE
#define LAST_PHASE 99
#endif

constexpr int DM = 1024, NB = 4, SEQ = 8192, CTX = 256;
constexpr int T = NB * SEQ;
constexpr int RPB = CTX + SEQ;
constexpr int MALL = NB * RPB;
constexpr int NPROJ = 2048;
constexpr int NEXP = 32, TOPK = 4, DFF = 1024;
constexpr int RMAX = T * TOPK + NEXP * 256;
constexpr float EPS = 1e-6f;
constexpr int NTHREADS = 512, NWAVES = 8;
constexpr float WQ_SCALE = 64.f;
constexpr int LDS_BYTES = 163840;

typedef unsigned short bf16_t;
typedef float f32x4 __attribute__((ext_vector_type(4)));
typedef float f32x2 __attribute__((ext_vector_type(2)));
typedef unsigned u32x4 __attribute__((ext_vector_type(4)));
typedef unsigned u32x2 __attribute__((ext_vector_type(2)));
#define LAS __attribute__((address_space(3)))

constexpr size_t KiB = 1024, MiB = 1u << 20;
constexpr size_t WS_CNT  = 0;
constexpr size_t WS_BAR  = 16 * KiB;
constexpr size_t WS_BAR_BYTES = 16 * KiB;
constexpr size_t WS_MODS = 64 * KiB;
constexpr size_t WS_DUMMY = 192 * KiB;
constexpr size_t WS_ROPE = 256 * KiB;
constexpr size_t WS_RWF  = 320 * KiB;
constexpr size_t WS_RSQ  = 512 * KiB;
constexpr size_t WS_RSKV = 768 * KiB;
constexpr size_t WS_TOPI = 1 * MiB;
constexpr size_t WS_GATE = 1 * MiB + 512 * KiB;
constexpr size_t WS_RANK = 2 * MiB;
constexpr size_t WS_GSRT = 2 * MiB + 512 * KiB;
constexpr size_t WS_RSX  = 3 * MiB + 64 * KiB;
constexpr size_t WS_DEST = 3 * MiB + 256 * KiB;
constexpr size_t WS_WIN  = 4 * MiB;
constexpr size_t WS_WOUT = 8 * MiB;
constexpr size_t WS_WUQ  = 10 * MiB;
constexpr size_t WS_WUKV = 11 * MiB;
constexpr size_t WS_W1   = 12 * MiB;
constexpr size_t WS_W2   = 140 * MiB;
constexpr size_t WS_XN   = 204 * MiB;
constexpr size_t WS_XS   = 332 * MiB;
constexpr size_t WS_ACT  = 604 * MiB;
constexpr size_t WS_HF   = 876 * MiB;
constexpr size_t WS_RTOK = 940 * MiB;
constexpr size_t WS_END  = 941 * MiB;
constexpr size_t WS_HB   = 332 * MiB;
constexpr size_t WS_PJ   = 398 * MiB;
constexpr size_t WS_QM   = 530 * MiB;
constexpr size_t WS_KV   = 580 * MiB;
constexpr size_t WS_AO   = 646 * MiB;
constexpr size_t WS_MIX  = 745 * MiB;
constexpr size_t WS_Q8D  = 646 * MiB;
constexpr size_t WS_K8D  = 663 * MiB;
constexpr size_t WS_VT8D = 680 * MiB;
constexpr size_t WS_KR8  = 697 * MiB;
constexpr size_t WS_Q8M  = 530 * MiB;
constexpr size_t WS_K8M  = 556 * MiB;
constexpr size_t WS_VT8M = 574 * MiB;
static_assert(WS_MIX + (size_t)MALL * 1024 * 2 <= WS_HF && WS_XS + (size_t)RMAX * 2048 <= WS_ACT && WS_ACT + (size_t)RMAX * 2048 <= WS_HF, "ws map");

struct Params {
    const float* x; const float* c; const float* ctx; const float* c_ctx; const float* w_ada; const float* b_ada;
    const float* attn_norm_w; const float* w_in; const float* q_norm_w; const float* kv_norm_w; const float* w_uq; const float* w_ukv;
    const float* lq1; const float* lk1; const float* lq2; const float* lk2; const float* subln_w; const float* w_out;
    const float* ffn_norm_w; const float* router_w; const float* router_b; const float* w1; const float* b1; const float* w2; const float* b2;
    const float* final_norm_w;
    float* out; unsigned char* ws;
};

__device__ __forceinline__ int tid_opaque() { int t = threadIdx.x; asm volatile("" : "+v"(t)); return t; }
__device__ __forceinline__ float wave_sum(float v) {
#pragma unroll
    for (int o = 1; o < 64; o <<= 1) v += __shfl_xor(v, o);
    return v;
}
__device__ __forceinline__ float wave_max(float v) {
#pragma unroll
    for (int o = 1; o < 64; o <<= 1) v = fmaxf(v, __shfl_xor(v, o));
    return v;
}
__device__ __forceinline__ float silu_f(float v) { return v / (1.f + __expf(-v)); }
__device__ __forceinline__ unsigned cvt_pk_bf16(float lo, float hi) { unsigned r; asm volatile("v_cvt_pk_bf16_f32 %0, %1, %2" : "=v"(r) : "v"(lo), "v"(hi)); return r; }
__device__ __forceinline__ unsigned cvt4_fp8o(int old, float a, float b, float c, float d) { int r = __builtin_amdgcn_cvt_pk_fp8_f32(a, b, old, false); r = __builtin_amdgcn_cvt_pk_fp8_f32(c, d, r, true); return (unsigned)r; }
__device__ __forceinline__ unsigned cvt4_fp8(float a, float b, float c, float d) { int r = __builtin_amdgcn_cvt_pk_fp8_f32(a, b, 0, false); r = __builtin_amdgcn_cvt_pk_fp8_f32(c, d, r, true); return (unsigned)r; }
__device__ __forceinline__ float q8(float x) { const int pk = __builtin_amdgcn_cvt_pk_fp8_f32(x, x, 0, false); return __builtin_amdgcn_cvt_f32_fp8(pk, 0); }
#ifdef SIM_FP8_ATT
#define Q8(x) q8(x)
#define PSHIFT 8.f
#else
#define Q8(x) (x)
#define PSHIFT 0.f
#endif
__device__ __forceinline__ unsigned char f2fp8(float x) { return (unsigned char)(__builtin_amdgcn_cvt_pk_fp8_f32(x, x, 0, false) & 0xff); }
__device__ __forceinline__ int vt_pos(int kk) { return ((kk >> 2) & 1) * 32 + (kk >> 5) * 16 + ((kk >> 3) & 3) * 4 + (kk & 3); }
__device__ __forceinline__ unsigned quad_tr_bytes(unsigned w, int j) {
    const unsigned t0 = (unsigned)__builtin_amdgcn_mov_dpp((int)w, 0x00, 0xf, 0xf, true), t1 = (unsigned)__builtin_amdgcn_mov_dpp((int)w, 0x55, 0xf, 0xf, true);
    const unsigned t2 = (unsigned)__builtin_amdgcn_mov_dpp((int)w, 0xaa, 0xf, 0xf, true), t3 = (unsigned)__builtin_amdgcn_mov_dpp((int)w, 0xff, 0xf, 0xf, true);
    const unsigned sel = 0x0c0c0000u | ((4u + (unsigned)j) << 8) | (unsigned)j;
    const unsigned a = __builtin_amdgcn_perm(t1, t0, sel), b = __builtin_amdgcn_perm(t3, t2, sel);
    return __builtin_amdgcn_perm(b, a, 0x05040100u);
}
__device__ __forceinline__ bf16_t f2bf(float f) { return (bf16_t)(cvt_pk_bf16(f, 0.f) & 0xffffu); }
__device__ __forceinline__ float bf2f(bf16_t v) { return __uint_as_float((unsigned)v << 16); }
__device__ __forceinline__ float bflo(unsigned w) { return __uint_as_float(w << 16); }
__device__ __forceinline__ float bfhi(unsigned w) { return __uint_as_float(w & 0xffff0000u); }
#define GAS __attribute__((address_space(1)))
#define RLX_AGENT __ATOMIC_RELAXED, __HIP_MEMORY_SCOPE_AGENT
#define XB_TMO      128
#define XB_XCNT(j)  (256  + 64 * (j))
#define XB_XSUB(j)  (1280 + 64 * (j))
#define XB_XGEN(j)  (2304 + 64 * (j))
#define XB_TOP      3328
#define XB_TOPGEN   3392
#define XCD_BAR_WORDS 3456
#define XB_SPIN_CAP (1u << 18)

__device__ __forceinline__ unsigned xb_ld(unsigned* p)              { return __hip_atomic_load(p, __ATOMIC_RELAXED, __HIP_MEMORY_SCOPE_AGENT); }
__device__ __forceinline__ unsigned xb_add(unsigned* p, unsigned v) { return __hip_atomic_fetch_add(p, v, __ATOMIC_RELAXED, __HIP_MEMORY_SCOPE_AGENT); }
__device__ __forceinline__ unsigned xb_xcc_id() { return (unsigned)__builtin_amdgcn_s_getreg((3 << 11) | 20) & 0xFu; }
#define XB_SPIN(cond, bar) do { unsigned _sp = 0; while (cond) { __builtin_amdgcn_s_sleep(1); \
    if ((++_sp & 255u) == 0u) { if (xb_ld(&(bar)[XB_TMO])) break; if (_sp > XB_SPIN_CAP) { atomicAdd(&(bar)[XB_TMO], 1u); break; } } } } while (0)

struct XcdBarrier {
    unsigned* bar; unsigned x;
    volatile LAS unsigned* st;
};

__device__ __forceinline__ XcdBarrier xcd_barrier_post(unsigned* bar, volatile LAS unsigned* st) {
    XcdBarrier b; b.bar = bar; b.x = xb_xcc_id(); b.st = st;
    if (threadIdx.x == 0) (void)xb_add(&bar[XB_XCNT(b.x)], 1u);
    return b;
}
__device__ __forceinline__ void xcd_barrier_complete(unsigned* bar, unsigned x, unsigned& nloc, unsigned& nx) {
    const unsigned G = gridDim.x * gridDim.y * gridDim.z;
    unsigned sum, cnt, mine, sp = 0u;
    for (;;) {
        sum = 0u; cnt = 0u; mine = 0u;
#pragma unroll
        for (unsigned j = 0; j < 16; ++j) { const unsigned c = xb_ld(&bar[XB_XCNT(j)]); sum += c; cnt += (c > 0u) ? 1u : 0u; mine = (j == x) ? c : mine; }
        if (sum == G) break;
        __builtin_amdgcn_s_sleep(1);
        if ((++sp & 255u) == 0u) { if (xb_ld(&bar[XB_TMO])) break; if (sp > XB_SPIN_CAP) { atomicAdd(&bar[XB_TMO], 1u); break; } }
    }
    nloc = mine > 0u ? mine : 1u; nx = cnt > 0u ? cnt : 1u;
}

__device__ __forceinline__ void xcd_barrier(const XcdBarrier& b) {
    asm volatile("s_waitcnt vmcnt(0)" ::: "memory");
    __syncthreads();
    if (threadIdx.x == 0) {
        unsigned* bar = b.bar;
        __builtin_amdgcn_s_waitcnt(0);
        unsigned nloc = b.st[0], nx = b.st[1];
        if (nloc == 0u) { xcd_barrier_complete(bar, b.x, nloc, nx); b.st[0] = nloc; b.st[1] = nx; }
        const unsigned old = xb_add(&bar[XB_XSUB(b.x)], 1u);
        const unsigned gen = old / nloc;
        if (old + 1u == (gen + 1u) * nloc) {
            __builtin_amdgcn_fence(__ATOMIC_RELEASE, "agent");
            asm volatile("s_waitcnt vmcnt(0)" ::: "memory");
            const unsigned og = xb_add(&bar[XB_TOP], 1u);
            const unsigned tg = og / nx;
            if (og + 1u == (tg + 1u) * nx) xb_add(&bar[XB_TOPGEN], 1u);
            else XB_SPIN(xb_ld(&bar[XB_TOPGEN]) == tg, bar);
            __builtin_amdgcn_fence(__ATOMIC_ACQUIRE, "agent");
            xb_add(&bar[XB_XGEN(b.x)], 1u);
            asm volatile("s_waitcnt vmcnt(0)" ::: "memory");
        } else {
            XB_SPIN(xb_ld(&bar[XB_XGEN(b.x)]) == gen, bar);
            __builtin_amdgcn_fence(__ATOMIC_ACQUIRE, "agent");
            asm volatile("s_waitcnt vmcnt(0)" ::: "memory");
        }
    }
    __syncthreads();
}

__device__ __forceinline__ void p0_mods(const Params& p, float* lds_f, int item) {
    const int tid = tid_opaque();
    float* sc = lds_f;
    float* red = lds_f + 5 * 1024;
    for (int i = tid; i < 5 * 1024; i += NTHREADS) { const int r = i >> 10, k = i & 1023; sc[i] = silu_f(r < 4 ? p.c[r * 1024 + k] : p.c_ctx[k]); }
    __syncthreads();
    const int col = tid & 31, kg = tid >> 5;
    const float* w = p.w_ada + (size_t)(kg * 64) * 6144 + item * 32 + col;
    float a0 = 0, a1 = 0, a2 = 0, a3 = 0, a4 = 0;
#pragma unroll 8
    for (int k = 0; k < 64; ++k) { const float wv = w[(size_t)k * 6144]; const int kk = kg * 64 + k;
        a0 += sc[kk] * wv; a1 += sc[1024 + kk] * wv; a2 += sc[2048 + kk] * wv; a3 += sc[3072 + kk] * wv; a4 += sc[4096 + kk] * wv; }
    red[(kg * 5 + 0) * 32 + col] = a0; red[(kg * 5 + 1) * 32 + col] = a1; red[(kg * 5 + 2) * 32 + col] = a2; red[(kg * 5 + 3) * 32 + col] = a3; red[(kg * 5 + 4) * 32 + col] = a4;
    __syncthreads();
    if (tid < 160) { const int r = tid >> 5, cc = tid & 31; float s = p.b_ada[item * 32 + cc];
        for (int g = 0; g < 16; ++g) s += red[(g * 5 + r) * 32 + cc];
        ((float*)(p.ws + WS_MODS))[r * 6144 + item * 32 + cc] = s; }
    __syncthreads();
}

template <int SIMQ = 0>
__device__ __forceinline__ void p0_tr_item(const float* W, int ldw, bf16_t* WT, int ldk, int k0, int n0, int drow0, const float* kscale, float* scr, int lane) {
    const int nq = (lane & 15) * 4, kr = lane >> 4;
#pragma unroll 4
    for (int i = 0; i < 16; ++i) { const int kk = 4 * i + kr;
        f32x4 v = *(const f32x4*)(W + (size_t)(k0 + kk) * ldw + n0 + nq);
        if (kscale) { const float s = kscale[k0 + kk]; v = v * s; }
        float* d = scr + kk * 65 + nq; d[0] = v.x; d[1] = v.y; d[2] = v.z; d[3] = v.w; }
    asm volatile("s_waitcnt lgkmcnt(0)" ::: "memory");
    const int c = lane & 7;
#pragma unroll
    for (int j = 0; j < 8; ++j) { const int n = (lane >> 3) + 8 * j; const float* s = scr + (8 * c) * 65 + n;
        float w_[8];
#pragma unroll
        for (int i = 0; i < 8; ++i) { w_[i] = s[i * 65]; if (SIMQ) w_[i] = q8(w_[i] * 64.f) * (1.f / 64.f); }
        u32x4 o; o.x = cvt_pk_bf16(w_[0], w_[1]); o.y = cvt_pk_bf16(w_[2], w_[3]); o.z = cvt_pk_bf16(w_[4], w_[5]); o.w = cvt_pk_bf16(w_[6], w_[7]);
        *(u32x4*)(WT + (size_t)(drow0 + n) * ldk + k0 + 8 * c) = o; }
    asm volatile("s_waitcnt lgkmcnt(0)" ::: "memory");
}

__device__ __forceinline__ void p0_tr_item_f8(const float* W, int ldw, unsigned char* WT, int ldk, int k0, int n0, int drow0, const float wscale, float* scr, int lane) {
    const int nq = (lane & 15) * 4, kr = lane >> 4;
#pragma unroll 4
    for (int i = 0; i < 16; ++i) { const int kk = 4 * i + kr;
        const f32x4 v = *(const f32x4*)(W + (size_t)(k0 + kk) * ldw + n0 + nq) * wscale;
        float* d = scr + kk * 65 + nq; d[0] = v.x; d[1] = v.y; d[2] = v.z; d[3] = v.w; }
    asm volatile("s_waitcnt lgkmcnt(0)" ::: "memory");
    const int c = lane & 3;
#pragma unroll
    for (int j = 0; j < 4; ++j) { const int n = (lane >> 2) + 16 * j; const float* s = scr + (16 * c) * 65 + n;
        u32x4 o; o.x = cvt4_fp8(s[0 * 65], s[1 * 65], s[2 * 65], s[3 * 65]); o.y = cvt4_fp8(s[4 * 65], s[5 * 65], s[6 * 65], s[7 * 65]);
        o.z = cvt4_fp8(s[8 * 65], s[9 * 65], s[10 * 65], s[11 * 65]); o.w = cvt4_fp8(s[12 * 65], s[13 * 65], s[14 * 65], s[15 * 65]);
        *(u32x4*)(WT + (size_t)(drow0 + n) * ldk + k0 + 16 * c) = o; }
    asm volatile("s_waitcnt lgkmcnt(0)" ::: "memory");
}

__device__ __forceinline__ void p0_prologue(const Params& p, unsigned char* lds) {
    const int tid = tid_opaque(), lane = tid & 63, wave = tid >> 6;
    unsigned char* ws = p.ws;
    if (blockIdx.x == 0 && tid < 128) ((unsigned*)(ws + WS_CNT))[tid] = 0u;
    if (blockIdx.x == gridDim.x - 1) {
        for (int i = tid; i < 128 * 16; i += NTHREADS) { const int pv = i >> 4, pp = i & 15;
            const float inv = exp2f(-(float)pp * (13.287712379549449f / 16.f));
            const float ang = (float)pv * inv; float sn, cs; sincosf(ang, &sn, &cs);
            ((f32x2*)(ws + WS_ROPE))[i] = (f32x2){cs, sn}; }
    }
    { const int gt = blockIdx.x * NTHREADS + tid;
      if (gt < 4096) { const int l = gt & 63, nb = (gt >> 6) & 1, s = gt >> 7; unsigned hi4[4], lo4[4];
#pragma unroll
        for (int j = 0; j < 4; ++j) { const float w0 = p.router_w[(32 * s + 8 * (l >> 4) + 2 * j) * 32 + 16 * nb + (l & 15)], w1 = p.router_w[(32 * s + 8 * (l >> 4) + 2 * j + 1) * 32 + 16 * nb + (l & 15)];
            const unsigned hw = cvt_pk_bf16(w0, w1); hi4[j] = hw; lo4[j] = cvt_pk_bf16(w0 - bflo(hw), w1 - bfhi(hw)); }
        u32x4* dst = (u32x4*)(ws + WS_RWF) + ((s * 2 + nb) * 2) * 64 + l;
        dst[0] = (u32x4){hi4[0], hi4[1], hi4[2], hi4[3]}; dst[64] = (u32x4){lo4[0], lo4[1], lo4[2], lo4[3]}; } }
    for (int it = blockIdx.x; it < 192; it += gridDim.x) p0_mods(p, (float*)lds, it);
    float* scr = (float*)lds + wave * (64 * 65);
    const int gw = blockIdx.x * NWAVES + wave, NGW = gridDim.x * NWAVES;
    constexpr int I_W1 = WCONV_IN_ATT ? 0 : 32 * 16 * 32, I_W2 = WCONV_IN_ATT ? 0 : 32 * 16 * 16, I_IN = 16 * 31, I_OUT = 16 * 16, I_UQ = 4 * 12, I_UKV = 2 * 16;
    constexpr int NITEMS = I_W1 + I_W2 + I_IN + I_OUT + I_UQ + I_UKV;
    for (int it = gw; it < NITEMS; it += NGW) {
        int r = it;
        if (r < I_W1) { const int e = r >> 9, q = r & 511, kb = q >> 5, nb = q & 31, n0 = nb * 64;
            const int drow = ((n0 & 1023) >> 7) * 256 + (n0 >> 10) * 128 + (n0 & 127);
            p0_tr_item_f8(p.w1 + (size_t)e * 1024 * 2048, 2048, ws + WS_W1 + (size_t)e * 2048 * 1024, 1024, kb * 64, n0, drow, WQ_SCALE, scr, lane); continue; } r -= I_W1;
        if (r < I_W2) { const int e = r >> 8, q = r & 255, kb = q >> 4, nb = q & 15;
            p0_tr_item_f8(p.w2 + (size_t)e * 1024 * 1024, 1024, ws + WS_W2 + (size_t)e * 1024 * 1024, 1024, kb * 64, nb * 64, nb * 64, WQ_SCALE, scr, lane); continue; } r -= I_W2;
        if (r < I_IN) { const int kb = r / 31, nb = r % 31;
#if P2_FP8
            p0_tr_item_f8(p.w_in, 1984, ws + WS_WIN, 1024, kb * 64, nb * 64, nb * 64, WQ_SCALE, scr, lane); continue; } r -= I_IN;
#else
            p0_tr_item<SIM_P2>(p.w_in, 1984, (bf16_t*)(ws + WS_WIN), 1024, kb * 64, nb * 64, nb * 64, nullptr, scr, lane); continue; } r -= I_IN;
#endif
        if (r < I_OUT) { const int kb = r >> 4, nb = r & 15;
            p0_tr_item<SIM_P6>(p.w_out, 1024, (bf16_t*)(ws + WS_WOUT), 1024, kb * 64, nb * 64, nb * 64, nullptr, scr, lane); continue; } r -= I_OUT;
        if (r < I_UQ) { const int kb = r / 12, nb = r % 12;
            p0_tr_item(p.w_uq, 768, (bf16_t*)(ws + WS_WUQ), 256, kb * 64, nb * 64, nb * 64, p.q_norm_w, scr, lane); continue; } r -= I_UQ;
        { const int kb = r >> 4, nb = r & 15;
            p0_tr_item(p.w_ukv, 1024, (bf16_t*)(ws + WS_WUKV), 256, kb * 64, nb * 64, nb * 64, p.kv_norm_w, scr, lane); }
    }
    { const int gt = blockIdx.x * NTHREADS + tid, NGT = gridDim.x * NTHREADS; const u32x4 z = {0u, 0u, 0u, 0u};
      for (int i = gt; i < 64 * (P2_FP8 ? 64 : 128); i += NGT) ((u32x4*)(ws + WS_WIN + (size_t)1984 * (P2_FP8 ? 1024 : 2048)))[i] = z;
      for (int i = gt; i < 1024 * 16; i += NGT) { const int row = i >> 4, ch = i & 15; *(u32x4*)((bf16_t*)(ws + WS_WUKV) + (size_t)row * 256 + 128 + ch * 8) = z; } }
}

__device__ __forceinline__ void p1_rows(const Params& p) {
    const int tid = tid_opaque(), lane = tid & 63, wave = tid >> 6;
    const int gw = blockIdx.x * NWAVES + wave, NGW = gridDim.x * NWAVES;
    const float* mods = (const float*)(p.ws + WS_MODS);
    bf16_t* HB = (bf16_t*)(p.ws + WS_HB);
    { const int gt = blockIdx.x * NTHREADS + tid, NGT = gridDim.x * NTHREADS;
      for (int i = gt; i < MALL; i += NGT) { ((float*)(p.ws + WS_RSQ))[i] = 0.f; ((float*)(p.ws + WS_RSKV))[i] = 0.f; }
      for (int i = gt; i < RMAX; i += NGT) ((int*)(p.ws + WS_RTOK))[i] = 0;
      for (int i = gt; i < T; i += NGT) ((float*)(p.ws + WS_RSX))[i] = 0.f; }
    f32x4 av[4], sv[4]; int curb = -1;
    for (int m0 = __builtin_amdgcn_readfirstlane(gw); m0 < MALL; m0 += 2 * NGW) {
        int mm[2]; bool ok[2]; f32x4 v[2][4];
#pragma unroll
        for (int q = 0; q < 2; ++q) { const int m_ = m0 + q * NGW; ok[q] = m_ < MALL; mm[q] = ok[q] ? m_ : m0;
            const int b = mm[q] / RPB, i = mm[q] - b * RPB; const bool isctx = i < CTX;
            const float* src = isctx ? p.ctx + ((size_t)b * CTX + i) * DM : p.x + ((size_t)b * SEQ + (i - CTX)) * DM;
            const f32x4* xr = (const f32x4*)src + lane;
#pragma unroll
            for (int j = 0; j < 4; ++j) v[q][j] = xr[64 * j]; }
#pragma unroll
        for (int q = 0; q < 2; ++q) { const int m = mm[q], b = m / RPB, i = m - b * RPB; const int bsel = i < CTX ? 4 : b;
            if (bsel != curb) { curb = bsel; const float* md = mods + bsel * 6144;
#pragma unroll
                for (int j = 0; j < 4; ++j) { av[j] = ((const f32x4*)p.attn_norm_w)[lane + 64 * j] * (((const f32x4*)(md + 1024))[lane + 64 * j] + 1.f); sv[j] = ((const f32x4*)md)[lane + 64 * j]; } }
            float s = 0.f;
#pragma unroll
            for (int j = 0; j < 4; ++j) s += (v[q][j].x * v[q][j].x + v[q][j].y * v[q][j].y) + (v[q][j].z * v[q][j].z + v[q][j].w * v[q][j].w);
            const float r = rsqrtf(wave_sum(s) * (1.f / DM) + EPS);
#if P2_FP8
            if (ok[q]) { unsigned* o = (unsigned*)((unsigned char*)HB + (size_t)m * DM) + lane;
#pragma unroll
                for (int j = 0; j < 4; ++j) { const f32x4 h = v[q][j] * r * av[j] + sv[j]; o[64 * j] = cvt4_fp8(h.x, h.y, h.z, h.w); } }
#else
            if (ok[q]) { u32x2* o = (u32x2*)(HB + (size_t)m * DM) + lane;
#pragma unroll
                for (int j = 0; j < 4; ++j) { const f32x4 h = v[q][j] * r * av[j] + sv[j];
                    f32x4 hq = h; if (SIM_P2) hq = (f32x4){q8(h.x), q8(h.y), q8(h.z), q8(h.w)};
                    u32x2 pk; pk.x = cvt_pk_bf16(hq.x, hq.y); pk.y = cvt_pk_bf16(hq.z, hq.w); o[64 * j] = pk; } }
#endif
        }
    }
}
namespace pg8 {
typedef short bf16x8 __attribute__((ext_vector_type(8)));
typedef int v4i32_t __attribute__((ext_vector_type(4)));
typedef int v8i32_t __attribute__((ext_vector_type(8)));
constexpr int BM = 256, BK = 64, HALF = 128, HTB = HALF * BK * 2  , STAGE_BYTES = 8 * HTB;
__host__ __device__ __forceinline__ int lds_byte(int r, int c) { const int st = (r >> 4) * 2 + (c >> 5), rr = r & 15, cc = c & 31, ob = rr * 64 + cc * 2; return st * 1024 + (ob ^ (((ob >> 9) & 1) << 5)); }
__host__ __device__ __forceinline__ void stage_rc(int b, int& R, int& C) { const int st = b / 1024, sb = b % 1024, swz = sb ^ (((sb >> 9) & 1) << 5); R = (st >> 1) * 16 + swz / 64; C = (st & 1) * 32 + (swz % 64) / 2; }

struct Unit { int am, bn, pm, pn, e; };
struct Gemm { const bf16_t* A; int lda; const bf16_t* Bt; int K; const int* rowtok; };

template <class Epi, class Sched, bool GATHER = false, bool FP8 = false, bool ALIGN_EPI = true>
__device__ __forceinline__ void gemm_phase(LAS unsigned char* lds, const Gemm g, const Sched& S, const Epi& E) {
    const int tid = tid_opaque(), wid = __builtin_amdgcn_readfirstlane(tid >> 6), lane = tid & 63, wr = wid >> 2, wc = wid & 3, fr = lane & 15, fq = lane >> 4;
    const int K = g.K, lda = g.lda; int nt = K / BK; asm volatile("" : "+s"(nt));
    unsigned voffA[2], voffB[2];
#pragma unroll
    for (int i = 0; i < 2; ++i) { int R, C; stage_rc(tid * 16 + i * 8192, R, C);
        voffA[i] = (unsigned)(R * lda + C) * 2u; voffB[i] = (unsigned)(R * K + C) * 2u; }
    unsigned vA0[2], vA1[2];
    LAS u32x4* gnx = (LAS u32x4*)(lds + STAGE_BYTES + 4096) + tid;
#define PG8_GOFF(AM, o00, o01, o10, o11) do { int t_ = tid; asm volatile("" : "+v"(t_)); int R0_, C0_, R1_, C1_; stage_rc(t_ * 16, R0_, C0_); stage_rc(t_ * 16 + 8192, R1_, C1_); \
        const int* rt_ = g.rowtok + (AM) * 256; const unsigned lb_ = (unsigned)(lda * 2); \
        o00 = (unsigned)rt_[R0_] * lb_ + (unsigned)(C0_ * 2); o01 = (unsigned)rt_[R1_] * lb_ + (unsigned)(C1_ * 2); o10 = (unsigned)rt_[128 + R0_] * lb_ + (unsigned)(C0_ * 2); o11 = (unsigned)rt_[128 + R1_] * lb_ + (unsigned)(C1_ * 2); } while (0)
#define PG8_STAGE_A(bufoff, soff, h, W0, W1) do { PG8_STAGE(bufoff, rA, soff, ((h) ? W1 : W0)); } while (0)
    const unsigned kstep = (unsigned)(BK * 2);
    const unsigned hstepA = (unsigned)(HALF * lda * 2), hstepB = (unsigned)(HALF * K * 2);
    const unsigned tstepA = 2 * hstepA, tstepB = 2 * hstepB;
    const __amdgpu_buffer_rsrc_t rA = __builtin_amdgcn_make_buffer_rsrc((void*)g.A, 0, 0xffffffff, 0x00020000), rB = __builtin_amdgcn_make_buffer_rsrc((void*)g.Bt, 0, 0xffffffff, 0x00020000);
    const unsigned ldsw = (unsigned)wid * 1024u;
    const int aoff = lds_byte(wr * 64 + fr, fq * 8), boff = lds_byte(wc * 32 + fr, fq * 8);
#define PG8_SA(b, h) (((b) * 2 + (h)) * HTB)
#define PG8_SB(b, h) ((4 + (b) * 2 + (h)) * HTB)
#define PG8_STAGE(bufoff, rs, soff, voff) do { _Pragma("unroll") for (int _i = 0; _i < 2; ++_i) \
        __builtin_amdgcn_raw_ptr_buffer_load_lds(rs, (LAS unsigned*)(lds + (bufoff) + ldsw + _i * 8192), 16, (int)(voff)[_i], (int)(soff), 0, 0); } while (0)
#define PG8_LDA(dst, b, h) do { _Pragma("unroll") for (int m = 0; m < 4; ++m) { const v4i32_t lo_ = *(const LAS v4i32_t*)(lds + PG8_SA(b, h) + aoff + m * 2048), hi_ = *(const LAS v4i32_t*)(lds + PG8_SA(b, h) + aoff + m * 2048 + 1024); \
        dst[m] = __builtin_shufflevector(lo_, hi_, 0, 1, 2, 3, 4, 5, 6, 7); } } while (0)
#define PG8_LDB(dst, b, h) do { _Pragma("unroll") for (int n = 0; n < 2; ++n) { const v4i32_t lo_ = *(const LAS v4i32_t*)(lds + PG8_SB(b, h) + boff + n * 2048), hi_ = *(const LAS v4i32_t*)(lds + PG8_SB(b, h) + boff + n * 2048 + 1024); \
        dst[n] = __builtin_shufflevector(lo_, hi_, 0, 1, 2, 3, 4, 5, 6, 7); } } while (0)
#define PG8_LO(x) __builtin_bit_cast(bf16x8, __builtin_shufflevector(x, x, 0, 1, 2, 3))
#define PG8_HI(x) __builtin_bit_cast(bf16x8, __builtin_shufflevector(x, x, 4, 5, 6, 7))
#define PG8_MMA(ai, bj, At, Bt) do { __builtin_amdgcn_s_setprio(1); _Pragma("unroll") for (int m = 0; m < 4; ++m) _Pragma("unroll") for (int n = 0; n < 2; ++n) { \
        if constexpr (FP8) acc[ai][bj][m][n] = __builtin_amdgcn_mfma_scale_f32_16x16x128_f8f6f4(Bt[n], At[m], acc[ai][bj][m][n], 0, 0, 0, 0, 0, 0)    ; \
        else { acc[ai][bj][m][n] = __builtin_amdgcn_mfma_f32_16x16x32_bf16(PG8_LO(Bt[n]), PG8_LO(At[m]), acc[ai][bj][m][n], 0, 0, 0); \
               acc[ai][bj][m][n] = __builtin_amdgcn_mfma_f32_16x16x32_bf16(PG8_HI(Bt[n]), PG8_HI(At[m]), acc[ai][bj][m][n], 0, 0, 0); } } __builtin_amdgcn_s_setprio(0); } while (0)
#define PG8_WAIT_V(n) asm volatile("s_waitcnt vmcnt(" #n ")" ::: "memory")
#define PG8_STR_(x) #x
#define PG8_XSTR_(x) PG8_STR_(x)
#define PG8_WAIT_V8X() do { if (relax) asm volatile("s_waitcnt vmcnt(%0)" :: "n"(8 + Epi::NST) : "memory"); else asm volatile("s_waitcnt vmcnt(8)" ::: "memory"); } while (0)
#define PG8_WAIT_L(n) asm volatile("s_waitcnt lgkmcnt(" #n ")" ::: "memory")
#define PG8_BAR __builtin_amdgcn_s_barrier()
#define PG8_SCHED __builtin_amdgcn_sched_barrier(0)
    Unit cur, nxt; int ui = 0;
    if (!S.next(0, cur)) return;
    f32x4 acc[2][2][4][2];
#pragma unroll
    for (int a = 0; a < 2; ++a)
#pragma unroll
        for (int b = 0; b < 2; ++b)
#pragma unroll
            for (int m = 0; m < 4; ++m)
#pragma unroll
                for (int n = 0; n < 2; ++n) acc[a][b][m][n] = (f32x4){0.f, 0.f, 0.f, 0.f};
    v8i32_t At[4], B0[2], B1[2];
    unsigned cA = GATHER ? 0u : (unsigned)cur.am * tstepA, cB = (unsigned)cur.bn * tstepB;
    if constexpr (GATHER) { PG8_GOFF(cur.am, vA0[0], vA0[1], vA1[0], vA1[1]); }
    else { vA0[0] = voffA[0]; vA0[1] = voffA[1]; vA1[0] = voffA[0] + hstepA; vA1[1] = voffA[1] + hstepA; }
    PG8_STAGE(PG8_SB(0, 0), rB, cB, voffB); PG8_STAGE(PG8_SB(0, 1), rB, cB + hstepB, voffB); PG8_STAGE_A(PG8_SA(0, 0), cA, 0, vA0, vA1); PG8_STAGE_A(PG8_SA(0, 1), cA, 1, vA0, vA1);
    if (wr == 1) PG8_BAR;
    PG8_WAIT_V(2); PG8_BAR;
    PG8_STAGE(PG8_SB(1, 0), rB, cB + kstep, voffB); PG8_STAGE_A(PG8_SA(1, 0), cA + kstep, 0, vA0, vA1); PG8_STAGE(PG8_SB(1, 1), rB, cB + hstepB + kstep, voffB);
    PG8_WAIT_V(6); PG8_BAR;
    for (;;) {
        const bool has_next = S.next(ui + 1, nxt);
        const unsigned nA = (has_next && !GATHER) ? (unsigned)nxt.am * tstepA : cA, nB = has_next ? (unsigned)nxt.bn * tstepB : cB;
        if constexpr (GATHER) { const int am_ = has_next ? nxt.am : cur.am; u32x4 nv_; PG8_GOFF(am_, nv_.x, nv_.y, nv_.z, nv_.w); *gnx = nv_; }
        for (int t = 0; t < nt; t += 2) {
            const bool last = (t == nt - 2); const bool relax = Epi::NST > 0 && t == 0 && ui > 0;
            const unsigned a1 = cA + (unsigned)(t + 1) * kstep;
            const unsigned a2 = last ? nA : cA + (unsigned)(t + 2) * kstep, b2 = last ? nB : cB + (unsigned)(t + 2) * kstep;
            const unsigned a3 = a2 + kstep, b3 = b2 + kstep;
            if constexpr (GATHER) { if (last) { const u32x4 nv_ = *gnx; vA0[0] = nv_.x; vA0[1] = nv_.y; }
            } else if constexpr (FP8) { if (last) asm volatile("s_nop 0"); }
            PG8_LDB(B0, 0, 0); PG8_LDB(B1, 0, 1); PG8_SCHED; PG8_LDA(At, 0, 0); PG8_STAGE_A(PG8_SA(1, 1), a1, 1, vA0, vA1);
            PG8_WAIT_V8X(); PG8_WAIT_L(0); PG8_BAR; PG8_MMA(0, 0, At, B0); PG8_MMA(0, 1, At, B1); PG8_BAR; PG8_SCHED;
            PG8_LDA(At, 0, 1); PG8_STAGE(PG8_SB(0, 0), rB, b2, voffB); PG8_STAGE(PG8_SB(0, 1), rB, b2 + hstepB, voffB); PG8_STAGE_A(PG8_SA(0, 0), a2, 0, vA0, vA1);
            if constexpr (GATHER) { if (last) { const u32x4 nv_ = *gnx; vA1[0] = nv_.z; vA1[1] = nv_.w; } }
            else if constexpr (FP8) { if (last) asm volatile("s_nop 0"); }
            PG8_WAIT_V8X(); PG8_WAIT_L(0); PG8_BAR; PG8_MMA(1, 0, At, B0); PG8_MMA(1, 1, At, B1); PG8_BAR; PG8_SCHED;
            PG8_LDB(B0, 1, 0); PG8_LDB(B1, 1, 1); PG8_SCHED; PG8_LDA(At, 1, 0); PG8_STAGE_A(PG8_SA(0, 1), a2, 1, vA0, vA1);
            PG8_WAIT_V(8); PG8_WAIT_L(0); PG8_BAR; PG8_MMA(0, 0, At, B0); PG8_MMA(0, 1, At, B1); PG8_BAR; PG8_SCHED;
            PG8_LDA(At, 1, 1); PG8_STAGE(PG8_SB(1, 0), rB, b3, voffB); PG8_STAGE(PG8_SB(1, 1), rB, b3 + hstepB, voffB); PG8_STAGE_A(PG8_SA(1, 0), a3, 0, vA0, vA1);
            PG8_WAIT_V(8); PG8_WAIT_L(0); PG8_BAR; PG8_MMA(1, 0, At, B0); PG8_MMA(1, 1, At, B1); PG8_BAR; PG8_SCHED;
        }
        if constexpr (ALIGN_EPI) { if (wr == 0) PG8_BAR; }
        PG8_SCHED;
        { int fr_ = fr, fq_ = fq; asm volatile("" : "+v"(fr_), "+v"(fq_));
          E(acc, cur, wr, wc, fr_, fq_); }
        if (!has_next) break;
#pragma unroll
        for (int a = 0; a < 2; ++a)
#pragma unroll
            for (int b = 0; b < 2; ++b)
#pragma unroll
                for (int m = 0; m < 4; ++m)
#pragma unroll
                    for (int n = 0; n < 2; ++n) acc[a][b][m][n] = (f32x4){0.f, 0.f, 0.f, 0.f};
        cur = nxt; cA = nA; cB = nB; ++ui;
        if constexpr (ALIGN_EPI) { if (wr == 1) PG8_BAR; }
    }
    PG8_WAIT_V(0);
    if constexpr (!ALIGN_EPI) { if (wr == 0) PG8_BAR; }
    PG8_BAR;
#undef PG8_SA
#undef PG8_SB
#undef PG8_STAGE
#undef PG8_STAGE_A
#undef PG8_GOFF
#undef PG8_LDA
#undef PG8_LDB
#undef PG8_MMA
#undef PG8_LO
#undef PG8_HI
#undef PG8_WAIT_V
#undef PG8_WAIT_V8X
#undef PG8_WAIT_L
#undef PG8_BAR
#undef PG8_SCHED
}
}
struct PlainOrder {
    int nM, nN, nwg, G, c, latent_only;
    __device__ void init(int nM_, int nN_, int G_, int c_, int latent_only_) { nM = nM_; nN = nN_; nwg = nM * nN; G = G_; c = c_; latent_only = latent_only_; }
    __device__ bool next(int i, pg8::Unit& u) const {
        const long L = (long)i * G + c; if (L >= nwg) return false;
        int wgid = (int)L; { const int q = nwg / 8, r = nwg % 8, xcd = wgid % 8, off = wgid / 8; wgid = (xcd < r ? xcd * (q + 1) : r * (q + 1) + (xcd - r) * q) + off; }
        const int WGM = 8, nig = WGM * nN, gid = wgid / nig, fm = gid * WGM, gsz = (nM - fm) < WGM ? (nM - fm) : WGM;
        const int pm = fm + ((wgid % nig) % gsz), pn = (wgid % nig) / gsz;
        u.pm = pm; u.pn = pn; u.e = 0; u.bn = pn;
        u.am = latent_only ? (pm >> 5) * 33 + 1 + (pm & 31) : pm;
        return true;
    }
};
struct ProjOrder {
    PlainOrder P; int G, c, part, split;
    __device__ void init(int G_, int c_, int part_) { G = G_; c = c_; part = part_; split = (G_ == 256); P.init(MALL / 256, 7, G_, c_, 0); }
    __device__ bool next(int i, pg8::Unit& u) const {
        int pm, pn;
        if (part == 0) { const long L = (long)i * G + c; if (L >= (split ? 1024 : 1056)) return false;
            if (L < 924) { if (!P.next(i, u)) return false; pm = u.pm; pn = u.pn + 1; } else { pm = (int)L - 924; pn = 0; } }
        else { if (!split || i > 0 || c >= 32) return false; pm = 100 + c; pn = 0; }
        u.pm = pm; u.pn = pn; u.e = 0; u.bn = pn; u.am = pm; return true;
    }
};
struct MoeOrder {
    const int* seg; int NT, ncol, G, c;
    __device__ bool next(int i, pg8::Unit& u) const {
        int rt, pn;
        if (G == 256) { const int x = c & 7, s = c >> 3;
            if (ncol == 8) { rt = i * 32 + x * 4 + (s >> 3); pn = s & 7; } else { rt = i * 64 + x * 8 + (s >> 2); pn = s & 3; } }
        else { const long L = (long)i * G + c; rt = (int)(L / ncol); pn = (int)(L % ncol); }
        if (rt >= NT) return false;
        const int r0 = rt * 256; int e = 0;
        while (e < 31 && r0 >= seg[e + 1]) ++e;
        u.am = rt; u.pm = rt; u.pn = pn; u.e = e; u.bn = e * ncol + pn; return true;
    }
};

typedef f32x4 AccT[2][2][4][2];
constexpr float QSCALE_DIFF = 0.125f * 1.4426950408889634f;
constexpr float QSCALE_MLA = 0.07216878364870322f * 1.4426950408889634f;
struct EpiProj {
    static constexpr int NST = 0;
    bf16_t* PJ; const f32x2* rope; float* rsq; float* rskv; unsigned char* ws;
    __device__ __forceinline__ void operator()(const AccT& acc, const pg8::Unit& u, int wr, int wc, int fr, int fq) const {
        const int pm = u.pm, pn = u.pn; const bool latent = (pm % 33) != 0;
        const int a = wc & 1;
#pragma unroll
        for (int ai = 0; ai < 2; ++ai)
#pragma unroll
            for (int m = 0; m < 4; ++m) {
                const int row = pm * 256 + ai * 128 + wr * 64 + m * 16 + fr;
                const int i = row % RPB, pos = i - CTX, pv = a ? (pos & 63) : (pos >> 6);
                float ss = 0.f;
#pragma unroll
                for (int bj = 0; bj < 2; ++bj) {
                    f32x4 v0 = acc[ai][bj][m][0] * (P2_FP8 ? 1.f / WQ_SCALE : 1.f), v1 = acc[ai][bj][m][1] * (P2_FP8 ? 1.f / WQ_SCALE : 1.f);
                    if (pn == 6 || (pn == 7 && bj == 0)) ss += (v0.x * v0.x + v0.y * v0.y) + (v0.z * v0.z + v0.w * v0.w) + (v1.x * v1.x + v1.y * v1.y) + (v1.z * v1.z + v1.w * v1.w);
                    if (pn < 2) { v0 = v0 * QSCALE_DIFF; v1 = v1 * QSCALE_DIFF; }
                    const bool rp = latent && (pn < 4 || (pn == 7 && bj == 1 && wc < 2));
                    if (rp) { const f32x4* t = (const f32x4*)(rope + pv * 16 + 4 * fq); const f32x4 t0 = t[0], t1 = t[1];
                        const f32x4 cs = {t0.x, t0.z, t1.x, t1.z}, sn = {t0.y, t0.w, t1.y, t1.w};
                        const f32x4 o0 = v0 * cs - v1 * sn, o1 = v1 * cs + v0 * sn; v0 = o0; v1 = o1; }
#ifdef SIM_FP8_ATT
                    if (pn < 6 || (pn == 7 && bj == 1 && wc < 2)) { v0 = (f32x4){q8(v0.x), q8(v0.y), q8(v0.z), q8(v0.w)}; v1 = (f32x4){q8(v1.x), q8(v1.y), q8(v1.z), q8(v1.w)}; }
#endif
#if ATT_FP8
                    const int cl = (pn & 1) * 256 + bj * 128 + wc * 32 + 4 * fq;
                    if (pn < 4) { unsigned char* d8 = ws + (pn < 2 ? WS_Q8D : WS_K8D) + (size_t)row * 512 + cl;
                        *(unsigned*)d8 = cvt4_fp8(v0.x, v0.y, v0.z, v0.w); *(unsigned*)(d8 + 16) = cvt4_fp8(v1.x, v1.y, v1.z, v1.w); }
                    else if (pn < 6) { const int b_ = row / RPB, i_ = row - b_ * RPB, hh = cl >> 7, e0 = cl & 127;
                        unsigned char* d8 = ws + WS_VT8D + ((size_t)(b_ * 4 + hh) * 128 + e0 + (fr & 3)) * RPB + (i_ & ~63) + vt_pos(i_ & 60);
                        *(unsigned*)d8 = quad_tr_bytes(cvt4_fp8(v0.x, v0.y, v0.z, v0.w), fr & 3); *(unsigned*)(d8 + 16 * RPB) = quad_tr_bytes(cvt4_fp8(v1.x, v1.y, v1.z, v1.w), fr & 3); }
                    else if (pn == 7 && bj == 1 && wc < 2) { unsigned char* d8 = ws + WS_KR8 + (size_t)row * 64 + wc * 32 + 4 * fq;
                        *(unsigned*)d8 = cvt4_fp8(v0.x, v0.y, v0.z, v0.w); *(unsigned*)(d8 + 16) = cvt4_fp8(v1.x, v1.y, v1.z, v1.w); }
                    if (pn >= 6)
#endif
                    { bf16_t* dst = PJ + (size_t)row * NPROJ + pn * 256 + bj * 128 + wc * 32 + 4 * fq;
                    u32x2 w0, w1; w0.x = cvt_pk_bf16(v0.x, v0.y); w0.y = cvt_pk_bf16(v0.z, v0.w); w1.x = cvt_pk_bf16(v1.x, v1.y); w1.y = cvt_pk_bf16(v1.z, v1.w);
                    *(u32x2*)dst = w0; *(u32x2*)(dst + 16) = w1; }
                }
                if (pn >= 6) { ss += __shfl_xor(ss, 16); ss += __shfl_xor(ss, 32); if (fq == 0) atomicAdd((pn == 6 ? rsq : rskv) + row, ss); }
                asm volatile("" ::: "memory");
            }
    }
};
struct EpiQ {
    static constexpr int NST = 0;
    bf16_t* QM; const f32x2* rope; const float* rsq; unsigned char* ws;
    __device__ __forceinline__ void operator()(const AccT& acc, const pg8::Unit& u, int wr, int wc, int fr, int fq) const {
        const int pm = u.pm, pn = u.pn; const bool latent = (pm % 33) != 0;
#pragma unroll
        for (int ai = 0; ai < 2; ++ai)
#pragma unroll
            for (int m = 0; m < 4; ++m) {
                const int row = pm * 256 + ai * 128 + wr * 64 + m * 16 + fr;
                const float rq = rsqrtf(rsq[row] * (1.f / 256.f) + EPS);
                const int i = row % RPB, pos = i - CTX;
#pragma unroll
                for (int bj = 0; bj < 2; ++bj) {
                    f32x4 v0 = acc[ai][bj][m][0] * rq, v1 = acc[ai][bj][m][1] * rq;
                    const int g6 = (pn * 8 + bj * 4 + wc) % 6;
                    if (latent && g6 >= 4) { const int pv = (g6 == 5) ? (pos & 63) : (pos >> 6);
                        const f32x4* t = (const f32x4*)(rope + pv * 16 + 4 * fq); const f32x4 t0 = t[0], t1 = t[1];
                        const f32x4 cs = {t0.x, t0.z, t1.x, t1.z}, sn = {t0.y, t0.w, t1.y, t1.w};
                        const f32x4 o0 = v0 * cs - v1 * sn, o1 = v1 * cs + v0 * sn; v0 = o0; v1 = o1; }
#ifdef SIM_FP8_ATT
                    v0 = (f32x4){q8(v0.x), q8(v0.y), q8(v0.z), q8(v0.w)}; v1 = (f32x4){q8(v1.x), q8(v1.y), q8(v1.z), q8(v1.w)};
#endif
#if ATT_FP8
                    { unsigned char* d8 = ws + WS_Q8M + (size_t)row * 768 + pn * 256 + bj * 128 + wc * 32 + 4 * fq; v0 = v0 * QSCALE_MLA; v1 = v1 * QSCALE_MLA;
                      *(unsigned*)d8 = cvt4_fp8(v0.x, v0.y, v0.z, v0.w); *(unsigned*)(d8 + 16) = cvt4_fp8(v1.x, v1.y, v1.z, v1.w); }
#else
                    bf16_t* dst = QM + (size_t)row * 768 + pn * 256 + bj * 128 + wc * 32 + 4 * fq;
                    u32x2 w0, w1; w0.x = cvt_pk_bf16(v0.x, v0.y); w0.y = cvt_pk_bf16(v0.z, v0.w); w1.x = cvt_pk_bf16(v1.x, v1.y); w1.y = cvt_pk_bf16(v1.z, v1.w);
                    *(u32x2*)dst = w0; *(u32x2*)(dst + 16) = w1;
#endif
                }
            }
    }
};
struct EpiKV {
    static constexpr int NST = 0;
    bf16_t* KV; const float* rskv; unsigned char* ws;
    __device__ __forceinline__ void operator()(const AccT& acc, const pg8::Unit& u, int wr, int wc, int fr, int fq) const {
        const int pm = u.pm, pn = u.pn;
#pragma unroll
        for (int ai = 0; ai < 2; ++ai)
#pragma unroll
            for (int m = 0; m < 4; ++m) {
                const int row = pm * 256 + ai * 128 + wr * 64 + m * 16 + fr;
                const float rk = rsqrtf(rskv[row] * (1.f / 128.f) + EPS);
#pragma unroll
                for (int bj = 0; bj < 2; ++bj) {
                    f32x4 v0 = acc[ai][bj][m][0] * rk, v1 = acc[ai][bj][m][1] * rk;
#ifdef SIM_FP8_ATT
                    v0 = (f32x4){q8(v0.x), q8(v0.y), q8(v0.z), q8(v0.w)}; v1 = (f32x4){q8(v1.x), q8(v1.y), q8(v1.z), q8(v1.w)};
#endif
#if ATT_FP8
                    if (bj == 0) { unsigned char* d8 = ws + WS_K8M + (size_t)row * 512 + pn * 128 + wc * 32 + 4 * fq;
                        *(unsigned*)d8 = cvt4_fp8(v0.x, v0.y, v0.z, v0.w); *(unsigned*)(d8 + 16) = cvt4_fp8(v1.x, v1.y, v1.z, v1.w); }
                    else { const int b_ = row / RPB, i_ = row - b_ * RPB, e0 = wc * 32 + 4 * fq;
                        unsigned char* d8 = ws + WS_VT8M + ((size_t)(b_ * 4 + pn) * 128 + e0 + (fr & 3)) * RPB + (i_ & ~63) + vt_pos(i_ & 60);
                        *(unsigned*)d8 = quad_tr_bytes(cvt4_fp8(v0.x, v0.y, v0.z, v0.w), fr & 3); *(unsigned*)(d8 + 16 * RPB) = quad_tr_bytes(cvt4_fp8(v1.x, v1.y, v1.z, v1.w), fr & 3); }
#else
                    bf16_t* dst = KV + (size_t)row * 1024 + pn * 256 + bj * 128 + wc * 32 + 4 * fq;
                    u32x2 w0, w1; w0.x = cvt_pk_bf16(v0.x, v0.y); w0.y = cvt_pk_bf16(v0.z, v0.w); w1.x = cvt_pk_bf16(v1.x, v1.y); w1.y = cvt_pk_bf16(v1.z, v1.w);
                    *(u32x2*)dst = w0; *(u32x2*)(dst + 16) = w1;
#endif
                }
            }
    }
};
struct EpiOut {
    static constexpr int NST = 0;
    bf16_t* XN; const float* x; const float* mods; float* rsx;
    __device__ __forceinline__ void operator()(const AccT& acc, const pg8::Unit& u, int wr, int wc, int fr, int fq) const {
        const int pm = u.pm, pn = u.pn, b = pm >> 5;
        const float* ga = mods + b * 6144 + 2 * 1024;
        float ssr[2][4];
#pragma unroll
        for (int ai = 0; ai < 2; ++ai)
#pragma unroll
            for (int m = 0; m < 4; ++m) ssr[ai][m] = 0.f;
#pragma unroll
        for (int bj = 0; bj < 2; ++bj) { const int cb = pn * 256 + bj * 128 + wc * 32;
            const f32x4 gv0 = *(const f32x4*)(ga + cb + 4 * fq), gv1 = *(const f32x4*)(ga + cb + 16 + 4 * fq);
#pragma unroll
            for (int ai = 0; ai < 2; ++ai)
#pragma unroll
                for (int m = 0; m < 4; ++m) { const size_t ro = (size_t)(pm * 256 + ai * 128 + wr * 64 + m * 16 + fr) * DM + cb;
                    const f32x4 v0 = *(const f32x4*)(x + ro + 4 * fq) + gv0 * acc[ai][bj][m][0], v1 = *(const f32x4*)(x + ro + 16 + 4 * fq) + gv1 * acc[ai][bj][m][1];
                    ssr[ai][m] += ((v0.x * v0.x + v0.y * v0.y) + (v0.z * v0.z + v0.w * v0.w)) + ((v1.x * v1.x + v1.y * v1.y) + (v1.z * v1.z + v1.w * v1.w));
                    unsigned ax = cvt_pk_bf16(v0.x, v0.y), ay = cvt_pk_bf16(v0.z, v0.w), bx = cvt_pk_bf16(v1.x, v1.y), by = cvt_pk_bf16(v1.z, v1.w);
                    { auto r_ = __builtin_amdgcn_permlane32_swap(ax, bx, false, false); ax = r_[0]; bx = r_[1]; } { auto r_ = __builtin_amdgcn_permlane32_swap(ay, by, false, false); ay = r_[0]; by = r_[1]; }
                    { auto r_ = __builtin_amdgcn_permlane16_swap(ax, bx, false, false); ax = r_[0]; bx = r_[1]; } { auto r_ = __builtin_amdgcn_permlane16_swap(ay, by, false, false); ay = r_[0]; by = r_[1]; }
                    *(u32x4*)(XN + ro + 8 * fq) = (u32x4){ax, ay, bx, by}; } }
#pragma unroll
        for (int ai = 0; ai < 2; ++ai)
#pragma unroll
            for (int m = 0; m < 4; ++m) { float s = ssr[ai][m]; s += __shfl_xor(s, 16); s += __shfl_xor(s, 32);
                if (fq == 0) atomicAdd(rsx + pm * 256 + ai * 128 + wr * 64 + m * 16 + fr, s); }
    }
};
struct EpiAct {
    static constexpr int NST = 16;
    unsigned char* ACT; const float* b1;
    __device__ __forceinline__ void operator()(const AccT& acc, const pg8::Unit& u, int wr, int wc, int fr, int fq) const {
        const int pm = u.pm, pn = u.pn; const float* bb = b1 + (size_t)u.e * 2048;
#pragma unroll
        for (int n = 0; n < 2; ++n) { const int col = pn * 128 + wc * 32 + n * 16 + 4 * fq; const f32x4 bg = *(const f32x4*)(bb + col), bu = *(const f32x4*)(bb + 1024 + col);
#pragma unroll
            for (int ai = 0; ai < 2; ++ai)
#pragma unroll
                for (int m = 0; m < 4; ++m) { const int row = pm * 256 + ai * 128 + wr * 64 + m * 16 + fr;
                    const f32x4 gq = acc[ai][0][m][n] * (1.f / WQ_SCALE) + bg, uq = acc[ai][1][m][n] * (1.f / WQ_SCALE) + bu; float o[4];
#pragma unroll
                    for (int e = 0; e < 4; ++e) { const float gg = fminf(gq[e], 7.f), uu = fminf(fmaxf(uq[e], -7.f), 7.f);
                        o[e] = gg * __builtin_amdgcn_rcpf(1.f + __builtin_amdgcn_exp2f(gg * (-1.702f * 1.4426950408889634f))) * (uu + 1.f); }
                    *(unsigned*)(ACT + (size_t)row * 1024 + col) = cvt4_fp8(o[0], o[1], o[2], o[3]); } }
    }
};
struct EpiY {
    static constexpr int NST = 16;
    bf16_t* YS; const float* b2; const float* gsrt; int mode = 0;
    __device__ __forceinline__ void operator()(const AccT& acc, const pg8::Unit& u, int wr, int wc, int fr, int fq) const {
        const int pm = u.pm, pn = u.pn; const float* bb = b2 + (size_t)u.e * 1024;
        float gt[2][4];
#pragma unroll
        for (int ai = 0; ai < 2; ++ai)
#pragma unroll
            for (int m = 0; m < 4; ++m) gt[ai][m] = gsrt[pm * 256 + ai * 128 + wr * 64 + m * 16 + fr] * (YS_FP8 ? YS_SCALE : 1.f);
#pragma unroll
        for (int bj = 0; bj < 2; ++bj) { const int cb = pn * 256 + bj * 128 + wc * 32;
            const f32x4 bv0 = *(const f32x4*)(bb + cb + 4 * fq), bv1 = *(const f32x4*)(bb + cb + 16 + 4 * fq);
#pragma unroll
            for (int ai = 0; ai < 2; ++ai)
#pragma unroll
                for (int m = 0; m < 4; ++m) { const int row = pm * 256 + ai * 128 + wr * 64 + m * 16 + fr;
                    const f32x4 v0 = (acc[ai][bj][m][0] * (1.f / WQ_SCALE) + bv0) * gt[ai][m], v1 = (acc[ai][bj][m][1] * (1.f / WQ_SCALE) + bv1) * gt[ai][m];
#if YS_FP8
                    unsigned ax = cvt4_fp8(v0.x, v0.y, v0.z, v0.w), bx = cvt4_fp8(v1.x, v1.y, v1.z, v1.w);
                    { auto r_ = __builtin_amdgcn_permlane32_swap(ax, bx, false, false); ax = r_[0]; bx = r_[1]; }
                    { auto r_ = __builtin_amdgcn_permlane16_swap(ax, bx, false, false); ax = r_[0]; bx = r_[1]; }
                    if (mode == 0 || ax == 0x12345678u) *(u32x2*)((unsigned char*)YS + (size_t)row * 1024 + cb + 8 * fq) = (u32x2){ax, bx};
#else
                    unsigned ax = cvt_pk_bf16(v0.x, v0.y), ay = cvt_pk_bf16(v0.z, v0.w), bx = cvt_pk_bf16(v1.x, v1.y), by = cvt_pk_bf16(v1.z, v1.w);
                    { auto r_ = __builtin_amdgcn_permlane32_swap(ax, bx, false, false); ax = r_[0]; bx = r_[1]; } { auto r_ = __builtin_amdgcn_permlane32_swap(ay, by, false, false); ay = r_[0]; by = r_[1]; }
                    { auto r_ = __builtin_amdgcn_permlane16_swap(ax, bx, false, false); ax = r_[0]; bx = r_[1]; } { auto r_ = __builtin_amdgcn_permlane16_swap(ay, by, false, false); ay = r_[0]; by = r_[1]; }
                    if (mode == 0 || ax == 0x12345678u) *(u32x4*)(YS + (size_t)row * 1024 + cb + 8 * fq) = (u32x4){ax, ay, bx, by};
#endif
                } }
    }
};
namespace attn {
using bf16x8 = __attribute__((ext_vector_type(8))) short;
using s16x4  = __attribute__((ext_vector_type(4))) short;
using f32x16 = __attribute__((ext_vector_type(16))) float;
constexpr int QBLK = 32, KVBLK = 64;
constexpr int SHM_V = KVBLK * 128 * 2;
#ifndef ATT_THR
#define ATT_THR 8.f
#endif
constexpr float THR = ATT_THR;
#define KOFF(row, ch) ((row) * 128 + ((((ch) ^ ((row) >> 1)) & 7) << 4))
#define SBAR() __builtin_amdgcn_sched_barrier(0)
__device__ __forceinline__ int crow(int r, int hi) { return (r & 3) + 8 * (r >> 2) + 4 * hi; }

template <int VAR = 0>
__device__ __forceinline__ void partialSM(f32x16& p0, f32x16& p1, float& m_reg, float& mn, float& alpha, const float C, const float thr_raw) {
  if constexpr (VAR == 1) { mn = m_reg; alpha = 1.f;
    _Pragma("unroll") for (int r = 0; r < 16; ++r) { p0[r] = p0[r] * C; p1[r] = p1[r] * C; } return; }
  float pmax = p0[0];
#pragma unroll
  for (int r = 1; r < 16; ++r) pmax = fmaxf(pmax, p0[r]);
#pragma unroll
  for (int r = 0; r < 16; ++r) pmax = fmaxf(pmax, p1[r]);
  { auto rr = __builtin_amdgcn_permlane32_swap(__float_as_uint(pmax), __float_as_uint(pmax), false, false);
    pmax = fmaxf(__uint_as_float(rr[0]), __uint_as_float(rr[1])); }
  if (__builtin_expect(__all(pmax - m_reg <= thr_raw), 1)) { mn = m_reg; alpha = 1.f; }
  else { mn = fmaxf(m_reg, pmax); alpha = __builtin_amdgcn_exp2f((m_reg - mn) * C); m_reg = mn; }
  const float mnC = -mn * C + PSHIFT;
#pragma unroll
  for (int r = 0; r < 16; ++r) p0[r] = fmaf(p0[r], C, mnC);
#pragma unroll
  for (int r = 0; r < 16; ++r) p1[r] = fmaf(p1[r], C, mnC);
#pragma unroll
  for (int r = 0; r < 16; ++r) p0[r] = __builtin_amdgcn_exp2f(p0[r]);
}
template <int VAR = 0>
__device__ __forceinline__ void finishSM(f32x16& p0, f32x16& p1, float alpha, float& l_reg, bf16x8& pa0, bf16x8& pa1, bf16x8& pa2, bf16x8& pa3) {
  if constexpr (VAR != 1) {
#pragma unroll
  for (int r = 0; r < 16; ++r) p1[r] = __builtin_amdgcn_exp2f(p1[r]); }
  float ps = 0;
#pragma unroll
  for (int r = 0; r < 16; ++r) ps += p0[r];
#pragma unroll
  for (int r = 0; r < 16; ++r) ps += p1[r];
  { auto rr = __builtin_amdgcn_permlane32_swap(__float_as_uint(ps), __float_as_uint(ps), false, false);
    ps = __uint_as_float(rr[0]) + __uint_as_float(rr[1]); }
  l_reg = l_reg * alpha + ps;
#define PK4(P, BASE, OUT) do { unsigned a0 = cvt_pk_bf16(P[BASE + 0], P[BASE + 1]), a1 = cvt_pk_bf16(P[BASE + 2], P[BASE + 3]);   \
    unsigned b0 = cvt_pk_bf16(P[BASE + 4], P[BASE + 5]), b1 = cvt_pk_bf16(P[BASE + 6], P[BASE + 7]);                              \
    auto r0 = __builtin_amdgcn_permlane32_swap(a0, b0, false, false); auto r1 = __builtin_amdgcn_permlane32_swap(a1, b1, false, false); \
    u32x4 w = {r0[0], r1[0], r0[1], r1[1]}; OUT = *reinterpret_cast<bf16x8*>(&w); } while (0)
  PK4(p0, 0, pa0); PK4(p0, 8, pa1); PK4(p1, 0, pa2); PK4(p1, 8, pa3);
#undef PK4
}
template <int NKC, int NQR, int KBOFF>
__device__ __forceinline__ void qkt(f32x16& p0, f32x16& p1, const int* kb, const bf16x8* qr, int ql) {
  p0 = f32x16{}; p1 = f32x16{};
  if constexpr (NQR != NKC) asm volatile("" : "+v"(ql));
#pragma unroll
  for (int c = 0; c < NKC; ++c)
#pragma unroll
    for (int d0 = 0; d0 < 4; ++d0) {
      const bf16x8 b0 = *(const LAS bf16x8*)(uintptr_t)(unsigned)(kb[d0] + (KBOFF + c * 8192));
      const bf16x8 b1 = *(const LAS bf16x8*)(uintptr_t)(unsigned)(kb[d0] + (KBOFF + c * 8192 + 4096));
      bf16x8 qf; if constexpr (NQR == NKC) qf = qr[c * 4 + d0]; else { if (c < NQR) qf = qr[(c < NQR ? c : 0) * 4 + d0]; else qf = *(const LAS bf16x8*)(uintptr_t)(unsigned)(ql + ((c - NQR) * 4 + d0) * 1024); }
      p0 = __builtin_amdgcn_mfma_f32_32x32x16_bf16(b0, qf, p0, 0, 0, 0);
      p1 = __builtin_amdgcn_mfma_f32_32x32x16_bf16(b1, qf, p1, 0, 0, 0); }
}
__device__ __forceinline__ int v_st(int k, int c) { const int kk = (k & ~0xC) | ((k & 4) << 1) | ((k & 8) >> 1); return ((kk >> 3) * 4 + (c >> 5)) * 512 + ((kk & 7) * 32 + (c & 31)) * 2; }
__device__ __forceinline__ int v_rd_base(int lane) { return ((lane & 3) << 3) | (((lane >> 2) & 3) << 6) | (((lane >> 4) & 1) << 5) | (((lane >> 5) & 1) << 8); }
constexpr int v_rd_off(int d0, int ks, int half) { return d0 * 512 + ks * 4096 + half * 2048; }
template <int OFF> __device__ __forceinline__ s16x4 tr_read(int vb) {
  s16x4 r; asm volatile("ds_read_b64_tr_b16 %0, %1 offset:%2" : "=&v"(r) : "v"(vb), "i"(OFF) : "memory"); return r;
}
template <int D0> __device__ __forceinline__ void pv_one(f32x16& od, int vb, bf16x8 pa0, bf16x8 pa1, bf16x8 pa2, bf16x8 pa3) {
  const s16x4 l0 = tr_read<v_rd_off(D0, 0, 0)>(vb), h0 = tr_read<v_rd_off(D0, 0, 1)>(vb), l1 = tr_read<v_rd_off(D0, 1, 0)>(vb), h1 = tr_read<v_rd_off(D0, 1, 1)>(vb);
  const s16x4 l2 = tr_read<v_rd_off(D0, 2, 0)>(vb), h2 = tr_read<v_rd_off(D0, 2, 1)>(vb), l3 = tr_read<v_rd_off(D0, 3, 0)>(vb), h3 = tr_read<v_rd_off(D0, 3, 1)>(vb);
  asm volatile("s_waitcnt lgkmcnt(0)" ::: "memory"); SBAR();
#define PK(L, H) (bf16x8){L[0], L[1], L[2], L[3], H[0], H[1], H[2], H[3]}
  od = __builtin_amdgcn_mfma_f32_32x32x16_bf16(pa0, PK(l0, h0), od, 0, 0, 0);
  od = __builtin_amdgcn_mfma_f32_32x32x16_bf16(pa1, PK(l1, h1), od, 0, 0, 0);
  od = __builtin_amdgcn_mfma_f32_32x32x16_bf16(pa2, PK(l2, h2), od, 0, 0, 0);
  od = __builtin_amdgcn_mfma_f32_32x32x16_bf16(pa3, PK(l3, h3), od, 0, 0, 0);
#undef PK
}
__device__ __forceinline__ void pv_d0(f32x16* o, int vb, bf16x8 pa0, bf16x8 pa1, bf16x8 pa2, bf16x8 pa3) {
  pv_one<0>(o[0], vb, pa0, pa1, pa2, pa3); pv_one<1>(o[1], vb, pa0, pa1, pa2, pa3); pv_one<2>(o[2], vb, pa0, pa1, pa2, pa3); pv_one<3>(o[3], vb, pa0, pa1, pa2, pa3);
}

typedef short v4i16 __attribute__((ext_vector_type(4)));
template <int OFF> __device__ __forceinline__ bf16x8 vfrag(int vb) {
  const v4i16 l = __builtin_amdgcn_ds_read_tr16_b64_v4i16((LAS v4i16*)(uintptr_t)(unsigned)(vb + OFF));
  const v4i16 h = __builtin_amdgcn_ds_read_tr16_b64_v4i16((LAS v4i16*)(uintptr_t)(unsigned)(vb + OFF + 2048));
  return (bf16x8){l[0], l[1], l[2], l[3], h[0], h[1], h[2], h[3]};
}
__device__ __forceinline__ float max3f(float a, float b, float c) { return __builtin_fmaxf(__builtin_fmaxf(a, b), c); }
#define PK4X(P, BASE, OUT) do { unsigned a0 = cvt_pk_bf16(Q8(P[BASE + 0]), Q8(P[BASE + 1])), a1 = cvt_pk_bf16(Q8(P[BASE + 2]), Q8(P[BASE + 3]));   \
    unsigned b0 = cvt_pk_bf16(Q8(P[BASE + 4]), Q8(P[BASE + 5])), b1 = cvt_pk_bf16(Q8(P[BASE + 6]), Q8(P[BASE + 7]));                              \
    auto r0 = __builtin_amdgcn_permlane32_swap(a0, b0, false, false); auto r1 = __builtin_amdgcn_permlane32_swap(a1, b1, false, false); \
    u32x4 w = {r0[0], r1[0], r0[1], r1[1]}; OUT = *reinterpret_cast<bf16x8*>(&w); } while (0)

template <int NKC, int NQR, int VAR = 0, int OM = 0>
__device__ __forceinline__ void attn_unit(const bf16_t* __restrict__ Qb, int ldq, const bf16_t* kp0, int kld0, const bf16_t* kp1, int kld1, const bf16_t* kp2, int kld2,
                                          const bf16_t* __restrict__ Vh, int ldv, bf16_t* __restrict__ Ob, int ldo, int seq, const float C, char* lds,
                                          char* stash = nullptr, const float lam = 0.f, const float* __restrict__ subw = nullptr) {
  constexpr int SHM_K = NKC * 8192, NG = NKC * 8;
  const int tid = tid_opaque(), wid = tid >> 6, lane = tid & 63, r32 = lane & 31, hi = lane >> 5;
  const float thr_raw = THR * 1.4426950408889634f / C;
  char* V_lds = lds; char* K_lds = lds + 3 * SHM_V;
  float* ws = (float*)(lds + 3 * SHM_V + 3 * SHM_K) + wid * 64; float* li_l = ws; float* al_l = ws + 32;
  float m_reg = -1e30f, l_reg = 0; f32x16 o[4] = {}; bf16x8 qr[NQR * 4];
  const bf16_t* Qw = Qb + (long)(wid * QBLK + r32) * ldq + hi * 8;
  int ql = (int)(uintptr_t)(lds + 3 * SHM_V + 3 * SHM_K + 2048) + wid * ((NKC - NQR) * 4096) + lane * 16;
  int kb[4];
#pragma unroll
  for (int d0 = 0; d0 < 4; ++d0) kb[d0] = (int)(uintptr_t)K_lds + KOFF(r32, d0 * 2 + hi);
  __syncthreads();
#pragma unroll
  for (int d0 = 0; d0 < NQR * 4; ++d0) qr[d0] = *reinterpret_cast<const bf16x8*>(Qw + d0 * 16);
#pragma unroll
  for (int d0 = NQR * 4; d0 < NKC * 4; ++d0) *(LAS bf16x8*)(uintptr_t)(unsigned)(ql + (d0 - NQR * 4) * 1024) = *reinterpret_cast<const bf16x8*>(Qw + d0 * 16);
  const int sr = tid >> 4, sc = (tid & 15) * 8, vst0 = v_st(sr, sc), vst1 = v_st(32 + sr, sc);
  const int krow = tid >> 3, kch = tid & 7, kst = KOFF(krow, kch);
  const int vb0 = (int)(uintptr_t)V_lds + v_rd_base(lane);
  const unsigned vo0 = (unsigned)(sr * ldv + sc) * 2u, vo1 = (unsigned)((32 + sr) * ldv + sc) * 2u;
  const unsigned ko0 = (unsigned)(krow * kld0 + kch * 8) * 2u, ko1 = (unsigned)(krow * kld1 + kch * 8) * 2u, ko2 = (unsigned)(krow * kld2 + kch * 8) * 2u;
  struct { bf16x8 vs0, vs1, k0, k1, k2; } sg;
  const __amdgpu_buffer_rsrc_t rV = __builtin_amdgcn_make_buffer_rsrc((void*)Vh, 0, 0xffffffff, 0x00020000);
  const __amdgpu_buffer_rsrc_t rK0 = __builtin_amdgcn_make_buffer_rsrc((void*)kp0, 0, 0xffffffff, 0x00020000);
  const __amdgpu_buffer_rsrc_t rK1 = __builtin_amdgcn_make_buffer_rsrc((void*)(NKC > 1 ? kp1 : kp0), 0, 0xffffffff, 0x00020000);
  const __amdgpu_buffer_rsrc_t rK2 = __builtin_amdgcn_make_buffer_rsrc((void*)(NKC > 2 ? kp2 : kp0), 0, 0xffffffff, 0x00020000);
#define BL128(r, vo, so) __builtin_bit_cast(bf16x8, __builtin_amdgcn_raw_buffer_load_b128(r, (int)(vo), (int)(so), 0))
#define SLOAD(kb_) do { const int so_ = (kb_) * (ldv * 2); \
    sg.vs0 = BL128(rV, vo0, so_); sg.vs1 = BL128(rV, vo1, so_); \
    sg.k0 = BL128(rK0, ko0, (kb_) * (kld0 * 2)); \
    if constexpr (NKC > 1) sg.k1 = BL128(rK1, ko1, (kb_) * (kld1 * 2)); \
    if constexpr (NKC > 2) sg.k2 = BL128(rK2, ko2, (kb_) * (kld2 * 2)); } while (0)
#define SWRITE(b) do { *(bf16x8*)(V_lds + (b) * SHM_V + vst0) = sg.vs0; *(bf16x8*)(V_lds + (b) * SHM_V + vst1) = sg.vs1; \
    *(bf16x8*)(K_lds + (b) * SHM_K + kst) = sg.k0; \
    if constexpr (NKC > 1) *(bf16x8*)(K_lds + (b) * SHM_K + 8192 + kst) = sg.k1; \
    if constexpr (NKC > 2) *(bf16x8*)(K_lds + (b) * SHM_K + 16384 + kst) = sg.k2; } while (0)
#define RESC(a) do { if (__any((a) < 1.f)) { if (hi == 0) al_l[r32] = (a); asm volatile("s_waitcnt lgkmcnt(0)" ::: "memory"); \
    _Pragma("unroll") for (int d = 0; d < 4; ++d) _Pragma("unroll") for (int r = 0; r < 16; ++r) o[d][r] *= al_l[crow(r, hi)]; } } while (0)
#define KLD(g, KB) (*(const LAS bf16x8*)(uintptr_t)(unsigned)(kb[((g) & 7) >> 1] + ((KB) + ((g) >> 3) * 8192 + ((g) & 1) * 4096)))
#define QLD(j) (*(const LAS bf16x8*)(uintptr_t)(unsigned)(ql + (j) * 1024))
  f32x16 pA0, pA1, pB0, pB1; float alA, alB; bf16x8 pa[4]; const int NT = seq / KVBLK;
  constexpr bool NEGM = (NKC == 1); f32x16 negm = {}; const float thr2 = THR * 1.4426950408889634f;
#define STEP(PN0, PN1, alN, PC0, PC1, alC, BKN, BVC, BW, DO_QK, DO_WR, DO_LD, tt) do { \
    bf16x8 kf[3], vf[3], qlf[2]; float ps = 0.f, mxa = 0.f, mxb = 0.f, mnC = 0.f; \
    SBAR(); \
    if (DO_QK) { if constexpr (NQR != NKC) asm volatile("" : "+v"(ql)); kf[0] = KLD(0, (BKN) * SHM_K); kf[1] = KLD(1, (BKN) * SHM_K); } \
    _Pragma("unroll") for (int g = 0; g < NG; ++g) { \
      const int c_ = g >> 3, d0_ = (g & 7) >> 1, s_ = g / NKC; const bool fs_ = (g % NKC) == 0; \
      if (DO_QK) { bf16x8 qf_; if (c_ < NQR) qf_ = qr[(c_ < NQR ? c_ : 0) * 4 + d0_]; else { if ((g & 1) == 0) qlf[d0_ & 1] = QLD((c_ - NQR) * 4 + d0_); qf_ = qlf[d0_ & 1]; } \
        if ((g & 1) == 0) { if (g == 0) PN0 = __builtin_amdgcn_mfma_f32_32x32x16_bf16(kf[g % 3], qf_, NEGM ? negm : (f32x16){}, 0, 0, 0); else PN0 = __builtin_amdgcn_mfma_f32_32x32x16_bf16(kf[g % 3], qf_, PN0, 0, 0, 0); } \
        else { if (g == 1) PN1 = __builtin_amdgcn_mfma_f32_32x32x16_bf16(kf[g % 3], qf_, NEGM ? negm : (f32x16){}, 0, 0, 0); else PN1 = __builtin_amdgcn_mfma_f32_32x32x16_bf16(kf[g % 3], qf_, PN1, 0, 0, 0); } } \
      if (fs_ && VAR < 4) {   \
        if (!NEGM && s_ < 7) { PC1[2 * s_] = __builtin_amdgcn_exp2f(PC1[2 * s_]); PC1[2 * s_ + 1] = __builtin_amdgcn_exp2f(PC1[2 * s_ + 1]); } \
        if (!NEGM && s_ == 4) { PC1[14] = __builtin_amdgcn_exp2f(PC1[14]); PC1[15] = __builtin_amdgcn_exp2f(PC1[15]); } \
        if (s_ == 0) { ps = (PC0[0] + PC0[1]) + (PC0[2] + PC0[3]); PK4X(PC0, 0, pa[0]); } \
        if (s_ == 1) { ps += (PC0[4] + PC0[5]) + (PC0[6] + PC0[7]); PK4X(PC0, 8, pa[1]); } \
        if (s_ == 2) { ps += (PC0[8] + PC0[9]) + (PC0[10] + PC0[11]); ps += (PC0[12] + PC0[13]) + (PC0[14] + PC0[15]); } \
        if (s_ == 3) { ps += (PC1[0] + PC1[1]) + (PC1[2] + PC1[3]); } \
        if (s_ == 4) { ps += (PC1[4] + PC1[5]) + (PC1[6] + PC1[7]); } \
        if (s_ == 5) { ps += (PC1[8] + PC1[9]); PK4X(PC1, 0, pa[2]); } \
        if (s_ == 6) { ps += (PC1[10] + PC1[11]) + (PC1[12] + PC1[13]); } \
        if (s_ == 7) { ps += (PC1[14] + PC1[15]); PK4X(PC1, 8, pa[3]); \
          auto rr_ = __builtin_amdgcn_permlane32_swap(__float_as_uint(ps), __float_as_uint(ps), false, false); ps = __uint_as_float(rr_[0]) + __uint_as_float(rr_[1]); l_reg = l_reg * (alC) + ps; } } \
      if (DO_QK && g + 2 < NG) kf[(g + 2) % 3] = KLD(g + 2, (BKN) * SHM_K); \
      if (g == NG - 2) vf[0] = vfrag<v_rd_off(0, 0, 0)>(vb0 + (BVC) * (int)SHM_V); \
      if (g == NG - 1) vf[1] = vfrag<v_rd_off(1, 0, 0)>(vb0 + (BVC) * (int)SHM_V); \
      SBAR(); } \
    _Pragma("unroll") for (int g = 0; g < 16; ++g) { \
      const int ks_ = g >> 2, d0_ = g & 3; \
      o[d0_] = __builtin_amdgcn_mfma_f32_32x32x16_bf16(pa[ks_], vf[g % 3], o[d0_], 0, 0, 0); \
      if (g == 0 && (DO_WR) && VAR != 5) { SWRITE(BW); } \
      if (g == 1 && (DO_LD) && VAR != 5) { SLOAD(((tt) + 3) * KVBLK); } \
      if (DO_QK && VAR < 4) {   \
        if (g == 2) { mxa = max3f(PN0[0], PN0[1], PN0[2]); mxa = max3f(mxa, PN0[3], PN0[4]); mxb = max3f(PN0[5], PN0[6], PN0[7]); mxb = max3f(mxb, PN0[8], PN0[9]); } \
        if (g == 3) { mxa = max3f(mxa, PN0[10], PN0[11]); mxb = max3f(mxb, PN0[12], PN0[13]); mxa = max3f(mxa, PN0[14], PN0[15]); mxb = max3f(mxb, PN1[0], PN1[1]); } \
        if (g == 4) { mxa = max3f(mxa, PN1[2], PN1[3]); mxb = max3f(mxb, PN1[4], PN1[5]); mxa = max3f(mxa, PN1[6], PN1[7]); mxb = max3f(mxb, PN1[8], PN1[9]); } \
        if (g == 5) { mxa = max3f(mxa, PN1[10], PN1[11]); mxb = max3f(mxb, PN1[12], PN1[13]); mxa = max3f(mxa, PN1[14], PN1[15]); mxa = __builtin_fmaxf(mxa, mxb); } \
        if (g == 6) { auto rr_ = __builtin_amdgcn_permlane32_swap(__float_as_uint(mxa), __float_as_uint(mxa), false, false); const float pmax_ = __builtin_fmaxf(__uint_as_float(rr_[0]), __uint_as_float(rr_[1])); \
          if constexpr (NEGM) { alN = 1.f; if (__builtin_expect(!__all(pmax_ <= thr2 + PSHIFT), 0)) { const float dl_ = __builtin_fmaxf(pmax_ - PSHIFT, 0.f); alN = __builtin_amdgcn_exp2f(-dl_); \
              _Pragma("unroll") for (int r = 0; r < 16; ++r) { PN0[r] -= dl_; PN1[r] -= dl_; negm[r] -= dl_; } } } \
          else { const bool ok_ = __all(pmax_ - m_reg <= thr_raw); const float mn_ = ok_ ? m_reg : __builtin_fmaxf(m_reg, pmax_); \
            alN = __builtin_amdgcn_exp2f((m_reg - mn_) * C); m_reg = mn_; mnC = -mn_ * C + PSHIFT; } } \
        if (g >= 7) { const int i_ = g - 7; \
          if constexpr (NEGM) {   \
            if (i_ < 4) { _Pragma("unroll") for (int r = 4 * i_; r < 4 * i_ + 4; ++r) PN0[r] = __builtin_amdgcn_exp2f(PN0[r]); } \
            else if (i_ < 8) { _Pragma("unroll") for (int r = 4 * (i_ - 4); r < 4 * (i_ - 4) + 4; ++r) PN1[r] = __builtin_amdgcn_exp2f(PN1[r]); } } \
          else {   \
          if (i_ < 4) { _Pragma("unroll") for (int r = 4 * i_; r < 4 * i_ + 4; ++r) PN0[r] = fmaf(PN0[r], C, mnC); } \
          else if (i_ < 8) { _Pragma("unroll") for (int r = 4 * (i_ - 4); r < 4 * (i_ - 4) + 4; ++r) PN1[r] = fmaf(PN1[r], C, mnC); } \
          if (i_ >= 1) { PN0[2 * (i_ - 1)] = __builtin_amdgcn_exp2f(PN0[2 * (i_ - 1)]); PN0[2 * (i_ - 1) + 1] = __builtin_amdgcn_exp2f(PN0[2 * (i_ - 1) + 1]); } } \
          asm volatile("" : "+v"(PN0), "+v"(PN1));   } } \
      if (g + 2 < 16) { constexpr int dummy_ = 0; (void)dummy_; \
        if (g + 2 == 2) vf[2] = vfrag<v_rd_off(2, 0, 0)>(vb0 + (BVC) * (int)SHM_V); if (g + 2 == 3) vf[0] = vfrag<v_rd_off(3, 0, 0)>(vb0 + (BVC) * (int)SHM_V); \
        if (g + 2 == 4) vf[1] = vfrag<v_rd_off(0, 1, 0)>(vb0 + (BVC) * (int)SHM_V); if (g + 2 == 5) vf[2] = vfrag<v_rd_off(1, 1, 0)>(vb0 + (BVC) * (int)SHM_V); \
        if (g + 2 == 6) vf[0] = vfrag<v_rd_off(2, 1, 0)>(vb0 + (BVC) * (int)SHM_V); if (g + 2 == 7) vf[1] = vfrag<v_rd_off(3, 1, 0)>(vb0 + (BVC) * (int)SHM_V); \
        if (g + 2 == 8) vf[2] = vfrag<v_rd_off(0, 2, 0)>(vb0 + (BVC) * (int)SHM_V); if (g + 2 == 9) vf[0] = vfrag<v_rd_off(1, 2, 0)>(vb0 + (BVC) * (int)SHM_V); \
        if (g + 2 == 10) vf[1] = vfrag<v_rd_off(2, 2, 0)>(vb0 + (BVC) * (int)SHM_V); if (g + 2 == 11) vf[2] = vfrag<v_rd_off(3, 2, 0)>(vb0 + (BVC) * (int)SHM_V); \
        if (g + 2 == 12) vf[0] = vfrag<v_rd_off(0, 3, 0)>(vb0 + (BVC) * (int)SHM_V); if (g + 2 == 13) vf[1] = vfrag<v_rd_off(1, 3, 0)>(vb0 + (BVC) * (int)SHM_V); \
        if (g + 2 == 14) vf[2] = vfrag<v_rd_off(2, 3, 0)>(vb0 + (BVC) * (int)SHM_V); if (g + 2 == 15) vf[0] = vfrag<v_rd_off(3, 3, 0)>(vb0 + (BVC) * (int)SHM_V); } \
      SBAR(); } \
    if (VAR >= 4) { asm volatile("" : "+v"(PN0), "+v"(PN1)); pa[0] = __builtin_bit_cast(bf16x8, (u32x4){(unsigned)tt, 1u, 2u, 3u}); pa[1] = pa[0]; pa[2] = pa[0]; pa[3] = pa[0]; } \
    if (DO_QK && VAR < 4) { RESC(alN); } \
    if (VAR != 5) __syncthreads(); } while (0)
  SLOAD(0); SWRITE(0); SLOAD(KVBLK); SWRITE(1); SLOAD(2 * KVBLK); __syncthreads();
  { float mn0_; qkt<NKC, NQR, 0>(pA0, pA1, kb, qr, ql);
    if constexpr (NEGM) { float pm_ = pA0[0];
      _Pragma("unroll") for (int r = 1; r < 16; ++r) pm_ = fmaxf(pm_, pA0[r]);
      _Pragma("unroll") for (int r = 0; r < 16; ++r) pm_ = fmaxf(pm_, pA1[r]);
      { auto rr_ = __builtin_amdgcn_permlane32_swap(__float_as_uint(pm_), __float_as_uint(pm_), false, false); pm_ = fmaxf(__uint_as_float(rr_[0]), __uint_as_float(rr_[1])); }
      _Pragma("unroll") for (int r = 0; r < 16; ++r) { pA0[r] = __builtin_amdgcn_exp2f(pA0[r] - pm_ + PSHIFT); pA1[r] = __builtin_amdgcn_exp2f(pA1[r] - pm_ + PSHIFT); negm[r] = -pm_ + PSHIFT; }
      alA = 1.f; (void)mn0_; }
    else partialSM(pA0, pA1, m_reg, mn0_, alA, C, thr_raw); }
#ifdef ATT_STATIC_PRIO
  if (__builtin_amdgcn_readfirstlane(tid) >= 256) __builtin_amdgcn_s_setprio(1);
#endif
  int t = 0;
  for (; t + 6 < NT; t += 6) {
    STEP(pB0, pB1, alB, pA0, pA1, alA, 1, 0, 2, true, true, true, t);
    STEP(pA0, pA1, alA, pB0, pB1, alB, 2, 1, 0, true, true, true, t + 1);
    STEP(pB0, pB1, alB, pA0, pA1, alA, 0, 2, 1, true, true, true, t + 2);
    STEP(pA0, pA1, alA, pB0, pB1, alB, 1, 0, 2, true, true, true, t + 3);
    STEP(pB0, pB1, alB, pA0, pA1, alA, 2, 1, 0, true, true, true, t + 4);
    STEP(pA0, pA1, alA, pB0, pB1, alB, 0, 2, 1, true, true, true, t + 5);
  }
  STEP(pB0, pB1, alB, pA0, pA1, alA, 1, 0, 2, true, true, true, t);
  STEP(pA0, pA1, alA, pB0, pB1, alB, 2, 1, 0, true, true, true, t + 1);
  STEP(pB0, pB1, alB, pA0, pA1, alA, 0, 2, 1, true, true, true, t + 2);
  STEP(pA0, pA1, alA, pB0, pB1, alB, 1, 0, 2, true, true, false, t + 3);
  STEP(pB0, pB1, alB, pA0, pA1, alA, 2, 1, 0, true, false, false, t + 4);
  STEP(pA0, pA1, alA, pB0, pB1, alB, 0, 2, 1, false, false, false, t + 5);
#ifdef ATT_STATIC_PRIO
  __builtin_amdgcn_s_setprio(0);
#endif
  if (hi == 0) li_l[r32] = l_reg; asm volatile("s_waitcnt lgkmcnt(0)" ::: "memory");
  float rli[16];
#pragma unroll
  for (int r = 0; r < 16; ++r) rli[r] = __builtin_amdgcn_rcpf(li_l[crow(r, hi)]);
  if constexpr (OM == 1) {
    unsigned* st = (unsigned*)stash + tid;
#pragma unroll
    for (int r = 0; r < 16; ++r) { st[(2 * r) * 512] = cvt_pk_bf16(o[0][r] * rli[r], o[1][r] * rli[r]); st[(2 * r + 1) * 512] = cvt_pk_bf16(o[2][r] * rli[r], o[3][r] * rli[r]); }
  } else if constexpr (OM == 2) {
    const unsigned* st = (const unsigned*)stash + tid;
    float sw[4];
#pragma unroll
    for (int d0 = 0; d0 < 4; ++d0) sw[d0] = subw[d0 * 32 + r32] * 0.8f;
    bf16_t* Ow = Ob + (long)(wid * QBLK) * ldo;
#pragma unroll
    for (int r = 0; r < 16; ++r) { const unsigned w01 = st[(2 * r) * 512], w23 = st[(2 * r + 1) * 512];
      const float d0v = bflo(w01) - lam * (o[0][r] * rli[r]), d1v = bfhi(w01) - lam * (o[1][r] * rli[r]), d2v = bflo(w23) - lam * (o[2][r] * rli[r]), d3v = bfhi(w23) - lam * (o[3][r] * rli[r]);
      float ss = (d0v * d0v + d1v * d1v) + (d2v * d2v + d3v * d3v);
      ss += __shfl_xor(ss, 1); ss += __shfl_xor(ss, 2); ss += __shfl_xor(ss, 4); ss += __shfl_xor(ss, 8); ss += __shfl_xor(ss, 16);
      const float rn = rsqrtf(ss * (1.f / 128.f) + EPS); const long ob = (long)crow(r, hi) * ldo + r32;
      Ow[ob] = f2bf(d0v * rn * sw[0]); Ow[ob + 32] = f2bf(d1v * rn * sw[1]); Ow[ob + 64] = f2bf(d2v * rn * sw[2]); Ow[ob + 96] = f2bf(d3v * rn * sw[3]); }
  } else {
  bf16_t* Ow = Ob + (long)(wid * QBLK) * ldo;
#pragma unroll
  for (int r = 0; r < 16; ++r) { const int orow = crow(r, hi);
#pragma unroll
    for (int d0 = 0; d0 < 4; ++d0) Ow[(long)orow * ldo + d0 * 32 + r32] = f2bf(o[d0][r] * rli[r]); }
  }
#undef SLOAD
#undef BL128
#undef SWRITE
#undef RESC
#undef STEP
#undef KLD
#undef QLD
}
#undef PK4X
#undef KOFF
#undef SBAR
}
namespace attn8 {
#if SIM_P6
#define SQ6(x) q8(x)
#else
#define SQ6(x) (x)
#endif
using attn::f32x16; using attn::crow; using attn::max3f;
typedef int v8i32 __attribute__((ext_vector_type(8)));
typedef int v4i32 __attribute__((ext_vector_type(4)));
#ifndef ATT8_THRL
#define ATT8_THRL 3.5f
#endif
constexpr float PSH = 5.f, THRL = ATT8_THRL;
#define OFF8(row, piece) ((row) * 64 + ((((piece) ^ ((row) >> 2)) & 3) << 4))
#define SBAR() __builtin_amdgcn_sched_barrier(0)
#define MFMA8(a, b, c) __builtin_amdgcn_mfma_scale_f32_32x32x64_f8f6f4(a, b, c, 0, 0, 0, 0, 0, 0)
#define LD32(addr0, addr1) __builtin_shufflevector(*(const LAS v4i32*)(uintptr_t)(unsigned)(addr0), *(const LAS v4i32*)(uintptr_t)(unsigned)(addr1), 0, 1, 2, 3, 4, 5, 6, 7)

constexpr int WCONV_I1 = 32 * 128 * 32, WCONV_I2 = 32 * 128 * 16, WCONV_ITEMS = WCONV_I1 + WCONV_I2;
struct WConv { float v[8]; };
__device__ __forceinline__ void wconv_load(const Params& p, int it, int lane, WConv& w) {
    it = min(it, WCONV_ITEMS - 1);
    const bool m1 = it < WCONV_I1; const int i2 = m1 ? it : it - WCONV_I1;
    const int e = m1 ? (i2 >> 12) : (i2 >> 11), kb = m1 ? ((i2 >> 5) & 127) : ((i2 >> 4) & 127), nb = m1 ? (i2 & 31) : (i2 & 15), ldn = m1 ? 2048 : 1024;
    const __amdgpu_buffer_rsrc_t r = __builtin_amdgcn_make_buffer_rsrc((void*)(m1 ? p.w1 : p.w2), 0, 0xffffffff, 0x00020000);
    const int so = ((e * 1024 + kb * 8) * ldn + nb * 64) * 4;
#pragma unroll
    for (int j = 0; j < 8; ++j) w.v[j] = __builtin_bit_cast(float, __builtin_amdgcn_raw_buffer_load_b32(r, lane * 4, so + j * ldn * 4, 0));
}
__device__ __forceinline__ void wconv_store(const Params& p, int it0, int lane, const WConv& w) {
    const int it = min(it0, WCONV_ITEMS - 1);
    const bool m1 = it < WCONV_I1; const int i2 = m1 ? it : it - WCONV_I1;
    const int e = m1 ? (i2 >> 12) : (i2 >> 11), kb = m1 ? ((i2 >> 5) & 127) : ((i2 >> 4) & 127), nb = m1 ? (i2 & 31) : (i2 & 15);
    const int n = nb * 64 + lane;
    const int drow = m1 ? (e * 2048 + ((n & 1023) >> 7) * 256 + (n >> 10) * 128 + (n & 127)) : (e * 1024 + n);
    unsigned char* dst = it0 < WCONV_ITEMS ? p.ws + (m1 ? WS_W1 : WS_W2) + (size_t)drow * 1024 + kb * 8 : p.ws + WS_DUMMY + lane * 8;
    u32x2 o; o.x = cvt4_fp8(w.v[0] * WQ_SCALE, w.v[1] * WQ_SCALE, w.v[2] * WQ_SCALE, w.v[3] * WQ_SCALE); o.y = cvt4_fp8(w.v[4] * WQ_SCALE, w.v[5] * WQ_SCALE, w.v[6] * WQ_SCALE, w.v[7] * WQ_SCALE);
    *(u32x2*)dst = o;
}
template <int NKC, int OM, int VAR = 0, bool WC = false>
__device__ __forceinline__ void attn_unit(const unsigned char* __restrict__ Qb, int ldq, const unsigned char* kp0, int kld0, const unsigned char* kp1, int kld1, const unsigned char* kp2, int kld2,
                                          const unsigned char* __restrict__ VT, bf16_t* __restrict__ Ob, int ldo, int seq, char* lds,
                                          char* stash = nullptr, const float lam = 0.f, const float* __restrict__ subw = nullptr, const Params* pp = nullptr, int wc_base = 0) {
  constexpr int SHM_K = NKC * 4096, SHM_V = 8192, NG = 2 * NKC;
  constexpr bool STG = ((STAGGER) >> (NKC == 1 ? 0 : 1)) & 1;
  constexpr bool V_M = VAR >= 32, V_NOLDS = VAR == 6 || VAR == 9 || V_M, V_NOSTG = VAR == 2 || VAR == 3 || VAR == 9 || V_M, V_NOBAR = VAR == 3 || VAR == 9 || V_M;
  constexpr bool V_NOEXP = VAR == 1 || VAR == 7 || (V_M && (VAR & 1)), V_NOMAX = VAR == 1 || VAR == 7 || (V_M && (VAR & 2)), V_NOPACK = V_M && (VAR & 4);
  constexpr bool V_NOPV = VAR == 4 || VAR == 7 || (V_M && (VAR & 8)), V_NOQK = VAR == 5 || (V_M && (VAR & 16));
  const int tid = tid_opaque(), wid = tid >> 6, lane = tid & 63, r32 = lane & 31, hi = lane >> 5;
  char* V_lds = lds; char* K_lds = lds + 4 * SHM_V;
  float* ws = (float*)(lds + 4 * SHM_V + 4 * SHM_K) + wid * 64; float* al_l = ws + 32;
  f32x16 o[4] = {}, ol = {}; v8i32 qf[NKC];
  v8i32 ones8 = {0x38383838, 0x38383838, 0x38383838, 0x38383838, 0x38383838, 0x38383838, 0x38383838, 0x38383838};
  asm volatile("" : "+v"(ones8));
  { const unsigned char* Qw = Qb + (long)(wid * 32 + r32) * ldq + hi * 32;
#pragma unroll
    for (int c = 0; c < NKC; ++c) qf[c] = __builtin_shufflevector(*(const v4i32*)(Qw + c * 64), *(const v4i32*)(Qw + c * 64 + 16), 0, 1, 2, 3, 4, 5, 6, 7); }
  const int fa0 = OFF8(r32, 2 * hi), fa1 = OFF8(r32, 2 * hi + 1);
  const LAS char* kA = (const LAS char*)(uintptr_t)(unsigned)((int)(uintptr_t)K_lds + fa0); const LAS char* kB = (const LAS char*)(uintptr_t)(unsigned)((int)(uintptr_t)K_lds + fa1);
  const LAS char* vA = (const LAS char*)(uintptr_t)(unsigned)((int)(uintptr_t)V_lds + fa0); const LAS char* vB = (const LAS char*)(uintptr_t)(unsigned)((int)(uintptr_t)V_lds + fa1);
  const int ve = tid >> 2, pc = tid & 3, krow = (tid & 255) >> 2;
  const int vst = OFF8(ve, pc), kst = OFF8(krow, pc);
  const bool lowhalf = tid < 256;
  const bool grpB = __builtin_amdgcn_readfirstlane(wid) >= 4;
  const unsigned vo = (unsigned)(ve * RPB + pc * 16);
  const unsigned ko0 = (unsigned)(krow * kld0 + pc * 16), ko1 = (unsigned)(krow * kld1 + pc * 16), ko2 = (unsigned)(krow * kld2 + pc * 16);
  const __amdgpu_buffer_rsrc_t rV = __builtin_amdgcn_make_buffer_rsrc((void*)VT, 0, 0xffffffff, 0x00020000);
  const __amdgpu_buffer_rsrc_t rK0 = __builtin_amdgcn_make_buffer_rsrc((void*)kp0, 0, 0xffffffff, 0x00020000);
  const __amdgpu_buffer_rsrc_t rK1 = __builtin_amdgcn_make_buffer_rsrc((void*)(NKC > 1 ? kp1 : kp0), 0, 0xffffffff, 0x00020000);
  const __amdgpu_buffer_rsrc_t rK2 = __builtin_amdgcn_make_buffer_rsrc((void*)(NKC > 2 ? kp2 : kp0), 0, 0xffffffff, 0x00020000);
  struct { v4i32 v, ka, kc; } sg;
#define BL16(r, vo_, so_) __builtin_bit_cast(v4i32, __builtin_amdgcn_raw_buffer_load_b128(r, (int)(vo_), (int)(so_), 0))
#define SLOAD(k0) do { sg.v = BL16(rV, vo, (k0)); \
    if constexpr (NKC == 1) { if (lowhalf) sg.ka = BL16(rK0, ko0, (k0) * kld0); } \
    else { if (lowhalf) { sg.ka = BL16(rK0, ko0, (k0) * kld0); sg.kc = BL16(rK2, ko2, (k0) * kld2); } else sg.ka = BL16(rK1, ko1, (k0) * kld1); } } while (0)
#define SWRITE(b) do { *(v4i32*)(V_lds + (b) * SHM_V + vst) = sg.v; \
    if constexpr (NKC == 1) { if (lowhalf) *(v4i32*)(K_lds + (b) * SHM_K + kst) = sg.ka; } \
    else { if (lowhalf) { *(v4i32*)(K_lds + (b) * SHM_K + kst) = sg.ka; *(v4i32*)(K_lds + (b) * SHM_K + 8192 + kst) = sg.kc; } else *(v4i32*)(K_lds + (b) * SHM_K + 4096 + kst) = sg.ka; } } while (0)
#define RESC(a) do { if (raised_) { if (hi == 0) al_l[r32] = (a); asm volatile("s_waitcnt lgkmcnt(0)" ::: "memory"); \
    _Pragma("unroll") for (int r = 0; r < 16; ++r) { const float a_ = al_l[crow(r, hi)]; o[0][r] *= a_; o[1][r] *= a_; o[2][r] *= a_; o[3][r] *= a_; ol[r] *= a_; } } } while (0)
#define LDP(pa, pb, off) __builtin_shufflevector(*(const LAS v4i32*)((pa) + (off)), *(const LAS v4i32*)((pb) + (off)), 0, 1, 2, 3, 4, 5, 6, 7)
#define KFR(g, KB) (V_NOLDS ? qf[0] : LDP(kA, kB, (KB) + ((g) >> 1) * 4096 + ((g) & 1) * 2048))
#define VFR(d0, VB) (V_NOLDS ? qf[0] : LDP(vA, vB, (VB) + (d0) * 2048))
  f32x16 P0, P1, negm; float al = 1.f; const int NT = seq / 64;
  v8i32 kpf0, kpf1;
  v8i32 pf;
#define PACKP() do { pf = (v8i32){(int)cvt4_fp8(P0[0], P0[1], P0[2], P0[3]), (int)cvt4_fp8(P0[4], P0[5], P0[6], P0[7]), (int)cvt4_fp8(P0[8], P0[9], P0[10], P0[11]), (int)cvt4_fp8(P0[12], P0[13], P0[14], P0[15]), \
    (int)cvt4_fp8(P1[0], P1[1], P1[2], P1[3]), (int)cvt4_fp8(P1[4], P1[5], P1[6], P1[7]), (int)cvt4_fp8(P1[8], P1[9], P1[10], P1[11]), (int)cvt4_fp8(P1[12], P1[13], P1[14], P1[15])}; } while (0)
#define PACK0() do { asm volatile("" : "+v"(P0)); pf[0] = (int)cvt4_fp8o(pf[0], P0[0], P0[1], P0[2], P0[3]); pf[1] = (int)cvt4_fp8o(pf[1], P0[4], P0[5], P0[6], P0[7]); \
    pf[2] = (int)cvt4_fp8o(pf[2], P0[8], P0[9], P0[10], P0[11]); pf[3] = (int)cvt4_fp8o(pf[3], P0[12], P0[13], P0[14], P0[15]); asm volatile("" : "+v"(pf)); } while (0)
#define PACK1() do { asm volatile("" : "+v"(P1)); pf[4] = (int)cvt4_fp8o(pf[4], P1[0], P1[1], P1[2], P1[3]); pf[5] = (int)cvt4_fp8o(pf[5], P1[4], P1[5], P1[6], P1[7]); \
    pf[6] = (int)cvt4_fp8o(pf[6], P1[8], P1[9], P1[10], P1[11]); pf[7] = (int)cvt4_fp8o(pf[7], P1[12], P1[13], P1[14], P1[15]); asm volatile("" : "+v"(pf)); } while (0)
#define MAX0() do { m0_ = max3f(P0[0], P0[1], P0[2]); m0_ = max3f(m0_, P0[3], P0[4]); m0_ = max3f(m0_, P0[5], P0[6]); m0_ = max3f(m0_, P0[7], P0[8]); m0_ = max3f(m0_, P0[9], P0[10]); \
    m0_ = max3f(m0_, P0[11], P0[12]); m0_ = max3f(m0_, P0[13], P0[14]); asm volatile("" : "+v"(m0_)); } while (0)
#define MAXFIN() do { float m1_ = max3f(P1[0], P1[1], P1[2]); m1_ = max3f(m1_, P1[3], P1[4]); m1_ = max3f(m1_, P1[5], P1[6]); m1_ = max3f(m1_, P1[7], P1[8]); m1_ = max3f(m1_, P1[9], P1[10]); \
    m1_ = max3f(m1_, P1[11], P1[12]); m1_ = max3f(m1_, P1[13], P1[14]); m1_ = max3f(m1_, P1[15], P0[15]); mx_ = fmaxf(m1_, m0_);          \
    if (__builtin_expect(!__all(mx_ <= PSH + THRL), 0)) { \
      { auto rr_ = __builtin_amdgcn_permlane32_swap(__float_as_uint(mx_), __float_as_uint(mx_), false, false); mx_ = fmaxf(__uint_as_float(rr_[0]), __uint_as_float(rr_[1])); }     \
      const float dl_ = fmaxf(mx_ - PSH, 0.f); al = __builtin_amdgcn_exp2f(-dl_); raised_ = true; \
      _Pragma("unroll") for (int r = 0; r < 16; ++r) { P0[r] -= dl_; P1[r] -= dl_; negm[r] -= dl_; } } } while (0)
#define EXPS(P, ra, rb) do { asm volatile("" : "+v"(P)); _Pragma("unroll") for (int r = (ra); r < (rb); ++r) P[r] = __builtin_amdgcn_exp2f(P[r]); asm volatile("" : "+v"(P)); } while (0)
#define MPIN(acc) asm volatile("" : "+v"(acc))
#define STEP(BKN, BVC, BW, BKP, DO_QK, DO_WR, DO_LD, DO_KP, tt) do { \
    v8i32 kf[2], vf[3]; float mx_ = 0.f, m0_ = 0.f; bool raised_ = false; \
    SBAR(); \
    if (DO_QK && NG > 2) { kf[0] = KFR(2, (BKN) * SHM_K); kf[1] = KFR(3, (BKN) * SHM_K); } \
    _Pragma("unroll") for (int g = 0; g < NG; ++g) { \
      if (DO_QK && !V_NOQK) { if (g == 0) { P0 = MFMA8(kpf0, qf[0], negm); MPIN(P0); } else if (g == 1) { P1 = MFMA8(kpf1, qf[0], negm); MPIN(P1); } \
        else if ((g & 1) == 0) { P0 = MFMA8(kf[g & 1], qf[g >> 1], P0); MPIN(P0); } else { P1 = MFMA8(kf[g & 1], qf[g >> 1], P1); MPIN(P1); } } \
      SBAR(); \
      if (g == 0 && !V_NOPACK) { PACK1(); }                            \
      if (DO_QK && NG == 2 && g == 1 && !V_NOMAX) { MAX0(); } \
      if (DO_QK && g >= 2 && g + 2 < NG) kf[g & 1] = KFR(g + 2, (BKN) * SHM_K); \
      if (g == NG - 2) vf[0] = VFR(0, (BVC) * SHM_V); if (g == NG - 1) vf[1] = VFR(1, (BVC) * SHM_V); \
      SBAR(); } \
      \
    if (!V_NOPV) { o[0] = MFMA8(pf, vf[0], o[0]); MPIN(o[0]); } SBAR(); if (DO_WR && !V_NOSTG) { SWRITE(BW); } if (DO_LD && !V_NOSTG) { SLOAD(((tt) + 4) * 64); } vf[2] = VFR(2, (BVC) * SHM_V); al = 1.f; \
    if (DO_QK && !V_NOMAX) { if (NG == 2) { MAXFIN(); } else { MAX0(); } } SBAR(); \
      \
    if (!V_NOPV) { o[1] = MFMA8(pf, vf[1], o[1]); MPIN(o[1]); } SBAR(); vf[0] = VFR(3, (BVC) * SHM_V); \
    if (DO_QK && NG == 2 && !V_NOEXP) { EXPS(P0, 0, 8); } if (DO_QK && NG != 2 && !V_NOMAX) { MAXFIN(); } SBAR(); \
    if (STG && grpB && !V_NOBAR) { __syncthreads(); } SBAR();   \
      \
    if (!V_NOPV) { o[2] = MFMA8(pf, vf[2], o[2]); MPIN(o[2]); } SBAR(); if (DO_QK && !V_NOEXP) { if (NG == 2) { EXPS(P0, 8, 16); } else { EXPS(P0, 0, 11); } } SBAR(); \
    if (!V_NOPV) { o[3] = MFMA8(pf, vf[0], o[3]); MPIN(o[3]); } SBAR(); if (DO_QK && !V_NOEXP) { if (NG == 2) { EXPS(P1, 0, 8); } else { EXPS(P0, 11, 16); EXPS(P1, 0, 6); } } \
    if (DO_KP) { kpf0 = KFR(0, (BKP) * SHM_K); kpf1 = KFR(1, (BKP) * SHM_K); } SBAR(); \
    if (!V_NOPV) { ol = MFMA8(pf, ones8, ol); MPIN(ol); } SBAR(); if (DO_QK && !V_NOEXP) { if (NG == 2) { EXPS(P1, 8, 16); } else { EXPS(P1, 6, 16); } } SBAR(); \
    if (DO_QK) { if (!V_NOPACK) { PACK0(); } RESC(al); } \
    if (!V_NOBAR && !(STG && grpB)) __syncthreads(); } while (0)
  __syncthreads();
  SLOAD(0); SWRITE(0); SLOAD(64); SWRITE(1); SLOAD(128); SWRITE(2); SLOAD(192); __syncthreads();
#pragma unroll
  for (int r = 0; r < 16; ++r) negm[r] = 0.f;
#pragma unroll
  for (int c = 0; c < NKC; ++c) { const v8i32 k0_ = KFR(2 * c, 0), k1_ = KFR(2 * c + 1, 0);
    if (c == 0) { P0 = MFMA8(k0_, qf[c], negm); P1 = MFMA8(k1_, qf[c], negm); } else { P0 = MFMA8(k0_, qf[c], P0); P1 = MFMA8(k1_, qf[c], P1); } }
  { float mx_ = P0[0];
#pragma unroll
    for (int r = 1; r < 16; ++r) mx_ = fmaxf(mx_, P0[r]);
#pragma unroll
    for (int r = 0; r < 16; ++r) mx_ = fmaxf(mx_, P1[r]);
    { auto rr_ = __builtin_amdgcn_permlane32_swap(__float_as_uint(mx_), __float_as_uint(mx_), false, false); mx_ = fmaxf(__uint_as_float(rr_[0]), __uint_as_float(rr_[1])); }
#pragma unroll
    for (int r = 0; r < 16; ++r) { P0[r] = __builtin_amdgcn_exp2f(P0[r] - mx_ + PSH); P1[r] = __builtin_amdgcn_exp2f(P1[r] - mx_ + PSH); negm[r] = PSH - mx_; } }
  PACKP();
  kpf0 = KFR(0, 1 * SHM_K); kpf1 = KFR(1, 1 * SHM_K);
  int t = 0;
  WConv wcv; int wc_it = wc_base + __builtin_amdgcn_readfirstlane(wid);
  for (; t + 7 < NT; t += 4) {
    STEP(1, 0, 3, 2, true, true, true, true, t);
    if constexpr (WC) wconv_load(*pp, wc_it, lane, wcv);
    STEP(2, 1, 0, 3, true, true, true, true, t + 1);
    STEP(3, 2, 1, 0, true, true, true, true, t + 2);
    if constexpr (WC) { wconv_store(*pp, wc_it, lane, wcv); wc_it += (int)gridDim.x * 8; }
    STEP(0, 3, 2, 1, true, true, true, true, t + 3);
  }
  STEP(1, 0, 3, 2, true, true, false, true, t);
  STEP(2, 1, 0, 3, true, false, false, true, t + 1);
  STEP(3, 2, 1, 0, true, false, false, false, t + 2);
  STEP(0, 3, 2, 1, false, false, false, false, t + 3);
  float rli[16];
#pragma unroll
  for (int r = 0; r < 16; ++r) rli[r] = __builtin_amdgcn_rcpf(ol[r]);
  if constexpr (OM == 1) {
    unsigned* st = (unsigned*)stash + tid;
#pragma unroll
    for (int r = 0; r < 16; ++r) { st[(2 * r) * 512] = cvt_pk_bf16(o[0][r] * rli[r], o[1][r] * rli[r]); st[(2 * r + 1) * 512] = cvt_pk_bf16(o[2][r] * rli[r], o[3][r] * rli[r]); }
  } else if constexpr (OM == 2) {
    const unsigned* st = (const unsigned*)stash + tid;
    float sw[4];
#pragma unroll
    for (int d0 = 0; d0 < 4; ++d0) sw[d0] = subw[d0 * 32 + r32] * 0.8f;
    bf16_t* Ow = Ob + (long)(wid * 32) * ldo;
#pragma unroll
    for (int r = 0; r < 16; ++r) { const unsigned w01 = st[(2 * r) * 512], w23 = st[(2 * r + 1) * 512];
      const float d0v = bflo(w01) - lam * (o[0][r] * rli[r]), d1v = bfhi(w01) - lam * (o[1][r] * rli[r]), d2v = bflo(w23) - lam * (o[2][r] * rli[r]), d3v = bfhi(w23) - lam * (o[3][r] * rli[r]);
      float ss = (d0v * d0v + d1v * d1v) + (d2v * d2v + d3v * d3v);
      ss += __shfl_xor(ss, 1); ss += __shfl_xor(ss, 2); ss += __shfl_xor(ss, 4); ss += __shfl_xor(ss, 8); ss += __shfl_xor(ss, 16);
      const float rn = rsqrtf(ss * (1.f / 128.f) + EPS); const long ob = (long)crow(r, hi) * ldo + r32;
      Ow[ob] = f2bf(SQ6(d0v * rn * sw[0])); Ow[ob + 32] = f2bf(SQ6(d1v * rn * sw[1])); Ow[ob + 64] = f2bf(SQ6(d2v * rn * sw[2])); Ow[ob + 96] = f2bf(SQ6(d3v * rn * sw[3])); }
  } else {
    bf16_t* Ow = Ob + (long)(wid * 32) * ldo;
#pragma unroll
    for (int r = 0; r < 16; ++r) { const int orow = crow(r, hi);
#pragma unroll
      for (int d0 = 0; d0 < 4; ++d0) Ow[(long)orow * ldo + d0 * 32 + r32] = f2bf(SQ6(o[d0][r] * rli[r] * 32.f) * (1.f / 32.f)); }
  }
#undef BL16
#undef SLOAD
#undef SWRITE
#undef RESC
#undef KFR
#undef VFR
#undef LDP
#undef STEP
#undef PACKP
#undef MPIN
#undef PACK0
#undef PACK1
#undef MAX0
#undef MAXFIN
#undef EXPS
}
#undef OFF8
#undef SBAR
#undef MFMA8
#undef LD32
}
#ifdef HW_XCD_MAP
__device__ __forceinline__ int att_cc(const Params& p, const char* lds, int u) {
    const volatile unsigned* bst = (const volatile unsigned*)(lds + 160 * 1024 - 512); const unsigned* cnt = (const unsigned*)(p.ws + WS_BAR) + 3500;
    bool ok = gridDim.x == 256;
#pragma unroll
    for (int i = 0; i < 8; ++i) ok = ok && (__hip_atomic_load(cnt + i, __ATOMIC_RELAXED, __HIP_MEMORY_SCOPE_AGENT) == 32u);
    return ok ? (int)(bst[2] + 8u * bst[3]) : -1;
}
#define ATT_CC(u) (hwcc_ >= 0 ? hwcc_ : ((u) & 255))
#else
#define ATT_CC(u) ((u) & 255)
#endif
#ifdef HW_XCD_MAP
#define ATT_CC_INIT const int hwcc_ = __builtin_amdgcn_readfirstlane(att_cc(p, lds, 0));
#else
#define ATT_CC_INIT
#endif
__device__ __forceinline__ void p4_attention_diff(const Params& p, char* lds) {
    unsigned char* ws = p.ws;
    const bf16_t* PJ = (const bf16_t*)(ws + WS_PJ); bf16_t* MIX = (bf16_t*)(ws + WS_MIX);
    char* stash = lds + 80 * 1024;
    ATT_CC_INIT
#if ATT_FP8 && WCONV_IN_ATT
    const int wcoff = gridDim.x == 256 ? 0 : attn8::WCONV_ITEMS;
    if (gridDim.x != 256) { const int tid_ = tid_opaque(), lane_ = tid_ & 63, gw_ = blockIdx.x * NWAVES + (tid_ >> 6), NGW_ = gridDim.x * NWAVES;
        for (int it = gw_; it < attn8::WCONV_ITEMS; it += NGW_) { attn8::WConv w_; attn8::wconv_load(p, it, lane_, w_); attn8::wconv_store(p, it, lane_, w_); } }
#else
    const int wcoff = 0;
#endif
    for (int u = blockIdx.x; u < 512 + ATT_EXTRA; u += gridDim.x) {
        const int round = (u >> 8) & 1, cc = ATT_CC(u), x = ATT_X(cc), j = ATT_J(cc);
        const int pd = x * 2 + round, b = pd >> 2, h = pd & 3;
        const size_t krow0 = (size_t)b * RPB, qrow0 = krow0 + CTX + (size_t)j * 256;
#if ATT_EXTRA
        if (u >= 512) { const unsigned char* vtx_ = ws + WS_VT8D + (size_t)(b * 4 + h) * 128 * RPB;
            attn8::attn_unit<1, 0, ATT_VAR>(ws + WS_Q8D + qrow0 * 512 + (2 * h) * 64, 512, ws + WS_K8D + krow0 * 512 + (2 * h) * 64, 512, nullptr, 0, nullptr, 0, vtx_, (bf16_t*)(ws + WS_AO) + qrow0 * 128, 128, RPB, lds);
            attn8::attn_unit<1, 0, ATT_VAR>(ws + WS_Q8D + qrow0 * 512 + (2 * h + 1) * 64, 512, ws + WS_K8D + krow0 * 512 + (2 * h + 1) * 64, 512, nullptr, 0, nullptr, 0, vtx_, (bf16_t*)(ws + WS_AO) + qrow0 * 128, 128, RPB, lds);
            continue; }
#endif
#if ATT_FP8
        const unsigned char* vt_ = ws + WS_VT8D + (size_t)(b * 4 + h) * 128 * RPB;
        const int wcb0 = wcoff + ((u / (int)gridDim.x) * 2 + 0) * 32 * (int)gridDim.x * 8 + (int)blockIdx.x * 8, wcb1 = wcb0 + 32 * (int)gridDim.x * 8;
        if (u < (int)gridDim.x) attn8::attn_unit<1, 1, 0, WCONV_IN_ATT != 0>(ws + WS_Q8D + qrow0 * 512 + (2 * h) * 64, 512, ws + WS_K8D + krow0 * 512 + (2 * h) * 64, 512, nullptr, 0, nullptr, 0, vt_, nullptr, 0, RPB, lds, stash, 0.f, nullptr, &p, wcoff + 131072 + (int)blockIdx.x * 8);
        else attn8::attn_unit<1, 1, 0, false>(ws + WS_Q8D + qrow0 * 512 + (2 * h) * 64, 512, ws + WS_K8D + krow0 * 512 + (2 * h) * 64, 512, nullptr, 0, nullptr, 0, vt_, nullptr, 0, RPB, lds, stash);
#else
        attn::attn_unit<1, 1, 0, 1>(PJ + qrow0 * NPROJ + (2 * h) * 64, NPROJ, PJ + krow0 * NPROJ + 512 + (2 * h) * 64, NPROJ, nullptr, 0, nullptr, 0,
                              PJ + krow0 * NPROJ + 1024 + h * 128, NPROJ, nullptr, 0, RPB, 1.f, lds, stash);
#endif
        const int lane_ = tid_opaque() & 63;
        const float s1 = wave_sum(p.lq1[lane_] * p.lk1[lane_]), s2 = wave_sum(p.lq2[lane_] * p.lk2[lane_]);
        const float lam = __expf(s1) - __expf(s2) + 0.2f;
#if ATT_FP8
        attn8::attn_unit<1, 2, 0, false>(ws + WS_Q8D + qrow0 * 512 + (2 * h + 1) * 64, 512, ws + WS_K8D + krow0 * 512 + (2 * h + 1) * 64, 512, nullptr, 0, nullptr, 0, vt_, MIX + qrow0 * 1024 + h * 128, 1024, RPB, lds, stash, lam, p.subln_w, &p, wcb1);
#else
        attn::attn_unit<1, 1, 0, 2>(PJ + qrow0 * NPROJ + (2 * h + 1) * 64, NPROJ, PJ + krow0 * NPROJ + 512 + (2 * h + 1) * 64, NPROJ, nullptr, 0, nullptr, 0,
                              PJ + krow0 * NPROJ + 1024 + h * 128, NPROJ, MIX + qrow0 * 1024 + h * 128, 1024, RPB, 1.f, lds, stash, lam, p.subln_w);
#endif
    }
}
__device__ __forceinline__ void p4_attention_mla(const Params& p, char* lds) {
    unsigned char* ws = p.ws;
    const bf16_t* PJ = (const bf16_t*)(ws + WS_PJ); const bf16_t* QM = (const bf16_t*)(ws + WS_QM); const bf16_t* KVb = (const bf16_t*)(ws + WS_KV);
    bf16_t* MIX = (bf16_t*)(ws + WS_MIX);
    constexpr float LOG2E = 1.4426950408889634f;
    ATT_CC_INIT
    for (int u = blockIdx.x; u < 512; u += gridDim.x) {
        const int round = u >> 8, cc = ATT_CC(u), x = ATT_X(cc), j = ATT_J(cc);
        const int pd = x * 2 + round, b = pd >> 2, h = pd & 3;
        const size_t krow0 = (size_t)b * RPB, qrow0 = krow0 + CTX + (size_t)j * 256;
#if ATT_FP8
        const int wcb = (gridDim.x == 256 ? 0 : attn8::WCONV_ITEMS) + (u / (int)gridDim.x) * 32 * (int)gridDim.x * 8 + (int)blockIdx.x * 8;
        attn8::attn_unit<3, 0, 0, WCONV_IN_ATT != 0>(ws + WS_Q8M + qrow0 * 768 + h * 192, 768, ws + WS_K8M + krow0 * 512 + h * 128, 512, ws + WS_K8M + krow0 * 512 + h * 128 + 64, 512, ws + WS_KR8 + krow0 * 64, 64,
                               ws + WS_VT8M + (size_t)(b * 4 + h) * 128 * RPB, MIX + qrow0 * 1024 + 512 + h * 128, 1024, RPB, lds, nullptr, 0.f, nullptr, &p, wcb);
#else
        attn::attn_unit<3, MLA_NQR>(QM + qrow0 * 768 + h * 192, 768, KVb + krow0 * 1024 + h * 256, 1024, KVb + krow0 * 1024 + h * 256 + 64, 1024, PJ + krow0 * NPROJ + 1920, NPROJ,
                              KVb + krow0 * 1024 + h * 256 + 128, 1024, MIX + qrow0 * 1024 + 512 + h * 128, 1024, RPB, 0.07216878364870322f * LOG2E, lds);
#endif
    }
}

__device__ __forceinline__ void p5_mix(const Params& p) {
    const int tid = tid_opaque(), lane = tid & 63, wave = tid >> 6;
    const int gw = blockIdx.x * NWAVES + wave, NGW = gridDim.x * NWAVES;
    const bf16_t* AO = (const bf16_t*)(p.ws + WS_AO); bf16_t* MIX = (bf16_t*)(p.ws + WS_MIX);
    const float s1 = wave_sum(p.lq1[lane] * p.lk1[lane]), s2 = wave_sum(p.lq2[lane] * p.lk2[lane]);
    const float lam_init = 0.2f, lam = __expf(s1) - __expf(s2) + lam_init;
    const int hh = lane >> 4, e0 = (lane & 15) * 8;
    float sw[8];
#pragma unroll
    for (int i = 0; i < 8; ++i) sw[i] = p.subln_w[e0 + i] * (1.f - lam_init);
    for (int t = gw; t < T; t += NGW) {
        const int b = t >> 13, row = b * RPB + CTX + (t & 8191);
        const bf16_t* src = AO + (size_t)row * 1536;
        const u32x4 a = *(const u32x4*)(src + hh * 256 + e0), bq = *(const u32x4*)(src + hh * 256 + 128 + e0), mq = *(const u32x4*)(src + 1024 + lane * 8);
        float o[8];
        o[0] = bflo(a.x) - lam * bflo(bq.x); o[1] = bfhi(a.x) - lam * bfhi(bq.x); o[2] = bflo(a.y) - lam * bflo(bq.y); o[3] = bfhi(a.y) - lam * bfhi(bq.y);
        o[4] = bflo(a.z) - lam * bflo(bq.z); o[5] = bfhi(a.z) - lam * bfhi(bq.z); o[6] = bflo(a.w) - lam * bflo(bq.w); o[7] = bfhi(a.w) - lam * bfhi(bq.w);
        float ss = 0.f;
#pragma unroll
        for (int i = 0; i < 8; ++i) ss += o[i] * o[i];
        ss += __shfl_xor(ss, 1); ss += __shfl_xor(ss, 2); ss += __shfl_xor(ss, 4); ss += __shfl_xor(ss, 8);
        const float r = rsqrtf(ss * (1.f / 128.f) + EPS);
        u32x4 w; w.x = cvt_pk_bf16(o[0] * r * sw[0], o[1] * r * sw[1]); w.y = cvt_pk_bf16(o[2] * r * sw[2], o[3] * r * sw[3]);
        w.z = cvt_pk_bf16(o[4] * r * sw[4], o[5] * r * sw[5]); w.w = cvt_pk_bf16(o[6] * r * sw[6], o[7] * r * sw[7]);
        bf16_t* dst = MIX + (size_t)row * 1024;
        *(u32x4*)(dst + hh * 128 + e0) = w; *(u32x4*)(dst + 512 + lane * 8) = mq;
    }
}

typedef short bf16x8_t __attribute__((ext_vector_type(8)));
__device__ __forceinline__ void p7a_route(const Params& p, unsigned char* lds) {
    const int tid = tid_opaque(), lane = tid & 63, wave = tid >> 6, row = lane & 15, kq = lane >> 4;
    int* lcnt = (int*)(lds + 147456); int* lbase = lcnt + 32; int* tok_e = lbase + 32; int* tok_r = tok_e + 1024;
    for (int i = tid; i < 8192; i += NTHREADS) ((u32x4*)lds)[i] = ((const u32x4*)(p.ws + WS_RWF))[i];
    if (tid < 32) lcnt[tid] = 0;
    const int chunk = (T + gridDim.x - 1) / gridDim.x;
    const int t0 = blockIdx.x * chunk, t1 = (t0 + chunk < T) ? t0 + chunk : T;
    float* vab = (float*)(lds + 131072); const int b0 = t0 >> 13;
    { const float* mods_ = (const float*)(p.ws + WS_MODS);
      for (int i = tid; i < 2048; i += NTHREADS) { const int bb = min(b0 + (i >> 10), NB - 1), k = i & 1023; const float* md_ = mods_ + bb * 6144;
          vab[(i >> 10) * 2048 + k] = p.ffn_norm_w[k] * (md_[4 * 1024 + k] + 1.f); vab[(i >> 10) * 2048 + 1024 + k] = md_[3 * 1024 + k]; } }
    __syncthreads();
    const bf16_t* XN = (const bf16_t*)(p.ws + WS_XN); const float* mods = (const float*)(p.ws + WS_MODS);
    unsigned char* HF = p.ws + WS_HF;
    int* TOPI = (int*)(p.ws + WS_TOPI); float* GATE = (float*)(p.ws + WS_GATE); int* RANK = (int*)(p.ws + WS_RANK); int* CNT = (int*)(p.ws + WS_CNT);
    const u32x4* rwf = (const u32x4*)lds + lane;
    for (int tb = t0 + 16 * wave; tb < t1; tb += 16 * NWAVES) {
        const int t = tb + row, b = tb >> 13; const float* md = mods + b * 6144;
        const bf16_t* xr = XN + (size_t)t * DM + 8 * kq;
        const float r = rsqrtf(((const float*)(p.ws + WS_RSX))[t] * (1.f / DM) + EPS);
        f32x4 acc0 = {0.f, 0.f, 0.f, 0.f}, acc1 = {0.f, 0.f, 0.f, 0.f};
        const float* va = vab + ((tb >> 13) - b0) * 2048 + 8 * kq; const float* vb = va + 1024;
        u32x4 xq[4];
#pragma unroll
        for (int j = 0; j < 4; ++j) xq[j] = *(const u32x4*)(xr + 32 * j);
#pragma unroll 4
        for (int s = 0; s < 32; ++s) { const int k0 = 32 * s + 8 * kq;
            const u32x4 xw = xq[s & 3]; if (s + 4 < 32) xq[s & 3] = *(const u32x4*)(xr + 32 * (s + 4));
            const f32x4 xa = {bflo(xw.x), bfhi(xw.x), bflo(xw.y), bfhi(xw.y)}, xc = {bflo(xw.z), bfhi(xw.z), bflo(xw.w), bfhi(xw.w)};
            const f32x4 ha = xa * r * *(const f32x4*)(va + 32 * s) + *(const f32x4*)(vb + 32 * s), hc = xc * r * *(const f32x4*)(va + 32 * s + 4) + *(const f32x4*)(vb + 32 * s + 4);
            u32x4 hi, lo;
            hi.x = cvt_pk_bf16(ha.x, ha.y); hi.y = cvt_pk_bf16(ha.z, ha.w); hi.z = cvt_pk_bf16(hc.x, hc.y); hi.w = cvt_pk_bf16(hc.z, hc.w);
            lo.x = cvt_pk_bf16(ha.x - bflo(hi.x), ha.y - bfhi(hi.x)); lo.y = cvt_pk_bf16(ha.z - bflo(hi.y), ha.w - bfhi(hi.y));
            lo.z = cvt_pk_bf16(hc.x - bflo(hi.z), hc.y - bfhi(hi.z)); lo.w = cvt_pk_bf16(hc.z - bflo(hi.w), hc.w - bfhi(hi.w));
            { u32x2 h8; h8.x = cvt4_fp8(ha.x, ha.y, ha.z, ha.w); h8.y = cvt4_fp8(hc.x, hc.y, hc.z, hc.w); *(u32x2*)(HF + (size_t)t * DM + k0) = h8; }
            const bf16x8_t Ah = __builtin_bit_cast(bf16x8_t, hi), Al = __builtin_bit_cast(bf16x8_t, lo);
            const bf16x8_t Bh0 = __builtin_bit_cast(bf16x8_t, rwf[(s * 4 + 0) * 64]), Bl0 = __builtin_bit_cast(bf16x8_t, rwf[(s * 4 + 1) * 64]);
            const bf16x8_t Bh1 = __builtin_bit_cast(bf16x8_t, rwf[(s * 4 + 2) * 64]), Bl1 = __builtin_bit_cast(bf16x8_t, rwf[(s * 4 + 3) * 64]);
            acc0 = __builtin_amdgcn_mfma_f32_16x16x32_bf16(Ah, Bh0, acc0, 0, 0, 0); acc0 = __builtin_amdgcn_mfma_f32_16x16x32_bf16(Ah, Bl0, acc0, 0, 0, 0); acc0 = __builtin_amdgcn_mfma_f32_16x16x32_bf16(Al, Bh0, acc0, 0, 0, 0);
            acc1 = __builtin_amdgcn_mfma_f32_16x16x32_bf16(Ah, Bh1, acc1, 0, 0, 0); acc1 = __builtin_amdgcn_mfma_f32_16x16x32_bf16(Ah, Bl1, acc1, 0, 0, 0); acc1 = __builtin_amdgcn_mfma_f32_16x16x32_bf16(Al, Bh1, acc1, 0, 0, 0); }
        const float rb0 = p.router_b[row], rb1 = p.router_b[16 + row];
#pragma unroll
        for (int reg = 0; reg < 4; ++reg) { float v0 = acc0[reg] + rb0, v1 = acc1[reg] + rb1; float tv[4]; int ti[4];
#pragma unroll
            for (int k = 0; k < 4; ++k) { float m = fmaxf(v0, v1);
                m = fmaxf(m, __shfl_xor(m, 1)); m = fmaxf(m, __shfl_xor(m, 2)); m = fmaxf(m, __shfl_xor(m, 4)); m = fmaxf(m, __shfl_xor(m, 8));
                int cand = (v0 == m) ? row : ((v1 == m) ? 16 + row : 99);
                cand = min(cand, __shfl_xor(cand, 1)); cand = min(cand, __shfl_xor(cand, 2)); cand = min(cand, __shfl_xor(cand, 4)); cand = min(cand, __shfl_xor(cand, 8));
                tv[k] = m; ti[k] = cand; if (cand == row) v0 = -INFINITY; if (cand == 16 + row) v1 = -INFINITY; }
            const float e1 = __expf(tv[1] - tv[0]), e2 = __expf(tv[2] - tv[0]), e3 = __expf(tv[3] - tv[0]); const float inv = 1.f / (1.f + e1 + e2 + e3);
            const int tt = tb + 4 * kq + reg;
            if (row < 4 && tt < t1) { const int ei = row == 0 ? ti[0] : row == 1 ? ti[1] : row == 2 ? ti[2] : ti[3]; const float gv = (row == 0 ? 1.f : row == 1 ? e1 : row == 2 ? e2 : e3) * inv;
                const int lr = atomicAdd(&lcnt[ei], 1);
                TOPI[tt * 4 + row] = ei; GATE[tt * 4 + row] = gv; tok_e[(tt - t0) * 4 + row] = ei; tok_r[(tt - t0) * 4 + row] = lr; } }
    }
    __syncthreads();
    if (tid < 32) lbase[tid] = atomicAdd(&CNT[tid], lcnt[tid]);
    __syncthreads();
    for (int i = tid; i < (t1 - t0) * 4; i += NTHREADS) RANK[t0 * 4 + i] = lbase[tok_e[i]] + tok_r[i];
}

__device__ __forceinline__ void moe_segments(const Params& p, int* seg) {
    if (threadIdx.x == 0) { const int* CNT = (const int*)(p.ws + WS_CNT); int s = 0;
        for (int e = 0; e < 32; ++e) { seg[e] = s; s += (CNT[e] + 255) & ~255; } seg[32] = s; }
    __syncthreads();
}
__device__ __forceinline__ void p7b_scatter(const Params& p, const int* seg) {
    const int tid = tid_opaque();
    const int gt = blockIdx.x * NTHREADS + tid, NGT = gridDim.x * NTHREADS;
    const int* TOPI = (const int*)(p.ws + WS_TOPI); const float* GATE = (const float*)(p.ws + WS_GATE); const int* RANK = (const int*)(p.ws + WS_RANK);
    int* DEST = (int*)(p.ws + WS_DEST); float* GS = (float*)(p.ws + WS_GSRT); int* RTOK = (int*)(p.ws + WS_RTOK);
    for (int i = gt; i < T * 4; i += NGT) { const int dest = seg[TOPI[i]] + RANK[i]; DEST[i] = dest; GS[dest] = GATE[i]; RTOK[dest] = i >> 2; }
}
__device__ __forceinline__ void p10_final(const Params& p, const bool with_moe) {
    const int tid = tid_opaque(), lane = tid & 63, wave = tid >> 6;
    const int gw = blockIdx.x * NWAVES + wave, NGW = gridDim.x * NWAVES;
    const bf16_t* XN = (const bf16_t*)(p.ws + WS_XN); const float* mods = (const float*)(p.ws + WS_MODS);
    const int* DEST = (const int*)(p.ws + WS_DEST);
    const f32x4* w4 = (const f32x4*)p.final_norm_w;
    for (int tb = gw; tb < T; tb += P10_NT * NGW) {
        int tt[P10_NT]; bool ok[P10_NT]; u32x2 xw[P10_NT][4];
#if YS_FP8
        unsigned yw[P10_NT][4][4];
#else
        u32x2 yw[P10_NT][4][4];
#endif
#pragma unroll
        for (int q = 0; q < P10_NT; ++q) { const int t_ = tb + q * NGW; ok[q] = t_ < T; tt[q] = ok[q] ? t_ : tb; }
#pragma unroll
        for (int q = 0; q < P10_NT; ++q) { const u32x2* xr = (const u32x2*)(XN + (size_t)tt[q] * DM);
#pragma unroll
            for (int j = 0; j < 4; ++j) xw[q][j] = xr[64 * j + lane];
            if (with_moe) {
#pragma unroll
                for (int k = 0; k < 4; ++k) { const int d = DEST[tt[q] * 4 + k];
#if YS_FP8
                    const unsigned* yr = (const unsigned*)(p.ws + WS_XS + (size_t)d * 1024);
#else
                    const u32x2* yr = (const u32x2*)(p.ws + WS_XS + (size_t)d * 2048);
#endif
#pragma unroll
                    for (int j = 0; j < 4; ++j) yw[q][k][j] = yr[64 * j + lane]; } } }
#pragma unroll
        for (int q = 0; q < P10_NT; ++q) { const int t = tt[q], b = t >> 13; const f32x4* g4 = (const f32x4*)(mods + b * 6144 + 5 * 1024);
            f32x4 xv[4];
#pragma unroll
            for (int j = 0; j < 4; ++j) { xv[j] = (f32x4){bflo(xw[q][j].x), bfhi(xw[q][j].x), bflo(xw[q][j].y), bfhi(xw[q][j].y)};
                if (with_moe) { f32x4 y = {0.f, 0.f, 0.f, 0.f};
#pragma unroll
                    for (int k = 0; k < 4; ++k) {
#if YS_FP8
                        const int w_ = (int)yw[q][k][j]; const auto lo_ = __builtin_amdgcn_cvt_pk_f32_fp8(w_, false), hi_ = __builtin_amdgcn_cvt_pk_f32_fp8(w_, true);
                        y += (f32x4){lo_[0], lo_[1], hi_[0], hi_[1]};
#else
                        const u32x2 w_ = yw[q][k][j]; y += (f32x4){bflo(w_.x), bfhi(w_.x), bflo(w_.y), bfhi(w_.y)};
#endif
                    }
                    xv[j] += g4[64 * j + lane] * y * (YS_FP8 ? 1.f / YS_SCALE : 1.f); } }
            float s = 0.f;
#pragma unroll
            for (int j = 0; j < 4; ++j) s += (xv[j].x * xv[j].x + xv[j].y * xv[j].y) + (xv[j].z * xv[j].z + xv[j].w * xv[j].w);
            float r = rsqrtf(wave_sum(s) * (1.f / DM) + EPS);
#if DBG_STAGE
            r *= 1.f + 10.f * fminf(__uint_as_float(((const unsigned*)(p.ws + WS_CNT))[64]), 100.f);
#endif
            if (ok[q]) { f32x4* o = (f32x4*)(p.out + (size_t)t * DM);
#pragma unroll
                for (int j = 0; j < 4; ++j) o[64 * j + lane] = xv[j] * r * w4[64 * j + lane]; }
        }
    }
}
#if DBG_STAGE
__device__ __forceinline__ void dbg_report(const Params& p, float err) {
    if (!(err >= 0.f)) err = 1e6f;
    atomicMax((unsigned*)(p.ws + WS_CNT) + 64, __float_as_uint(err));
}
__device__ __forceinline__ void dbg_rope(float& x1, float& x2, int pv, int pp) {
    const float inv = exp2f(-(float)pp * (13.287712379549449f / 16.f)); float sn, cs; sincosf((float)pv * inv, &sn, &cs);
    const float a = x1 * cs - x2 * sn, b = x2 * cs + x1 * sn; x1 = a; x2 = b;
}
__device__ __forceinline__ void dbg_check_proj(const Params& p) {
    const int gt = blockIdx.x * NTHREADS + threadIdx.x, NGT = gridDim.x * NTHREADS;
    const bf16_t* HB = (const bf16_t*)(p.ws + WS_HB); const bf16_t* PJ = (const bf16_t*)(p.ws + WS_PJ); const bf16_t* QM = (const bf16_t*)(p.ws + WS_QM); const bf16_t* KVb = (const bf16_t*)(p.ws + WS_KV);
    float emax = 0.f;
    for (int it = gt; it < 24 * 224; it += NGT) { const int rs = it / 224, cpi = it % 224; const int row = rs < 6 ? (rs & 3) * RPB + (rs * 37) % CTX : (rs * 1409 + 77) % MALL; const int grp = cpi >> 4, pp = cpi & 15, c0 = 1536 + grp * 32 + pp, c1 = c0 + 16;
        float a0 = 0.f, a1 = 0.f;
        for (int k = 0; k < 1024; ++k) { const float h = bf2f(HB[(size_t)row * 1024 + k]); a0 += h * bf2f(f2bf(p.w_in[(size_t)k * 1984 + c0])); a1 += h * bf2f(f2bf(p.w_in[(size_t)k * 1984 + c1])); }
        const int i = row % RPB; if (i >= CTX && c0 >= 1920) { const int pos = i - CTX, a = (c0 >> 5) & 1; dbg_rope(a0, a1, a ? (pos & 63) : (pos >> 6), pp); }
        const float f0 = bf2f(PJ[(size_t)row * NPROJ + c0]), f1 = bf2f(PJ[(size_t)row * NPROJ + c1]);
        emax = fmaxf(emax, fmaxf(fabsf(f0 - a0), fabsf(f1 - a1))); }
    for (int it = gt; it < 24 * 384; it += NGT) { const int rs = it / 384, cpi = it % 384; const int row = rs < 6 ? (rs & 3) * RPB + (rs * 41) % CTX : (rs * 1409 + 300) % MALL; const int grp = cpi >> 4, pp = cpi & 15, c0 = grp * 32 + pp, c1 = c0 + 16;
        float ss = 0.f, a0 = 0.f, a1 = 0.f;
        for (int k = 0; k < 256; ++k) { const float v = bf2f(PJ[(size_t)row * NPROJ + 1536 + k]); ss += v * v; const float vw = v * p.q_norm_w[k]; a0 += vw * p.w_uq[(size_t)k * 768 + c0]; a1 += vw * p.w_uq[(size_t)k * 768 + c1]; }
        const float r = rsqrtf(ss / 256.f + EPS); a0 *= r; a1 *= r;
        const int i = row % RPB, g6 = grp % 6; if (i >= CTX && g6 >= 4) { const int pos = i - CTX; dbg_rope(a0, a1, g6 == 5 ? (pos & 63) : (pos >> 6), pp); }
        const float f0 = bf2f(QM[(size_t)row * 768 + c0]), f1 = bf2f(QM[(size_t)row * 768 + c1]);
        emax = fmaxf(emax, fmaxf(fabsf(f0 - a0), fabsf(f1 - a1))); }
    for (int it = gt; it < 24 * 1024; it += NGT) { const int rs = it >> 10, c0 = it & 1023; const int row = rs < 6 ? (rs & 3) * RPB + (rs * 43) % CTX : (rs * 1409 + 555) % MALL;
        float ss = 0.f, a0 = 0.f;
        for (int k = 0; k < 128; ++k) { const float v = bf2f(PJ[(size_t)row * NPROJ + 1792 + k]); ss += v * v; a0 += v * p.kv_norm_w[k] * p.w_ukv[(size_t)k * 1024 + c0]; }
        a0 *= rsqrtf(ss / 128.f + EPS);
        emax = fmaxf(emax, fabsf(bf2f(KVb[(size_t)row * 1024 + c0]) - a0)); }
    emax = wave_max(emax);
    if ((threadIdx.x & 63) == 0) dbg_report(p, emax);
}
__device__ __forceinline__ void dbg_check_attn(const Params& p, unsigned char* lds, int kind_sel) {
    const int tid = threadIdx.x;
    const bf16_t* PJ = (const bf16_t*)(p.ws + WS_PJ); const bf16_t* QM = (const bf16_t*)(p.ws + WS_QM); const bf16_t* KVb = (const bf16_t*)(p.ws + WS_KV); const bf16_t* AO = (const bf16_t*)(p.ws + WS_MIX);
    float* sc = (float*)lds; float* red = sc + 8448; float* qv = red + 1024;
    for (int s = blockIdx.x; s < 128; s += gridDim.x) {
        const int kind = s & 1; if (kind_sel >= 0 && kind != kind_sel) continue;
        const int b = (s >> 1) & 3, hh = (s >> 3) & 7, qpos = ((s >> 1) * 2731 + 13) & 8191;
        const size_t krow0 = (size_t)b * RPB, qrow = krow0 + CTX + qpos;
        const int dqk = kind ? 192 : 64; const int h = kind ? (hh & 3) : hh;
#if ATT_FP8
        const float scale = 0.6931471805599453f;
        const unsigned char* W8 = p.ws;
#define F8(ptr) __builtin_amdgcn_cvt_f32_fp8((int)(*(const unsigned char*)(ptr)), 0)
        __syncthreads();
        if (tid < dqk) qv[tid] = kind ? F8(W8 + WS_Q8M + qrow * 768 + h * 192 + tid) : F8(W8 + WS_Q8D + qrow * 512 + h * 64 + tid);
        __syncthreads();
        float lmax = -1e30f;
        for (int k = tid; k < RPB; k += NTHREADS) { float a = 0.f;
            if (kind) { for (int d = 0; d < 128; ++d) a += qv[d] * F8(W8 + WS_K8M + (krow0 + k) * 512 + h * 128 + d); for (int d = 0; d < 64; ++d) a += qv[128 + d] * F8(W8 + WS_KR8 + (krow0 + k) * 64 + d); }
            else { for (int d = 0; d < 64; ++d) a += qv[d] * F8(W8 + WS_K8D + (krow0 + k) * 512 + h * 64 + d); }
            a *= scale; sc[k] = a; lmax = fmaxf(lmax, a); }
#else
        const float scale = kind ? 0.07216878364870322f : 0.6931471805599453f;
        __syncthreads();
        if (tid < dqk) qv[tid] = kind ? bf2f(QM[qrow * 768 + h * 192 + tid]) : bf2f(PJ[qrow * NPROJ + h * 64 + tid]);
        __syncthreads();
        float lmax = -1e30f;
        for (int k = tid; k < RPB; k += NTHREADS) { float a = 0.f;
            if (kind) { for (int d = 0; d < 128; ++d) a += qv[d] * bf2f(KVb[(krow0 + k) * 1024 + h * 256 + d]); for (int d = 0; d < 64; ++d) a += qv[128 + d] * bf2f(PJ[(krow0 + k) * NPROJ + 1920 + d]); }
            else { for (int d = 0; d < 64; ++d) a += qv[d] * bf2f(PJ[(krow0 + k) * NPROJ + 512 + h * 64 + d]); }
            a *= scale; sc[k] = a; lmax = fmaxf(lmax, a); }
#endif
        lmax = wave_max(lmax); if ((tid & 63) == 0) red[tid >> 6] = lmax; __syncthreads();
        float m = red[0]; for (int w = 1; w < 8; ++w) m = fmaxf(m, red[w]); __syncthreads();
        float lsum = 0.f; for (int k = tid; k < RPB; k += NTHREADS) { const float e = __expf(sc[k] - m); sc[k] = e; lsum += e; }
        lsum = wave_sum(lsum); if ((tid & 63) == 0) red[tid >> 6] = lsum; __syncthreads();
        float l = 0.f; for (int w = 0; w < 8; ++w) l += red[w]; __syncthreads();
        const int e = tid & 127, part = tid >> 7; float o = 0.f;
#if ATT_FP8
        for (int k = part; k < RPB; k += 4) { const unsigned char* vt = p.ws + (kind ? WS_VT8M : WS_VT8D) + ((size_t)(b * 4 + (kind ? h : (h >> 1))) * 128 + e) * RPB + (k & ~63) + vt_pos(k & 63); o += sc[k] * F8(vt); }
#else
        for (int k = part; k < RPB; k += 4) { const float v = kind ? bf2f(KVb[(krow0 + k) * 1024 + h * 256 + 128 + e]) : bf2f(PJ[(krow0 + k) * NPROJ + 1024 + (h >> 1) * 128 + e]); o += sc[k] * v; }
#endif
        red[tid] = o; __syncthreads();
        if (tid < 128) { const float on = (red[tid] + red[tid + 128] + red[tid + 256] + red[tid + 384]) / l;
            const float of = bf2f(AO[qrow * 1024 + 512 + h * 128 + tid]);
            float d2 = (of - on) * (of - on), n2 = on * on;
            d2 = wave_sum(d2); n2 = wave_sum(n2); red[512 + (tid >> 6) * 2] = d2; red[512 + (tid >> 6) * 2 + 1] = n2; }
        __syncthreads();
        if (tid == 0) { const float d2 = red[512] + red[514], n2 = red[513] + red[515]; dbg_report(p, sqrtf(d2 / (n2 + 1e-30f))); }
    }
    __syncthreads();
}
#endif
typedef const __attribute__((address_space(4))) Params* ParamsK;
#if defined(__HIP_DEVICE_COMPILE__)
#define LOAD_PARAMS() ({ ParamsK q_ = (ParamsK)__builtin_amdgcn_kernarg_segment_ptr(); asm volatile("" : "+s"(q_)); Params r_ = *q_; r_; })
#else
#define LOAD_PARAMS() (Params{})
#endif
#ifndef FIRST_PHASE
#define FIRST_PHASE 0
#endif
#define PH(k) ((k) >= FIRST_PHASE && (k) <= LAST_PHASE)
#ifndef EPIY_PROBE
#define EPIY_PROBE 0
#endif
#ifndef REP_MASK
#define REP_MASK 0
#endif
#define REP(k) for (int rep_ = 0; rep_ < (((REP_MASK) >> (k)) & 1) + 1; ++rep_)
#define PH_BEGIN { const Params p = LOAD_PARAMS(); unsigned char* ws = p.ws; (void)ws;
#define PH_END }
__global__ void __launch_bounds__(NTHREADS, 2) fwd_kernel(Params p_unused) {
    extern __shared__ __attribute__((aligned(16))) unsigned char lds[];
    cg::grid_group grid = cg::this_grid();
    LAS unsigned char* lds3 = (LAS unsigned char*)lds;
    const int G = gridDim.x, c = blockIdx.x;
    int* seg = (int*)(lds + 160 * 1024 - 256);
    volatile LAS unsigned* bst = (volatile LAS unsigned*)(lds3 + 160 * 1024 - 512);
    if (threadIdx.x < 2) bst[threadIdx.x] = 0u;
    __syncthreads();
    XcdBarrier bar;
    { ParamsK q_ = (ParamsK)__builtin_amdgcn_kernarg_segment_ptr(); bar = xcd_barrier_post((unsigned*)(q_->ws + WS_BAR), bst);
#ifdef HW_XCD_MAP
      if (threadIdx.x == 0) { const unsigned x_ = xb_xcc_id() & 7u; bst[2] = x_; bst[3] = atomicAdd((unsigned*)(q_->ws + WS_BAR) + 3500 + x_, 1u); }
#endif
    }
#ifdef USE_CG_SYNC
#define GRID_SYNC() grid.sync()
#else
#define GRID_SYNC() xcd_barrier(bar)
#endif

#ifdef ONLY4
#ifndef NO_DIFF
    PH_BEGIN p4_attention_diff(p, (char*)lds); PH_END
#endif
#ifndef NO_MLA
    PH_BEGIN p4_attention_mla(p, (char*)lds); PH_END
#endif
    return;
#endif
#ifdef UBENCH
    { typedef int v8i32_ __attribute__((ext_vector_type(8))); typedef float f32x16_ __attribute__((ext_vector_type(16))); typedef int v4i32_ __attribute__((ext_vector_type(4)));
      const int wv_ = __builtin_amdgcn_readfirstlane((int)threadIdx.x >> 6);
      float s_ = 0.f;
      LAS v4i32_* lp_ = (LAS v4i32_*)(lds3 + 65536) + threadIdx.x * 2;
      if (wv_ >= 4) { if (UBENCH != 5) {
          v8i32_ a_ = {(int)threadIdx.x, 1, 2, 3, 4, 5, 6, 7}, b_ = {7, 6, 5, 4, 3, 2, 1, (int)blockIdx.x}; f32x16_ c0 = {}, c1 = {}, c2 = {}, c3 = {}, c4 = {};
          for (int it = 0; it < 10000; ++it) {
              if (UBENCH >= 8) { const v4i32_ x0 = lp_[0], x1 = lp_[1]; b_ = __builtin_shufflevector(x0, x1, 0, 1, 2, 3, 4, 5, 6, 7); }
              c0 = __builtin_amdgcn_mfma_scale_f32_32x32x64_f8f6f4(a_, b_, c0, 0, 0, 0, 0, 0, 0); c1 = __builtin_amdgcn_mfma_scale_f32_32x32x64_f8f6f4(a_, b_, c1, 0, 0, 0, 0, 0, 0);
              c2 = __builtin_amdgcn_mfma_scale_f32_32x32x64_f8f6f4(a_, b_, c2, 0, 0, 0, 0, 0, 0); c3 = __builtin_amdgcn_mfma_scale_f32_32x32x64_f8f6f4(a_, b_, c3, 0, 0, 0, 0, 0, 0);
              c4 = __builtin_amdgcn_mfma_scale_f32_32x32x64_f8f6f4(a_, b_, c4, 0, 0, 0, 0, 0, 0); __builtin_amdgcn_sched_barrier(0);
              if (UBENCH >= 7) __syncthreads(); }
#pragma unroll
          for (int i = 0; i < 16; ++i) s_ += c0[i] + c1[i] + c2[i] + c3[i] + c4[i]; } }
      else if (UBENCH != 6) {
          float e_[32]; unsigned pk_[8];
#pragma unroll
          for (int i = 0; i < 32; ++i) e_[i] = (float)(threadIdx.x + i) * 1e-3f;
#pragma unroll
          for (int i = 0; i < 8; ++i) pk_[i] = 0u;
          for (int it = 0; it < 10000; ++it) {
              float m_ = e_[0];
#pragma unroll
              for (int i = 1; i < 31; i += 2) m_ = __builtin_fmaxf(__builtin_fmaxf(m_, e_[i]), e_[i + 1]);
#pragma unroll
              for (int i = 0; i < 32; ++i) e_[i] = __builtin_amdgcn_exp2f(e_[i] - m_);
#pragma unroll
              for (int i = 0; i < 8; ++i) pk_[i] = cvt4_fp8o((int)pk_[i], e_[4 * i], e_[4 * i + 1], e_[4 * i + 2], e_[4 * i + 3]);
              if (UBENCH >= 8) { lp_[0] = (v4i32_){(int)pk_[0], (int)pk_[1], (int)pk_[2], (int)pk_[3]}; lp_[1] = (v4i32_){(int)pk_[4], (int)pk_[5], (int)pk_[6], (int)pk_[7]}; }
              __builtin_amdgcn_sched_barrier(0);
              if (UBENCH >= 7) __syncthreads(); }
#pragma unroll
          for (int i = 0; i < 8; ++i) s_ += (float)pk_[i]; }
      if (s_ == 123.456f) ((float*)(LOAD_PARAMS().ws + WS_CNT))[100] = s_; }
#endif
#if PH(0)
    REP(0) { PH_BEGIN p0_prologue(p, lds); PH_END
    GRID_SYNC(); }
    if (gridDim.y == 0x7fffffffu) grid.sync();
#endif
    REP(2) {
#if PH(1)
    PH_BEGIN p1_rows(p); PH_END
    GRID_SYNC();
#endif
#if PH(2)
    PH_BEGIN { pg8::Gemm g{(const bf16_t*)(ws + WS_HB), P2_FP8 ? 512 : 1024, (const bf16_t*)(ws + WS_WIN), P2_FP8 ? 512 : 1024}; ProjOrder S; S.init(G, c, 0);
      EpiProj E{(bf16_t*)(ws + WS_PJ), (const f32x2*)(ws + WS_ROPE), (float*)(ws + WS_RSQ), (float*)(ws + WS_RSKV), ws};
      pg8::gemm_phase<EpiProj, ProjOrder, false, P2_FP8 != 0>(lds3, g, S, E); } PH_END
    GRID_SYNC();
#endif
    }
#if PH(3)
    REP(3) {
    const bool p3split = (G == 256); const int G3 = p3split ? G - 32 : G, c3 = p3split ? c - 32 : c;
    if (p3split && c < 32) {
    PH_BEGIN { pg8::Gemm g{(const bf16_t*)(ws + WS_HB), P2_FP8 ? 512 : 1024, (const bf16_t*)(ws + WS_WIN), P2_FP8 ? 512 : 1024}; ProjOrder S; S.init(G, c, 1);
      EpiProj E{(bf16_t*)(ws + WS_PJ), (const f32x2*)(ws + WS_ROPE), (float*)(ws + WS_RSQ), (float*)(ws + WS_RSKV), ws};
      pg8::gemm_phase<EpiProj, ProjOrder, false, P2_FP8 != 0>(lds3, g, S, E); } PH_END
    } else {
#ifndef NO_P3A
    PH_BEGIN { pg8::Gemm g{(const bf16_t*)(ws + WS_PJ) + 1536, NPROJ, (const bf16_t*)(ws + WS_WUQ), 256}; PlainOrder S; S.init(MALL / 256, 3, G3, c3, 0);
      EpiQ E{(bf16_t*)(ws + WS_QM), (const f32x2*)(ws + WS_ROPE), (const float*)(ws + WS_RSQ), ws};
      pg8::gemm_phase<EpiQ, PlainOrder>(lds3, g, S, E); } PH_END
#endif
#ifndef NO_P3B
    PH_BEGIN { pg8::Gemm g{(const bf16_t*)(ws + WS_PJ) + 1792, NPROJ, (const bf16_t*)(ws + WS_WUKV), 256}; PlainOrder S; S.init(MALL / 256, 4, G3, c3, 0);
      EpiKV E{(bf16_t*)(ws + WS_KV), (const float*)(ws + WS_RSKV), ws};
      pg8::gemm_phase<EpiKV, PlainOrder>(lds3, g, S, E); } PH_END
#endif
    }
    GRID_SYNC(); }
#endif
#if PH(4)
    REP(4) { PH_BEGIN p4_attention_diff(p, (char*)lds); PH_END
    PH_BEGIN p4_attention_mla(p, (char*)lds); PH_END
    GRID_SYNC(); }
#endif
#if DBG_STAGE == 1
    PH_BEGIN dbg_check_proj(p); PH_END
#elif DBG_STAGE == 2
    PH_BEGIN dbg_check_attn(p, lds, 0); PH_END
#elif DBG_STAGE == 3
    PH_BEGIN dbg_check_attn(p, lds, 1); PH_END
#endif
#if PH(6)
    REP(6) {
    PH_BEGIN { pg8::Gemm g{(const bf16_t*)(ws + WS_MIX), 1024, (const bf16_t*)(ws + WS_WOUT), 1024}; PlainOrder S; S.init(T / 256, 4, G, c, 1);
      EpiOut E{(bf16_t*)(ws + WS_XN), p.x, (const float*)(ws + WS_MODS), (float*)(ws + WS_RSX)};
      pg8::gemm_phase<EpiOut, PlainOrder>(lds3, g, S, E); } PH_END
    GRID_SYNC(); }
#endif
#if PH(7)
#if (REP_MASK >> 11) & 1
    PH_BEGIN p7a_route(p, lds); PH_END
    GRID_SYNC();
    PH_BEGIN if (blockIdx.x == 0 && threadIdx.x < 32) ((unsigned*)(p.ws + WS_CNT))[threadIdx.x] = 0u; PH_END
    GRID_SYNC();
#endif
    PH_BEGIN p7a_route(p, lds); PH_END
    GRID_SYNC();
    REP(12) { PH_BEGIN moe_segments(p, seg); p7b_scatter(p, seg); PH_END }
    GRID_SYNC();
#endif
#if PH(8)
    REP(8) {
    PH_BEGIN { pg8::Gemm g{(const bf16_t*)(ws + WS_HF), 512, (const bf16_t*)(ws + WS_W1), 512, (const int*)(ws + WS_RTOK)}; MoeOrder S{seg, seg[32] >> 8, 8, G, c};
      EpiAct E{ws + WS_ACT, p.b1};
      pg8::gemm_phase<EpiAct, MoeOrder, true, true>(lds3, g, S, E); } PH_END
    GRID_SYNC(); }
#endif
#if PH(9)
    REP(9) {
    PH_BEGIN { pg8::Gemm g{(const bf16_t*)(ws + WS_ACT), 512, (const bf16_t*)(ws + WS_W2), 512}; MoeOrder S{seg, seg[32] >> 8, 4, G, c};
      EpiY E{(bf16_t*)(ws + WS_XS), p.b2, (const float*)(ws + WS_GSRT), (EPIY_PROBE) ? rep_ : 0};
      pg8::gemm_phase<EpiY, MoeOrder, false, true>(lds3, g, S, E); } PH_END
    GRID_SYNC(); }
#endif
#if LAST_PHASE >= 9
    REP(10) { PH_BEGIN p10_final(p, true); PH_END }
#elif LAST_PHASE >= 6
    PH_BEGIN p10_final(p, false); PH_END
#else
    PH_BEGIN { const int lane = threadIdx.x & 63, wave = threadIdx.x >> 6; const int gw = blockIdx.x * NWAVES + wave, NGW = gridDim.x * NWAVES;
      for (int t = gw; t < T; t += NGW) { const f32x4* xr = (const f32x4*)(p.x + (size_t)t * DM) + lane; f32x4 v[4]; float s = 0.f;
#pragma unroll
        for (int j = 0; j < 4; ++j) { v[j] = xr[64 * j]; s += (v[j].x * v[j].x + v[j].y * v[j].y) + (v[j].z * v[j].z + v[j].w * v[j].w); }
        const float r = rsqrtf(wave_sum(s) * (1.f / DM) + EPS); f32x4* o = (f32x4*)(p.out + (size_t)t * DM) + lane;
#pragma unroll
        for (int j = 0; j < 4; ++j) o[64 * j] = v[j] * r * ((const f32x4*)p.final_norm_w)[lane + 64 * j]; } } PH_END
#endif
}

extern "C" void kernel_launch(void* const* d_in, const int* in_sizes, int n_in, void* d_out, int out_size, void* d_ws, size_t ws_size, hipStream_t stream) {
    static int grid = 0;
    if (grid == 0) {
        if (n_in != 26 || in_sizes[0] != T * DM || out_size != T * DM || ws_size < WS_END) {
            fprintf(stderr, "kernel_launch: unexpected shapes: n_in %d in0 %d out %d ws %zu (need %zu)\n", n_in, n_in > 0 ? in_sizes[0] : -1, out_size, ws_size, (size_t)WS_END);
            grid = -1; return; }
        int dev = 0, cus = 0, per_cu = 0;
        (void)hipGetDevice(&dev);
        (void)hipDeviceGetAttribute(&cus, hipDeviceAttributeMultiprocessorCount, dev);
        if (hipFuncSetAttribute((const void*)fwd_kernel, hipFuncAttributeMaxDynamicSharedMemorySize, LDS_BYTES) != hipSuccess) { fprintf(stderr, "kernel_launch: hipFuncSetAttribute failed\n"); grid = -1; return; }
        if (hipOccupancyMaxActiveBlocksPerMultiprocessor(&per_cu, (const void*)fwd_kernel, NTHREADS, LDS_BYTES) != hipSuccess || per_cu < 1) { fprintf(stderr, "kernel_launch: occupancy query failed (%d)\n", per_cu); (void)hipGetLastError(); grid = -1; return; }
        grid = cus;
        if (grid < 128 || grid > 1024) { fprintf(stderr, "kernel_launch: unsupported CU count %d\n", cus); grid = -1; return; }
    }
    if (grid < 0) return;
    Params p{};
    const float** pp = (const float**)&p;
    for (int i = 0; i < 26; ++i) pp[i] = (const float*)d_in[i];
    p.out = (float*)d_out; p.ws = (unsigned char*)d_ws;
    if (hipMemsetAsync((char*)d_ws + WS_BAR, 0, WS_BAR_BYTES, stream) != hipSuccess) { fprintf(stderr, "kernel_launch: hipMemsetAsync failed\n"); return; }
    void* args[] = {&p};
    hipError_t e = hipLaunchCooperativeKernel((const void*)fwd_kernel, dim3(grid), dim3(NTHREADS), args, LDS_BYTES, stream);
    if (e != hipSuccess) fprintf(stderr, "cooperative launch failed: %s (grid %d)\n", hipGetErrorString(e), grid);
}
```

```cpp
#define MLA_NQR 2
#define STAGGER 0
#define ATT8_THRL 3.8f
#define P6_FP8 1
#include <hip/hip_runtime.h>
#include <hip/hip_cooperative_groups.h>
#include <cstdio>
#include <cstdint>
namespace cg = cooperative_groups;

#ifndef DBG_STAGE
#define DBG_STAGE 0
#endif
#ifndef ATT_EXTRA
#define ATT_EXTRA 0
#define ATT_EXTRA_ROUND0 0
#endif
#ifndef ATT_X
#define ATT_X(cc) ((cc) & 7)
#define ATT_J(cc) ((cc) >> 3)
#endif
#ifndef ATT_FP8
#define ATT_FP8 1
#endif
#ifndef SIM_P2
#define SIM_P2 0
#endif
#ifndef SIM_P6
#define SIM_P6 0
#endif
#ifndef WCONV_IN_ATT
#define WCONV_IN_ATT 1
#endif
#ifndef P7A_VAR
#define P7A_VAR 0
#endif
#ifndef P10_NT
#define P10_NT 4
#endif
#ifndef MLA_RECHAIN
#define MLA_RECHAIN 1
#endif
#ifndef T15_DIFF
#define T15_DIFF 1
#endif
#ifndef P6_FP8
#define P6_FP8 0
#endif
#ifndef P2_FP8
#define P2_FP8 1
#endif
#ifndef YS_FP8
#define YS_FP8 1
#endif
constexpr float YS_SCALE = 16.f;
#ifndef STAGGER
#define STAGGER 1
#endif
#ifndef ATT_VAR
#define ATT_VAR 0
#endif
#ifndef LAST_PHASE
#define LAST_PHASE 99
#endif

constexpr int DM = 1024, NB = 4, SEQ = 8192, CTX = 256;
constexpr int T = NB * SEQ;
constexpr int RPB = CTX + SEQ;
constexpr int MALL = NB * RPB;
constexpr int NPROJ = 2048;
constexpr int NEXP = 32, TOPK = 4, DFF = 1024;
constexpr int RMAX = T * TOPK + NEXP * 256;
constexpr float EPS = 1e-6f;
constexpr int NTHREADS = 512, NWAVES = 8;
constexpr float WQ_SCALE = 64.f;
constexpr int LDS_BYTES = 163840;

typedef unsigned short bf16_t;
typedef float f32x4 __attribute__((ext_vector_type(4)));
typedef float f32x2 __attribute__((ext_vector_type(2)));
typedef unsigned u32x4 __attribute__((ext_vector_type(4)));
typedef unsigned u32x2 __attribute__((ext_vector_type(2)));
#define LAS __attribute__((address_space(3)))

constexpr size_t KiB = 1024, MiB = 1u << 20;
constexpr size_t WS_CNT  = 0;
constexpr size_t WS_BAR  = 16 * KiB;
constexpr size_t WS_BAR_BYTES = 16 * KiB;
constexpr size_t WS_MODS = 64 * KiB;
constexpr size_t WS_DUMMY = 192 * KiB;
constexpr size_t WS_ROPE = 256 * KiB;
constexpr size_t WS_RWF  = 320 * KiB;
constexpr size_t WS_RSQ  = 512 * KiB;
constexpr size_t WS_RSKV = 768 * KiB;
constexpr size_t WS_TOPI = 1 * MiB;
constexpr size_t WS_GATE = 1 * MiB + 512 * KiB;
constexpr size_t WS_RANK = 2 * MiB;
constexpr size_t WS_GSRT = 2 * MiB + 512 * KiB;
constexpr size_t WS_RSX  = 3 * MiB + 64 * KiB;
constexpr size_t WS_DEST = 3 * MiB + 256 * KiB;
constexpr size_t WS_WIN  = 4 * MiB;
constexpr size_t WS_WOUT = 8 * MiB;
constexpr size_t WS_WUQ  = 10 * MiB;
constexpr size_t WS_WUKV = 11 * MiB;
constexpr size_t WS_W1   = 12 * MiB;
constexpr size_t WS_W2   = 140 * MiB;
constexpr size_t WS_XN   = 204 * MiB;
constexpr size_t WS_XS   = 332 * MiB;
constexpr size_t WS_ACT  = 604 * MiB;
constexpr size_t WS_HF   = 876 * MiB;
constexpr size_t WS_RTOK = 940 * MiB;
constexpr size_t WS_END  = 941 * MiB;
constexpr size_t WS_HB   = 332 * MiB;
constexpr size_t WS_PJ   = 398 * MiB;
constexpr size_t WS_QM   = 530 * MiB;
constexpr size_t WS_KV   = 580 * MiB;
constexpr size_t WS_AO   = 646 * MiB;
constexpr size_t WS_MIX  = 745 * MiB;
constexpr size_t WS_Q8D  = 646 * MiB;
constexpr size_t WS_K8D  = 663 * MiB;
constexpr size_t WS_VT8D = 680 * MiB;
constexpr size_t WS_KR8  = 697 * MiB;
constexpr size_t WS_Q8M  = 530 * MiB;
constexpr size_t WS_K8M  = 556 * MiB;
constexpr size_t WS_VT8M = 574 * MiB;
static_assert(WS_MIX + (size_t)MALL * 1024 * 2 <= WS_HF && WS_XS + (size_t)RMAX * 2048 <= WS_ACT && WS_ACT + (size_t)RMAX * 2048 <= WS_HF, "ws map");

struct Params {
    const float* x; const float* c; const float* ctx; const float* c_ctx; const float* w_ada; const float* b_ada;
    const float* attn_norm_w; const float* w_in; const float* q_norm_w; const float* kv_norm_w; const float* w_uq; const float* w_ukv;
    const float* lq1; const float* lk1; const float* lq2; const float* lk2; const float* subln_w; const float* w_out;
    const float* ffn_norm_w; const float* router_w; const float* router_b; const float* w1; const float* b1; const float* w2; const float* b2;
    const float* final_norm_w;
    float* out; unsigned char* ws;
};

__device__ __forceinline__ int tid_opaque() { int t = threadIdx.x; asm volatile("" : "+v"(t)); return t; }
__device__ __forceinline__ float wave_sum(float v) {
#pragma unroll
    for (int o = 1; o < 64; o <<= 1) v += __shfl_xor(v, o);
    return v;
}
__device__ __forceinline__ float wave_max(float v) {
#pragma unroll
    for (int o = 1; o < 64; o <<= 1) v = fmaxf(v, __shfl_xor(v, o));
    return v;
}
__device__ __forceinline__ float silu_f(float v) { return v / (1.f + __expf(-v)); }
__device__ __forceinline__ unsigned cvt_pk_bf16(float lo, float hi) { unsigned r; asm volatile("v_cvt_pk_bf16_f32 %0, %1, %2" : "=v"(r) : "v"(lo), "v"(hi)); return r; }
__device__ __forceinline__ unsigned cvt4_fp8o(int old, float a, float b, float c, float d) { int r = __builtin_amdgcn_cvt_pk_fp8_f32(a, b, old, false); r = __builtin_amdgcn_cvt_pk_fp8_f32(c, d, r, true); return (unsigned)r; }
__device__ __forceinline__ unsigned cvt4_fp8(float a, float b, float c, float d) { int r = __builtin_amdgcn_cvt_pk_fp8_f32(a, b, 0, false); r = __builtin_amdgcn_cvt_pk_fp8_f32(c, d, r, true); return (unsigned)r; }
__device__ __forceinline__ float q8(float x) { const int pk = __builtin_amdgcn_cvt_pk_fp8_f32(x, x, 0, false); return __builtin_amdgcn_cvt_f32_fp8(pk, 0); }
#ifdef SIM_FP8_ATT
#define Q8(x) q8(x)
#define PSHIFT 8.f
#else
#define Q8(x) (x)
#define PSHIFT 0.f
#endif
__device__ __forceinline__ unsigned char f2fp8(float x) { return (unsigned char)(__builtin_amdgcn_cvt_pk_fp8_f32(x, x, 0, false) & 0xff); }
__device__ __forceinline__ int vt_pos(int kk) { return ((kk >> 2) & 1) * 32 + (kk >> 5) * 16 + ((kk >> 3) & 3) * 4 + (kk & 3); }
__device__ __forceinline__ unsigned quad_tr_bytes(unsigned w, int j) {
    const unsigned t0 = (unsigned)__builtin_amdgcn_mov_dpp((int)w, 0x00, 0xf, 0xf, true), t1 = (unsigned)__builtin_amdgcn_mov_dpp((int)w, 0x55, 0xf, 0xf, true);
    const unsigned t2 = (unsigned)__builtin_amdgcn_mov_dpp((int)w, 0xaa, 0xf, 0xf, true), t3 = (unsigned)__builtin_amdgcn_mov_dpp((int)w, 0xff, 0xf, 0xf, true);
    const unsigned sel = 0x0c0c0000u | ((4u + (unsigned)j) << 8) | (unsigned)j;
    const unsigned a = __builtin_amdgcn_perm(t1, t0, sel), b = __builtin_amdgcn_perm(t3, t2, sel);
    return __builtin_amdgcn_perm(b, a, 0x05040100u);
}
__device__ __forceinline__ bf16_t f2bf(float f) { return (bf16_t)(cvt_pk_bf16(f, 0.f) & 0xffffu); }
__device__ __forceinline__ float bf2f(bf16_t v) { return __uint_as_float((unsigned)v << 16); }
__device__ __forceinline__ float bflo(unsigned w) { return __uint_as_float(w << 16); }
__device__ __forceinline__ float bfhi(unsigned w) { return __uint_as_float(w & 0xffff0000u); }
#define GAS __attribute__((address_space(1)))
#define RLX_AGENT __ATOMIC_RELAXED, __HIP_MEMORY_SCOPE_AGENT
#define XB_TMO      128
#define XB_XCNT(j)  (256  + 64 * (j))
#define XB_XSUB(j)  (1280 + 64 * (j))
#define XB_XGEN(j)  (2304 + 64 * (j))
#define XB_TOP      3328
#define XB_TOPGEN   3392
#define XCD_BAR_WORDS 3456
#define XB_SPIN_CAP (1u << 18)

__device__ __forceinline__ unsigned xb_ld(unsigned* p)              { return __hip_atomic_load(p, __ATOMIC_RELAXED, __HIP_MEMORY_SCOPE_AGENT); }
__device__ __forceinline__ unsigned xb_add(unsigned* p, unsigned v) { return __hip_atomic_fetch_add(p, v, __ATOMIC_RELAXED, __HIP_MEMORY_SCOPE_AGENT); }
__device__ __forceinline__ unsigned xb_xcc_id() { return (unsigned)__builtin_amdgcn_s_getreg((3 << 11) | 20) & 0xFu; }
#define XB_SPIN(cond, bar) do { unsigned _sp = 0; while (cond) { __builtin_amdgcn_s_sleep(1); \
    if ((++_sp & 255u) == 0u) { if (xb_ld(&(bar)[XB_TMO])) break; if (_sp > XB_SPIN_CAP) { atomicAdd(&(bar)[XB_TMO], 1u); break; } } } } while (0)

struct XcdBarrier {
    unsigned* bar; unsigned x;
    volatile LAS unsigned* st;
};

__device__ __forceinline__ XcdBarrier xcd_barrier_post(unsigned* bar, volatile LAS unsigned* st) {
    XcdBarrier b; b.bar = bar; b.x = xb_xcc_id(); b.st = st;
    if (threadIdx.x == 0) (void)xb_add(&bar[XB_XCNT(b.x)], 1u);
    return b;
}
__device__ __forceinline__ void xcd_barrier_complete(unsigned* bar, unsigned x, unsigned& nloc, unsigned& nx) {
    const unsigned G = gridDim.x * gridDim.y * gridDim.z;
    unsigned sum, cnt, mine, sp = 0u;
    for (;;) {
        sum = 0u; cnt = 0u; mine = 0u;
#pragma unroll
        for (unsigned j = 0; j < 16; ++j) { const unsigned c = xb_ld(&bar[XB_XCNT(j)]); sum += c; cnt += (c > 0u) ? 1u : 0u; mine = (j == x) ? c : mine; }
        if (sum == G) break;
        __builtin_amdgcn_s_sleep(1);
        if ((++sp & 255u) == 0u) { if (xb_ld(&bar[XB_TMO])) break; if (sp > XB_SPIN_CAP) { atomicAdd(&bar[XB_TMO], 1u); break; } }
    }
    nloc = mine > 0u ? mine : 1u; nx = cnt > 0u ? cnt : 1u;
}

__device__ __forceinline__ void xcd_barrier(const XcdBarrier& b) {
    asm volatile("s_waitcnt vmcnt(0)" ::: "memory");
    __syncthreads();
    if (threadIdx.x == 0) {
        unsigned* bar = b.bar;
        __builtin_amdgcn_s_waitcnt(0);
        unsigned nloc = b.st[0], nx = b.st[1];
        if (nloc == 0u) { xcd_barrier_complete(bar, b.x, nloc, nx); b.st[0] = nloc; b.st[1] = nx; }
        const unsigned old = xb_add(&bar[XB_XSUB(b.x)], 1u);
        const unsigned gen = old / nloc;
        if (old + 1u == (gen + 1u) * nloc) {
            __builtin_amdgcn_fence(__ATOMIC_RELEASE, "agent");
            asm volatile("s_waitcnt vmcnt(0)" ::: "memory");
            const unsigned og = xb_add(&bar[XB_TOP], 1u);
            const unsigned tg = og / nx;
            if (og + 1u == (tg + 1u) * nx) xb_add(&bar[XB_TOPGEN], 1u);
            else XB_SPIN(xb_ld(&bar[XB_TOPGEN]) == tg, bar);
            __builtin_amdgcn_fence(__ATOMIC_ACQUIRE, "agent");
            xb_add(&bar[XB_XGEN(b.x)], 1u);
            asm volatile("s_waitcnt vmcnt(0)" ::: "memory");
        } else {
            XB_SPIN(xb_ld(&bar[XB_XGEN(b.x)]) == gen, bar);
            __builtin_amdgcn_fence(__ATOMIC_ACQUIRE, "agent");
            asm volatile("s_waitcnt vmcnt(0)" ::: "memory");
        }
    }
    __syncthreads();
}

__device__ __forceinline__ void p0_mods(const Params& p, float* lds_f, int item) {
    const int tid = tid_opaque();
    float* sc = lds_f;
    float* red = lds_f + 5 * 1024;
    for (int i = tid; i < 5 * 1024; i += NTHREADS) { const int r = i >> 10, k = i & 1023; sc[i] = silu_f(r < 4 ? p.c[r * 1024 + k] : p.c_ctx[k]); }
    __syncthreads();
    const int col = tid & 31, kg = tid >> 5;
    const float* w = p.w_ada + (size_t)(kg * 64) * 6144 + item * 32 + col;
    float a0 = 0, a1 = 0, a2 = 0, a3 = 0, a4 = 0;
#pragma unroll 8
    for (int k = 0; k < 64; ++k) { const float wv = w[(size_t)k * 6144]; const int kk = kg * 64 + k;
        a0 += sc[kk] * wv; a1 += sc[1024 + kk] * wv; a2 += sc[2048 + kk] * wv; a3 += sc[3072 + kk] * wv; a4 += sc[4096 + kk] * wv; }
    red[(kg * 5 + 0) * 32 + col] = a0; red[(kg * 5 + 1) * 32 + col] = a1; red[(kg * 5 + 2) * 32 + col] = a2; red[(kg * 5 + 3) * 32 + col] = a3; red[(kg * 5 + 4) * 32 + col] = a4;
    __syncthreads();
    if (tid < 160) { const int r = tid >> 5, cc = tid & 31; float s = p.b_ada[item * 32 + cc];
        for (int g = 0; g < 16; ++g) s += red[(g * 5 + r) * 32 + cc];
        ((float*)(p.ws + WS_MODS))[r * 6144 + item * 32 + cc] = s; }
    __syncthreads();
}

template <int SIMQ = 0>
__device__ __forceinline__ void p0_tr_item(const float* W, int ldw, bf16_t* WT, int ldk, int k0, int n0, int drow0, const float* kscale, float* scr, int lane) {
    const int nq = (lane & 15) * 4, kr = lane >> 4;
#pragma unroll 4
    for (int i = 0; i < 16; ++i) { const int kk = 4 * i + kr;
        f32x4 v = *(const f32x4*)(W + (size_t)(k0 + kk) * ldw + n0 + nq);
        if (kscale) { const float s = kscale[k0 + kk]; v = v * s; }
        float* d = scr + kk * 65 + nq; d[0] = v.x; d[1] = v.y; d[2] = v.z; d[3] = v.w; }
    asm volatile("s_waitcnt lgkmcnt(0)" ::: "memory");
    const int c = lane & 7;
#pragma unroll
    for (int j = 0; j < 8; ++j) { const int n = (lane >> 3) + 8 * j; const float* s = scr + (8 * c) * 65 + n;
        float w_[8];
#pragma unroll
        for (int i = 0; i < 8; ++i) { w_[i] = s[i * 65]; if (SIMQ) w_[i] = q8(w_[i] * 64.f) * (1.f / 64.f); }
        u32x4 o; o.x = cvt_pk_bf16(w_[0], w_[1]); o.y = cvt_pk_bf16(w_[2], w_[3]); o.z = cvt_pk_bf16(w_[4], w_[5]); o.w = cvt_pk_bf16(w_[6], w_[7]);
        *(u32x4*)(WT + (size_t)(drow0 + n) * ldk + k0 + 8 * c) = o; }
    asm volatile("s_waitcnt lgkmcnt(0)" ::: "memory");
}

__device__ __forceinline__ void p0_tr_item_f8(const float* W, int ldw, unsigned char* WT, int ldk, int k0, int n0, int drow0, const float wscale, float* scr, int lane) {
    const int nq = (lane & 15) * 4, kr = lane >> 4;
#pragma unroll 4
    for (int i = 0; i < 16; ++i) { const int kk = 4 * i + kr;
        const f32x4 v = *(const f32x4*)(W + (size_t)(k0 + kk) * ldw + n0 + nq) * wscale;
        float* d = scr + kk * 65 + nq; d[0] = v.x; d[1] = v.y; d[2] = v.z; d[3] = v.w; }
    asm volatile("s_waitcnt lgkmcnt(0)" ::: "memory");
    const int c = lane & 3;
#pragma unroll
    for (int j = 0; j < 4; ++j) { const int n = (lane >> 2) + 16 * j; const float* s = scr + (16 * c) * 65 + n;
        u32x4 o; o.x = cvt4_fp8(s[0 * 65], s[1 * 65], s[2 * 65], s[3 * 65]); o.y = cvt4_fp8(s[4 * 65], s[5 * 65], s[6 * 65], s[7 * 65]);
        o.z = cvt4_fp8(s[8 * 65], s[9 * 65], s[10 * 65], s[11 * 65]); o.w = cvt4_fp8(s[12 * 65], s[13 * 65], s[14 * 65], s[15 * 65]);
        *(u32x4*)(WT + (size_t)(drow0 + n) * ldk + k0 + 16 * c) = o; }
    asm volatile("s_waitcnt lgkmcnt(0)" ::: "memory");
}

__device__ __forceinline__ void p0_prologue(const Params& p, unsigned char* lds) {
    const int tid = tid_opaque(), lane = tid & 63, wave = tid >> 6;
    unsigned char* ws = p.ws;
    if (blockIdx.x == 0 && tid < 128) ((unsigned*)(ws + WS_CNT))[tid] = 0u;
    if (blockIdx.x == gridDim.x - 1) {
        for (int i = tid; i < 128 * 16; i += NTHREADS) { const int pv = i >> 4, pp = i & 15;
            const float inv = exp2f(-(float)pp * (13.287712379549449f / 16.f));
            const float ang = (float)pv * inv; float sn, cs; sincosf(ang, &sn, &cs);
            ((f32x2*)(ws + WS_ROPE))[i] = (f32x2){cs, sn}; }
    }
    { const int gt = blockIdx.x * NTHREADS + tid;
      if (gt < 4096) { const int l = gt & 63, nb = (gt >> 6) & 1, s = gt >> 7; unsigned hi4[4], lo4[4];
#pragma unroll
        for (int j = 0; j < 4; ++j) { const float w0 = p.router_w[(32 * s + 8 * (l >> 4) + 2 * j) * 32 + 16 * nb + (l & 15)], w1 = p.router_w[(32 * s + 8 * (l >> 4) + 2 * j + 1) * 32 + 16 * nb + (l & 15)];
            const unsigned hw = cvt_pk_bf16(w0, w1); hi4[j] = hw; lo4[j] = cvt_pk_bf16(w0 - bflo(hw), w1 - bfhi(hw)); }
        u32x4* dst = (u32x4*)(ws + WS_RWF) + ((s * 2 + nb) * 2) * 64 + l;
        dst[0] = (u32x4){hi4[0], hi4[1], hi4[2], hi4[3]}; dst[64] = (u32x4){lo4[0], lo4[1], lo4[2], lo4[3]}; } }
    for (int it = blockIdx.x; it < 192; it += gridDim.x) p0_mods(p, (float*)lds, it);
    float* scr = (float*)lds + wave * (64 * 65);
    const int gw = blockIdx.x * NWAVES + wave, NGW = gridDim.x * NWAVES;
    constexpr int I_W1 = WCONV_IN_ATT ? 0 : 32 * 16 * 32, I_W2 = WCONV_IN_ATT ? 0 : 32 * 16 * 16, I_IN = 16 * 31, I_OUT = 16 * 16, I_UQ = 4 * 12, I_UKV = 2 * 16;
    constexpr int NITEMS = I_W1 + I_W2 + I_IN + I_OUT + I_UQ + I_UKV;
    for (int it = gw; it < NITEMS; it += NGW) {
        int r = it;
        if (r < I_W1) { const int e = r >> 9, q = r & 511, kb = q >> 5, nb = q & 31, n0 = nb * 64;
            const int drow = ((n0 & 1023) >> 7) * 256 + (n0 >> 10) * 128 + (n0 & 127);
            p0_tr_item_f8(p.w1 + (size_t)e * 1024 * 2048, 2048, ws + WS_W1 + (size_t)e * 2048 * 1024, 1024, kb * 64, n0, drow, WQ_SCALE, scr, lane); continue; } r -= I_W1;
        if (r < I_W2) { const int e = r >> 8, q = r & 255, kb = q >> 4, nb = q & 15;
            p0_tr_item_f8(p.w2 + (size_t)e * 1024 * 1024, 1024, ws + WS_W2 + (size_t)e * 1024 * 1024, 1024, kb * 64, nb * 64, nb * 64, WQ_SCALE, scr, lane); continue; } r -= I_W2;
        if (r < I_IN) { const int kb = r / 31, nb = r % 31;
#if P2_FP8
            p0_tr_item_f8(p.w_in, 1984, ws + WS_WIN, 1024, kb * 64, nb * 64, nb * 64, WQ_SCALE, scr, lane); continue; } r -= I_IN;
#else
            p0_tr_item<SIM_P2>(p.w_in, 1984, (bf16_t*)(ws + WS_WIN), 1024, kb * 64, nb * 64, nb * 64, nullptr, scr, lane); continue; } r -= I_IN;
#endif
        if (r < I_OUT) { const int kb = r >> 4, nb = r & 15;
#if P6_FP8
            p0_tr_item_f8(p.w_out, 1024, ws + WS_WOUT, 1024, kb * 64, nb * 64, nb * 64, WQ_SCALE, scr, lane); continue; } r -= I_OUT;
#else
            p0_tr_item<SIM_P6>(p.w_out, 1024, (bf16_t*)(ws + WS_WOUT), 1024, kb * 64, nb * 64, nb * 64, nullptr, scr, lane); continue; } r -= I_OUT;
#endif
        if (r < I_UQ) { const int kb = r / 12, nb = r % 12;
            p0_tr_item(p.w_uq, 768, (bf16_t*)(ws + WS_WUQ), 256, kb * 64, nb * 64, nb * 64, p.q_norm_w, scr, lane); continue; } r -= I_UQ;
        { const int kb = r >> 4, nb = r & 15;
            p0_tr_item(p.w_ukv, 1024, (bf16_t*)(ws + WS_WUKV), 128, kb * 64, nb * 64, nb * 64, p.kv_norm_w, scr, lane); }
    }
    { const int gt = blockIdx.x * NTHREADS + tid, NGT = gridDim.x * NTHREADS; const u32x4 z = {0u, 0u, 0u, 0u};
      for (int i = gt; i < 64 * (P2_FP8 ? 64 : 128); i += NGT) ((u32x4*)(ws + WS_WIN + (size_t)1984 * (P2_FP8 ? 1024 : 2048)))[i] = z;
      }
}

__device__ __forceinline__ void p1_rows(const Params& p) {
    const int tid = tid_opaque(), lane = tid & 63, wave = tid >> 6;
    const int gw = blockIdx.x * NWAVES + wave, NGW = gridDim.x * NWAVES;
    const float* mods = (const float*)(p.ws + WS_MODS);
    bf16_t* HB = (bf16_t*)(p.ws + WS_HB);
    { const int gt = blockIdx.x * NTHREADS + tid, NGT = gridDim.x * NTHREADS;
      for (int i = gt; i < MALL; i += NGT) { ((float*)(p.ws + WS_RSQ))[i] = 0.f; ((float*)(p.ws + WS_RSKV))[i] = 0.f; }
      for (int i = gt; i < RMAX; i += NGT) ((int*)(p.ws + WS_RTOK))[i] = 0;
      for (int i = gt; i < T; i += NGT) ((float*)(p.ws + WS_RSX))[i] = 0.f; }
    f32x4 av[4], sv[4]; int curb = -1;
    for (int m0 = __builtin_amdgcn_readfirstlane(gw); m0 < MALL; m0 += 2 * NGW) {
        int mm[2]; bool ok[2]; f32x4 v[2][4];
#pragma unroll
        for (int q = 0; q < 2; ++q) { const int m_ = m0 + q * NGW; ok[q] = m_ < MALL; mm[q] = ok[q] ? m_ : m0;
            const int b = mm[q] / RPB, i = mm[q] - b * RPB; const bool isctx = i < CTX;
            const float* src = isctx ? p.ctx + ((size_t)b * CTX + i) * DM : p.x + ((size_t)b * SEQ + (i - CTX)) * DM;
            const f32x4* xr = (const f32x4*)src + lane;
#pragma unroll
            for (int j = 0; j < 4; ++j) v[q][j] = __builtin_nontemporal_load(xr + 64 * j); }
#pragma unroll
        for (int q = 0; q < 2; ++q) { const int m = mm[q], b = m / RPB, i = m - b * RPB; const int bsel = i < CTX ? 4 : b;
            if (bsel != curb) { curb = bsel; const float* md = mods + bsel * 6144;
#pragma unroll
                for (int j = 0; j < 4; ++j) { av[j] = ((const f32x4*)p.attn_norm_w)[lane + 64 * j] * (((const f32x4*)(md + 1024))[lane + 64 * j] + 1.f); sv[j] = ((const f32x4*)md)[lane + 64 * j]; } }
            float s = 0.f;
#pragma unroll
            for (int j = 0; j < 4; ++j) s += (v[q][j].x * v[q][j].x + v[q][j].y * v[q][j].y) + (v[q][j].z * v[q][j].z + v[q][j].w * v[q][j].w);
            const float r = rsqrtf(wave_sum(s) * (1.f / DM) + EPS);
#if P2_FP8
            if (ok[q]) { unsigned* o = (unsigned*)((unsigned char*)HB + (size_t)m * DM) + lane;
#pragma unroll
                for (int j = 0; j < 4; ++j) { const f32x4 h = v[q][j] * r * av[j] + sv[j]; __builtin_nontemporal_store(cvt4_fp8(h.x, h.y, h.z, h.w), o + 64 * j); } }
#else
            if (ok[q]) { u32x2* o = (u32x2*)(HB + (size_t)m * DM) + lane;
#pragma unroll
                for (int j = 0; j < 4; ++j) { const f32x4 h = v[q][j] * r * av[j] + sv[j];
                    f32x4 hq = h; if (SIM_P2) hq = (f32x4){q8(h.x), q8(h.y), q8(h.z), q8(h.w)};
                    u32x2 pk; pk.x = cvt_pk_bf16(hq.x, hq.y); pk.y = cvt_pk_bf16(hq.z, hq.w); o[64 * j] = pk; } }
#endif
        }
    }
}
namespace pg8 {
typedef short bf16x8 __attribute__((ext_vector_type(8)));
typedef int v4i32_t __attribute__((ext_vector_type(4)));
typedef int v8i32_t __attribute__((ext_vector_type(8)));
constexpr int BM = 256, BK = 64, HALF = 128, HTB = HALF * BK * 2  , STAGE_BYTES = 8 * HTB;
__host__ __device__ __forceinline__ int lds_byte(int r, int c) { const int st = (r >> 4) * 2 + (c >> 5), rr = r & 15, cc = c & 31, ob = rr * 64 + cc * 2; return st * 1024 + (ob ^ (((ob >> 9) & 1) << 5)); }
__host__ __device__ __forceinline__ void stage_rc(int b, int& R, int& C) { const int st = b / 1024, sb = b % 1024, swz = sb ^ (((sb >> 9) & 1) << 5); R = (st >> 1) * 16 + swz / 64; C = (st & 1) * 32 + (swz % 64) / 2; }

struct Unit { int am, bn, pm, pn, e; };
struct Gemm { const bf16_t* A; int lda; const bf16_t* Bt; int K; const int* rowtok; };

template <class Epi, class Sched, bool GATHER = false, bool FP8 = false, bool ALIGN_EPI = true>
__device__ __forceinline__ void gemm_phase(LAS unsigned char* lds, const Gemm g, const Sched& S, const Epi& E) {
    const int tid = tid_opaque(), wid = __builtin_amdgcn_readfirstlane(tid >> 6), lane = tid & 63, wr = wid >> 2, wc = wid & 3, fr = lane & 15, fq = lane >> 4;
    const int K = g.K, lda = g.lda; int nt = K / BK; asm volatile("" : "+s"(nt));
    unsigned voffA[2], voffB[2];
#pragma unroll
    for (int i = 0; i < 2; ++i) { int R, C; stage_rc(tid * 16 + i * 8192, R, C);
        voffA[i] = (unsigned)(R * lda + C) * 2u; voffB[i] = (unsigned)(R * K + C) * 2u; }
    unsigned vA0[2], vA1[2];
    LAS u32x4* gnx = (LAS u32x4*)(lds + STAGE_BYTES + 4096) + tid;
#define PG8_GOFF(AM, o00, o01, o10, o11) do { int t_ = tid; asm volatile("" : "+v"(t_)); int R0_, C0_, R1_, C1_; stage_rc(t_ * 16, R0_, C0_); stage_rc(t_ * 16 + 8192, R1_, C1_); \
        const int* rt_ = g.rowtok + (AM) * 256; const unsigned lb_ = (unsigned)(lda * 2); \
        o00 = (unsigned)rt_[R0_] * lb_ + (unsigned)(C0_ * 2); o01 = (unsigned)rt_[R1_] * lb_ + (unsigned)(C1_ * 2); o10 = (unsigned)rt_[128 + R0_] * lb_ + (unsigned)(C0_ * 2); o11 = (unsigned)rt_[128 + R1_] * lb_ + (unsigned)(C1_ * 2); } while (0)
#define PG8_STAGE_A(bufoff, soff, h, W0, W1) do { PG8_STAGE(bufoff, rA, soff, ((h) ? W1 : W0)); } while (0)
    const unsigned kstep = (unsigned)(BK * 2);
    const unsigned hstepA = (unsigned)(HALF * lda * 2), hstepB = (unsigned)(HALF * K * 2);
    const unsigned tstepA = 2 * hstepA, tstepB = 2 * hstepB;
    const __amdgpu_buffer_rsrc_t rA = __builtin_amdgcn_make_buffer_rsrc((void*)g.A, 0, 0xffffffff, 0x00020000), rB = __builtin_amdgcn_make_buffer_rsrc((void*)g.Bt, 0, 0xffffffff, 0x00020000);
    const unsigned ldsw = (unsigned)wid * 1024u;
    const int aoff = lds_byte(wr * 64 + fr, fq * 8), boff = lds_byte(wc * 32 + fr, fq * 8);
#define PG8_SA(b, h) (((b) * 2 + (h)) * HTB)
#define PG8_SB(b, h) ((4 + (b) * 2 + (h)) * HTB)
#define PG8_STAGE(bufoff, rs, soff, voff) do { _Pragma("unroll") for (int _i = 0; _i < 2; ++_i) \
        __builtin_amdgcn_raw_ptr_buffer_load_lds(rs, (LAS unsigned*)(lds + (bufoff) + ldsw + _i * 8192), 16, (int)(voff)[_i], (int)(soff), 0, 0); } while (0)
#define PG8_LDA(dst, b, h) do { _Pragma("unroll") for (int m = 0; m < 4; ++m) { const v4i32_t lo_ = *(const LAS v4i32_t*)(lds + PG8_SA(b, h) + aoff + m * 2048), hi_ = *(const LAS v4i32_t*)(lds + PG8_SA(b, h) + aoff + m * 2048 + 1024); \
        dst[m] = __builtin_shufflevector(lo_, hi_, 0, 1, 2, 3, 4, 5, 6, 7); } } while (0)
#define PG8_LDB(dst, b, h) do { _Pragma("unroll") for (int n = 0; n < 2; ++n) { const v4i32_t lo_ = *(const LAS v4i32_t*)(lds + PG8_SB(b, h) + boff + n * 2048), hi_ = *(const LAS v4i32_t*)(lds + PG8_SB(b, h) + boff + n * 2048 + 1024); \
        dst[n] = __builtin_shufflevector(lo_, hi_, 0, 1, 2, 3, 4, 5, 6, 7); } } while (0)
#define PG8_LO(x) __builtin_bit_cast(bf16x8, __builtin_shufflevector(x, x, 0, 1, 2, 3))
#define PG8_HI(x) __builtin_bit_cast(bf16x8, __builtin_shufflevector(x, x, 4, 5, 6, 7))
#define PG8_MMA(ai, bj, At, Bt) do { __builtin_amdgcn_s_setprio(1); _Pragma("unroll") for (int m = 0; m < 4; ++m) _Pragma("unroll") for (int n = 0; n < 2; ++n) { \
        if constexpr (FP8) acc[ai][bj][m][n] = __builtin_amdgcn_mfma_scale_f32_16x16x128_f8f6f4(Bt[n], At[m], acc[ai][bj][m][n], 0, 0, 0, 0, 0, 0)    ; \
        else { acc[ai][bj][m][n] = __builtin_amdgcn_mfma_f32_16x16x32_bf16(PG8_LO(Bt[n]), PG8_LO(At[m]), acc[ai][bj][m][n], 0, 0, 0); \
               acc[ai][bj][m][n] = __builtin_amdgcn_mfma_f32_16x16x32_bf16(PG8_HI(Bt[n]), PG8_HI(At[m]), acc[ai][bj][m][n], 0, 0, 0); } } __builtin_amdgcn_s_setprio(0); } while (0)
#define PG8_WAIT_V(n) asm volatile("s_waitcnt vmcnt(" #n ")" ::: "memory")
#define PG8_STR_(x) #x
#define PG8_XSTR_(x) PG8_STR_(x)
#define PG8_WAIT_V8X() do { if (relax) asm volatile("s_waitcnt vmcnt(%0)" :: "n"(8 + Epi::NST) : "memory"); else asm volatile("s_waitcnt vmcnt(8)" ::: "memory"); } while (0)
#define PG8_WAIT_L(n) asm volatile("s_waitcnt lgkmcnt(" #n ")" ::: "memory")
#define PG8_BAR __builtin_amdgcn_s_barrier()
#define PG8_SCHED __builtin_amdgcn_sched_barrier(0)
    Unit cur, nxt; int ui = 0;
    cur.e = 0; if (!S.next(0, cur)) return;
    nxt = cur;
    f32x4 acc[2][2][4][2];
#pragma unroll
    for (int a = 0; a < 2; ++a)
#pragma unroll
        for (int b = 0; b < 2; ++b)
#pragma unroll
            for (int m = 0; m < 4; ++m)
#pragma unroll
                for (int n = 0; n < 2; ++n) acc[a][b][m][n] = (f32x4){0.f, 0.f, 0.f, 0.f};
    v8i32_t At[4], B0[2], B1[2];
    unsigned cA = GATHER ? 0u : (unsigned)cur.am * tstepA, cB = (unsigned)cur.bn * tstepB;
    if constexpr (GATHER) { PG8_GOFF(cur.am, vA0[0], vA0[1], vA1[0], vA1[1]); }
    else { vA0[0] = voffA[0]; vA0[1] = voffA[1]; vA1[0] = voffA[0] + hstepA; vA1[1] = voffA[1] + hstepA; }
    PG8_STAGE(PG8_SB(0, 0), rB, cB, voffB); PG8_STAGE(PG8_SB(0, 1), rB, cB + hstepB, voffB); PG8_STAGE_A(PG8_SA(0, 0), cA, 0, vA0, vA1); PG8_STAGE_A(PG8_SA(0, 1), cA, 1, vA0, vA1);
    if (wr == 1) PG8_BAR;
    PG8_WAIT_V(2); PG8_BAR;
    PG8_STAGE(PG8_SB(1, 0), rB, cB + kstep, voffB); PG8_STAGE_A(PG8_SA(1, 0), cA + kstep, 0, vA0, vA1); PG8_STAGE(PG8_SB(1, 1), rB, cB + hstepB + kstep, voffB);
    PG8_WAIT_V(6); PG8_BAR;
    for (;;) {
        const bool has_next = S.next(ui + 1, nxt);
        const unsigned nA = (has_next && !GATHER) ? (unsigned)nxt.am * tstepA : cA, nB = has_next ? (unsigned)nxt.bn * tstepB : cB;
        if constexpr (GATHER) { const int am_ = has_next ? nxt.am : cur.am; u32x4 nv_; PG8_GOFF(am_, nv_.x, nv_.y, nv_.z, nv_.w); *gnx = nv_; }
        for (int t = 0; t < nt; t += 2) {
            const bool last = (t == nt - 2); const bool relax = Epi::NST > 0 && t == 0 && ui > 0;
            const unsigned a1 = cA + (unsigned)(t + 1) * kstep;
            const unsigned a2 = last ? nA : cA + (unsigned)(t + 2) * kstep, b2 = last ? nB : cB + (unsigned)(t + 2) * kstep;
            const unsigned a3 = a2 + kstep, b3 = b2 + kstep;
            if constexpr (GATHER) { if (last) { const u32x4 nv_ = *gnx; vA0[0] = nv_.x; vA0[1] = nv_.y; }
            } else if constexpr (FP8) { if (last) asm volatile("s_nop 0"); }
            PG8_LDB(B0, 0, 0); PG8_LDB(B1, 0, 1); PG8_SCHED; PG8_LDA(At, 0, 0); PG8_STAGE_A(PG8_SA(1, 1), a1, 1, vA0, vA1);
            PG8_WAIT_V8X(); PG8_WAIT_L(0); PG8_BAR; PG8_MMA(0, 0, At, B0); PG8_MMA(0, 1, At, B1); PG8_BAR; PG8_SCHED;
            PG8_LDA(At, 0, 1); PG8_STAGE(PG8_SB(0, 0), rB, b2, voffB); PG8_STAGE(PG8_SB(0, 1), rB, b2 + hstepB, voffB); PG8_STAGE_A(PG8_SA(0, 0), a2, 0, vA0, vA1);
            if constexpr (GATHER) { if (last) { const u32x4 nv_ = *gnx; vA1[0] = nv_.z; vA1[1] = nv_.w; } }
            else if constexpr (FP8) { if (last) asm volatile("s_nop 0"); }
            PG8_WAIT_V8X(); PG8_WAIT_L(0); PG8_BAR; PG8_MMA(1, 0, At, B0); PG8_MMA(1, 1, At, B1); PG8_BAR; PG8_SCHED;
            PG8_LDB(B0, 1, 0); PG8_LDB(B1, 1, 1); PG8_SCHED; PG8_LDA(At, 1, 0); PG8_STAGE_A(PG8_SA(0, 1), a2, 1, vA0, vA1);
            PG8_WAIT_V(8); PG8_WAIT_L(0); PG8_BAR; PG8_MMA(0, 0, At, B0); PG8_MMA(0, 1, At, B1); PG8_BAR; PG8_SCHED;
            PG8_LDA(At, 1, 1); PG8_STAGE(PG8_SB(1, 0), rB, b3, voffB); PG8_STAGE(PG8_SB(1, 1), rB, b3 + hstepB, voffB); PG8_STAGE_A(PG8_SA(1, 0), a3, 0, vA0, vA1);
            PG8_WAIT_V(8); PG8_WAIT_L(0); PG8_BAR; PG8_MMA(1, 0, At, B0); PG8_MMA(1, 1, At, B1); PG8_BAR; PG8_SCHED;
        }
        if constexpr (ALIGN_EPI) { if (wr == 0) PG8_BAR; }
        PG8_SCHED;
        { int fr_ = fr, fq_ = fq; asm volatile("" : "+v"(fr_), "+v"(fq_));
          E(acc, cur, wr, wc, fr_, fq_); }
        if (!has_next) break;
#pragma unroll
        for (int a = 0; a < 2; ++a)
#pragma unroll
            for (int b = 0; b < 2; ++b)
#pragma unroll
                for (int m = 0; m < 4; ++m)
#pragma unroll
                    for (int n = 0; n < 2; ++n) acc[a][b][m][n] = (f32x4){0.f, 0.f, 0.f, 0.f};
        cur = nxt; cA = nA; cB = nB; ++ui;
        if constexpr (ALIGN_EPI) { if (wr == 1) PG8_BAR; }
    }
    PG8_WAIT_V(0);
    if constexpr (!ALIGN_EPI) { if (wr == 0) PG8_BAR; }
    PG8_BAR;
#undef PG8_SA
#undef PG8_SB
#undef PG8_STAGE
#undef PG8_STAGE_A
#undef PG8_GOFF
#undef PG8_LDA
#undef PG8_LDB
#undef PG8_MMA
#undef PG8_LO
#undef PG8_HI
#undef PG8_WAIT_V
#undef PG8_WAIT_V8X
#undef PG8_WAIT_L
#undef PG8_BAR
#undef PG8_SCHED
}
}
struct PlainOrder {
    int nM, nN, nwg, G, c, latent_only;
    __device__ void init(int nM_, int nN_, int G_, int c_, int latent_only_) { nM = nM_; nN = nN_; nwg = nM * nN; G = G_; c = c_; latent_only = latent_only_; }
    __device__ bool next(int i, pg8::Unit& u) const {
        const long L = (long)i * G + c; if (L >= nwg) return false;
        int wgid = (int)L; { const int q = nwg / 8, r = nwg % 8, xcd = wgid % 8, off = wgid / 8; wgid = (xcd < r ? xcd * (q + 1) : r * (q + 1) + (xcd - r) * q) + off; }
        const int WGM = 8, nig = WGM * nN, gid = wgid / nig, fm = gid * WGM, gsz = (nM - fm) < WGM ? (nM - fm) : WGM;
        const int pm = fm + ((wgid % nig) % gsz), pn = (wgid % nig) / gsz;
        u.pm = pm; u.pn = pn; u.e = 0; u.bn = pn;
        u.am = latent_only ? (pm >> 5) * 33 + 1 + (pm & 31) : pm;
        return true;
    }
};
struct ProjOrder {
    PlainOrder P; int G, c, part, split;
    __device__ void init(int G_, int c_, int part_) { G = G_; c = c_; part = part_; split = (G_ == 256); P.init(MALL / 256, 7, G_, c_, 0); }
    __device__ bool next(int i, pg8::Unit& u) const {
        int pm, pn;
        if (part == 0) { const long L = (long)i * G + c; if (L >= (split ? 1024 : 1056)) return false;
            if (L < 924) { if (!P.next(i, u)) return false; pm = u.pm; pn = u.pn + 1; } else { pm = (int)L - 924; pn = 0; }
            if (split && pm % 33 == 0 && (pn == 0 || pn == 1 || pn == 6)) { pm = 100 + (pm / 33) * 3 + (pn == 0 ? 0 : pn == 1 ? 1 : 2); pn = 0; } }
        else { if (!split || i > 0 || c >= 20) return false; pm = 112 + c; pn = 0; }
        u.pm = pm; u.pn = pn; u.e = 0; u.bn = pn; u.am = pm; return true;
    }
};
struct MoeOrder {
    const int* seg; int NT, ncol, G, c;
    __device__ bool next(int i, pg8::Unit& u) const {
        int rt, pn;
        if (G == 256) { const int x = c & 7, s = c >> 3;
            if (ncol == 8) { rt = i * 32 + x * 4 + (s >> 3); pn = s & 7; } else { rt = i * 64 + x * 8 + (s >> 2); pn = s & 3; } }
        else { const long L = (long)i * G + c; rt = (int)(L / ncol); pn = (int)(L % ncol); }
        if (rt >= NT) return false;
        const int r0 = rt * 256; int e = u.e;
        while (e < 31 && r0 >= seg[e + 1]) ++e;
        u.am = rt; u.pm = rt; u.pn = pn; u.e = e; u.bn = e * ncol + pn; return true;
    }
};

typedef f32x4 AccT[2][2][4][2];
constexpr float QSCALE_DIFF = 0.125f * 1.4426950408889634f;
constexpr float QSCALE_MLA = 0.07216878364870322f * 1.4426950408889634f;
struct EpiProj {
    static constexpr int NST = 0;
    bf16_t* PJ; const f32x2* rope; float* rsq; float* rskv; unsigned char* ws;
    __device__ __forceinline__ void operator()(const AccT& acc, const pg8::Unit& u, int wr, int wc, int fr, int fq) const {
        const int pm = u.pm, pn = u.pn; const bool latent = (pm % 33) != 0;
        const int a = wc & 1;
#pragma unroll
        for (int ai = 0; ai < 2; ++ai)
#pragma unroll
            for (int m = 0; m < 4; ++m) {
                const int row = pm * 256 + ai * 128 + wr * 64 + m * 16 + fr;
                const int i = row % RPB, pos = i - CTX, pv = a ? (pos & 63) : (pos >> 6);
                float ss = 0.f;
#pragma unroll
                for (int bj = 0; bj < 2; ++bj) {
                    f32x4 v0 = acc[ai][bj][m][0] * (P2_FP8 ? 1.f / WQ_SCALE : 1.f), v1 = acc[ai][bj][m][1] * (P2_FP8 ? 1.f / WQ_SCALE : 1.f);
                    if (pn == 6 || (pn == 7 && bj == 0)) ss += (v0.x * v0.x + v0.y * v0.y) + (v0.z * v0.z + v0.w * v0.w) + (v1.x * v1.x + v1.y * v1.y) + (v1.z * v1.z + v1.w * v1.w);
                    if (pn < 2) { v0 = v0 * QSCALE_DIFF; v1 = v1 * QSCALE_DIFF; }
                    const bool rp = latent && (pn < 4 || (pn == 7 && bj == 1 && wc < 2));
                    if (rp) { const f32x4* t = (const f32x4*)(rope + pv * 16 + 4 * fq); const f32x4 t0 = t[0], t1 = t[1];
                        const f32x4 cs = {t0.x, t0.z, t1.x, t1.z}, sn = {t0.y, t0.w, t1.y, t1.w};
                        const f32x4 o0 = v0 * cs - v1 * sn, o1 = v1 * cs + v0 * sn; v0 = o0; v1 = o1; }
#ifdef SIM_FP8_ATT
                    if (pn < 6 || (pn == 7 && bj == 1 && wc < 2)) { v0 = (f32x4){q8(v0.x), q8(v0.y), q8(v0.z), q8(v0.w)}; v1 = (f32x4){q8(v1.x), q8(v1.y), q8(v1.z), q8(v1.w)}; }
#endif
#if ATT_FP8
                    const int cl = (pn & 1) * 256 + bj * 128 + wc * 32 + 4 * fq;
                    if (pn < 4) { unsigned char* d8 = ws + (pn < 2 ? WS_Q8D : WS_K8D) + (size_t)row * 512 + cl;
                        *(unsigned*)d8 = cvt4_fp8(v0.x, v0.y, v0.z, v0.w); *(unsigned*)(d8 + 16) = cvt4_fp8(v1.x, v1.y, v1.z, v1.w); }
                    else if (pn < 6) { const int b_ = row / RPB, i_ = row - b_ * RPB, hh = cl >> 7, e0 = cl & 127;
                        unsigned char* d8 = ws + WS_VT8D + ((size_t)(b_ * 4 + hh) * 128 + e0 + (fr & 3)) * RPB + (i_ & ~63) + vt_pos(i_ & 60);
                        *(unsigned*)d8 = quad_tr_bytes(cvt4_fp8(v0.x, v0.y, v0.z, v0.w), fr & 3); *(unsigned*)(d8 + 16 * RPB) = quad_tr_bytes(cvt4_fp8(v1.x, v1.y, v1.z, v1.w), fr & 3); }
                    else if (pn == 7 && bj == 1 && wc < 2) { unsigned char* d8 = ws + WS_KR8 + (size_t)row * 64 + wc * 32 + 4 * fq;
                        *(unsigned*)d8 = cvt4_fp8(v0.x, v0.y, v0.z, v0.w); *(unsigned*)(d8 + 16) = cvt4_fp8(v1.x, v1.y, v1.z, v1.w); }
                    if (pn >= 6)
#endif
                    { bf16_t* dst = PJ + (size_t)row * NPROJ + pn * 256 + bj * 128 + wc * 32 + 4 * fq;
                    u32x2 w0, w1; w0.x = cvt_pk_bf16(v0.x, v0.y); w0.y = cvt_pk_bf16(v0.z, v0.w); w1.x = cvt_pk_bf16(v1.x, v1.y); w1.y = cvt_pk_bf16(v1.z, v1.w);
                    *(u32x2*)dst = w0; *(u32x2*)(dst + 16) = w1; }
                }
                if (pn >= 6) { ss += __shfl_xor(ss, 16); ss += __shfl_xor(ss, 32); if (fq == 0) atomicAdd((pn == 6 ? rsq : rskv) + row, ss); }
                asm volatile("" ::: "memory");
            }
    }
};
struct EpiQ {
    static constexpr int NST = 0;
    bf16_t* QM; const f32x2* rope; const float* rsq; unsigned char* ws;
    __device__ __forceinline__ void operator()(const AccT& acc, const pg8::Unit& u, int wr, int wc, int fr, int fq) const {
        const int pm = u.am, pn = u.pn;     const bool latent = (pm % 33) != 0;
#pragma unroll
        for (int ai = 0; ai < 2; ++ai)
#pragma unroll
            for (int m = 0; m < 4; ++m) {
                const int row = pm * 256 + ai * 128 + wr * 64 + m * 16 + fr;
                const float rq = rsqrtf(rsq[row] * (1.f / 256.f) + EPS);
                const int i = row % RPB, pos = i - CTX;
#pragma unroll
                for (int bj = 0; bj < 2; ++bj) {
                    f32x4 v0 = acc[ai][bj][m][0] * rq, v1 = acc[ai][bj][m][1] * rq;
                    const int g6 = (pn * 8 + bj * 4 + wc) % 6;
                    if (latent && g6 >= 4) { const int pv = (g6 == 5) ? (pos & 63) : (pos >> 6);
                        const f32x4* t = (const f32x4*)(rope + pv * 16 + 4 * fq); const f32x4 t0 = t[0], t1 = t[1];
                        const f32x4 cs = {t0.x, t0.z, t1.x, t1.z}, sn = {t0.y, t0.w, t1.y, t1.w};
                        const f32x4 o0 = v0 * cs - v1 * sn, o1 = v1 * cs + v0 * sn; v0 = o0; v1 = o1; }
#ifdef SIM_FP8_ATT
                    v0 = (f32x4){q8(v0.x), q8(v0.y), q8(v0.z), q8(v0.w)}; v1 = (f32x4){q8(v1.x), q8(v1.y), q8(v1.z), q8(v1.w)};
#endif
#if ATT_FP8
                    { unsigned char* d8 = ws + WS_Q8M + (size_t)row * 768 + pn * 256 + bj * 128 + wc * 32 + 4 * fq; v0 = v0 * QSCALE_MLA; v1 = v1 * QSCALE_MLA;
                      *(unsigned*)d8 = cvt4_fp8(v0.x, v0.y, v0.z, v0.w); *(unsigned*)(d8 + 16) = cvt4_fp8(v1.x, v1.y, v1.z, v1.w); }
#else
                    bf16_t* dst = QM + (size_t)row * 768 + pn * 256 + bj * 128 + wc * 32 + 4 * fq;
                    u32x2 w0, w1; w0.x = cvt_pk_bf16(v0.x, v0.y); w0.y = cvt_pk_bf16(v0.z, v0.w); w1.x = cvt_pk_bf16(v1.x, v1.y); w1.y = cvt_pk_bf16(v1.z, v1.w);
                    *(u32x2*)dst = w0; *(u32x2*)(dst + 16) = w1;
#endif
                }
            }
    }
};
struct EpiKV {
    static constexpr int NST = 0;
    bf16_t* KV; const float* rskv; unsigned char* ws;
    __device__ __forceinline__ void operator()(const AccT& acc, const pg8::Unit& u, int wr, int wc, int fr, int fq) const {
        const int pm = u.pm, pn = u.pn;
#pragma unroll
        for (int ai = 0; ai < 2; ++ai)
#pragma unroll
            for (int m = 0; m < 4; ++m) {
                const int row = pm * 256 + ai * 128 + wr * 64 + m * 16 + fr;
                const float rk = rsqrtf(rskv[row] * (1.f / 128.f) + EPS);
#pragma unroll
                for (int bj = 0; bj < 2; ++bj) {
                    f32x4 v0 = acc[ai][bj][m][0] * rk, v1 = acc[ai][bj][m][1] * rk;
#ifdef SIM_FP8_ATT
                    v0 = (f32x4){q8(v0.x), q8(v0.y), q8(v0.z), q8(v0.w)}; v1 = (f32x4){q8(v1.x), q8(v1.y), q8(v1.z), q8(v1.w)};
#endif
#if ATT_FP8
                    if (bj == 0) { unsigned char* d8 = ws + WS_K8M + (size_t)row * 512 + pn * 128 + wc * 32 + 4 * fq;
                        *(unsigned*)d8 = cvt4_fp8(v0.x, v0.y, v0.z, v0.w); *(unsigned*)(d8 + 16) = cvt4_fp8(v1.x, v1.y, v1.z, v1.w); }
                    else { const int b_ = row / RPB, i_ = row - b_ * RPB, e0 = wc * 32 + 4 * fq;
                        unsigned char* d8 = ws + WS_VT8M + ((size_t)(b_ * 4 + pn) * 128 + e0 + (fr & 3)) * RPB + (i_ & ~63) + vt_pos(i_ & 60);
                        *(unsigned*)d8 = quad_tr_bytes(cvt4_fp8(v0.x, v0.y, v0.z, v0.w), fr & 3); *(unsigned*)(d8 + 16 * RPB) = quad_tr_bytes(cvt4_fp8(v1.x, v1.y, v1.z, v1.w), fr & 3); }
#else
                    bf16_t* dst = KV + (size_t)row * 1024 + pn * 256 + bj * 128 + wc * 32 + 4 * fq;
                    u32x2 w0, w1; w0.x = cvt_pk_bf16(v0.x, v0.y); w0.y = cvt_pk_bf16(v0.z, v0.w); w1.x = cvt_pk_bf16(v1.x, v1.y); w1.y = cvt_pk_bf16(v1.z, v1.w);
                    *(u32x2*)dst = w0; *(u32x2*)(dst + 16) = w1;
#endif
                }
            }
    }
};
struct EpiOut {
    static constexpr int NST = 0;
    bf16_t* XN; const float* x; const float* mods; float* rsx;
    __device__ __forceinline__ void operator()(const AccT& acc, const pg8::Unit& u, int wr, int wc, int fr, int fq) const {
        const int pm = u.pm, pn = u.pn, b = pm >> 5;
        const float* ga = mods + b * 6144 + 2 * 1024;
        float ssr[2][4];
#pragma unroll
        for (int ai = 0; ai < 2; ++ai)
#pragma unroll
            for (int m = 0; m < 4; ++m) ssr[ai][m] = 0.f;
#pragma unroll
        for (int bj = 0; bj < 2; ++bj) { const int cb = pn * 256 + bj * 128 + wc * 32;
            const f32x4 gv0 = *(const f32x4*)(ga + cb + 4 * fq), gv1 = *(const f32x4*)(ga + cb + 16 + 4 * fq);
#pragma unroll
            for (int ai = 0; ai < 2; ++ai)
#pragma unroll
                for (int m = 0; m < 4; ++m) { const size_t ro = (size_t)(pm * 256 + ai * 128 + wr * 64 + m * 16 + fr) * DM + cb;
                    const f32x4 v0 = __builtin_nontemporal_load((const f32x4*)(x + ro + 4 * fq)) + gv0 * (acc[ai][bj][m][0] * (P6_FP8 ? 1.f / WQ_SCALE : 1.f)), v1 = __builtin_nontemporal_load((const f32x4*)(x + ro + 16 + 4 * fq)) + gv1 * (acc[ai][bj][m][1] * (P6_FP8 ? 1.f / WQ_SCALE : 1.f));
                    ssr[ai][m] += ((v0.x * v0.x + v0.y * v0.y) + (v0.z * v0.z + v0.w * v0.w)) + ((v1.x * v1.x + v1.y * v1.y) + (v1.z * v1.z + v1.w * v1.w));
                    unsigned ax = cvt_pk_bf16(v0.x, v0.y), ay = cvt_pk_bf16(v0.z, v0.w), bx = cvt_pk_bf16(v1.x, v1.y), by = cvt_pk_bf16(v1.z, v1.w);
                    { auto r_ = __builtin_amdgcn_permlane32_swap(ax, bx, false, false); ax = r_[0]; bx = r_[1]; } { auto r_ = __builtin_amdgcn_permlane32_swap(ay, by, false, false); ay = r_[0]; by = r_[1]; }
                    { auto r_ = __builtin_amdgcn_permlane16_swap(ax, bx, false, false); ax = r_[0]; bx = r_[1]; } { auto r_ = __builtin_amdgcn_permlane16_swap(ay, by, false, false); ay = r_[0]; by = r_[1]; }
                    *(u32x4*)(XN + ro + 8 * fq) = (u32x4){ax, ay, bx, by}; } }
#pragma unroll
        for (int ai = 0; ai < 2; ++ai)
#pragma unroll
            for (int m = 0; m < 4; ++m) { float s = ssr[ai][m]; s += __shfl_xor(s, 16); s += __shfl_xor(s, 32);
                if (fq == 0) atomicAdd(rsx + pm * 256 + ai * 128 + wr * 64 + m * 16 + fr, s); }
    }
};
struct EpiAct {
    static constexpr int NST = 16;
    unsigned char* ACT; const float* b1;
    __device__ __forceinline__ void operator()(const AccT& acc, const pg8::Unit& u, int wr, int wc, int fr, int fq) const {
        const int pm = u.pm, pn = u.pn; const float* bb = b1 + (size_t)u.e * 2048;
#pragma unroll
        for (int n = 0; n < 2; ++n) { const int col = pn * 128 + wc * 32 + n * 16 + 4 * fq; const f32x4 bg = *(const f32x4*)(bb + col), bu = *(const f32x4*)(bb + 1024 + col);
#pragma unroll
            for (int ai = 0; ai < 2; ++ai)
#pragma unroll
                for (int m = 0; m < 4; ++m) { const int row = pm * 256 + ai * 128 + wr * 64 + m * 16 + fr;
                    const f32x4 gq = acc[ai][0][m][n] * (1.f / WQ_SCALE) + bg, uq = acc[ai][1][m][n] * (1.f / WQ_SCALE) + bu; float o[4];
#pragma unroll
                    for (int e = 0; e < 4; ++e) { const float gg = fminf(gq[e], 7.f), uu = fminf(fmaxf(uq[e], -7.f), 7.f);
                        o[e] = gg * __builtin_amdgcn_rcpf(1.f + __builtin_amdgcn_exp2f(gg * (-1.702f * 1.4426950408889634f))) * (uu + 1.f); }
                    *(unsigned*)(ACT + (size_t)row * 1024 + col) = cvt4_fp8(o[0], o[1], o[2], o[3]); } }
    }
};
struct EpiY {
    static constexpr int NST = 16;
    bf16_t* YS; const float* b2; const float* gsrt; int mode = 0;
    __device__ __forceinline__ void operator()(const AccT& acc, const pg8::Unit& u, int wr, int wc, int fr, int fq) const {
        const int pm = u.pm, pn = u.pn; const float* bb = b2 + (size_t)u.e * 1024;
        float gt[2][4];
#pragma unroll
        for (int ai = 0; ai < 2; ++ai)
#pragma unroll
            for (int m = 0; m < 4; ++m) gt[ai][m] = gsrt[pm * 256 + ai * 128 + wr * 64 + m * 16 + fr] * (YS_FP8 ? YS_SCALE : 1.f);
#pragma unroll
        for (int bj = 0; bj < 2; ++bj) { const int cb = pn * 256 + bj * 128 + wc * 32;
            const f32x4 bv0 = *(const f32x4*)(bb + cb + 4 * fq), bv1 = *(const f32x4*)(bb + cb + 16 + 4 * fq);
#pragma unroll
            for (int ai = 0; ai < 2; ++ai)
#pragma unroll
                for (int m = 0; m < 4; ++m) { const int row = pm * 256 + ai * 128 + wr * 64 + m * 16 + fr;
                    const f32x4 v0 = (acc[ai][bj][m][0] * (1.f / WQ_SCALE) + bv0) * gt[ai][m], v1 = (acc[ai][bj][m][1] * (1.f / WQ_SCALE) + bv1) * gt[ai][m];
#if YS_FP8
                    unsigned ax = cvt4_fp8(v0.x, v0.y, v0.z, v0.w), bx = cvt4_fp8(v1.x, v1.y, v1.z, v1.w);
                    { auto r_ = __builtin_amdgcn_permlane32_swap(ax, bx, false, false); ax = r_[0]; bx = r_[1]; }
                    { auto r_ = __builtin_amdgcn_permlane16_swap(ax, bx, false, false); ax = r_[0]; bx = r_[1]; }
                    if (mode == 0 || ax == 0x12345678u) *(u32x2*)((unsigned char*)YS + (size_t)row * 1024 + cb + 8 * fq) = (u32x2){ax, bx};
#else
                    unsigned ax = cvt_pk_bf16(v0.x, v0.y), ay = cvt_pk_bf16(v0.z, v0.w), bx = cvt_pk_bf16(v1.x, v1.y), by = cvt_pk_bf16(v1.z, v1.w);
                    { auto r_ = __builtin_amdgcn_permlane32_swap(ax, bx, false, false); ax = r_[0]; bx = r_[1]; } { auto r_ = __builtin_amdgcn_permlane32_swap(ay, by, false, false); ay = r_[0]; by = r_[1]; }
                    { auto r_ = __builtin_amdgcn_permlane16_swap(ax, bx, false, false); ax = r_[0]; bx = r_[1]; } { auto r_ = __builtin_amdgcn_permlane16_swap(ay, by, false, false); ay = r_[0]; by = r_[1]; }
                    if (mode == 0 || ax == 0x12345678u) *(u32x4*)(YS + (size_t)row * 1024 + cb + 8 * fq) = (u32x4){ax, ay, bx, by};
#endif
                } }
    }
};
namespace attn {
using bf16x8 = __attribute__((ext_vector_type(8))) short;
using s16x4  = __attribute__((ext_vector_type(4))) short;
using f32x16 = __attribute__((ext_vector_type(16))) float;
constexpr int QBLK = 32, KVBLK = 64;
constexpr int SHM_V = KVBLK * 128 * 2;
#ifndef ATT_THR
#define ATT_THR 8.f
#endif
constexpr float THR = ATT_THR;
#define KOFF(row, ch) ((row) * 128 + ((((ch) ^ ((row) >> 1)) & 7) << 4))
#define SBAR() __builtin_amdgcn_sched_barrier(0)
__device__ __forceinline__ int crow(int r, int hi) { return (r & 3) + 8 * (r >> 2) + 4 * hi; }

template <int VAR = 0>
__device__ __forceinline__ void partialSM(f32x16& p0, f32x16& p1, float& m_reg, float& mn, float& alpha, const float C, const float thr_raw) {
  if constexpr (VAR == 1) { mn = m_reg; alpha = 1.f;
    _Pragma("unroll") for (int r = 0; r < 16; ++r) { p0[r] = p0[r] * C; p1[r] = p1[r] * C; } return; }
  float pmax = p0[0];
#pragma unroll
  for (int r = 1; r < 16; ++r) pmax = fmaxf(pmax, p0[r]);
#pragma unroll
  for (int r = 0; r < 16; ++r) pmax = fmaxf(pmax, p1[r]);
  { auto rr = __builtin_amdgcn_permlane32_swap(__float_as_uint(pmax), __float_as_uint(pmax), false, false);
    pmax = fmaxf(__uint_as_float(rr[0]), __uint_as_float(rr[1])); }
  if (__builtin_expect(__all(pmax - m_reg <= thr_raw), 1)) { mn = m_reg; alpha = 1.f; }
  else { mn = fmaxf(m_reg, pmax); alpha = __builtin_amdgcn_exp2f((m_reg - mn) * C); m_reg = mn; }
  const float mnC = -mn * C + PSHIFT;
#pragma unroll
  for (int r = 0; r < 16; ++r) p0[r] = fmaf(p0[r], C, mnC);
#pragma unroll
  for (int r = 0; r < 16; ++r) p1[r] = fmaf(p1[r], C, mnC);
#pragma unroll
  for (int r = 0; r < 16; ++r) p0[r] = __builtin_amdgcn_exp2f(p0[r]);
}
template <int VAR = 0>
__device__ __forceinline__ void finishSM(f32x16& p0, f32x16& p1, float alpha, float& l_reg, bf16x8& pa0, bf16x8& pa1, bf16x8& pa2, bf16x8& pa3) {
  if constexpr (VAR != 1) {
#pragma unroll
  for (int r = 0; r < 16; ++r) p1[r] = __builtin_amdgcn_exp2f(p1[r]); }
  float ps = 0;
#pragma unroll
  for (int r = 0; r < 16; ++r) ps += p0[r];
#pragma unroll
  for (int r = 0; r < 16; ++r) ps += p1[r];
  { auto rr = __builtin_amdgcn_permlane32_swap(__float_as_uint(ps), __float_as_uint(ps), false, false);
    ps = __uint_as_float(rr[0]) + __uint_as_float(rr[1]); }
  l_reg = l_reg * alpha + ps;
#define PK4(P, BASE, OUT) do { unsigned a0 = cvt_pk_bf16(P[BASE + 0], P[BASE + 1]), a1 = cvt_pk_bf16(P[BASE + 2], P[BASE + 3]);   \
    unsigned b0 = cvt_pk_bf16(P[BASE + 4], P[BASE + 5]), b1 = cvt_pk_bf16(P[BASE + 6], P[BASE + 7]);                              \
    auto r0 = __builtin_amdgcn_permlane32_swap(a0, b0, false, false); auto r1 = __builtin_amdgcn_permlane32_swap(a1, b1, false, false); \
    u32x4 w = {r0[0], r1[0], r0[1], r1[1]}; OUT = *reinterpret_cast<bf16x8*>(&w); } while (0)
  PK4(p0, 0, pa0); PK4(p0, 8, pa1); PK4(p1, 0, pa2); PK4(p1, 8, pa3);
#undef PK4
}
template <int NKC, int NQR, int KBOFF>
__device__ __forceinline__ void qkt(f32x16& p0, f32x16& p1, const int* kb, const bf16x8* qr, int ql) {
  p0 = f32x16{}; p1 = f32x16{};
  if constexpr (NQR != NKC) asm volatile("" : "+v"(ql));
#pragma unroll
  for (int c = 0; c < NKC; ++c)
#pragma unroll
    for (int d0 = 0; d0 < 4; ++d0) {
      const bf16x8 b0 = *(const LAS bf16x8*)(uintptr_t)(unsigned)(kb[d0] + (KBOFF + c * 8192));
      const bf16x8 b1 = *(const LAS bf16x8*)(uintptr_t)(unsigned)(kb[d0] + (KBOFF + c * 8192 + 4096));
      bf16x8 qf; if constexpr (NQR == NKC) qf = qr[c * 4 + d0]; else { if (c < NQR) qf = qr[(c < NQR ? c : 0) * 4 + d0]; else qf = *(const LAS bf16x8*)(uintptr_t)(unsigned)(ql + ((c - NQR) * 4 + d0) * 1024); }
      p0 = __builtin_amdgcn_mfma_f32_32x32x16_bf16(b0, qf, p0, 0, 0, 0);
      p1 = __builtin_amdgcn_mfma_f32_32x32x16_bf16(b1, qf, p1, 0, 0, 0); }
}
__device__ __forceinline__ int v_st(int k, int c) { const int kk = (k & ~0xC) | ((k & 4) << 1) | ((k & 8) >> 1); return ((kk >> 3) * 4 + (c >> 5)) * 512 + ((kk & 7) * 32 + (c & 31)) * 2; }
__device__ __forceinline__ int v_rd_base(int lane) { return ((lane & 3) << 3) | (((lane >> 2) & 3) << 6) | (((lane >> 4) & 1) << 5) | (((lane >> 5) & 1) << 8); }
constexpr int v_rd_off(int d0, int ks, int half) { return d0 * 512 + ks * 4096 + half * 2048; }
template <int OFF> __device__ __forceinline__ s16x4 tr_read(int vb) {
  s16x4 r; asm volatile("ds_read_b64_tr_b16 %0, %1 offset:%2" : "=&v"(r) : "v"(vb), "i"(OFF) : "memory"); return r;
}
template <int D0> __device__ __forceinline__ void pv_one(f32x16& od, int vb, bf16x8 pa0, bf16x8 pa1, bf16x8 pa2, bf16x8 pa3) {
  const s16x4 l0 = tr_read<v_rd_off(D0, 0, 0)>(vb), h0 = tr_read<v_rd_off(D0, 0, 1)>(vb), l1 = tr_read<v_rd_off(D0, 1, 0)>(vb), h1 = tr_read<v_rd_off(D0, 1, 1)>(vb);
  const s16x4 l2 = tr_read<v_rd_off(D0, 2, 0)>(vb), h2 = tr_read<v_rd_off(D0, 2, 1)>(vb), l3 = tr_read<v_rd_off(D0, 3, 0)>(vb), h3 = tr_read<v_rd_off(D0, 3, 1)>(vb);
  asm volatile("s_waitcnt lgkmcnt(0)" ::: "memory"); SBAR();
#define PK(L, H) (bf16x8){L[0], L[1], L[2], L[3], H[0], H[1], H[2], H[3]}
  od = __builtin_amdgcn_mfma_f32_32x32x16_bf16(pa0, PK(l0, h0), od, 0, 0, 0);
  od = __builtin_amdgcn_mfma_f32_32x32x16_bf16(pa1, PK(l1, h1), od, 0, 0, 0);
  od = __builtin_amdgcn_mfma_f32_32x32x16_bf16(pa2, PK(l2, h2), od, 0, 0, 0);
  od = __builtin_amdgcn_mfma_f32_32x32x16_bf16(pa3, PK(l3, h3), od, 0, 0, 0);
#undef PK
}
__device__ __forceinline__ void pv_d0(f32x16* o, int vb, bf16x8 pa0, bf16x8 pa1, bf16x8 pa2, bf16x8 pa3) {
  pv_one<0>(o[0], vb, pa0, pa1, pa2, pa3); pv_one<1>(o[1], vb, pa0, pa1, pa2, pa3); pv_one<2>(o[2], vb, pa0, pa1, pa2, pa3); pv_one<3>(o[3], vb, pa0, pa1, pa2, pa3);
}

typedef short v4i16 __attribute__((ext_vector_type(4)));
template <int OFF> __device__ __forceinline__ bf16x8 vfrag(int vb) {
  const v4i16 l = __builtin_amdgcn_ds_read_tr16_b64_v4i16((LAS v4i16*)(uintptr_t)(unsigned)(vb + OFF));
  const v4i16 h = __builtin_amdgcn_ds_read_tr16_b64_v4i16((LAS v4i16*)(uintptr_t)(unsigned)(vb + OFF + 2048));
  return (bf16x8){l[0], l[1], l[2], l[3], h[0], h[1], h[2], h[3]};
}
__device__ __forceinline__ float max3f(float a, float b, float c) { return __builtin_fmaxf(__builtin_fmaxf(a, b), c); }
#define PK4X(P, BASE, OUT) do { unsigned a0 = cvt_pk_bf16(Q8(P[BASE + 0]), Q8(P[BASE + 1])), a1 = cvt_pk_bf16(Q8(P[BASE + 2]), Q8(P[BASE + 3]));   \
    unsigned b0 = cvt_pk_bf16(Q8(P[BASE + 4]), Q8(P[BASE + 5])), b1 = cvt_pk_bf16(Q8(P[BASE + 6]), Q8(P[BASE + 7]));                              \
    auto r0 = __builtin_amdgcn_permlane32_swap(a0, b0, false, false); auto r1 = __builtin_amdgcn_permlane32_swap(a1, b1, false, false); \
    u32x4 w = {r0[0], r1[0], r0[1], r1[1]}; OUT = *reinterpret_cast<bf16x8*>(&w); } while (0)

template <int NKC, int NQR, int VAR = 0, int OM = 0>
__device__ __forceinline__ void attn_unit(const bf16_t* __restrict__ Qb, int ldq, const bf16_t* kp0, int kld0, const bf16_t* kp1, int kld1, const bf16_t* kp2, int kld2,
                                          const bf16_t* __restrict__ Vh, int ldv, bf16_t* __restrict__ Ob, int ldo, int seq, const float C, char* lds,
                                          char* stash = nullptr, const float lam = 0.f, const float* __restrict__ subw = nullptr) {
  constexpr int SHM_K = NKC * 8192, NG = NKC * 8;
  const int tid = tid_opaque(), wid = tid >> 6, lane = tid & 63, r32 = lane & 31, hi = lane >> 5;
  const float thr_raw = THR * 1.4426950408889634f / C;
  char* V_lds = lds; char* K_lds = lds + 3 * SHM_V;
  float* ws = (float*)(lds + 3 * SHM_V + 3 * SHM_K) + wid * 64; float* li_l = ws; float* al_l = ws + 32;
  float m_reg = -1e30f, l_reg = 0; f32x16 o[4] = {}; bf16x8 qr[NQR * 4];
  const bf16_t* Qw = Qb + (long)(wid * QBLK + r32) * ldq + hi * 8;
  int ql = (int)(uintptr_t)(lds + 3 * SHM_V + 3 * SHM_K + 2048) + wid * ((NKC - NQR) * 4096) + lane * 16;
  int kb[4];
#pragma unroll
  for (int d0 = 0; d0 < 4; ++d0) kb[d0] = (int)(uintptr_t)K_lds + KOFF(r32, d0 * 2 + hi);
  __syncthreads();
#pragma unroll
  for (int d0 = 0; d0 < NQR * 4; ++d0) qr[d0] = *reinterpret_cast<const bf16x8*>(Qw + d0 * 16);
#pragma unroll
  for (int d0 = NQR * 4; d0 < NKC * 4; ++d0) *(LAS bf16x8*)(uintptr_t)(unsigned)(ql + (d0 - NQR * 4) * 1024) = *reinterpret_cast<const bf16x8*>(Qw + d0 * 16);
  const int sr = tid >> 4, sc = (tid & 15) * 8, vst0 = v_st(sr, sc), vst1 = v_st(32 + sr, sc);
  const int krow = tid >> 3, kch = tid & 7, kst = KOFF(krow, kch);
  const int vb0 = (int)(uintptr_t)V_lds + v_rd_base(lane);
  const unsigned vo0 = (unsigned)(sr * ldv + sc) * 2u, vo1 = (unsigned)((32 + sr) * ldv + sc) * 2u;
  const unsigned ko0 = (unsigned)(krow * kld0 + kch * 8) * 2u, ko1 = (unsigned)(krow * kld1 + kch * 8) * 2u, ko2 = (unsigned)(krow * kld2 + kch * 8) * 2u;
  struct { bf16x8 vs0, vs1, k0, k1, k2; } sg;
  const __amdgpu_buffer_rsrc_t rV = __builtin_amdgcn_make_buffer_rsrc((void*)Vh, 0, 0xffffffff, 0x00020000);
  const __amdgpu_buffer_rsrc_t rK0 = __builtin_amdgcn_make_buffer_rsrc((void*)kp0, 0, 0xffffffff, 0x00020000);
  const __amdgpu_buffer_rsrc_t rK1 = __builtin_amdgcn_make_buffer_rsrc((void*)(NKC > 1 ? kp1 : kp0), 0, 0xffffffff, 0x00020000);
  const __amdgpu_buffer_rsrc_t rK2 = __builtin_amdgcn_make_buffer_rsrc((void*)(NKC > 2 ? kp2 : kp0), 0, 0xffffffff, 0x00020000);
#define BL128(r, vo, so) __builtin_bit_cast(bf16x8, __builtin_amdgcn_raw_buffer_load_b128(r, (int)(vo), (int)(so), 0))
#define SLOAD(kb_) do { const int so_ = (kb_) * (ldv * 2); \
    sg.vs0 = BL128(rV, vo0, so_); sg.vs1 = BL128(rV, vo1, so_); \
    sg.k0 = BL128(rK0, ko0, (kb_) * (kld0 * 2)); \
    if constexpr (NKC > 1) sg.k1 = BL128(rK1, ko1, (kb_) * (kld1 * 2)); \
    if constexpr (NKC > 2) sg.k2 = BL128(rK2, ko2, (kb_) * (kld2 * 2)); } while (0)
#define SWRITE(b) do { *(bf16x8*)(V_lds + (b) * SHM_V + vst0) = sg.vs0; *(bf16x8*)(V_lds + (b) * SHM_V + vst1) = sg.vs1; \
    *(bf16x8*)(K_lds + (b) * SHM_K + kst) = sg.k0; \
    if constexpr (NKC > 1) *(bf16x8*)(K_lds + (b) * SHM_K + 8192 + kst) = sg.k1; \
    if constexpr (NKC > 2) *(bf16x8*)(K_lds + (b) * SHM_K + 16384 + kst) = sg.k2; } while (0)
#define RESC(a) do { if (__any((a) < 1.f)) { if (hi == 0) al_l[r32] = (a); asm volatile("s_waitcnt lgkmcnt(0)" ::: "memory"); \
    _Pragma("unroll") for (int d = 0; d < 4; ++d) _Pragma("unroll") for (int r = 0; r < 16; ++r) o[d][r] *= al_l[crow(r, hi)]; } } while (0)
#define KLD(g, KB) (*(const LAS bf16x8*)(uintptr_t)(unsigned)(kb[((g) & 7) >> 1] + ((KB) + ((g) >> 3) * 8192 + ((g) & 1) * 4096)))
#define QLD(j) (*(const LAS bf16x8*)(uintptr_t)(unsigned)(ql + (j) * 1024))
  f32x16 pA0, pA1, pB0, pB1; float alA, alB; bf16x8 pa[4]; const int NT = seq / KVBLK;
  constexpr bool NEGM = (NKC == 1); f32x16 negm = {}; const float thr2 = THR * 1.4426950408889634f;
#define STEP(PN0, PN1, alN, PC0, PC1, alC, BKN, BVC, BW, DO_QK, DO_WR, DO_LD, tt) do { \
    bf16x8 kf[3], vf[3], qlf[2]; float ps = 0.f, mxa = 0.f, mxb = 0.f, mnC = 0.f; \
    SBAR(); \
    if (DO_QK) { if constexpr (NQR != NKC) asm volatile("" : "+v"(ql)); kf[0] = KLD(0, (BKN) * SHM_K); kf[1] = KLD(1, (BKN) * SHM_K); } \
    _Pragma("unroll") for (int g = 0; g < NG; ++g) { \
      const int c_ = g >> 3, d0_ = (g & 7) >> 1, s_ = g / NKC; const bool fs_ = (g % NKC) == 0; \
      if (DO_QK) { bf16x8 qf_; if (c_ < NQR) qf_ = qr[(c_ < NQR ? c_ : 0) * 4 + d0_]; else { if ((g & 1) == 0) qlf[d0_ & 1] = QLD((c_ - NQR) * 4 + d0_); qf_ = qlf[d0_ & 1]; } \
        if ((g & 1) == 0) { if (g == 0) PN0 = __builtin_amdgcn_mfma_f32_32x32x16_bf16(kf[g % 3], qf_, NEGM ? negm : (f32x16){}, 0, 0, 0); else PN0 = __builtin_amdgcn_mfma_f32_32x32x16_bf16(kf[g % 3], qf_, PN0, 0, 0, 0); } \
        else { if (g == 1) PN1 = __builtin_amdgcn_mfma_f32_32x32x16_bf16(kf[g % 3], qf_, NEGM ? negm : (f32x16){}, 0, 0, 0); else PN1 = __builtin_amdgcn_mfma_f32_32x32x16_bf16(kf[g % 3], qf_, PN1, 0, 0, 0); } } \
      if (fs_ && VAR < 4) {   \
        if (!NEGM && s_ < 7) { PC1[2 * s_] = __builtin_amdgcn_exp2f(PC1[2 * s_]); PC1[2 * s_ + 1] = __builtin_amdgcn_exp2f(PC1[2 * s_ + 1]); } \
        if (!NEGM && s_ == 4) { PC1[14] = __builtin_amdgcn_exp2f(PC1[14]); PC1[15] = __builtin_amdgcn_exp2f(PC1[15]); } \
        if (s_ == 0) { ps = (PC0[0] + PC0[1]) + (PC0[2] + PC0[3]); PK4X(PC0, 0, pa[0]); } \
        if (s_ == 1) { ps += (PC0[4] + PC0[5]) + (PC0[6] + PC0[7]); PK4X(PC0, 8, pa[1]); } \
        if (s_ == 2) { ps += (PC0[8] + PC0[9]) + (PC0[10] + PC0[11]); ps += (PC0[12] + PC0[13]) + (PC0[14] + PC0[15]); } \
        if (s_ == 3) { ps += (PC1[0] + PC1[1]) + (PC1[2] + PC1[3]); } \
        if (s_ == 4) { ps += (PC1[4] + PC1[5]) + (PC1[6] + PC1[7]); } \
        if (s_ == 5) { ps += (PC1[8] + PC1[9]); PK4X(PC1, 0, pa[2]); } \
        if (s_ == 6) { ps += (PC1[10] + PC1[11]) + (PC1[12] + PC1[13]); } \
        if (s_ == 7) { ps += (PC1[14] + PC1[15]); PK4X(PC1, 8, pa[3]); \
          auto rr_ = __builtin_amdgcn_permlane32_swap(__float_as_uint(ps), __float_as_uint(ps), false, false); ps = __uint_as_float(rr_[0]) + __uint_as_float(rr_[1]); l_reg = l_reg * (alC) + ps; } } \
      if (DO_QK && g + 2 < NG) kf[(g + 2) % 3] = KLD(g + 2, (BKN) * SHM_K); \
      if (g == NG - 2) vf[0] = vfrag<v_rd_off(0, 0, 0)>(vb0 + (BVC) * (int)SHM_V); \
      if (g == NG - 1) vf[1] = vfrag<v_rd_off(1, 0, 0)>(vb0 + (BVC) * (int)SHM_V); \
      SBAR(); } \
    _Pragma("unroll") for (int g = 0; g < 16; ++g) { \
      const int ks_ = g >> 2, d0_ = g & 3; \
      o[d0_] = __builtin_amdgcn_mfma_f32_32x32x16_bf16(pa[ks_], vf[g % 3], o[d0_], 0, 0, 0); \
      if (g == 0 && (DO_WR) && VAR != 5) { SWRITE(BW); } \
      if (g == 1 && (DO_LD) && VAR != 5) { SLOAD(((tt) + 3) * KVBLK); } \
      if (DO_QK && VAR < 4) {   \
        if (g == 2) { mxa = max3f(PN0[0], PN0[1], PN0[2]); mxa = max3f(mxa, PN0[3], PN0[4]); mxb = max3f(PN0[5], PN0[6], PN0[7]); mxb = max3f(mxb, PN0[8], PN0[9]); } \
        if (g == 3) { mxa = max3f(mxa, PN0[10], PN0[11]); mxb = max3f(mxb, PN0[12], PN0[13]); mxa = max3f(mxa, PN0[14], PN0[15]); mxb = max3f(mxb, PN1[0], PN1[1]); } \
        if (g == 4) { mxa = max3f(mxa, PN1[2], PN1[3]); mxb = max3f(mxb, PN1[4], PN1[5]); mxa = max3f(mxa, PN1[6], PN1[7]); mxb = max3f(mxb, PN1[8], PN1[9]); } \
        if (g == 5) { mxa = max3f(mxa, PN1[10], PN1[11]); mxb = max3f(mxb, PN1[12], PN1[13]); mxa = max3f(mxa, PN1[14], PN1[15]); mxa = __builtin_fmaxf(mxa, mxb); } \
        if (g == 6) { auto rr_ = __builtin_amdgcn_permlane32_swap(__float_as_uint(mxa), __float_as_uint(mxa), false, false); const float pmax_ = __builtin_fmaxf(__uint_as_float(rr_[0]), __uint_as_float(rr_[1])); \
          if constexpr (NEGM) { alN = 1.f; if (__builtin_expect(!__all(pmax_ <= thr2 + PSHIFT), 0)) { const float dl_ = __builtin_fmaxf(pmax_ - PSHIFT, 0.f); alN = __builtin_amdgcn_exp2f(-dl_); \
              _Pragma("unroll") for (int r = 0; r < 16; ++r) { PN0[r] -= dl_; PN1[r] -= dl_; negm[r] -= dl_; } } } \
          else { const bool ok_ = __all(pmax_ - m_reg <= thr_raw); const float mn_ = ok_ ? m_reg : __builtin_fmaxf(m_reg, pmax_); \
            alN = __builtin_amdgcn_exp2f((m_reg - mn_) * C); m_reg = mn_; mnC = -mn_ * C + PSHIFT; } } \
        if (g >= 7) { const int i_ = g - 7; \
          if constexpr (NEGM) {   \
            if (i_ < 4) { _Pragma("unroll") for (int r = 4 * i_; r < 4 * i_ + 4; ++r) PN0[r] = __builtin_amdgcn_exp2f(PN0[r]); } \
            else if (i_ < 8) { _Pragma("unroll") for (int r = 4 * (i_ - 4); r < 4 * (i_ - 4) + 4; ++r) PN1[r] = __builtin_amdgcn_exp2f(PN1[r]); } } \
          else {   \
          if (i_ < 4) { _Pragma("unroll") for (int r = 4 * i_; r < 4 * i_ + 4; ++r) PN0[r] = fmaf(PN0[r], C, mnC); } \
          else if (i_ < 8) { _Pragma("unroll") for (int r = 4 * (i_ - 4); r < 4 * (i_ - 4) + 4; ++r) PN1[r] = fmaf(PN1[r], C, mnC); } \
          if (i_ >= 1) { PN0[2 * (i_ - 1)] = __builtin_amdgcn_exp2f(PN0[2 * (i_ - 1)]); PN0[2 * (i_ - 1) + 1] = __builtin_amdgcn_exp2f(PN0[2 * (i_ - 1) + 1]); } } \
          asm volatile("" : "+v"(PN0), "+v"(PN1));   } } \
      if (g + 2 < 16) { constexpr int dummy_ = 0; (void)dummy_; \
        if (g + 2 == 2) vf[2] = vfrag<v_rd_off(2, 0, 0)>(vb0 + (BVC) * (int)SHM_V); if (g + 2 == 3) vf[0] = vfrag<v_rd_off(3, 0, 0)>(vb0 + (BVC) * (int)SHM_V); \
        if (g + 2 == 4) vf[1] = vfrag<v_rd_off(0, 1, 0)>(vb0 + (BVC) * (int)SHM_V); if (g + 2 == 5) vf[2] = vfrag<v_rd_off(1, 1, 0)>(vb0 + (BVC) * (int)SHM_V); \
        if (g + 2 == 6) vf[0] = vfrag<v_rd_off(2, 1, 0)>(vb0 + (BVC) * (int)SHM_V); if (g + 2 == 7) vf[1] = vfrag<v_rd_off(3, 1, 0)>(vb0 + (BVC) * (int)SHM_V); \
        if (g + 2 == 8) vf[2] = vfrag<v_rd_off(0, 2, 0)>(vb0 + (BVC) * (int)SHM_V); if (g + 2 == 9) vf[0] = vfrag<v_rd_off(1, 2, 0)>(vb0 + (BVC) * (int)SHM_V); \
        if (g + 2 == 10) vf[1] = vfrag<v_rd_off(2, 2, 0)>(vb0 + (BVC) * (int)SHM_V); if (g + 2 == 11) vf[2] = vfrag<v_rd_off(3, 2, 0)>(vb0 + (BVC) * (int)SHM_V); \
        if (g + 2 == 12) vf[0] = vfrag<v_rd_off(0, 3, 0)>(vb0 + (BVC) * (int)SHM_V); if (g + 2 == 13) vf[1] = vfrag<v_rd_off(1, 3, 0)>(vb0 + (BVC) * (int)SHM_V); \
        if (g + 2 == 14) vf[2] = vfrag<v_rd_off(2, 3, 0)>(vb0 + (BVC) * (int)SHM_V); if (g + 2 == 15) vf[0] = vfrag<v_rd_off(3, 3, 0)>(vb0 + (BVC) * (int)SHM_V); } \
      SBAR(); } \
    if (VAR >= 4) { asm volatile("" : "+v"(PN0), "+v"(PN1)); pa[0] = __builtin_bit_cast(bf16x8, (u32x4){(unsigned)tt, 1u, 2u, 3u}); pa[1] = pa[0]; pa[2] = pa[0]; pa[3] = pa[0]; } \
    if (DO_QK && VAR < 4) { RESC(alN); } \
    if (VAR != 5) __syncthreads(); } while (0)
  SLOAD(0); SWRITE(0); SLOAD(KVBLK); SWRITE(1); SLOAD(2 * KVBLK); __syncthreads();
  { float mn0_; qkt<NKC, NQR, 0>(pA0, pA1, kb, qr, ql);
    if constexpr (NEGM) { float pm_ = pA0[0];
      _Pragma("unroll") for (int r = 1; r < 16; ++r) pm_ = fmaxf(pm_, pA0[r]);
      _Pragma("unroll") for (int r = 0; r < 16; ++r) pm_ = fmaxf(pm_, pA1[r]);
      { auto rr_ = __builtin_amdgcn_permlane32_swap(__float_as_uint(pm_), __float_as_uint(pm_), false, false); pm_ = fmaxf(__uint_as_float(rr_[0]), __uint_as_float(rr_[1])); }
      _Pragma("unroll") for (int r = 0; r < 16; ++r) { pA0[r] = __builtin_amdgcn_exp2f(pA0[r] - pm_ + PSHIFT); pA1[r] = __builtin_amdgcn_exp2f(pA1[r] - pm_ + PSHIFT); negm[r] = -pm_ + PSHIFT; }
      alA = 1.f; (void)mn0_; }
    else partialSM(pA0, pA1, m_reg, mn0_, alA, C, thr_raw); }
#ifdef ATT_STATIC_PRIO
  if (__builtin_amdgcn_readfirstlane(tid) >= 256) __builtin_amdgcn_s_setprio(1);
#endif
  int t = 0;
  for (; t + 6 < NT; t += 6) {
    STEP(pB0, pB1, alB, pA0, pA1, alA, 1, 0, 2, true, true, true, t);
    STEP(pA0, pA1, alA, pB0, pB1, alB, 2, 1, 0, true, true, true, t + 1);
    STEP(pB0, pB1, alB, pA0, pA1, alA, 0, 2, 1, true, true, true, t + 2);
    STEP(pA0, pA1, alA, pB0, pB1, alB, 1, 0, 2, true, true, true, t + 3);
    STEP(pB0, pB1, alB, pA0, pA1, alA, 2, 1, 0, true, true, true, t + 4);
    STEP(pA0, pA1, alA, pB0, pB1, alB, 0, 2, 1, true, true, true, t + 5);
  }
  STEP(pB0, pB1, alB, pA0, pA1, alA, 1, 0, 2, true, true, true, t);
  STEP(pA0, pA1, alA, pB0, pB1, alB, 2, 1, 0, true, true, true, t + 1);
  STEP(pB0, pB1, alB, pA0, pA1, alA, 0, 2, 1, true, true, true, t + 2);
  STEP(pA0, pA1, alA, pB0, pB1, alB, 1, 0, 2, true, true, false, t + 3);
  STEP(pB0, pB1, alB, pA0, pA1, alA, 2, 1, 0, true, false, false, t + 4);
  STEP(pA0, pA1, alA, pB0, pB1, alB, 0, 2, 1, false, false, false, t + 5);
#ifdef ATT_STATIC_PRIO
  __builtin_amdgcn_s_setprio(0);
#endif
  if (hi == 0) li_l[r32] = l_reg; asm volatile("s_waitcnt lgkmcnt(0)" ::: "memory");
  float rli[16];
#pragma unroll
  for (int r = 0; r < 16; ++r) rli[r] = __builtin_amdgcn_rcpf(li_l[crow(r, hi)]);
  if constexpr (OM == 1) {
    unsigned* st = (unsigned*)stash + tid;
#pragma unroll
    for (int r = 0; r < 16; ++r) { st[(2 * r) * 512] = cvt_pk_bf16(o[0][r] * rli[r], o[1][r] * rli[r]); st[(2 * r + 1) * 512] = cvt_pk_bf16(o[2][r] * rli[r], o[3][r] * rli[r]); }
  } else if constexpr (OM == 2) {
    const unsigned* st = (const unsigned*)stash + tid;
    float sw[4];
#pragma unroll
    for (int d0 = 0; d0 < 4; ++d0) sw[d0] = subw[d0 * 32 + r32] * 0.8f;
    bf16_t* Ow = Ob + (long)(wid * QBLK) * ldo;
#pragma unroll
    for (int r = 0; r < 16; ++r) { const unsigned w01 = st[(2 * r) * 512], w23 = st[(2 * r + 1) * 512];
      const float d0v = bflo(w01) - lam * (o[0][r] * rli[r]), d1v = bfhi(w01) - lam * (o[1][r] * rli[r]), d2v = bflo(w23) - lam * (o[2][r] * rli[r]), d3v = bfhi(w23) - lam * (o[3][r] * rli[r]);
      float ss = (d0v * d0v + d1v * d1v) + (d2v * d2v + d3v * d3v);
      ss += __shfl_xor(ss, 1); ss += __shfl_xor(ss, 2); ss += __shfl_xor(ss, 4); ss += __shfl_xor(ss, 8); ss += __shfl_xor(ss, 16);
      const float rn = rsqrtf(ss * (1.f / 128.f) + EPS); const long ob = (long)crow(r, hi) * ldo + r32;
      Ow[ob] = f2bf(d0v * rn * sw[0]); Ow[ob + 32] = f2bf(d1v * rn * sw[1]); Ow[ob + 64] = f2bf(d2v * rn * sw[2]); Ow[ob + 96] = f2bf(d3v * rn * sw[3]); }
  } else {
  bf16_t* Ow = Ob + (long)(wid * QBLK) * ldo;
#pragma unroll
  for (int r = 0; r < 16; ++r) { const int orow = crow(r, hi);
#pragma unroll
    for (int d0 = 0; d0 < 4; ++d0) Ow[(long)orow * ldo + d0 * 32 + r32] = f2bf(o[d0][r] * rli[r]); }
  }
#undef SLOAD
#undef BL128
#undef SWRITE
#undef RESC
#undef STEP
#undef KLD
#undef QLD
}
#undef PK4X
#undef KOFF
#undef SBAR
}
namespace attn8 {
#if SIM_P6
#define SQ6(x) q8(x)
#else
#define SQ6(x) (x)
#endif
using attn::f32x16; using attn::crow; using attn::max3f;
typedef int v8i32 __attribute__((ext_vector_type(8)));
typedef int v4i32 __attribute__((ext_vector_type(4)));
#ifndef ATT8_THRL
#define ATT8_THRL 3.5f
#endif
constexpr float PSH = 5.f, THRL = ATT8_THRL;
#define OFF8(row, piece) ((row) * 64 + ((((piece) ^ ((row) >> 2)) & 3) << 4))
#define SBAR() __builtin_amdgcn_sched_barrier(0)
#define MFMA8(a, b, c) __builtin_amdgcn_mfma_scale_f32_32x32x64_f8f6f4(a, b, c, 0, 0, 0, 0, 0, 0)
#define LD32(addr0, addr1) __builtin_shufflevector(*(const LAS v4i32*)(uintptr_t)(unsigned)(addr0), *(const LAS v4i32*)(uintptr_t)(unsigned)(addr1), 0, 1, 2, 3, 4, 5, 6, 7)

constexpr int WCONV_I1 = 32 * 128 * 32, WCONV_I2 = 32 * 128 * 16, WCONV_ITEMS = WCONV_I1 + WCONV_I2;
struct WConv { float v[8]; };
__device__ __forceinline__ void wconv_load(const Params& p, int it, int lane, WConv& w) {
    it = min(it, WCONV_ITEMS - 1);
    const bool m1 = it < WCONV_I1; const int i2 = m1 ? it : it - WCONV_I1;
    const int e = m1 ? (i2 >> 12) : (i2 >> 11), kb = m1 ? ((i2 >> 5) & 127) : ((i2 >> 4) & 127), nb = m1 ? (i2 & 31) : (i2 & 15), ldn = m1 ? 2048 : 1024;
    const __amdgpu_buffer_rsrc_t r = __builtin_amdgcn_make_buffer_rsrc((void*)(m1 ? p.w1 : p.w2), 0, 0xffffffff, 0x00020000);
    const int so = ((e * 1024 + kb * 8) * ldn + nb * 64) * 4;
#pragma unroll
    for (int j = 0; j < 8; ++j) w.v[j] = __builtin_bit_cast(float, __builtin_amdgcn_raw_buffer_load_b32(r, lane * 4, so + j * ldn * 4, 2));
}
__device__ __forceinline__ void wconv_store(const Params& p, int it0, int lane, const WConv& w) {
    const int it = min(it0, WCONV_ITEMS - 1);
    const bool m1 = it < WCONV_I1; const int i2 = m1 ? it : it - WCONV_I1;
    const int e = m1 ? (i2 >> 12) : (i2 >> 11), kb = m1 ? ((i2 >> 5) & 127) : ((i2 >> 4) & 127), nb = m1 ? (i2 & 31) : (i2 & 15);
    const int n = nb * 64 + lane;
    const int drow = m1 ? (e * 2048 + ((n & 1023) >> 7) * 256 + (n >> 10) * 128 + (n & 127)) : (e * 1024 + n);
    unsigned char* dst = it0 < WCONV_ITEMS ? p.ws + (m1 ? WS_W1 : WS_W2) + (size_t)drow * 1024 + kb * 8 : p.ws + WS_DUMMY + lane * 8;
    u32x2 o; o.x = cvt4_fp8(w.v[0] * WQ_SCALE, w.v[1] * WQ_SCALE, w.v[2] * WQ_SCALE, w.v[3] * WQ_SCALE); o.y = cvt4_fp8(w.v[4] * WQ_SCALE, w.v[5] * WQ_SCALE, w.v[6] * WQ_SCALE, w.v[7] * WQ_SCALE);
    *(u32x2*)dst = o;
}
template <int NKC, int OM, int VAR = 0, bool WC = false>
__device__ __forceinline__ void attn_unit(const unsigned char* __restrict__ Qb, int ldq, const unsigned char* kp0, int kld0, const unsigned char* kp1, int kld1, const unsigned char* kp2, int kld2,
                                          const unsigned char* __restrict__ VT, bf16_t* __restrict__ Ob, int ldo, int seq, char* lds,
                                          char* stash = nullptr, const float lam = 0.f, const float* __restrict__ subw = nullptr, const Params* pp = nullptr, int wc_base = 0) {
  constexpr int SHM_K = NKC * 4096, SHM_V = 8192, NG = 2 * NKC;
  constexpr bool STG = ((STAGGER) >> (NKC == 1 ? 0 : 1)) & 1;
  constexpr bool V_M = VAR >= 32, V_NOLDS = VAR == 6 || VAR == 9 || V_M, V_NOSTG = VAR == 2 || VAR == 3 || VAR == 9 || V_M, V_NOBAR = VAR == 3 || VAR == 9 || V_M;
  constexpr bool V_NOEXP = VAR == 1 || VAR == 7 || (V_M && (VAR & 1)), V_NOMAX = VAR == 1 || VAR == 7 || (V_M && (VAR & 2)), V_NOPACK = V_M && (VAR & 4);
  constexpr bool V_NOPV = VAR == 4 || VAR == 7 || (V_M && (VAR & 8)), V_NOQK = VAR == 5 || (V_M && (VAR & 16));
  const int tid = tid_opaque(), wid = tid >> 6, lane = tid & 63, r32 = lane & 31, hi = lane >> 5;
  char* V_lds = lds; char* K_lds = lds + 4 * SHM_V;
  float* ws = (float*)(lds + 4 * SHM_V + 4 * SHM_K) + wid * 64; float* al_l = ws + 32;
  f32x16 o[4] = {}, ol = {}; v8i32 qf[NKC];
  v8i32 ones8 = {0x38383838, 0x38383838, 0x38383838, 0x38383838, 0x38383838, 0x38383838, 0x38383838, 0x38383838};
  asm volatile("" : "+v"(ones8));
  { const unsigned char* Qw = Qb + (long)(wid * 32 + r32) * ldq + hi * 32;
#pragma unroll
    for (int c = 0; c < NKC; ++c) qf[c] = __builtin_shufflevector(*(const v4i32*)(Qw + c * 64), *(const v4i32*)(Qw + c * 64 + 16), 0, 1, 2, 3, 4, 5, 6, 7); }
  const int fa0 = OFF8(r32, 2 * hi), fa1 = OFF8(r32, 2 * hi + 1);
  const LAS char* kA = (const LAS char*)(uintptr_t)(unsigned)((int)(uintptr_t)K_lds + fa0); const LAS char* kB = (const LAS char*)(uintptr_t)(unsigned)((int)(uintptr_t)K_lds + fa1);
  const LAS char* vA = (const LAS char*)(uintptr_t)(unsigned)((int)(uintptr_t)V_lds + fa0); const LAS char* vB = (const LAS char*)(uintptr_t)(unsigned)((int)(uintptr_t)V_lds + fa1);
  const int ve = tid >> 2, pc = tid & 3, krow = (tid & 255) >> 2;
  const int vst = OFF8(ve, pc), kst = OFF8(krow, pc);
  const bool lowhalf = tid < 256;
  const bool grpB = __builtin_amdgcn_readfirstlane(wid) >= 4;
  const unsigned vo = (unsigned)(ve * RPB + pc * 16);
  const unsigned ko0 = (unsigned)(krow * kld0 + pc * 16), ko1 = (unsigned)(krow * kld1 + pc * 16), ko2 = (unsigned)(krow * kld2 + pc * 16);
  const __amdgpu_buffer_rsrc_t rV = __builtin_amdgcn_make_buffer_rsrc((void*)VT, 0, 0xffffffff, 0x00020000);
  const __amdgpu_buffer_rsrc_t rK0 = __builtin_amdgcn_make_buffer_rsrc((void*)kp0, 0, 0xffffffff, 0x00020000);
  const __amdgpu_buffer_rsrc_t rK1 = __builtin_amdgcn_make_buffer_rsrc((void*)(NKC > 1 ? kp1 : kp0), 0, 0xffffffff, 0x00020000);
  const __amdgpu_buffer_rsrc_t rK2 = __builtin_amdgcn_make_buffer_rsrc((void*)(NKC > 2 ? kp2 : kp0), 0, 0xffffffff, 0x00020000);
  struct { v4i32 v, ka, kc; } sg;
#define BL16(r, vo_, so_) __builtin_bit_cast(v4i32, __builtin_amdgcn_raw_buffer_load_b128(r, (int)(vo_), (int)(so_), 0))
#define SLOAD(k0) do { sg.v = BL16(rV, vo, (k0)); \
    if constexpr (NKC == 1) { if (lowhalf) sg.ka = BL16(rK0, ko0, (k0) * kld0); } \
    else { if (lowhalf) { sg.ka = BL16(rK0, ko0, (k0) * kld0); sg.kc = BL16(rK2, ko2, (k0) * kld2); } else sg.ka = BL16(rK1, ko1, (k0) * kld1); } } while (0)
#define SWRITE(b) do { *(v4i32*)(V_lds + (b) * SHM_V + vst) = sg.v; \
    if constexpr (NKC == 1) { if (lowhalf) *(v4i32*)(K_lds + (b) * SHM_K + kst) = sg.ka; } \
    else { if (lowhalf) { *(v4i32*)(K_lds + (b) * SHM_K + kst) = sg.ka; *(v4i32*)(K_lds + (b) * SHM_K + 8192 + kst) = sg.kc; } else *(v4i32*)(K_lds + (b) * SHM_K + 4096 + kst) = sg.ka; } } while (0)
#define RESC(a) do { if (raised_) { if (hi == 0) al_l[r32] = (a); asm volatile("s_waitcnt lgkmcnt(0)" ::: "memory"); \
    _Pragma("unroll") for (int r = 0; r < 16; ++r) { const float a_ = al_l[crow(r, hi)]; o[0][r] *= a_; o[1][r] *= a_; o[2][r] *= a_; o[3][r] *= a_; ol[r] *= a_; } } } while (0)
#define LDP(pa, pb, off) __builtin_shufflevector(*(const LAS v4i32*)((pa) + (off)), *(const LAS v4i32*)((pb) + (off)), 0, 1, 2, 3, 4, 5, 6, 7)
#define KFR(g, KB) (V_NOLDS ? qf[0] : LDP(kA, kB, (KB) + ((g) >> 1) * 4096 + ((g) & 1) * 2048))
#define VFR(d0, VB) (V_NOLDS ? qf[0] : LDP(vA, vB, (VB) + (d0) * 2048))
  f32x16 P0, P1, negm; float al = 1.f; const int NT = seq / 64;
  v8i32 kpf0, kpf1;
  v8i32 pf;
#define PACKP() do { pf = (v8i32){(int)cvt4_fp8(P0[0], P0[1], P0[2], P0[3]), (int)cvt4_fp8(P0[4], P0[5], P0[6], P0[7]), (int)cvt4_fp8(P0[8], P0[9], P0[10], P0[11]), (int)cvt4_fp8(P0[12], P0[13], P0[14], P0[15]), \
    (int)cvt4_fp8(P1[0], P1[1], P1[2], P1[3]), (int)cvt4_fp8(P1[4], P1[5], P1[6], P1[7]), (int)cvt4_fp8(P1[8], P1[9], P1[10], P1[11]), (int)cvt4_fp8(P1[12], P1[13], P1[14], P1[15])}; } while (0)
#define PACK0() do { asm volatile("" : "+v"(P0)); pf[0] = (int)cvt4_fp8o(pf[0], P0[0], P0[1], P0[2], P0[3]); pf[1] = (int)cvt4_fp8o(pf[1], P0[4], P0[5], P0[6], P0[7]); \
    pf[2] = (int)cvt4_fp8o(pf[2], P0[8], P0[9], P0[10], P0[11]); pf[3] = (int)cvt4_fp8o(pf[3], P0[12], P0[13], P0[14], P0[15]); asm volatile("" : "+v"(pf)); } while (0)
#define PACK1() do { asm volatile("" : "+v"(P1)); pf[4] = (int)cvt4_fp8o(pf[4], P1[0], P1[1], P1[2], P1[3]); pf[5] = (int)cvt4_fp8o(pf[5], P1[4], P1[5], P1[6], P1[7]); \
    pf[6] = (int)cvt4_fp8o(pf[6], P1[8], P1[9], P1[10], P1[11]); pf[7] = (int)cvt4_fp8o(pf[7], P1[12], P1[13], P1[14], P1[15]); asm volatile("" : "+v"(pf)); } while (0)
#define MAX0() do { m0_ = max3f(P0[0], P0[1], P0[2]); m0_ = max3f(m0_, P0[3], P0[4]); m0_ = max3f(m0_, P0[5], P0[6]); m0_ = max3f(m0_, P0[7], P0[8]); m0_ = max3f(m0_, P0[9], P0[10]); \
    m0_ = max3f(m0_, P0[11], P0[12]); m0_ = max3f(m0_, P0[13], P0[14]); asm volatile("" : "+v"(m0_)); } while (0)
#define MAXFIN() do { float m1_ = max3f(P1[0], P1[1], P1[2]); m1_ = max3f(m1_, P1[3], P1[4]); m1_ = max3f(m1_, P1[5], P1[6]); m1_ = max3f(m1_, P1[7], P1[8]); m1_ = max3f(m1_, P1[9], P1[10]); \
    m1_ = max3f(m1_, P1[11], P1[12]); m1_ = max3f(m1_, P1[13], P1[14]); m1_ = max3f(m1_, P1[15], P0[15]); mx_ = fmaxf(m1_, m0_);          \
    if (__builtin_expect(!__all(mx_ <= PSH + THRL), 0)) { \
      { auto rr_ = __builtin_amdgcn_permlane32_swap(__float_as_uint(mx_), __float_as_uint(mx_), false, false); mx_ = fmaxf(__uint_as_float(rr_[0]), __uint_as_float(rr_[1])); }     \
      const float dl_ = fmaxf(mx_ - PSH, 0.f); al = __builtin_amdgcn_exp2f(-dl_); raised_ = true; \
      _Pragma("unroll") for (int r = 0; r < 16; ++r) { P0[r] -= dl_; P1[r] -= dl_; negm[r] -= dl_; } } } while (0)
#define EXPS(P, ra, rb) do { asm volatile("" : "+v"(P)); _Pragma("unroll") for (int r = (ra); r < (rb); ++r) P[r] = __builtin_amdgcn_exp2f(P[r]); asm volatile("" : "+v"(P)); } while (0)
#define MPIN(acc) asm volatile("" : "+v"(acc))
#define STEP(BKN, BVC, BW, BKP, DO_QK, DO_WR, DO_LD, DO_KP, tt) do { \
    v8i32 kf[2], vf[3]; float mx_ = 0.f, m0_ = 0.f; bool raised_ = false; \
    SBAR(); \
    if (DO_QK && NG > 2) { kf[0] = KFR(2, (BKN) * SHM_K); kf[1] = KFR(3, (BKN) * SHM_K); } \
    _Pragma("unroll") for (int g = 0; g < NG; ++g) { \
      if (DO_QK && !V_NOQK) { if (g == 0) { P0 = MFMA8(kpf0, qf[0], negm); MPIN(P0); } else if (g == 1) { P1 = MFMA8(kpf1, qf[0], negm); MPIN(P1); } \
        else if ((g & 1) == 0) { P0 = MFMA8(kf[g & 1], qf[g >> 1], P0); MPIN(P0); } else { P1 = MFMA8(kf[g & 1], qf[g >> 1], P1); MPIN(P1); } } \
      SBAR(); \
      if (g == 0 && !V_NOPACK) { PACK1(); }                            \
      if (DO_QK && NG == 2 && g == 1 && !V_NOMAX) { MAX0(); } \
      if (DO_QK && g >= 2 && g + 2 < NG) kf[g & 1] = KFR(g + 2, (BKN) * SHM_K); \
      if (g == NG - 2) vf[0] = VFR(0, (BVC) * SHM_V); if (g == NG - 1) vf[1] = VFR(1, (BVC) * SHM_V); \
      SBAR(); } \
      \
    if (!V_NOPV) { o[0] = MFMA8(pf, vf[0], o[0]); MPIN(o[0]); } SBAR(); if (DO_WR && !V_NOSTG) { SWRITE(BW); } if (DO_LD && !V_NOSTG) { SLOAD(((tt) + 4) * 64); } vf[2] = VFR(2, (BVC) * SHM_V); al = 1.f; \
    if (DO_QK && !V_NOMAX) { if (NG == 2) { MAXFIN(); } else { MAX0(); } } SBAR(); \
      \
    if (!V_NOPV) { o[1] = MFMA8(pf, vf[1], o[1]); MPIN(o[1]); } SBAR(); vf[0] = VFR(3, (BVC) * SHM_V); \
    if (DO_QK && NG == 2 && !V_NOEXP) { EXPS(P0, 0, 8); } if (DO_QK && NG != 2 && !V_NOMAX) { MAXFIN(); } SBAR(); \
    if (STG && grpB && !V_NOBAR) { __syncthreads(); } SBAR();   \
      \
    if (!V_NOPV) { o[2] = MFMA8(pf, vf[2], o[2]); MPIN(o[2]); } SBAR(); if (DO_QK && !V_NOEXP) { if (NG == 2) { EXPS(P0, 8, 16); } else { EXPS(P0, 0, 11); } } SBAR(); \
    if (!V_NOPV) { o[3] = MFMA8(pf, vf[0], o[3]); MPIN(o[3]); } SBAR(); if (DO_QK && !V_NOEXP) { if (NG == 2) { EXPS(P1, 0, 8); } else { EXPS(P0, 11, 16); EXPS(P1, 0, 6); } } \
    if (DO_KP) { kpf0 = KFR(0, (BKP) * SHM_K); kpf1 = KFR(1, (BKP) * SHM_K); } SBAR(); \
    if (!V_NOPV) { ol = MFMA8(pf, ones8, ol); MPIN(ol); } SBAR(); if (DO_QK && !V_NOEXP) { if (NG == 2) { EXPS(P1, 8, 16); } else { EXPS(P1, 6, 16); } } SBAR(); \
    if (DO_QK) { if (!V_NOPACK) { PACK0(); } RESC(al); } \
    if (!V_NOBAR && !(STG && grpB)) __syncthreads(); } while (0)
  __syncthreads();
  SLOAD(0); SWRITE(0); SLOAD(64); SWRITE(1); SLOAD(128); SWRITE(2); SLOAD(192); __syncthreads();
#pragma unroll
  for (int r = 0; r < 16; ++r) negm[r] = 0.f;
#pragma unroll
  for (int c = 0; c < NKC; ++c) { const v8i32 k0_ = KFR(2 * c, 0), k1_ = KFR(2 * c + 1, 0);
    if (c == 0) { P0 = MFMA8(k0_, qf[c], negm); P1 = MFMA8(k1_, qf[c], negm); } else { P0 = MFMA8(k0_, qf[c], P0); P1 = MFMA8(k1_, qf[c], P1); } }
  { float mx_ = P0[0];
#pragma unroll
    for (int r = 1; r < 16; ++r) mx_ = fmaxf(mx_, P0[r]);
#pragma unroll
    for (int r = 0; r < 16; ++r) mx_ = fmaxf(mx_, P1[r]);
    { auto rr_ = __builtin_amdgcn_permlane32_swap(__float_as_uint(mx_), __float_as_uint(mx_), false, false); mx_ = fmaxf(__uint_as_float(rr_[0]), __uint_as_float(rr_[1])); }
#pragma unroll
    for (int r = 0; r < 16; ++r) { P0[r] = __builtin_amdgcn_exp2f(P0[r] - mx_ + PSH); P1[r] = __builtin_amdgcn_exp2f(P1[r] - mx_ + PSH); negm[r] = PSH - mx_; } }
  PACKP();
  if constexpr (T15_DIFF && NG == 2 && VAR == 0) {
    f32x16 Q0, Q1;
    { const v8i32 k0_ = KFR(0, 1 * SHM_K), k1_ = KFR(1, 1 * SHM_K); P0 = MFMA8(k0_, qf[0], negm); P1 = MFMA8(k1_, qf[0], negm); }
    v8i32 vp0 = VFR(0, 0), vp1 = VFR(1, 0);
#define MAXA(S0) do { m0_ = max3f(S0[0], S0[1], S0[2]); m0_ = max3f(m0_, S0[3], S0[4]); m0_ = max3f(m0_, S0[5], S0[6]); m0_ = max3f(m0_, S0[7], S0[8]); m0_ = max3f(m0_, S0[9], S0[10]); \
      m0_ = max3f(m0_, S0[11], S0[12]); m0_ = max3f(m0_, S0[13], S0[14]); asm volatile("" : "+v"(m0_)); } while (0)
#define MAXB(S0, S1) do { float m1_ = max3f(S1[0], S1[1], S1[2]); m1_ = max3f(m1_, S1[3], S1[4]); m1_ = max3f(m1_, S1[5], S1[6]); m1_ = max3f(m1_, S1[7], S1[8]); m1_ = max3f(m1_, S1[9], S1[10]); \
      m1_ = max3f(m1_, S1[11], S1[12]); m1_ = max3f(m1_, S1[13], S1[14]); m1_ = max3f(m1_, S1[15], S0[15]); mx_ = fmaxf(m1_, m0_); \
      if (__builtin_expect(!__all(mx_ <= PSH + THRL), 0)) { \
        { auto rr_ = __builtin_amdgcn_permlane32_swap(__float_as_uint(mx_), __float_as_uint(mx_), false, false); mx_ = fmaxf(__uint_as_float(rr_[0]), __uint_as_float(rr_[1])); } \
        const float dl_ = fmaxf(mx_ - PSH, 0.f); al = __builtin_amdgcn_exp2f(-dl_); raised_ = true; \
        _Pragma("unroll") for (int r = 0; r < 16; ++r) { S0[r] -= dl_; S1[r] -= dl_; negm[r] -= dl_; } } } while (0)
#define PACKQ(S0, S1) do { asm volatile("" : "+v"(S0), "+v"(S1)); \
      pf[0] = (int)cvt4_fp8o(pf[0], S0[0], S0[1], S0[2], S0[3]); pf[1] = (int)cvt4_fp8o(pf[1], S0[4], S0[5], S0[6], S0[7]); pf[2] = (int)cvt4_fp8o(pf[2], S0[8], S0[9], S0[10], S0[11]); pf[3] = (int)cvt4_fp8o(pf[3], S0[12], S0[13], S0[14], S0[15]); \
      pf[4] = (int)cvt4_fp8o(pf[4], S1[0], S1[1], S1[2], S1[3]); pf[5] = (int)cvt4_fp8o(pf[5], S1[4], S1[5], S1[6], S1[7]); pf[6] = (int)cvt4_fp8o(pf[6], S1[8], S1[9], S1[10], S1[11]); pf[7] = (int)cvt4_fp8o(pf[7], S1[12], S1[13], S1[14], S1[15]); \
      asm volatile("" : "+v"(pf)); } while (0)
#define STEP2(SC0, SC1, SN0, SN1, BK2, BVC, BVN, BW, DO_SOFT, DO_QK2, DO_WR, DO_LD, DO_VP, tt) do { \
      v8i32 kf0, kf1, vf2, vf3; float mx_ = 0.f, m0_ = 0.f; bool raised_ = false; al = 1.f; \
      SBAR(); \
      if (DO_QK2) { kf0 = KFR(0, (BK2) * SHM_K); kf1 = KFR(1, (BK2) * SHM_K); } \
      o[0] = MFMA8(pf, vp0, o[0]); MPIN(o[0]); SBAR(); if (DO_WR) { SWRITE(BW); } if (DO_LD) { SLOAD(((tt) + 4) * 64); } vf2 = VFR(2, (BVC) * SHM_V); if (DO_SOFT) { MAXA(SC0); } SBAR(); \
      o[1] = MFMA8(pf, vp1, o[1]); MPIN(o[1]); SBAR(); vf3 = VFR(3, (BVC) * SHM_V); if (DO_SOFT) { MAXB(SC0, SC1); } SBAR(); \
      if (DO_QK2) { SN0 = MFMA8(kf0, qf[0], negm); MPIN(SN0); } SBAR(); if (DO_SOFT) { EXPS(SC0, 0, 8); } SBAR(); \
      if (DO_QK2) { SN1 = MFMA8(kf1, qf[0], negm); MPIN(SN1); } SBAR(); if (DO_SOFT) { EXPS(SC0, 8, 16); } SBAR(); \
      o[2] = MFMA8(pf, vf2, o[2]); MPIN(o[2]); SBAR(); if (DO_SOFT) { EXPS(SC1, 0, 8); } SBAR(); \
      o[3] = MFMA8(pf, vf3, o[3]); MPIN(o[3]); SBAR(); if (DO_SOFT) { EXPS(SC1, 8, 16); } if (DO_VP) { vp0 = VFR(0, (BVN) * SHM_V); vp1 = VFR(1, (BVN) * SHM_V); } SBAR(); \
      ol = MFMA8(pf, ones8, ol); MPIN(ol); SBAR(); if (DO_SOFT) { PACKQ(SC0, SC1); RESC(al); } \
      __syncthreads(); } while (0)
    int t = 0;
    WConv wcv; int wc_it = wc_base + __builtin_amdgcn_readfirstlane(wid);
    for (; t + 7 < NT; t += 4) {
      STEP2(P0, P1, Q0, Q1, 2, 0, 1, 3, true, true, true, true, true, t);
      if constexpr (WC) wconv_load(*pp, wc_it, lane, wcv);
      STEP2(Q0, Q1, P0, P1, 3, 1, 2, 0, true, true, true, true, true, t + 1);
      STEP2(P0, P1, Q0, Q1, 0, 2, 3, 1, true, true, true, true, true, t + 2);
      if constexpr (WC) { wconv_store(*pp, wc_it, lane, wcv); wc_it += (int)gridDim.x * 8; }
      STEP2(Q0, Q1, P0, P1, 1, 3, 0, 2, true, true, true, true, true, t + 3);
    }
    STEP2(P0, P1, Q0, Q1, 2, 0, 1, 3, true, true, true, false, true, t);
    STEP2(Q0, Q1, P0, P1, 3, 1, 2, 0, true, true, false, false, true, t + 1);
    STEP2(P0, P1, Q0, Q1, 0, 2, 3, 1, true, false, false, false, true, t + 2);
    STEP2(Q0, Q1, P0, P1, 1, 3, 0, 2, false, false, false, false, false, t + 3);
#undef STEP2
#undef PACKQ
#undef MAXB
#undef MAXA
  } else if constexpr (MLA_RECHAIN && NG == 6 && VAR == 0) {
    kpf0 = KFR(1, 1 * SHM_K); kpf1 = KFR(3, 1 * SHM_K);
#define PACK0A() do { asm volatile("" : "+v"(P0)); pf[0] = (int)cvt4_fp8o(pf[0], P0[0], P0[1], P0[2], P0[3]); pf[1] = (int)cvt4_fp8o(pf[1], P0[4], P0[5], P0[6], P0[7]); asm volatile("" : "+v"(pf)); } while (0)
#define PACK0B() do { asm volatile("" : "+v"(P0)); pf[2] = (int)cvt4_fp8o(pf[2], P0[8], P0[9], P0[10], P0[11]); pf[3] = (int)cvt4_fp8o(pf[3], P0[12], P0[13], P0[14], P0[15]); asm volatile("" : "+v"(pf)); } while (0)
#define MAXP1() do { m1_ = max3f(P1[0], P1[1], P1[2]); m1_ = max3f(m1_, P1[3], P1[4]); m1_ = max3f(m1_, P1[5], P1[6]); m1_ = max3f(m1_, P1[7], P1[8]); m1_ = max3f(m1_, P1[9], P1[10]); \
      m1_ = max3f(m1_, P1[11], P1[12]); m1_ = max3f(m1_, P1[13], P1[14]); asm volatile("" : "+v"(m1_)); } while (0)
#define MAXP0D() do { float m0_ = max3f(P0[0], P0[1], P0[2]); m0_ = max3f(m0_, P0[3], P0[4]); m0_ = max3f(m0_, P0[5], P0[6]); m0_ = max3f(m0_, P0[7], P0[8]); m0_ = max3f(m0_, P0[9], P0[10]); \
      m0_ = max3f(m0_, P0[11], P0[12]); m0_ = max3f(m0_, P0[13], P0[14]); m0_ = max3f(m0_, P0[15], P1[15]); mx_ = fmaxf(m0_, m1_); \
      if (__builtin_expect(!__all(mx_ <= PSH + THRL), 0)) { \
        { auto rr_ = __builtin_amdgcn_permlane32_swap(__float_as_uint(mx_), __float_as_uint(mx_), false, false); mx_ = fmaxf(__uint_as_float(rr_[0]), __uint_as_float(rr_[1])); } \
        const float dl_ = fmaxf(mx_ - PSH, 0.f); al = __builtin_amdgcn_exp2f(-dl_); raised_ = true; \
        _Pragma("unroll") for (int r = 0; r < 16; ++r) { P0[r] -= dl_; P1[r] -= dl_; negm[r] -= dl_; } } } while (0)
#define STEP3(BKN, BVC, BW, BKP, DO_QK, DO_WR, DO_LD, DO_KP, tt, RIDER) do { \
      v8i32 kfa, kfb, vf[3]; float mx_ = 0.f, m1_ = 0.f; bool raised_ = false; \
      SBAR(); \
      if (DO_QK) { kfa = KFR(5, (BKN) * SHM_K); kfb = KFR(0, (BKN) * SHM_K); } \
      if (DO_QK) { P1 = MFMA8(kpf0, qf[0], negm); MPIN(P1); } SBAR(); PACK0A(); SBAR(); \
      if (DO_QK) { P1 = MFMA8(kpf1, qf[1], P1); MPIN(P1); } SBAR(); PACK0B(); SBAR(); \
      if (DO_QK) { P1 = MFMA8(kfa, qf[2], P1); MPIN(P1); } SBAR(); if (DO_QK) { kfa = KFR(2, (BKN) * SHM_K); } RIDER; SBAR();     \
      if (DO_QK) { P0 = MFMA8(kfb, qf[0], negm); MPIN(P0); } SBAR(); if (DO_QK) { kfb = KFR(4, (BKN) * SHM_K); } SBAR(); \
      if (DO_QK) { P0 = MFMA8(kfa, qf[1], P0); MPIN(P0); } SBAR(); vf[0] = VFR(0, (BVC) * SHM_V); if (DO_QK) { MAXP1(); } SBAR(); \
      if (DO_QK) { P0 = MFMA8(kfb, qf[2], P0); MPIN(P0); } SBAR(); vf[1] = VFR(1, (BVC) * SHM_V); SBAR(); \
      o[0] = MFMA8(pf, vf[0], o[0]); MPIN(o[0]); SBAR(); if (DO_WR) { SWRITE(BW); } if (DO_LD) { SLOAD(((tt) + 4) * 64); } vf[2] = VFR(2, (BVC) * SHM_V); al = 1.f; if (DO_QK) { MAXP0D(); } SBAR(); \
      o[1] = MFMA8(pf, vf[1], o[1]); MPIN(o[1]); SBAR(); vf[0] = VFR(3, (BVC) * SHM_V); if (DO_QK) { EXPS(P1, 0, 8); } SBAR(); \
      o[2] = MFMA8(pf, vf[2], o[2]); MPIN(o[2]); SBAR(); if (DO_QK) { EXPS(P1, 8, 16); } SBAR(); \
      o[3] = MFMA8(pf, vf[0], o[3]); MPIN(o[3]); SBAR(); if (DO_QK) { EXPS(P0, 0, 8); } if (DO_KP) { kpf0 = KFR(1, (BKP) * SHM_K); kpf1 = KFR(3, (BKP) * SHM_K); } SBAR(); \
      ol = MFMA8(pf, ones8, ol); MPIN(ol); SBAR(); if (DO_QK) { EXPS(P0, 8, 16); } SBAR(); \
      if (DO_QK) { PACK1(); RESC(al); } \
      __syncthreads(); } while (0)
    int t = 0;
    WConv wcv; int wc_it = wc_base + __builtin_amdgcn_readfirstlane(wid);
#define RNONE ((void)0)
#define RLOAD do { if constexpr (WC) wconv_load(*pp, wc_it, lane, wcv); } while (0)
#define RSTORE do { if constexpr (WC) { wconv_store(*pp, wc_it, lane, wcv); wc_it += (int)gridDim.x * 8; } } while (0)
    for (; t + 7 < NT; t += 4) {
      STEP3(1, 0, 3, 2, true, true, true, true, t, RNONE);
      STEP3(2, 1, 0, 3, true, true, true, true, t + 1, RLOAD);
      STEP3(3, 2, 1, 0, true, true, true, true, t + 2, RNONE);
      STEP3(0, 3, 2, 1, true, true, true, true, t + 3, RSTORE);
    }
    STEP3(1, 0, 3, 2, true, true, false, true, t, RNONE);
    STEP3(2, 1, 0, 3, true, false, false, true, t + 1, RNONE);
    STEP3(3, 2, 1, 0, true, false, false, false, t + 2, RNONE);
    STEP3(0, 3, 2, 1, false, false, false, false, t + 3, RNONE);
#undef RSTORE
#undef RLOAD
#undef RNONE
#undef STEP3
#undef MAXP0D
#undef MAXP1
#undef PACK0B
#undef PACK0A
  } else {
  kpf0 = KFR(0, 1 * SHM_K); kpf1 = KFR(1, 1 * SHM_K);
  int t = 0;
  WConv wcv; int wc_it = wc_base + __builtin_amdgcn_readfirstlane(wid);
  for (; t + 7 < NT; t += 4) {
    STEP(1, 0, 3, 2, true, true, true, true, t);
    if constexpr (WC) wconv_load(*pp, wc_it, lane, wcv);
    STEP(2, 1, 0, 3, true, true, true, true, t + 1);
    STEP(3, 2, 1, 0, true, true, true, true, t + 2);
    if constexpr (WC) { wconv_store(*pp, wc_it, lane, wcv); wc_it += (int)gridDim.x * 8; }
    STEP(0, 3, 2, 1, true, true, true, true, t + 3);
  }
  STEP(1, 0, 3, 2, true, true, false, true, t);
  STEP(2, 1, 0, 3, true, false, false, true, t + 1);
  STEP(3, 2, 1, 0, true, false, false, false, t + 2);
  STEP(0, 3, 2, 1, false, false, false, false, t + 3);
  }
  float rli[16];
#pragma unroll
  for (int r = 0; r < 16; ++r) rli[r] = __builtin_amdgcn_rcpf(ol[r]);
  if constexpr (OM == 1) {
    unsigned* st = (unsigned*)stash + tid;
#pragma unroll
    for (int r = 0; r < 16; ++r) { st[(2 * r) * 512] = cvt_pk_bf16(o[0][r] * rli[r], o[1][r] * rli[r]); st[(2 * r + 1) * 512] = cvt_pk_bf16(o[2][r] * rli[r], o[3][r] * rli[r]); }
  } else if constexpr (OM == 2) {
    const unsigned* st = (const unsigned*)stash + tid;
    float sw[4];
#pragma unroll
    for (int d0 = 0; d0 < 4; ++d0) sw[d0] = subw[d0 * 32 + r32] * 0.8f;
    bf16_t* Ow = Ob + (long)(wid * 32) * ldo;
#pragma unroll
    for (int r = 0; r < 16; ++r) { const unsigned w01 = st[(2 * r) * 512], w23 = st[(2 * r + 1) * 512];
      const float d0v = bflo(w01) - lam * (o[0][r] * rli[r]), d1v = bfhi(w01) - lam * (o[1][r] * rli[r]), d2v = bflo(w23) - lam * (o[2][r] * rli[r]), d3v = bfhi(w23) - lam * (o[3][r] * rli[r]);
      float ss = (d0v * d0v + d1v * d1v) + (d2v * d2v + d3v * d3v);
      ss += __shfl_xor(ss, 1); ss += __shfl_xor(ss, 2); ss += __shfl_xor(ss, 4); ss += __shfl_xor(ss, 8); ss += __shfl_xor(ss, 16);
      const float rn = rsqrtf(ss * (1.f / 128.f) + EPS); const long ob = (long)crow(r, hi) * ldo + r32;
#if P6_FP8
      unsigned char* O8 = (unsigned char*)Ob + (long)(wid * 32) * ldo; O8[ob] = f2fp8(d0v * rn * sw[0]); O8[ob + 32] = f2fp8(d1v * rn * sw[1]); O8[ob + 64] = f2fp8(d2v * rn * sw[2]); O8[ob + 96] = f2fp8(d3v * rn * sw[3]); }
#else
      Ow[ob] = f2bf(SQ6(d0v * rn * sw[0])); Ow[ob + 32] = f2bf(SQ6(d1v * rn * sw[1])); Ow[ob + 64] = f2bf(SQ6(d2v * rn * sw[2])); Ow[ob + 96] = f2bf(SQ6(d3v * rn * sw[3])); }
#endif
  } else {
    bf16_t* Ow = Ob + (long)(wid * 32) * ldo;
#pragma unroll
    for (int r = 0; r < 16; ++r) { const int orow = crow(r, hi);
#pragma unroll
#if P6_FP8
      for (int d0 = 0; d0 < 4; ++d0) ((unsigned char*)Ob + (long)(wid * 32) * ldo)[(long)orow * ldo + d0 * 32 + r32] = f2fp8(o[d0][r] * rli[r]); }
#else
      for (int d0 = 0; d0 < 4; ++d0) Ow[(long)orow * ldo + d0 * 32 + r32] = f2bf(SQ6(o[d0][r] * rli[r] * 32.f) * (1.f / 32.f)); }
#endif
  }
#undef BL16
#undef SLOAD
#undef SWRITE
#undef RESC
#undef KFR
#undef VFR
#undef LDP
#undef STEP
#undef PACKP
#undef MPIN
#undef PACK0
#undef PACK1
#undef MAX0
#undef MAXFIN
#undef EXPS
}
#undef OFF8
#undef SBAR
#undef MFMA8
#undef LD32
}
#ifdef HW_XCD_MAP
__device__ __forceinline__ int att_cc(const Params& p, const char* lds, int u) {
    const volatile unsigned* bst = (const volatile unsigned*)(lds + 160 * 1024 - 512); const unsigned* cnt = (const unsigned*)(p.ws + WS_BAR) + 3500;
    bool ok = gridDim.x == 256;
#pragma unroll
    for (int i = 0; i < 8; ++i) ok = ok && (__hip_atomic_load(cnt + i, __ATOMIC_RELAXED, __HIP_MEMORY_SCOPE_AGENT) == 32u);
    return ok ? (int)(bst[2] + 8u * bst[3]) : -1;
}
#define ATT_CC(u) (hwcc_ >= 0 ? hwcc_ : ((u) & 255))
#else
#define ATT_CC(u) ((u) & 255)
#endif
#ifdef HW_XCD_MAP
#define ATT_CC_INIT const int hwcc_ = __builtin_amdgcn_readfirstlane(att_cc(p, lds, 0));
#else
#define ATT_CC_INIT
#endif
__device__ __forceinline__ void p4_attention_diff(const Params& p, char* lds) {
    unsigned char* ws = p.ws;
    const bf16_t* PJ = (const bf16_t*)(ws + WS_PJ); bf16_t* MIX = (bf16_t*)(ws + WS_MIX);
    char* stash = lds + 80 * 1024;
    ATT_CC_INIT
#if ATT_FP8 && WCONV_IN_ATT
    const int wcoff = gridDim.x == 256 ? 0 : attn8::WCONV_ITEMS;
    if (gridDim.x != 256) { const int tid_ = tid_opaque(), lane_ = tid_ & 63, gw_ = blockIdx.x * NWAVES + (tid_ >> 6), NGW_ = gridDim.x * NWAVES;
        for (int it = gw_; it < attn8::WCONV_ITEMS; it += NGW_) { attn8::WConv w_; attn8::wconv_load(p, it, lane_, w_); attn8::wconv_store(p, it, lane_, w_); } }
#else
    const int wcoff = 0;
#endif
    for (int u = blockIdx.x; u < 512 + ATT_EXTRA; u += gridDim.x) {
        const int round = (u >> 8) & 1, cc = ATT_CC(u), x = ATT_X(cc), j = ATT_J(cc);
        const int pd = x * 2 + round, b = pd >> 2, h = pd & 3;
        const size_t krow0 = (size_t)b * RPB, qrow0 = krow0 + CTX + (size_t)j * 256;
#if ATT_EXTRA
        if (u >= 512) { const unsigned char* vtx_ = ws + WS_VT8D + (size_t)(b * 4 + h) * 128 * RPB;
            attn8::attn_unit<1, 0, ATT_VAR>(ws + WS_Q8D + qrow0 * 512 + (2 * h) * 64, 512, ws + WS_K8D + krow0 * 512 + (2 * h) * 64, 512, nullptr, 0, nullptr, 0, vtx_, (bf16_t*)(ws + WS_AO) + qrow0 * 128, 128, RPB, lds);
            attn8::attn_unit<1, 0, ATT_VAR>(ws + WS_Q8D + qrow0 * 512 + (2 * h + 1) * 64, 512, ws + WS_K8D + krow0 * 512 + (2 * h + 1) * 64, 512, nullptr, 0, nullptr, 0, vtx_, (bf16_t*)(ws + WS_AO) + qrow0 * 128, 128, RPB, lds);
            continue; }
#endif
#if ATT_FP8
        const unsigned char* vt_ = ws + WS_VT8D + (size_t)(b * 4 + h) * 128 * RPB;
        const int wcb0 = wcoff + ((u / (int)gridDim.x) * 2 + 0) * 32 * (int)gridDim.x * 8 + (int)blockIdx.x * 8, wcb1 = wcb0 + 32 * (int)gridDim.x * 8;
        if (u < (int)gridDim.x) attn8::attn_unit<1, 1, 0, WCONV_IN_ATT != 0>(ws + WS_Q8D + qrow0 * 512 + (2 * h) * 64, 512, ws + WS_K8D + krow0 * 512 + (2 * h) * 64, 512, nullptr, 0, nullptr, 0, vt_, nullptr, 0, RPB, lds, stash, 0.f, nullptr, &p, wcoff + 131072 + (int)blockIdx.x * 8);
        else attn8::attn_unit<1, 1, 0, false>(ws + WS_Q8D + qrow0 * 512 + (2 * h) * 64, 512, ws + WS_K8D + krow0 * 512 + (2 * h) * 64, 512, nullptr, 0, nullptr, 0, vt_, nullptr, 0, RPB, lds, stash);
#else
        attn::attn_unit<1, 1, 0, 1>(PJ + qrow0 * NPROJ + (2 * h) * 64, NPROJ, PJ + krow0 * NPROJ + 512 + (2 * h) * 64, NPROJ, nullptr, 0, nullptr, 0,
                              PJ + krow0 * NPROJ + 1024 + h * 128, NPROJ, nullptr, 0, RPB, 1.f, lds, stash);
#endif
        const int lane_ = tid_opaque() & 63;
        const float s1 = wave_sum(p.lq1[lane_] * p.lk1[lane_]), s2 = wave_sum(p.lq2[lane_] * p.lk2[lane_]);
        const float lam = __expf(s1) - __expf(s2) + 0.2f;
#if ATT_FP8
        attn8::attn_unit<1, 2, 0, false>(ws + WS_Q8D + qrow0 * 512 + (2 * h + 1) * 64, 512, ws + WS_K8D + krow0 * 512 + (2 * h + 1) * 64, 512, nullptr, 0, nullptr, 0, vt_, P6_FP8 ? (bf16_t*)((unsigned char*)MIX + qrow0 * 1024 + h * 128) : MIX + qrow0 * 1024 + h * 128, 1024, RPB, lds, stash, lam, p.subln_w, &p, wcb1);
#else
        attn::attn_unit<1, 1, 0, 2>(PJ + qrow0 * NPROJ + (2 * h + 1) * 64, NPROJ, PJ + krow0 * NPROJ + 512 + (2 * h + 1) * 64, NPROJ, nullptr, 0, nullptr, 0,
                              PJ + krow0 * NPROJ + 1024 + h * 128, NPROJ, MIX + qrow0 * 1024 + h * 128, 1024, RPB, 1.f, lds, stash, lam, p.subln_w);
#endif
    }
}
__device__ __forceinline__ void p4_attention_mla(const Params& p, char* lds) {
    unsigned char* ws = p.ws;
    const bf16_t* PJ = (const bf16_t*)(ws + WS_PJ); const bf16_t* QM = (const bf16_t*)(ws + WS_QM); const bf16_t* KVb = (const bf16_t*)(ws + WS_KV);
    bf16_t* MIX = (bf16_t*)(ws + WS_MIX);
    constexpr float LOG2E = 1.4426950408889634f;
    ATT_CC_INIT
    for (int u = blockIdx.x; u < 512; u += gridDim.x) {
        const int round = u >> 8, cc = ATT_CC(u), x = ATT_X(cc), j = ATT_J(cc);
        const int pd = x * 2 + round, b = pd >> 2, h = pd & 3;
        const size_t krow0 = (size_t)b * RPB, qrow0 = krow0 + CTX + (size_t)j * 256;
#if ATT_FP8
        const int wcb = (gridDim.x == 256 ? 0 : attn8::WCONV_ITEMS) + (u / (int)gridDim.x) * 32 * (int)gridDim.x * 8 + (int)blockIdx.x * 8;
        attn8::attn_unit<3, 0, 0, WCONV_IN_ATT != 0>(ws + WS_Q8M + qrow0 * 768 + h * 192, 768, ws + WS_K8M + krow0 * 512 + h * 128, 512, ws + WS_K8M + krow0 * 512 + h * 128 + 64, 512, ws + WS_KR8 + krow0 * 64, 64,
                               ws + WS_VT8M + (size_t)(b * 4 + h) * 128 * RPB, P6_FP8 ? (bf16_t*)((unsigned char*)MIX + qrow0 * 1024 + 512 + h * 128) : MIX + qrow0 * 1024 + 512 + h * 128, 1024, RPB, lds, nullptr, 0.f, nullptr, &p, wcb);
#else
        attn::attn_unit<3, MLA_NQR>(QM + qrow0 * 768 + h * 192, 768, KVb + krow0 * 1024 + h * 256, 1024, KVb + krow0 * 1024 + h * 256 + 64, 1024, PJ + krow0 * NPROJ + 1920, NPROJ,
                              KVb + krow0 * 1024 + h * 256 + 128, 1024, MIX + qrow0 * 1024 + 512 + h * 128, 1024, RPB, 0.07216878364870322f * LOG2E, lds);
#endif
    }
}

__device__ __forceinline__ void p5_mix(const Params& p) {
    const int tid = tid_opaque(), lane = tid & 63, wave = tid >> 6;
    const int gw = blockIdx.x * NWAVES + wave, NGW = gridDim.x * NWAVES;
    const bf16_t* AO = (const bf16_t*)(p.ws + WS_AO); bf16_t* MIX = (bf16_t*)(p.ws + WS_MIX);
    const float s1 = wave_sum(p.lq1[lane] * p.lk1[lane]), s2 = wave_sum(p.lq2[lane] * p.lk2[lane]);
    const float lam_init = 0.2f, lam = __expf(s1) - __expf(s2) + lam_init;
    const int hh = lane >> 4, e0 = (lane & 15) * 8;
    float sw[8];
#pragma unroll
    for (int i = 0; i < 8; ++i) sw[i] = p.subln_w[e0 + i] * (1.f - lam_init);
    for (int t = gw; t < T; t += NGW) {
        const int b = t >> 13, row = b * RPB + CTX + (t & 8191);
        const bf16_t* src = AO + (size_t)row * 1536;
        const u32x4 a = *(const u32x4*)(src + hh * 256 + e0), bq = *(const u32x4*)(src + hh * 256 + 128 + e0), mq = *(const u32x4*)(src + 1024 + lane * 8);
        float o[8];
        o[0] = bflo(a.x) - lam * bflo(bq.x); o[1] = bfhi(a.x) - lam * bfhi(bq.x); o[2] = bflo(a.y) - lam * bflo(bq.y); o[3] = bfhi(a.y) - lam * bfhi(bq.y);
        o[4] = bflo(a.z) - lam * bflo(bq.z); o[5] = bfhi(a.z) - lam * bfhi(bq.z); o[6] = bflo(a.w) - lam * bflo(bq.w); o[7] = bfhi(a.w) - lam * bfhi(bq.w);
        float ss = 0.f;
#pragma unroll
        for (int i = 0; i < 8; ++i) ss += o[i] * o[i];
        ss += __shfl_xor(ss, 1); ss += __shfl_xor(ss, 2); ss += __shfl_xor(ss, 4); ss += __shfl_xor(ss, 8);
        const float r = rsqrtf(ss * (1.f / 128.f) + EPS);
        u32x4 w; w.x = cvt_pk_bf16(o[0] * r * sw[0], o[1] * r * sw[1]); w.y = cvt_pk_bf16(o[2] * r * sw[2], o[3] * r * sw[3]);
        w.z = cvt_pk_bf16(o[4] * r * sw[4], o[5] * r * sw[5]); w.w = cvt_pk_bf16(o[6] * r * sw[6], o[7] * r * sw[7]);
        bf16_t* dst = MIX + (size_t)row * 1024;
        *(u32x4*)(dst + hh * 128 + e0) = w; *(u32x4*)(dst + 512 + lane * 8) = mq;
    }
}

typedef short bf16x8_t __attribute__((ext_vector_type(8)));
__device__ __forceinline__ void p7a_route(const Params& p, unsigned char* lds) {
    const int tid = tid_opaque(), lane = tid & 63, wave = tid >> 6, row = lane & 15, kq = lane >> 4;
    int* lcnt = (int*)(lds + 147456); int* lbase = lcnt + 32; int* tok_e = lbase + 32; int* tok_r = tok_e + 1024;
    for (int i = tid; i < 8192; i += NTHREADS) ((u32x4*)lds)[i] = ((const u32x4*)(p.ws + WS_RWF))[i];
    if (tid < 32) lcnt[tid] = 0;
    const int chunk = (T + gridDim.x - 1) / gridDim.x;
    const int t0 = blockIdx.x * chunk, t1 = (t0 + chunk < T) ? t0 + chunk : T;
    float* vab = (float*)(lds + 131072); const int b0 = t0 >> 13;
    { const float* mods_ = (const float*)(p.ws + WS_MODS);
      for (int i = tid; i < 2048; i += NTHREADS) { const int bb = min(b0 + (i >> 10), NB - 1), k = i & 1023; const float* md_ = mods_ + bb * 6144;
          vab[(i >> 10) * 2048 + k] = p.ffn_norm_w[k] * (md_[4 * 1024 + k] + 1.f); vab[(i >> 10) * 2048 + 1024 + k] = md_[3 * 1024 + k]; } }
    __syncthreads();
    const bf16_t* XN = (const bf16_t*)(p.ws + WS_XN); const float* mods = (const float*)(p.ws + WS_MODS);
    unsigned char* HF = p.ws + WS_HF;
    int* TOPI = (int*)(p.ws + WS_TOPI); float* GATE = (float*)(p.ws + WS_GATE); int* RANK = (int*)(p.ws + WS_RANK); int* CNT = (int*)(p.ws + WS_CNT);
    const u32x4* rwf = (const u32x4*)lds + lane;
    for (int tb = t0 + 16 * wave; tb < t1; tb += 16 * NWAVES) {
        const int t = tb + row, b = tb >> 13; const float* md = mods + b * 6144;
        const bf16_t* xr = XN + (size_t)t * DM + 8 * kq;
        const float r = rsqrtf(((const float*)(p.ws + WS_RSX))[t] * (1.f / DM) + EPS);
        f32x4 acc0 = {0.f, 0.f, 0.f, 0.f}, acc1 = {0.f, 0.f, 0.f, 0.f};
        const float* va = vab + ((tb >> 13) - b0) * 2048 + 8 * kq; const float* vb = va + 1024;
        u32x4 xq[4];
#pragma unroll
        for (int j = 0; j < 4; ++j) xq[j] = *(const u32x4*)(xr + 32 * j);
#pragma unroll 4
        for (int s = 0; s < 32; ++s) { const int k0 = 32 * s + 8 * kq;
            const u32x4 xw = xq[s & 3]; if (s + 4 < 32) xq[s & 3] = *(const u32x4*)(xr + 32 * (s + 4));
            const f32x4 xa = {bflo(xw.x), bfhi(xw.x), bflo(xw.y), bfhi(xw.y)}, xc = {bflo(xw.z), bfhi(xw.z), bflo(xw.w), bfhi(xw.w)};
            const f32x4 ha = xa * r * *(const f32x4*)(va + 32 * s) + *(const f32x4*)(vb + 32 * s), hc = xc * r * *(const f32x4*)(va + 32 * s + 4) + *(const f32x4*)(vb + 32 * s + 4);
            u32x4 hi, lo;
            hi.x = cvt_pk_bf16(ha.x, ha.y); hi.y = cvt_pk_bf16(ha.z, ha.w); hi.z = cvt_pk_bf16(hc.x, hc.y); hi.w = cvt_pk_bf16(hc.z, hc.w);
            lo.x = cvt_pk_bf16(ha.x - bflo(hi.x), ha.y - bfhi(hi.x)); lo.y = cvt_pk_bf16(ha.z - bflo(hi.y), ha.w - bfhi(hi.y));
            lo.z = cvt_pk_bf16(hc.x - bflo(hi.z), hc.y - bfhi(hi.z)); lo.w = cvt_pk_bf16(hc.z - bflo(hi.w), hc.w - bfhi(hi.w));
            { u32x2 h8; h8.x = cvt4_fp8(ha.x, ha.y, ha.z, ha.w); h8.y = cvt4_fp8(hc.x, hc.y, hc.z, hc.w); *(u32x2*)(HF + (size_t)t * DM + k0) = h8; }
            const bf16x8_t Ah = __builtin_bit_cast(bf16x8_t, hi), Al = __builtin_bit_cast(bf16x8_t, lo);
            const bf16x8_t Bh0 = __builtin_bit_cast(bf16x8_t, rwf[(s * 4 + 0) * 64]), Bl0 = __builtin_bit_cast(bf16x8_t, rwf[(s * 4 + 1) * 64]);
            const bf16x8_t Bh1 = __builtin_bit_cast(bf16x8_t, rwf[(s * 4 + 2) * 64]), Bl1 = __builtin_bit_cast(bf16x8_t, rwf[(s * 4 + 3) * 64]);
            acc0 = __builtin_amdgcn_mfma_f32_16x16x32_bf16(Ah, Bh0, acc0, 0, 0, 0); acc0 = __builtin_amdgcn_mfma_f32_16x16x32_bf16(Ah, Bl0, acc0, 0, 0, 0); acc0 = __builtin_amdgcn_mfma_f32_16x16x32_bf16(Al, Bh0, acc0, 0, 0, 0);
            acc1 = __builtin_amdgcn_mfma_f32_16x16x32_bf16(Ah, Bh1, acc1, 0, 0, 0); acc1 = __builtin_amdgcn_mfma_f32_16x16x32_bf16(Ah, Bl1, acc1, 0, 0, 0); acc1 = __builtin_amdgcn_mfma_f32_16x16x32_bf16(Al, Bh1, acc1, 0, 0, 0); }
        const float rb0 = p.router_b[row], rb1 = p.router_b[16 + row];
#pragma unroll
        for (int reg = 0; reg < 4; ++reg) { float v0 = acc0[reg] + rb0, v1 = acc1[reg] + rb1; float tv[4]; int ti[4];
#pragma unroll
            for (int k = 0; k < 4; ++k) { float m = fmaxf(v0, v1);
                m = fmaxf(m, __shfl_xor(m, 1)); m = fmaxf(m, __shfl_xor(m, 2)); m = fmaxf(m, __shfl_xor(m, 4)); m = fmaxf(m, __shfl_xor(m, 8));
                int cand = (v0 == m) ? row : ((v1 == m) ? 16 + row : 99);
                cand = min(cand, __shfl_xor(cand, 1)); cand = min(cand, __shfl_xor(cand, 2)); cand = min(cand, __shfl_xor(cand, 4)); cand = min(cand, __shfl_xor(cand, 8));
                tv[k] = m; ti[k] = cand; if (cand == row) v0 = -INFINITY; if (cand == 16 + row) v1 = -INFINITY; }
            const float e1 = __expf(tv[1] - tv[0]), e2 = __expf(tv[2] - tv[0]), e3 = __expf(tv[3] - tv[0]); const float inv = 1.f / (1.f + e1 + e2 + e3);
            const int tt = tb + 4 * kq + reg;
            if (row < 4 && tt < t1) { const int ei = row == 0 ? ti[0] : row == 1 ? ti[1] : row == 2 ? ti[2] : ti[3]; const float gv = (row == 0 ? 1.f : row == 1 ? e1 : row == 2 ? e2 : e3) * inv;
                const int lr = atomicAdd(&lcnt[ei], 1);
                TOPI[tt * 4 + row] = ei; GATE[tt * 4 + row] = gv; tok_e[(tt - t0) * 4 + row] = ei; tok_r[(tt - t0) * 4 + row] = lr; } }
    }
    __syncthreads();
    if (tid < 32) lbase[tid] = atomicAdd(&CNT[tid], lcnt[tid]);
    __syncthreads();
    for (int i = tid; i < (t1 - t0) * 4; i += NTHREADS) RANK[t0 * 4 + i] = lbase[tok_e[i]] + tok_r[i];
}

__device__ __forceinline__ void moe_segments(const Params& p, int* seg) {
    if (threadIdx.x == 0) { const int* CNT = (const int*)(p.ws + WS_CNT); int s = 0;
        for (int e = 0; e < 32; ++e) { seg[e] = s; s += (CNT[e] + 255) & ~255; } seg[32] = s; }
    __syncthreads();
}
__device__ __forceinline__ void p7b_scatter(const Params& p, const int* seg) {
    const int tid = tid_opaque();
    const int gt = blockIdx.x * NTHREADS + tid, NGT = gridDim.x * NTHREADS;
    const int* TOPI = (const int*)(p.ws + WS_TOPI); const float* GATE = (const float*)(p.ws + WS_GATE); const int* RANK = (const int*)(p.ws + WS_RANK);
    int* DEST = (int*)(p.ws + WS_DEST); float* GS = (float*)(p.ws + WS_GSRT); int* RTOK = (int*)(p.ws + WS_RTOK);
    for (int i = gt; i < T * 4; i += NGT) { const int dest = seg[TOPI[i]] + RANK[i]; DEST[i] = dest; GS[dest] = GATE[i]; RTOK[dest] = i >> 2; }
}
__device__ __forceinline__ void p10_final(const Params& p, const bool with_moe) {
    const int tid = tid_opaque(), lane = tid & 63, wave = tid >> 6;
    const int gw = blockIdx.x * NWAVES + wave, NGW = gridDim.x * NWAVES;
    const bf16_t* XN = (const bf16_t*)(p.ws + WS_XN); const float* mods = (const float*)(p.ws + WS_MODS);
    const int* DEST = (const int*)(p.ws + WS_DEST);
    const f32x4* w4 = (const f32x4*)p.final_norm_w;
    for (int tb = gw; tb < T; tb += P10_NT * NGW) {
        int tt[P10_NT]; bool ok[P10_NT]; u32x2 xw[P10_NT][4];
#if YS_FP8
        unsigned yw[P10_NT][4][4];
#else
        u32x2 yw[P10_NT][4][4];
#endif
#pragma unroll
        for (int q = 0; q < P10_NT; ++q) { const int t_ = tb + q * NGW; ok[q] = t_ < T; tt[q] = ok[q] ? t_ : tb; }
#pragma unroll
        for (int q = 0; q < P10_NT; ++q) { const u32x2* xr = (const u32x2*)(XN + (size_t)tt[q] * DM);
#pragma unroll
            for (int j = 0; j < 4; ++j) xw[q][j] = xr[64 * j + lane];
            if (with_moe) {
#pragma unroll
                for (int k = 0; k < 4; ++k) { const int d = DEST[tt[q] * 4 + k];
#if YS_FP8
                    const unsigned* yr = (const unsigned*)(p.ws + WS_XS + (size_t)d * 1024);
#else
                    const u32x2* yr = (const u32x2*)(p.ws + WS_XS + (size_t)d * 2048);
#endif
#pragma unroll
                    for (int j = 0; j < 4; ++j) yw[q][k][j] = yr[64 * j + lane]; } } }
#pragma unroll
        for (int q = 0; q < P10_NT; ++q) { const int t = tt[q], b = t >> 13; const f32x4* g4 = (const f32x4*)(mods + b * 6144 + 5 * 1024);
            f32x4 xv[4];
#pragma unroll
            for (int j = 0; j < 4; ++j) { xv[j] = (f32x4){bflo(xw[q][j].x), bfhi(xw[q][j].x), bflo(xw[q][j].y), bfhi(xw[q][j].y)};
                if (with_moe) { f32x4 y = {0.f, 0.f, 0.f, 0.f};
#pragma unroll
                    for (int k = 0; k < 4; ++k) {
#if YS_FP8
                        const int w_ = (int)yw[q][k][j]; const auto lo_ = __builtin_amdgcn_cvt_pk_f32_fp8(w_, false), hi_ = __builtin_amdgcn_cvt_pk_f32_fp8(w_, true);
                        y += (f32x4){lo_[0], lo_[1], hi_[0], hi_[1]};
#else
                        const u32x2 w_ = yw[q][k][j]; y += (f32x4){bflo(w_.x), bfhi(w_.x), bflo(w_.y), bfhi(w_.y)};
#endif
                    }
                    xv[j] += g4[64 * j + lane] * y * (YS_FP8 ? 1.f / YS_SCALE : 1.f); } }
            float s = 0.f;
#pragma unroll
            for (int j = 0; j < 4; ++j) s += (xv[j].x * xv[j].x + xv[j].y * xv[j].y) + (xv[j].z * xv[j].z + xv[j].w * xv[j].w);
            float r = rsqrtf(wave_sum(s) * (1.f / DM) + EPS);
#if DBG_STAGE
            r *= 1.f + 10.f * fminf(__uint_as_float(((const unsigned*)(p.ws + WS_CNT))[64]), 100.f);
#endif
            if (ok[q]) { f32x4* o = (f32x4*)(p.out + (size_t)t * DM);
#pragma unroll
                for (int j = 0; j < 4; ++j) __builtin_nontemporal_store(xv[j] * r * w4[64 * j + lane], o + 64 * j + lane); }
        }
    }
}
#if DBG_STAGE
__device__ __forceinline__ void dbg_report(const Params& p, float err) {
    if (!(err >= 0.f)) err = 1e6f;
    atomicMax((unsigned*)(p.ws + WS_CNT) + 64, __float_as_uint(err));
}
__device__ __forceinline__ void dbg_rope(float& x1, float& x2, int pv, int pp) {
    const float inv = exp2f(-(float)pp * (13.287712379549449f / 16.f)); float sn, cs; sincosf((float)pv * inv, &sn, &cs);
    const float a = x1 * cs - x2 * sn, b = x2 * cs + x1 * sn; x1 = a; x2 = b;
}
__device__ __forceinline__ void dbg_check_proj(const Params& p) {
    const int gt = blockIdx.x * NTHREADS + threadIdx.x, NGT = gridDim.x * NTHREADS;
    const bf16_t* HB = (const bf16_t*)(p.ws + WS_HB); const bf16_t* PJ = (const bf16_t*)(p.ws + WS_PJ); const bf16_t* QM = (const bf16_t*)(p.ws + WS_QM); const bf16_t* KVb = (const bf16_t*)(p.ws + WS_KV);
    float emax = 0.f;
    for (int it = gt; it < 24 * 224; it += NGT) { const int rs = it / 224, cpi = it % 224; const int row = rs < 6 ? (rs & 3) * RPB + (rs * 37) % CTX : (rs * 1409 + 77) % MALL; const int grp = cpi >> 4, pp = cpi & 15, c0 = 1536 + grp * 32 + pp, c1 = c0 + 16;
        float a0 = 0.f, a1 = 0.f;
        for (int k = 0; k < 1024; ++k) { const float h = bf2f(HB[(size_t)row * 1024 + k]); a0 += h * bf2f(f2bf(p.w_in[(size_t)k * 1984 + c0])); a1 += h * bf2f(f2bf(p.w_in[(size_t)k * 1984 + c1])); }
        const int i = row % RPB; if (i >= CTX && c0 >= 1920) { const int pos = i - CTX, a = (c0 >> 5) & 1; dbg_rope(a0, a1, a ? (pos & 63) : (pos >> 6), pp); }
        const float f0 = bf2f(PJ[(size_t)row * NPROJ + c0]), f1 = bf2f(PJ[(size_t)row * NPROJ + c1]);
        emax = fmaxf(emax, fmaxf(fabsf(f0 - a0), fabsf(f1 - a1))); }
    for (int it = gt; it < 24 * 384; it += NGT) { const int rs = it / 384, cpi = it % 384; const int row = rs < 6 ? (rs & 3) * RPB + (rs * 41) % CTX : (rs * 1409 + 300) % MALL; const int grp = cpi >> 4, pp = cpi & 15, c0 = grp * 32 + pp, c1 = c0 + 16;
        float ss = 0.f, a0 = 0.f, a1 = 0.f;
        for (int k = 0; k < 256; ++k) { const float v = bf2f(PJ[(size_t)row * NPROJ + 1536 + k]); ss += v * v; const float vw = v * p.q_norm_w[k]; a0 += vw * p.w_uq[(size_t)k * 768 + c0]; a1 += vw * p.w_uq[(size_t)k * 768 + c1]; }
        const float r = rsqrtf(ss / 256.f + EPS); a0 *= r; a1 *= r;
        const int i = row % RPB, g6 = grp % 6; if (i >= CTX && g6 >= 4) { const int pos = i - CTX; dbg_rope(a0, a1, g6 == 5 ? (pos & 63) : (pos >> 6), pp); }
        const float f0 = bf2f(QM[(size_t)row * 768 + c0]), f1 = bf2f(QM[(size_t)row * 768 + c1]);
        emax = fmaxf(emax, fmaxf(fabsf(f0 - a0), fabsf(f1 - a1))); }
    for (int it = gt; it < 24 * 1024; it += NGT) { const int rs = it >> 10, c0 = it & 1023; const int row = rs < 6 ? (rs & 3) * RPB + (rs * 43) % CTX : (rs * 1409 + 555) % MALL;
        float ss = 0.f, a0 = 0.f;
        for (int k = 0; k < 128; ++k) { const float v = bf2f(PJ[(size_t)row * NPROJ + 1792 + k]); ss += v * v; a0 += v * p.kv_norm_w[k] * p.w_ukv[(size_t)k * 1024 + c0]; }
        a0 *= rsqrtf(ss / 128.f + EPS);
        emax = fmaxf(emax, fabsf(bf2f(KVb[(size_t)row * 1024 + c0]) - a0)); }
    emax = wave_max(emax);
    if ((threadIdx.x & 63) == 0) dbg_report(p, emax);
}
__device__ __forceinline__ void dbg_check_attn(const Params& p, unsigned char* lds, int kind_sel) {
    const int tid = threadIdx.x;
    const bf16_t* PJ = (const bf16_t*)(p.ws + WS_PJ); const bf16_t* QM = (const bf16_t*)(p.ws + WS_QM); const bf16_t* KVb = (const bf16_t*)(p.ws + WS_KV); const bf16_t* AO = (const bf16_t*)(p.ws + WS_MIX);
    float* sc = (float*)lds; float* red = sc + 8448; float* qv = red + 1024;
    for (int s = blockIdx.x; s < 128; s += gridDim.x) {
        const int kind = s & 1; if (kind_sel >= 0 && kind != kind_sel) continue;
        const int b = (s >> 1) & 3, hh = (s >> 3) & 7, qpos = ((s >> 1) * 2731 + 13) & 8191;
        const size_t krow0 = (size_t)b * RPB, qrow = krow0 + CTX + qpos;
        const int dqk = kind ? 192 : 64; const int h = kind ? (hh & 3) : hh;
#if ATT_FP8
        const float scale = 0.6931471805599453f;
        const unsigned char* W8 = p.ws;
#define F8(ptr) __builtin_amdgcn_cvt_f32_fp8((int)(*(const unsigned char*)(ptr)), 0)
        __syncthreads();
        if (tid < dqk) qv[tid] = kind ? F8(W8 + WS_Q8M + qrow * 768 + h * 192 + tid) : F8(W8 + WS_Q8D + qrow * 512 + h * 64 + tid);
        __syncthreads();
        float lmax = -1e30f;
        for (int k = tid; k < RPB; k += NTHREADS) { float a = 0.f;
            if (kind) { for (int d = 0; d < 128; ++d) a += qv[d] * F8(W8 + WS_K8M + (krow0 + k) * 512 + h * 128 + d); for (int d = 0; d < 64; ++d) a += qv[128 + d] * F8(W8 + WS_KR8 + (krow0 + k) * 64 + d); }
            else { for (int d = 0; d < 64; ++d) a += qv[d] * F8(W8 + WS_K8D + (krow0 + k) * 512 + h * 64 + d); }
            a *= scale; sc[k] = a; lmax = fmaxf(lmax, a); }
#else
        const float scale = kind ? 0.07216878364870322f : 0.6931471805599453f;
        __syncthreads();
        if (tid < dqk) qv[tid] = kind ? bf2f(QM[qrow * 768 + h * 192 + tid]) : bf2f(PJ[qrow * NPROJ + h * 64 + tid]);
        __syncthreads();
        float lmax = -1e30f;
        for (int k = tid; k < RPB; k += NTHREADS) { float a = 0.f;
            if (kind) { for (int d = 0; d < 128; ++d) a += qv[d] * bf2f(KVb[(krow0 + k) * 1024 + h * 256 + d]); for (int d = 0; d < 64; ++d) a += qv[128 + d] * bf2f(PJ[(krow0 + k) * NPROJ + 1920 + d]); }
            else { for (int d = 0; d < 64; ++d) a += qv[d] * bf2f(PJ[(krow0 + k) * NPROJ + 512 + h * 64 + d]); }
            a *= scale; sc[k] = a; lmax = fmaxf(lmax, a); }
#endif
        lmax = wave_max(lmax); if ((tid & 63) == 0) red[tid >> 6] = lmax; __syncthreads();
        float m = red[0]; for (int w = 1; w < 8; ++w) m = fmaxf(m, red[w]); __syncthreads();
        float lsum = 0.f; for (int k = tid; k < RPB; k += NTHREADS) { const float e = __expf(sc[k] - m); sc[k] = e; lsum += e; }
        lsum = wave_sum(lsum); if ((tid & 63) == 0) red[tid >> 6] = lsum; __syncthreads();
        float l = 0.f; for (int w = 0; w < 8; ++w) l += red[w]; __syncthreads();
        const int e = tid & 127, part = tid >> 7; float o = 0.f;
#if ATT_FP8
        for (int k = part; k < RPB; k += 4) { const unsigned char* vt = p.ws + (kind ? WS_VT8M : WS_VT8D) + ((size_t)(b * 4 + (kind ? h : (h >> 1))) * 128 + e) * RPB + (k & ~63) + vt_pos(k & 63); o += sc[k] * F8(vt); }
#else
        for (int k = part; k < RPB; k += 4) { const float v = kind ? bf2f(KVb[(krow0 + k) * 1024 + h * 256 + 128 + e]) : bf2f(PJ[(krow0 + k) * NPROJ + 1024 + (h >> 1) * 128 + e]); o += sc[k] * v; }
#endif
        red[tid] = o; __syncthreads();
        if (tid < 128) { const float on = (red[tid] + red[tid + 128] + red[tid + 256] + red[tid + 384]) / l;
            const float of = bf2f(AO[qrow * 1024 + 512 + h * 128 + tid]);
            float d2 = (of - on) * (of - on), n2 = on * on;
            d2 = wave_sum(d2); n2 = wave_sum(n2); red[512 + (tid >> 6) * 2] = d2; red[512 + (tid >> 6) * 2 + 1] = n2; }
        __syncthreads();
        if (tid == 0) { const float d2 = red[512] + red[514], n2 = red[513] + red[515]; dbg_report(p, sqrtf(d2 / (n2 + 1e-30f))); }
    }
    __syncthreads();
}
#endif
typedef const __attribute__((address_space(4))) Params* ParamsK;
#if defined(__HIP_DEVICE_COMPILE__)
#define LOAD_PARAMS() ({ ParamsK q_ = (ParamsK)__builtin_amdgcn_kernarg_segment_ptr(); asm volatile("" : "+s"(q_)); Params r_ = *q_; r_; })
#else
#define LOAD_PARAMS() (Params{})
#endif
#ifndef FIRST_PHASE
#define FIRST_PHASE 0
#endif
#define PH(k) ((k) >= FIRST_PHASE && (k) <= LAST_PHASE)
#ifndef EPIY_PROBE
#define EPIY_PROBE 0
#endif
#ifndef REP_MASK
#define REP_MASK 0
#endif
#define REP(k) for (int rep_ = 0; rep_ < (((REP_MASK) >> (k)) & 1) + 1; ++rep_)
#define PH_BEGIN { const Params p = LOAD_PARAMS(); unsigned char* ws = p.ws; (void)ws;
#define PH_END }
__global__ void __launch_bounds__(NTHREADS, 2) fwd_kernel(Params p_unused) {
    extern __shared__ __attribute__((aligned(16))) unsigned char lds[];
    cg::grid_group grid = cg::this_grid();
    LAS unsigned char* lds3 = (LAS unsigned char*)lds;
    const int G = gridDim.x, c = blockIdx.x;
    int* seg = (int*)(lds + 160 * 1024 - 256);
    volatile LAS unsigned* bst = (volatile LAS unsigned*)(lds3 + 160 * 1024 - 512);
    if (threadIdx.x < 2) bst[threadIdx.x] = 0u;
    __syncthreads();
    XcdBarrier bar;
    { ParamsK q_ = (ParamsK)__builtin_amdgcn_kernarg_segment_ptr(); bar = xcd_barrier_post((unsigned*)(q_->ws + WS_BAR), bst);
#ifdef HW_XCD_MAP
      if (threadIdx.x == 0) { const unsigned x_ = xb_xcc_id() & 7u; bst[2] = x_; bst[3] = atomicAdd((unsigned*)(q_->ws + WS_BAR) + 3500 + x_, 1u); }
#endif
    }
#ifdef USE_CG_SYNC
#define GRID_SYNC() grid.sync()
#else
#define GRID_SYNC() xcd_barrier(bar)
#endif

#ifdef ONLY4
#ifndef NO_DIFF
    PH_BEGIN p4_attention_diff(p, (char*)lds); PH_END
#endif
#ifndef NO_MLA
    PH_BEGIN p4_attention_mla(p, (char*)lds); PH_END
#endif
    return;
#endif
#ifdef UBENCH
    { typedef int v8i32_ __attribute__((ext_vector_type(8))); typedef float f32x16_ __attribute__((ext_vector_type(16))); typedef int v4i32_ __attribute__((ext_vector_type(4)));
      const int wv_ = __builtin_amdgcn_readfirstlane((int)threadIdx.x >> 6);
      float s_ = 0.f;
      LAS v4i32_* lp_ = (LAS v4i32_*)(lds3 + 65536) + threadIdx.x * 2;
      if (wv_ >= 4) { if (UBENCH != 5) {
          v8i32_ a_ = {(int)threadIdx.x, 1, 2, 3, 4, 5, 6, 7}, b_ = {7, 6, 5, 4, 3, 2, 1, (int)blockIdx.x}; f32x16_ c0 = {}, c1 = {}, c2 = {}, c3 = {}, c4 = {};
          for (int it = 0; it < 10000; ++it) {
              if (UBENCH >= 8) { const v4i32_ x0 = lp_[0], x1 = lp_[1]; b_ = __builtin_shufflevector(x0, x1, 0, 1, 2, 3, 4, 5, 6, 7); }
              c0 = __builtin_amdgcn_mfma_scale_f32_32x32x64_f8f6f4(a_, b_, c0, 0, 0, 0, 0, 0, 0); c1 = __builtin_amdgcn_mfma_scale_f32_32x32x64_f8f6f4(a_, b_, c1, 0, 0, 0, 0, 0, 0);
              c2 = __builtin_amdgcn_mfma_scale_f32_32x32x64_f8f6f4(a_, b_, c2, 0, 0, 0, 0, 0, 0); c3 = __builtin_amdgcn_mfma_scale_f32_32x32x64_f8f6f4(a_, b_, c3, 0, 0, 0, 0, 0, 0);
              c4 = __builtin_amdgcn_mfma_scale_f32_32x32x64_f8f6f4(a_, b_, c4, 0, 0, 0, 0, 0, 0); __builtin_amdgcn_sched_barrier(0);
              if (UBENCH >= 7) __syncthreads(); }
#pragma unroll
          for (int i = 0; i < 16; ++i) s_ += c0[i] + c1[i] + c2[i] + c3[i] + c4[i]; } }
      else if (UBENCH != 6) {
          float e_[32]; unsigned pk_[8];
#pragma unroll
          for (int i = 0; i < 32; ++i) e_[i] = (float)(threadIdx.x + i) * 1e-3f;
#pragma unroll
          for (int i = 0; i < 8; ++i) pk_[i] = 0u;
          for (int it = 0; it < 10000; ++it) {
              float m_ = e_[0];
#pragma unroll
              for (int i = 1; i < 31; i += 2) m_ = __builtin_fmaxf(__builtin_fmaxf(m_, e_[i]), e_[i + 1]);
#pragma unroll
              for (int i = 0; i < 32; ++i) e_[i] = __builtin_amdgcn_exp2f(e_[i] - m_);
#pragma unroll
              for (int i = 0; i < 8; ++i) pk_[i] = cvt4_fp8o((int)pk_[i], e_[4 * i], e_[4 * i + 1], e_[4 * i + 2], e_[4 * i + 3]);
              if (UBENCH >= 8) { lp_[0] = (v4i32_){(int)pk_[0], (int)pk_[1], (int)pk_[2], (int)pk_[3]}; lp_[1] = (v4i32_){(int)pk_[4], (int)pk_[5], (int)pk_[6], (int)pk_[7]}; }
              __builtin_amdgcn_sched_barrier(0);
              if (UBENCH >= 7) __syncthreads(); }
#pragma unroll
          for (int i = 0; i < 8; ++i) s_ += (float)pk_[i]; }
      if (s_ == 123.456f) ((float*)(LOAD_PARAMS().ws + WS_CNT))[100] = s_; }
#endif
#if PH(0)
    REP(0) { PH_BEGIN p0_prologue(p, lds); PH_END
    GRID_SYNC(); }
    if (gridDim.y == 0x7fffffffu) grid.sync();
#endif
    REP(2) {
#if PH(1)
    PH_BEGIN p1_rows(p); PH_END
    GRID_SYNC();
#endif
#if PH(2)
    PH_BEGIN { pg8::Gemm g{(const bf16_t*)(ws + WS_HB), P2_FP8 ? 512 : 1024, (const bf16_t*)(ws + WS_WIN), P2_FP8 ? 512 : 1024}; ProjOrder S; S.init(G, c, 0);
      EpiProj E{(bf16_t*)(ws + WS_PJ), (const f32x2*)(ws + WS_ROPE), (float*)(ws + WS_RSQ), (float*)(ws + WS_RSKV), ws};
      pg8::gemm_phase<EpiProj, ProjOrder, false, P2_FP8 != 0>(lds3, g, S, E); } PH_END
    GRID_SYNC();
#endif
    }
#if PH(3)
    REP(3) {
    const bool p3split = (G == 256); const int G3 = p3split ? G - 24 : G, c3 = p3split ? c - 24 : c;
    if (p3split && c < 24) {
    PH_BEGIN { pg8::Gemm g{(const bf16_t*)(ws + WS_HB), P2_FP8 ? 512 : 1024, (const bf16_t*)(ws + WS_WIN), P2_FP8 ? 512 : 1024}; ProjOrder S; S.init(G, c, 1);
      EpiProj E{(bf16_t*)(ws + WS_PJ), (const f32x2*)(ws + WS_ROPE), (float*)(ws + WS_RSQ), (float*)(ws + WS_RSKV), ws};
      pg8::gemm_phase<EpiProj, ProjOrder, false, P2_FP8 != 0>(lds3, g, S, E); } PH_END
    } else {
#ifndef NO_P3A
    PH_BEGIN { pg8::Gemm g{(const bf16_t*)(ws + WS_PJ) + 1536, NPROJ, (const bf16_t*)(ws + WS_WUQ), 256}; PlainOrder S; if (p3split) S.init(T / 256, 3, G3, c3, 1); else S.init(MALL / 256, 3, G3, c3, 0);
      EpiQ E{(bf16_t*)(ws + WS_QM), (const f32x2*)(ws + WS_ROPE), (const float*)(ws + WS_RSQ), ws};
      pg8::gemm_phase<EpiQ, PlainOrder>(lds3, g, S, E); } PH_END
#endif
#ifndef NO_P3B
    PH_BEGIN { pg8::Gemm g{(const bf16_t*)(ws + WS_PJ) + 1792, NPROJ, (const bf16_t*)(ws + WS_WUKV), 128}; PlainOrder S; S.init(MALL / 256, 4, G3, p3split ? (c3 + 80) % 232 : c3, 0);
      EpiKV E{(bf16_t*)(ws + WS_KV), (const float*)(ws + WS_RSKV), ws};
      pg8::gemm_phase<EpiKV, PlainOrder>(lds3, g, S, E); } PH_END
#endif
    }
    GRID_SYNC(); }
#endif
#if PH(4)
    REP(4) { PH_BEGIN p4_attention_diff(p, (char*)lds); PH_END
    PH_BEGIN p4_attention_mla(p, (char*)lds); PH_END
    GRID_SYNC(); }
#endif
#if DBG_STAGE == 1
    PH_BEGIN dbg_check_proj(p); PH_END
#elif DBG_STAGE == 2
    PH_BEGIN dbg_check_attn(p, lds, 0); PH_END
#elif DBG_STAGE == 3
    PH_BEGIN dbg_check_attn(p, lds, 1); PH_END
#endif
#if PH(6)
    REP(6) {
    PH_BEGIN { pg8::Gemm g{(const bf16_t*)(ws + WS_MIX), P6_FP8 ? 512 : 1024, (const bf16_t*)(ws + WS_WOUT), P6_FP8 ? 512 : 1024}; PlainOrder S; S.init(T / 256, 4, G, c, 1);
      EpiOut E{(bf16_t*)(ws + WS_XN), p.x, (const float*)(ws + WS_MODS), (float*)(ws + WS_RSX)};
      pg8::gemm_phase<EpiOut, PlainOrder, false, P6_FP8 != 0>(lds3, g, S, E); } PH_END
    GRID_SYNC(); }
#endif
#if PH(7)
#if (REP_MASK >> 11) & 1
    PH_BEGIN p7a_route(p, lds); PH_END
    GRID_SYNC();
    PH_BEGIN if (blockIdx.x == 0 && threadIdx.x < 32) ((unsigned*)(p.ws + WS_CNT))[threadIdx.x] = 0u; PH_END
    GRID_SYNC();
#endif
    PH_BEGIN p7a_route(p, lds); PH_END
    GRID_SYNC();
    REP(12) { PH_BEGIN moe_segments(p, seg); p7b_scatter(p, seg); PH_END }
    GRID_SYNC();
#endif
#if PH(8)
    REP(8) {
    PH_BEGIN { pg8::Gemm g{(const bf16_t*)(ws + WS_HF), 512, (const bf16_t*)(ws + WS_W1), 512, (const int*)(ws + WS_RTOK)}; MoeOrder S{seg, seg[32] >> 8, 8, G, c};
      EpiAct E{ws + WS_ACT, p.b1};
      pg8::gemm_phase<EpiAct, MoeOrder, true, true>(lds3, g, S, E); } PH_END
    GRID_SYNC(); }
#endif
#if PH(9)
    REP(9) {
    PH_BEGIN { pg8::Gemm g{(const bf16_t*)(ws + WS_ACT), 512, (const bf16_t*)(ws + WS_W2), 512}; MoeOrder S{seg, seg[32] >> 8, 4, G, c};
      EpiY E{(bf16_t*)(ws + WS_XS), p.b2, (const float*)(ws + WS_GSRT), (EPIY_PROBE) ? rep_ : 0};
      pg8::gemm_phase<EpiY, MoeOrder, false, true>(lds3, g, S, E); } PH_END
    GRID_SYNC(); }
#endif
#if LAST_PHASE >= 9
    REP(10) { PH_BEGIN p10_final(p, true); PH_END }
#elif LAST_PHASE >= 6
    PH_BEGIN p10_final(p, false); PH_END
#else
    PH_BEGIN { const int lane = threadIdx.x & 63, wave = threadIdx.x >> 6; const int gw = blockIdx.x * NWAVES + wave, NGW = gridDim.x * NWAVES;
      for (int t = gw; t < T; t += NGW) { const f32x4* xr = (const f32x4*)(p.x + (size_t)t * DM) + lane; f32x4 v[4]; float s = 0.f;
#pragma unroll
        for (int j = 0; j < 4; ++j) { v[j] = xr[64 * j]; s += (v[j].x * v[j].x + v[j].y * v[j].y) + (v[j].z * v[j].z + v[j].w * v[j].w); }
        const float r = rsqrtf(wave_sum(s) * (1.f / DM) + EPS); f32x4* o = (f32x4*)(p.out + (size_t)t * DM) + lane;
#pragma unroll
        for (int j = 0; j < 4; ++j) o[64 * j] = v[j] * r * ((const f32x4*)p.final_norm_w)[lane + 64 * j]; } } PH_END
#endif
}

extern "C" void kernel_launch(void* const* d_in, const int* in_sizes, int n_in, void* d_out, int out_size, void* d_ws, size_t ws_size, hipStream_t stream) {
    static int grid = 0;
    if (grid == 0) {
        if (n_in != 26 || in_sizes[0] != T * DM || out_size != T * DM || ws_size < WS_END) {
            fprintf(stderr, "kernel_launch: unexpected shapes: n_in %d in0 %d out %d ws %zu (need %zu)\n", n_in, n_in > 0 ? in_sizes[0] : -1, out_size, ws_size, (size_t)WS_END);
            grid = -1; return; }
        int dev = 0, cus = 0, per_cu = 0;
        (void)hipGetDevice(&dev);
        (void)hipDeviceGetAttribute(&cus, hipDeviceAttributeMultiprocessorCount, dev);
        if (hipFuncSetAttribute((const void*)fwd_kernel, hipFuncAttributeMaxDynamicSharedMemorySize, LDS_BYTES) != hipSuccess) { fprintf(stderr, "kernel_launch: hipFuncSetAttribute failed\n"); grid = -1; return; }
        if (hipOccupancyMaxActiveBlocksPerMultiprocessor(&per_cu, (const void*)fwd_kernel, NTHREADS, LDS_BYTES) != hipSuccess || per_cu < 1) { fprintf(stderr, "kernel_launch: occupancy query failed (%d)\n", per_cu); (void)hipGetLastError(); grid = -1; return; }
        grid = cus;
        if (grid < 128 || grid > 1024) { fprintf(stderr, "kernel_launch: unsupported CU count %d\n", cus); grid = -1; return; }
    }
    if (grid < 0) return;
    Params p{};
    const float** pp = (const float**)&p;
    for (int i = 0; i < 26; ++i) pp[i] = (const float*)d_in[i];
    p.out = (float*)d_out; p.ws = (unsigned char*)d_ws;
    if (hipMemsetAsync((char*)d_ws + WS_BAR, 0, WS_BAR_BYTES, stream) != hipSuccess) { fprintf(stderr, "kernel_launch: hipMemsetAsync failed\n"); return; }
    void* args[] = {&p};
    hipError_t e = hipLaunchCooperativeKernel((const void*)fwd_kernel, dim3(grid), dim3(NTHREADS), args, LDS_BYTES, stream);
    if (e != hipSuccess) fprintf(stderr, "cooperative launch failed: %s (grid %d)\n", hipGetErrorString(e), grid);
}
```
